# Optimizing an MI355X kernel written in HIP

```python
import jax, jax.numpy as jnp
from jax import lax
import numpy as np

D_MODEL = 1024
BATCH = 8
SEQ = 4096
DEPTH = 1

CTX_LEN = 256
GRID_W = 64
RET_HEADS = 4
RET_DK = 64
RET_DV = 128
RET_WIDTH = RET_HEADS * RET_DV
RET_CHUNK = 128
GMLP_GROUPS = 4
GMLP_DG = 128
GMLP_WIDTH = GMLP_GROUPS * GMLP_DG
GMLP_CHUNK = 128
D_MIX = RET_WIDTH + GMLP_WIDTH
Q0 = 0
K0 = Q0 + RET_HEADS * RET_DK
V0 = K0 + RET_HEADS * RET_DK
GR0 = V0 + RET_WIDTH
U0 = GR0 + RET_WIDTH
VM0 = U0 + GMLP_WIDTH
GM0 = VM0 + GMLP_WIDTH
D_IN_PROJ = GM0 + GMLP_WIDTH
ROPE_BASE = 10000.0
EPS = 1e-6

kernel_name = "hybrid_retention_gmlp_dit_block"


def rms_norm(x, w):
    xf = x.astype(jnp.float32)
    y = xf * lax.rsqrt(jnp.mean(xf * xf, axis=-1, keepdims=True) + EPS)
    return (y * w.astype(jnp.float32)).astype(x.dtype)


def layer_norm(x, w):
    xf = x.astype(jnp.float32)
    mu = jnp.mean(xf, axis=-1, keepdims=True)
    var = jnp.mean(jnp.square(xf - mu), axis=-1, keepdims=True)
    return ((xf - mu) * lax.rsqrt(var + EPS) * w.astype(jnp.float32)).astype(x.dtype)


def heads(t, d):
    b, t_len, _ = t.shape
    return t.reshape(b, t_len, -1, d).transpose(0, 2, 1, 3)


def flip_t(t):
    return jnp.flip(t, axis=2)


def group_norm_heads(o, w):
    of = o.astype(jnp.float32)
    mu = jnp.mean(of, axis=-1, keepdims=True)
    var = jnp.mean(jnp.square(of - mu), axis=-1, keepdims=True)
    y = (of - mu) * lax.rsqrt(var + EPS)
    b, h, t_len, d = y.shape
    return y.transpose(0, 2, 1, 3).reshape(b, t_len, h * d) * w.astype(jnp.float32)


def rope_2d(x, rows, cols):
    quarter = RET_DK // 4
    half = RET_DK // 2
    inv_freq = ROPE_BASE ** (-jnp.arange(quarter, dtype=jnp.float32) / quarter)

    def rot(xh, pos):
        ang = pos.astype(jnp.float32)[:, None] * inv_freq[None, :]
        cos, sin = jnp.cos(ang), jnp.sin(ang)
        x1, x2 = xh[..., :quarter], xh[..., quarter:]
        return jnp.concatenate([x1 * cos - x2 * sin, x1 * sin + x2 * cos], axis=-1)

    return jnp.concatenate([rot(x[..., :half], rows), rot(x[..., half:], cols)], axis=-1)


def retention_chunk_states(k, v, log_g, s0):
    b, h, t_len, dk = k.shape
    dv = v.shape[-1]
    nc = t_len // RET_CHUNK
    kc = k.reshape(b, h, nc, RET_CHUNK, dk)
    vc = v.reshape(b, h, nc, RET_CHUNK, dv)
    j = jnp.arange(RET_CHUNK, dtype=jnp.float32)
    to_end = jnp.exp((RET_CHUNK - 1 - j)[None, :] * log_g[:, None])
    kv = jnp.einsum('bhcmd,hm,bhcme->cbhde', kc, to_end, vc)
    g_chunk = jnp.exp(RET_CHUNK * log_g)[None, :, None, None]

    def step(s, kv_c):
        return g_chunk * s + kv_c, s

    s_final, states = lax.scan(step, s0, kv)
    return states, s_final


def retention_chunk_outputs(q, k, v, log_g, states):
    b, h, t_len, dk = q.shape
    dv = v.shape[-1]
    nc = t_len // RET_CHUNK
    qc = q.reshape(b, h, nc, RET_CHUNK, dk)
    kc = k.reshape(b, h, nc, RET_CHUNK, dk)
    vc = v.reshape(b, h, nc, RET_CHUNK, dv)
    j = jnp.arange(RET_CHUNK, dtype=jnp.float32)
    diff = j[:, None] - j[None, :]
    decay = jnp.where(diff >= 0,
                      jnp.exp(jnp.maximum(diff, 0.0)[None] * log_g[:, None, None]),
                      0.0)
    scores = jnp.einsum('bhcnd,bhcmd->bhcnm', qc, kc) * decay[None, :, None]
    intra = jnp.einsum('bhcnm,bhcme->bhcne', scores, vc)
    from_start = jnp.exp((j + 1.0)[None, :] * log_g[:, None])
    cross = jnp.einsum('bhcnd,hn,cbhde->bhcne', qc, from_start, states)
    return (intra + cross).reshape(b, h, t_len, dv)


def bidirectional_retention(q, k, v, log_g_f, log_g_b, s0_f, s0_b):
    st_f, _ = retention_chunk_states(k, v, log_g_f, s0_f)
    out_f = retention_chunk_outputs(q, k, v, log_g_f, st_f)
    qr, kr, vr = flip_t(q), flip_t(k), flip_t(v)
    st_b, _ = retention_chunk_states(kr, vr, log_g_b, s0_b)
    out_b = flip_t(retention_chunk_outputs(qr, kr, vr, log_g_b, st_b))
    return out_f + out_b


def chunk_spatial_gating(u, vg, ln_w, w_s, b_s):
    b, t_len, _ = u.shape
    nc = t_len // GMLP_CHUNK
    vn = layer_norm(vg, ln_w).reshape(b, nc, GMLP_CHUNK, GMLP_GROUPS, GMLP_DG)
    s = jnp.einsum('gnm,bcmgd->bcngd', w_s, vn) + b_s.T[None, None, :, :, None]
    return u * s.reshape(b, t_len, GMLP_WIDTH)


def mixer_output(p, ret, ret_gn_w, gmlp_ln_w, w_s, b_s, w_out):
    y_ret = group_norm_heads(ret, ret_gn_w).astype(p.dtype) * jax.nn.silu(p[..., GR0:U0])
    u = jax.nn.gelu(p[..., U0:VM0], approximate=False)
    vg = jax.nn.gelu(p[..., VM0:GM0], approximate=False)
    y_sg = chunk_spatial_gating(u, vg, gmlp_ln_w, w_s, b_s) * jax.nn.silu(p[..., GM0:D_IN_PROJ])
    return jnp.concatenate([y_ret, y_sg], axis=-1) @ w_out


def hybrid_layer(x, ctx, mod_x, mod_c, norm_w, w_in, dec_f, dec_b, ret_gn_w,
                 gmlp_ln_w, w_s, b_s, w_out, rows, cols, update_ctx):
    f32 = jnp.float32
    lg_f = -jnp.exp(dec_f.astype(f32))
    lg_b = -jnp.exp(dec_b.astype(f32))
    shift, scale, gate = jnp.split(mod_x[:, None, :], 3, axis=-1)
    shift_c, scale_c, gate_c = jnp.split(mod_c, 3, axis=-1)
    h = rms_norm(x, norm_w) * (1 + scale) + shift
    hc = rms_norm(ctx, norm_w) * (1 + scale_c) + shift_c
    b = x.shape[0]
    zeros = jnp.zeros((b, RET_HEADS, RET_DK, RET_DV), f32)

    if update_ctx:
        pc = hc @ w_in
        pc_k, pc_v = pc[..., K0:V0], pc[..., V0:GR0]
    else:
        pc_kv = hc @ w_in[:, K0:GR0]
        pc_k, pc_v = pc_kv[..., :V0 - K0], pc_kv[..., V0 - K0:]
    kc = heads(pc_k.astype(f32), RET_DK) * RET_DK ** -0.5
    vc = heads(pc_v.astype(f32), RET_DV)
    st_cf, s_cf = retention_chunk_states(kc, vc, lg_f, zeros)
    st_cb, s_cb = retention_chunk_states(flip_t(kc), flip_t(vc), lg_b, zeros)

    p = h @ w_in
    q = rope_2d(heads(p[..., Q0:K0].astype(f32), RET_DK), rows, cols)
    k = rope_2d(heads(p[..., K0:V0].astype(f32), RET_DK), rows, cols) * RET_DK ** -0.5
    v = heads(p[..., V0:GR0].astype(f32), RET_DV)
    ret = bidirectional_retention(q, k, v, lg_f, lg_b, s_cf, s_cb)
    x_new = x + gate * mixer_output(p, ret, ret_gn_w, gmlp_ln_w, w_s, b_s, w_out)

    if update_ctx:
        qc = heads(pc[..., Q0:K0].astype(f32), RET_DK)
        ret_c = retention_chunk_outputs(qc, kc, vc, lg_f, st_cf) + flip_t(
            retention_chunk_outputs(flip_t(qc), flip_t(kc), flip_t(vc), lg_b, st_cb))
        ctx = ctx + gate_c * mixer_output(pc, ret_c, ret_gn_w, gmlp_ln_w, w_s, b_s, w_out)
    return x_new, ctx


def setup_inputs(seed: int = 0) -> dict:
    key = jax.random.key(seed)
    ks = jax.random.split(key, 16)
    f32 = jnp.float32
    nrm = lambda k, s: jax.random.normal(k, s, dtype=f32)
    base = jnp.log(-jnp.log1p(-(2.0 ** (-5.0 - jnp.arange(RET_HEADS, dtype=f32)))))
    return {
        "x": nrm(ks[0], (BATCH, SEQ, D_MODEL)),
        "c": nrm(ks[1], (BATCH, D_MODEL)),
        "ctx": nrm(ks[2], (BATCH, CTX_LEN, D_MODEL)),
        "c_ctx": nrm(ks[3], (D_MODEL,)),
        "w_ada": nrm(ks[4], (DEPTH, D_MODEL, 3 * D_MODEL)) * (0.5 * D_MODEL ** -0.5),
        "b_ada": 0.01 * nrm(ks[5], (DEPTH, 3 * D_MODEL)),
        "norm_w": 1.0 + 0.01 * nrm(ks[6], (DEPTH, D_MODEL)),
        "w_in": nrm(ks[7], (DEPTH, D_MODEL, D_IN_PROJ)) * D_MODEL ** -0.5,
        "ret_decay_f": base + 0.01 * nrm(ks[8], (DEPTH, RET_HEADS)),
        "ret_decay_b": base + 0.01 * nrm(ks[9], (DEPTH, RET_HEADS)),
        "ret_gn_w": 1.0 + 0.01 * nrm(ks[10], (DEPTH, RET_WIDTH)),
        "gmlp_ln_w": 1.0 + 0.01 * nrm(ks[11], (DEPTH, GMLP_WIDTH)),
        "w_s": nrm(ks[12], (DEPTH, GMLP_GROUPS, GMLP_CHUNK, GMLP_CHUNK)) * GMLP_CHUNK ** -0.5,
        "b_s": 1.0 + 0.01 * nrm(ks[13], (DEPTH, GMLP_GROUPS, GMLP_CHUNK)),
        "w_out": nrm(ks[14], (DEPTH, D_MIX, D_MODEL)) * D_MIX ** -0.5,
        "final_norm_w": 1.0 + 0.01 * nrm(ks[15], (D_MODEL,)),
    }


def reference(x, c, ctx, c_ctx, w_ada, b_ada, norm_w, w_in, ret_decay_f, ret_decay_b,
              ret_gn_w, gmlp_ln_w, w_s, b_s, w_out, final_norm_w):
    n_tok = x.shape[1]
    ROWS = n_tok // GRID_W
    rows = jnp.repeat(jnp.arange(ROWS, dtype=jnp.int32), GRID_W)
    cols = jnp.tile(jnp.arange(GRID_W, dtype=jnp.int32), ROWS)
    sc = jax.nn.silu(c)
    sc_ctx = jax.nn.silu(c_ctx)
    for layer in range(DEPTH):
        mod_x = sc @ w_ada[layer] + b_ada[layer]
        mod_c = sc_ctx @ w_ada[layer] + b_ada[layer]
        x, ctx = hybrid_layer(x, ctx, mod_x, mod_c, norm_w[layer], w_in[layer],
                              ret_decay_f[layer], ret_decay_b[layer], ret_gn_w[layer],
                              gmlp_ln_w[layer], w_s[layer], b_s[layer], w_out[layer],
                              rows, cols, layer < DEPTH - 1)
    return rms_norm(x, final_norm_w)
```

```cpp
#include <hip/hip_runtime.h>
#include <hip/hip_cooperative_groups.h>
#include <cstdio>
namespace cg = cooperative_groups;
#ifndef N_LAUNCHES
#define N_LAUNCHES 8
#endif
namespace pg8 {
#define PG8_LAS __attribute__((address_space(3)))
typedef unsigned short bf16_t;
typedef short bf16x8 __attribute__((ext_vector_type(8)));
typedef float f32x4 __attribute__((ext_vector_type(4)));
typedef unsigned u32x4 __attribute__((ext_vector_type(4)));
constexpr int BM = 256, BK = 64, HALF = 128, HTB = HALF * BK * 2  , STAGE_BYTES = 8 * HTB, NXCD = 8, WGM = 8;

__host__ __device__ __forceinline__ int lds_byte(int r, int c) { const int st = (r >> 4) * 2 + (c >> 5), rr = r & 15, cc = c & 31, ob = rr * 64 + cc * 2; return st * 1024 + (ob ^ (((ob >> 9) & 1) << 5)); }
__host__ __device__ __forceinline__ void stage_rc(int b, int& R, int& C) { const int st = b / 1024, sb = b % 1024, swz = sb ^ (((sb >> 9) & 1) << 5); R = (st >> 1) * 16 + swz / 64; C = (st & 1) * 32 + (swz % 64) / 2; }
__host__ __device__ __forceinline__ int perm32(int rho) { const int n = rho >> 4, i = rho & 15; return 8 * (i >> 2) + 4 * n + (i & 3); }

struct Unit { int pm, pn; };
struct Gemm { const bf16_t* A; const bf16_t* Bt; int M, N, K; };

struct StaticOrder {
    int nM, nN, nwg, G, c;
    __host__ __device__ void init(int M, int N, int G_, int c_) { nM = M / BM; nN = N / BM; nwg = nM * nN; G = G_; c = c_; }
    __host__ __device__ bool next(int i, Unit& u) const {
        const long L = (long)i * G + c; if (L >= nwg) return false;
        int wgid = (int)L; { const int q = nwg / NXCD, r = nwg % NXCD, xcd = wgid % NXCD, off = wgid / NXCD; wgid = (xcd < r ? xcd * (q + 1) : r * (q + 1) + (xcd - r) * q) + off; }
        const int nig = WGM * nN, gid = wgid / nig, fm = gid * WGM, gsz = (nM - fm) < WGM ? (nM - fm) : WGM;
        u.pm = fm + ((wgid % nig) % gsz); u.pn = (wgid % nig) / gsz; return true;
    }
    __device__ __forceinline__ void a_ready(const Unit&) const {}
    __device__ __forceinline__ void done(const Unit&) const {}
};
struct CountedOrder : StaticOrder {
    const unsigned* ready; unsigned need; unsigned* tmo;
    __device__ __forceinline__ void a_ready(const Unit& u) const {
        if (threadIdx.x < 64) {
            const unsigned long long t0 = __builtin_amdgcn_s_memrealtime(); unsigned polls = 0;
            while ((unsigned)__builtin_amdgcn_readfirstlane(__hip_atomic_load(ready + 64 * u.pm, __ATOMIC_RELAXED, __HIP_MEMORY_SCOPE_AGENT)) < need) {
                if ((++polls & 255u) == 0u && __builtin_amdgcn_readfirstlane(__hip_atomic_load(tmo, __ATOMIC_RELAXED, __HIP_MEMORY_SCOPE_AGENT)) != 0u) break;
                if (__builtin_amdgcn_s_memrealtime() - t0 > 2000000ull) {
                    if (threadIdx.x == 0) { unsigned expect = 0u; __hip_atomic_compare_exchange_strong(tmo + 1, &expect, 0x600u | (unsigned)(u.pm & 0xff), __ATOMIC_RELAXED, __ATOMIC_RELAXED, __HIP_MEMORY_SCOPE_AGENT); __hip_atomic_store(tmo, 1u, __ATOMIC_RELAXED, __HIP_MEMORY_SCOPE_AGENT); }
                    break; }
                __builtin_amdgcn_s_sleep(2); }
            __builtin_amdgcn_fence(__ATOMIC_ACQUIRE, "agent");
            asm volatile("s_waitcnt vmcnt(0)" ::: "memory");
        }
#if !defined(BROKEN_HOOK_NO_BARRIER)
        asm volatile("" ::: "memory"); __builtin_amdgcn_s_barrier(); asm volatile("" ::: "memory");
#endif
    }
};

__device__ __forceinline__ unsigned cvt_pk_bf16(float lo, float hi) { unsigned r; asm volatile("v_cvt_pk_bf16_f32 %0, %1, %2" : "=v"(r) : "v"(lo), "v"(hi)); return r; }
typedef float f32x2 __attribute__((ext_vector_type(2)));
__device__ __forceinline__ f32x2 gelu_pk(f32x2 v) {
    const f32x2 av = __builtin_elementwise_abs(v), d = av * 0.2316418882f + 1.0f;
    f32x2 t; t.x = __builtin_amdgcn_rcpf(d.x); t.y = __builtin_amdgcn_rcpf(d.y);
    f32x2 q = t * 0.5307027145f + (-0.7265760135f); q = q * t + 0.7107068705f; q = q * t + (-0.142248368f); q = q * t + 0.127414796f; q = q * t;
    const f32x2 s = (v * v) * (-0.72134752044f);
    f32x2 e; e.x = __builtin_amdgcn_exp2f(s.x); e.y = __builtin_amdgcn_exp2f(s.y);
    const f32x2 m = v * (q * e), r = v - m;
    f32x2 o; o.x = v.x < 0.f ? m.x : r.x; o.y = v.y < 0.f ? m.y : r.y; return o;
}
template <class Epi, class Sched, bool STAMP = false>
__device__ __forceinline__ void gemm_phase(PG8_LAS unsigned char* lds, const Gemm g, const Sched& S, const Epi& E, unsigned long long* stamps) {
    const int tid = threadIdx.x, wid = __builtin_amdgcn_readfirstlane(tid >> 6), lane = tid & 63, wr = wid >> 2, wc = wid & 3, fr = lane & 15, fq = lane >> 4;
    const int K = g.K, nt = K / BK;
    int ts_lo = 0, ts_hi = 0, nts = 0; const unsigned long long rt_entry = STAMP ? (unsigned long long)wall_clock64() : 0ull;
#define PG8_STAMP() do { if (STAMP && wid == 0 && nts < 64) { const unsigned long long _c = (unsigned long long)clock64(); \
        ts_lo = (lane == nts) ? (int)(unsigned)_c : ts_lo; ts_hi = (lane == nts) ? (int)(unsigned)(_c >> 32) : ts_hi; ++nts; } } while (0)
    PG8_STAMP();
    unsigned voffA[2], voffB[2];
#pragma unroll
    for (int i = 0; i < 2; ++i) { int R, C; stage_rc(tid * 16 + i * 8192, R, C); const int Rb = Epi::PERM ? ((R & ~31) + perm32(R & 31)) : R;
        voffA[i] = (unsigned)(R * K + C) * 2u; voffB[i] = (unsigned)(Rb * K + C) * 2u; }
    const size_t kstep = (size_t)(BK * 2);
    const size_t hstep = (size_t)HALF * K * 2;
    const size_t tstep = 2 * hstep;
    const unsigned ldsw = (unsigned)wid * 1024u;
    const int aoff = lds_byte(wr * 64 + fr, fq * 8), boff = lds_byte(wc * 32 + fr, fq * 8);
#define PG8_SA(b, h) (((b) * 2 + (h)) * HTB)
#define PG8_SB(b, h) ((4 + (b) * 2 + (h)) * HTB)
#define PG8_STAGE(bufoff, gbase, voff) do { _Pragma("unroll") for (int _i = 0; _i < 2; ++_i) \
        __builtin_amdgcn_global_load_lds((const unsigned*)((const char*)(gbase) + (voff)[_i]), (PG8_LAS unsigned*)(lds + (bufoff) + ldsw + _i * 8192), 16, 0, 0); } while (0)
#define PG8_LDA(dst, b, h) do { _Pragma("unroll") for (int m = 0; m < 4; ++m) _Pragma("unroll") for (int k = 0; k < 2; ++k) dst[m][k] = *(const PG8_LAS bf16x8*)(lds + PG8_SA(b, h) + aoff + m * 2048 + k * 1024); } while (0)
#define PG8_LDB(dst, b, h) do { _Pragma("unroll") for (int n = 0; n < 2; ++n) _Pragma("unroll") for (int k = 0; k < 2; ++k) dst[n][k] = *(const PG8_LAS bf16x8*)(lds + PG8_SB(b, h) + boff + n * 2048 + k * 1024); } while (0)
#define PG8_MMA(ai, bj, At, Bt) do { __builtin_amdgcn_s_setprio(1); _Pragma("unroll") for (int m = 0; m < 4; ++m) _Pragma("unroll") for (int n = 0; n < 2; ++n) _Pragma("unroll") for (int k = 0; k < 2; ++k) \
        acc[ai][bj][m][n] = __builtin_amdgcn_mfma_f32_16x16x32_bf16(Bt[n][k], At[m][k], acc[ai][bj][m][n], 0, 0, 0); __builtin_amdgcn_s_setprio(0); } while (0)
#define PG8_WAIT_V(n) asm volatile("s_waitcnt vmcnt(" #n ")" ::: "memory")
#define PG8_WAIT_L(n) asm volatile("s_waitcnt lgkmcnt(" #n ")" ::: "memory")
#define PG8_BAR __builtin_amdgcn_s_barrier()
#define PG8_SCHED __builtin_amdgcn_sched_barrier(0)
    Unit cur, nxt; int ui = 0;
    if (!S.next(0, cur)) return;
    f32x4 acc[2][2][4][2];
#pragma unroll
    for (int a = 0; a < 2; ++a)
#pragma unroll
        for (int b = 0; b < 2; ++b)
#pragma unroll
            for (int m = 0; m < 4; ++m)
#pragma unroll
                for (int n = 0; n < 2; ++n) acc[a][b][m][n] = (f32x4){0.f, 0.f, 0.f, 0.f};
    bf16x8 At[4][2], B0[2][2], B1[2][2];
    const char* cA = (const char*)g.A + (size_t)cur.pm * tstep; const char* cB = (const char*)g.Bt + (size_t)cur.pn * tstep;
    S.a_ready(cur);
    PG8_STAGE(PG8_SB(0, 0), cB, voffB); PG8_STAGE(PG8_SA(0, 0), cA, voffA); PG8_STAGE(PG8_SB(0, 1), cB + hstep, voffB); PG8_STAGE(PG8_SA(0, 1), cA + hstep, voffA);
    if (wr == 1) PG8_BAR;
    PG8_WAIT_V(4); PG8_BAR;
    PG8_STAGE(PG8_SB(1, 0), cB + kstep, voffB); PG8_STAGE(PG8_SA(1, 0), cA + kstep, voffA); PG8_STAGE(PG8_SB(1, 1), cB + hstep + kstep, voffB);
    PG8_WAIT_V(6); PG8_BAR;
    PG8_STAMP();
    for (;;) {
        const bool has_next = S.next(ui + 1, nxt);
        const char* nA = has_next ? (const char*)g.A + (size_t)nxt.pm * tstep : cA; const char* nB = has_next ? (const char*)g.Bt + (size_t)nxt.pn * tstep : cB;
        for (int t = 0; t < nt; t += 2) {
            const bool last = (t == nt - 2);
            const char* a1 = cA + (size_t)(t + 1) * kstep;
            const char* a2 = last ? nA : cA + (size_t)(t + 2) * kstep; const char* b2 = last ? nB : cB + (size_t)(t + 2) * kstep;
            const char* a3 = a2 + kstep; const char* b3 = b2 + kstep;
            if (last && has_next) S.a_ready(nxt);
            PG8_LDB(B0, 0, 0); PG8_SCHED; PG8_LDA(At, 0, 0); PG8_STAGE(PG8_SA(1, 1), a1 + hstep, voffA);
            PG8_WAIT_L(8); PG8_BAR; PG8_WAIT_L(0); PG8_MMA(0, 0, At, B0); PG8_BAR; PG8_SCHED;
            PG8_LDB(B1, 0, 1); PG8_STAGE(PG8_SB(0, 0), b2, voffB);
            PG8_BAR; PG8_WAIT_L(0); PG8_MMA(0, 1, At, B1); PG8_BAR;
            PG8_LDA(At, 0, 1); PG8_STAGE(PG8_SA(0, 0), a2, voffA);
            PG8_BAR; PG8_WAIT_L(0); PG8_MMA(1, 0, At, B0); PG8_BAR; PG8_SCHED;
            PG8_STAGE(PG8_SB(0, 1), b2 + hstep, voffB);
            PG8_WAIT_V(6); PG8_BAR; PG8_MMA(1, 1, At, B1); PG8_BAR;
            PG8_LDB(B0, 1, 0); PG8_SCHED; PG8_LDA(At, 1, 0); PG8_STAGE(PG8_SA(0, 1), a2 + hstep, voffA);
            PG8_WAIT_L(8); PG8_BAR; PG8_WAIT_L(0); PG8_MMA(0, 0, At, B0); PG8_BAR; PG8_SCHED;
            PG8_LDB(B1, 1, 1); PG8_STAGE(PG8_SB(1, 0), b3, voffB);
            PG8_BAR; PG8_WAIT_L(0); PG8_MMA(0, 1, At, B1); PG8_BAR;
            PG8_LDA(At, 1, 1); PG8_STAGE(PG8_SA(1, 0), a3, voffA);
            PG8_BAR; PG8_WAIT_L(0); PG8_MMA(1, 0, At, B0); PG8_BAR; PG8_SCHED;
            PG8_STAGE(PG8_SB(1, 1), b3 + hstep, voffB);
            PG8_WAIT_V(6); PG8_BAR; PG8_MMA(1, 1, At, B1); PG8_BAR;
        }
        PG8_STAMP();
        if constexpr (!Epi::AFTER_DRAIN) { E(acc, cur, wr, wc, fr, fq); S.done(cur); }
        PG8_STAMP();
        if (!has_next) break;
#pragma unroll
        for (int a = 0; a < 2; ++a)
#pragma unroll
            for (int b = 0; b < 2; ++b)
#pragma unroll
                for (int m = 0; m < 4; ++m)
#pragma unroll
                    for (int n = 0; n < 2; ++n) acc[a][b][m][n] = (f32x4){0.f, 0.f, 0.f, 0.f};
        cur = nxt; cA = nA; cB = nB; ++ui;
    }
    PG8_WAIT_V(0);
    if (wr == 0) PG8_BAR;
    PG8_BAR;
    if constexpr (Epi::AFTER_DRAIN) { E.fused(acc, cur, wr, wc, fr, fq, lds, wid, lane); S.done(cur); }
    PG8_STAMP();
    if (STAMP && wid == 0) { stamps[lane] = lane < nts ? (((unsigned long long)(unsigned)ts_hi << 32) | (unsigned)ts_lo) : 0ull;
        if (lane == 62) stamps[62] = rt_entry; if (lane == 63) stamps[63] = (unsigned long long)wall_clock64(); }
#undef PG8_STAMP
#undef PG8_SA
#undef PG8_SB
#undef PG8_STAGE
#undef PG8_LDA
#undef PG8_LDB
#undef PG8_MMA
#undef PG8_WAIT_V
#undef PG8_WAIT_L
#undef PG8_BAR
#undef PG8_SCHED
}
}

#define DI __device__ __forceinline__
#define LAS __attribute__((address_space(3)))
using pg8::bf16_t; using pg8::bf16x8; using pg8::f32x4; using pg8::f32x2; using pg8::u32x4; using pg8::Unit;
typedef unsigned u32x2 __attribute__((ext_vector_type(2)));
typedef short s16x4 __attribute__((ext_vector_type(4)));
typedef __bf16 bf2_t __attribute__((ext_vector_type(2)));

constexpr int NB = 8, T = 4096, D = 1024, NTOK = NB * T, CTXL = 256, NCTX = NB * CTXL, NP = 3072, NC = 32;
constexpr int NTHREADS = 512;
constexpr int LDS_BYTES = 147456;
constexpr float EPS = 1e-6f, LOG2E = 1.4426950408889634f;

constexpr size_t al256(size_t x) { return (x + 255) & ~(size_t)255; }
constexpr size_t WS_MOD  = 0;
constexpr size_t WS_ROPE = WS_MOD + al256(9 * 3072 * 4);
constexpr size_t WS_WIN  = WS_ROPE + 8192;
constexpr size_t WS_WOUT = WS_WIN + (size_t)3072 * 1024 * 2;
constexpr size_t WS_WSB  = WS_WOUT + (size_t)1024 * 1024 * 2;
constexpr size_t WS_H    = WS_WSB + (size_t)4 * 128 * 128 * 2;
constexpr size_t WS_Q    = WS_H + (size_t)(NTOK + NCTX) * 1024 * 2;
constexpr size_t WS_K    = WS_Q + (size_t)NTOK * 256 * 2;
constexpr size_t WS_V    = WS_K + (size_t)NTOK * 256 * 2;
constexpr size_t WS_GR   = WS_V + (size_t)NTOK * 512 * 2;
constexpr size_t WS_U    = WS_GR + (size_t)NTOK * 512 * 2;
constexpr size_t WS_VG   = WS_U + (size_t)NTOK * 512 * 2;
constexpr size_t WS_GM   = WS_VG + (size_t)NTOK * 512 * 2;
constexpr size_t WS_KC   = WS_GM + (size_t)NTOK * 512 * 2;
constexpr size_t WS_VC   = WS_KC + (size_t)NCTX * 256 * 2;
constexpr size_t WS_KV   = WS_VC + (size_t)NCTX * 512 * 2;
constexpr size_t WS_KVC  = WS_KV + (size_t)1024 * 2 * 8192 * 4;
constexpr size_t WS_ST   = WS_KVC + (size_t)64 * 2 * 8192 * 4;
constexpr size_t WS_END  = WS_ST + (size_t)1024 * 2 * 8192 * 2;

struct Args {
    const float* x; const float* c; const float* ctx; const float* c_ctx; const float* w_ada; const float* b_ada; const float* norm_w; const float* w_in;
    const float* dec_f; const float* dec_b; const float* gn_w; const float* ln_w; const float* w_s; const float* b_s; const float* w_out; const float* fnorm_w;
    float* out; unsigned char* ws; int ph_lo, ph_hi;
};

DI unsigned pk2(float lo, float hi) { f32x2 v = {lo, hi}; bf2_t r = __builtin_convertvector(v, bf2_t); return __builtin_bit_cast(unsigned, r); }
DI float bflo(unsigned w) { return __uint_as_float(w << 16); }
DI float bfhi(unsigned w) { return __uint_as_float(w & 0xffff0000u); }
DI float silu_f(float v) { return v * __builtin_amdgcn_rcpf(1.0f + __expf(-v)); }
DI f32x4 mfma16(bf16x8 a, bf16x8 b, f32x4 c) { return __builtin_amdgcn_mfma_f32_16x16x32_bf16(a, b, c, 0, 0, 0); }

DI bf16x8 frag_tr(LAS const unsigned char* base, int S, int k0, int n0, int lane) {
    const int i = lane & 15, g = lane >> 4;
    LAS const unsigned char* p = base + (k0 + 4 * g + (i >> 2)) * S + (n0 + 4 * (i & 3)) * 2;
    const s16x4 lo = __builtin_amdgcn_ds_read_tr16_b64_v4i16((LAS s16x4*)p);
    const s16x4 hi = __builtin_amdgcn_ds_read_tr16_b64_v4i16((LAS s16x4*)(p + 16 * S));
    return __builtin_shufflevector(lo, hi, 0, 1, 2, 3, 4, 5, 6, 7);
}
DI bf16x8 frag_rowP(const bf16_t* rowk0, int g) {
    const u32x2 lo = *(const u32x2*)(rowk0 + 4 * g), hi = *(const u32x2*)(rowk0 + 16 + 4 * g);
    const u32x4 v = {lo.x, lo.y, hi.x, hi.y}; return __builtin_bit_cast(bf16x8, v);
}
DI bf16x8 frag_rowP_lds(LAS const unsigned char* rowk0, int g) {
    const u32x2 lo = *(LAS const u32x2*)(rowk0 + 8 * g), hi = *(LAS const u32x2*)(rowk0 + 32 + 8 * g);
    const u32x4 v = {lo.x, lo.y, hi.x, hi.y}; return __builtin_bit_cast(bf16x8, v);
}
DI bf16x8 scale_frag(bf16x8 f, float s) {
    const u32x4 u = __builtin_bit_cast(u32x4, f); u32x4 r;
#pragma unroll
    for (int q = 0; q < 4; ++q) r[q] = pk2(bflo(u[q]) * s, bfhi(u[q]) * s);
    return __builtin_bit_cast(bf16x8, r);
}

struct EpiIn {
    static constexpr bool PERM = true, AFTER_DRAIN = false;
    unsigned char* ws;
    DI void operator()(const f32x4 (&acc)[2][2][4][2], const Unit& u, int wr, int wc, int fr, int fq) const {
        const int pn = u.pn, rbase = u.pm * 256 + wr * 64 + fr, cbase = wc * 32 + 8 * fq;
        if (u.pm >= 128) {
            bf16_t* dst = (bf16_t*)(ws + (pn == 1 ? WS_KC : WS_VC));
            const float scl = pn == 1 ? 0.125f : 1.0f;
#pragma unroll
            for (int ai = 0; ai < 2; ++ai)
#pragma unroll
                for (int m = 0; m < 4; ++m) {
                    const int rc = rbase + ai * 128 + m * 16 - NTOK, b = rc >> 8, t = rc & 255;
#pragma unroll
                    for (int bj = 0; bj < 2; ++bj) {
                        const f32x4 v0 = acc[ai][bj][m][0] * scl, v1 = acc[ai][bj][m][1] * scl;
                        const u32x4 o = {pk2(v0[0], v0[1]), pk2(v0[2], v0[3]), pk2(v1[0], v1[1]), pk2(v1[2], v1[3])};
                        size_t off;
                        if (pn == 1) { const int head = bj * 2 + (wc >> 1), d0 = (wc & 1) * 32 + 8 * fq; off = ((size_t)((b * 4 + head) * 256 + t)) * 64 + d0; }
                        else { const int head = (pn - 2) * 2 + bj; off = ((size_t)((b * 4 + head) * 256 + t)) * 128 + cbase; }
                        *(u32x4*)(dst + off) = o;
                    }
                }
            return;
        }
        if (pn <= 1) {
            bf16_t* dst = (bf16_t*)(ws + (pn == 0 ? WS_Q : WS_K));
            const float scl = pn == 0 ? 1.0f : 0.125f;
            const float* rc = (const float*)(ws + WS_ROPE); const float* rs = rc + 1024;
            const int hh = wc & 1, fi0 = 8 * (fq & 1); const bool second = fq >= 2;
#pragma unroll
            for (int ai = 0; ai < 2; ++ai)
#pragma unroll
                for (int m = 0; m < 4; ++m) {
                    const int r = rbase + ai * 128 + m * 16, b = r >> 12, t = r & 4095, pos = hh ? (t & 63) : (t >> 6);
                    const f32x4 c0 = *(const f32x4*)(rc + pos * 16 + fi0), c1 = *(const f32x4*)(rc + pos * 16 + fi0 + 4);
                    const f32x4 s0 = *(const f32x4*)(rs + pos * 16 + fi0), s1 = *(const f32x4*)(rs + pos * 16 + fi0 + 4);
#pragma unroll
                    for (int bj = 0; bj < 2; ++bj) {
                        const f32x4 v0 = acc[ai][bj][m][0], v1 = acc[ai][bj][m][1];
                        float o[8];
#pragma unroll
                        for (int j = 0; j < 4; ++j) {
                            const float xa = v0[j], xb = v1[j], pa = __shfl_xor(xa, 32), pb = __shfl_xor(xb, 32);
                            o[j]     = (second ? (pa * s0[j] + xa * c0[j]) : (xa * c0[j] - pa * s0[j])) * scl;
                            o[4 + j] = (second ? (pb * s1[j] + xb * c1[j]) : (xb * c1[j] - pb * s1[j])) * scl;
                        }
                        const u32x4 ov = {pk2(o[0], o[1]), pk2(o[2], o[3]), pk2(o[4], o[5]), pk2(o[6], o[7])};
                        const int head = bj * 2 + (wc >> 1), d0 = hh * 32 + 8 * fq;
                        *(u32x4*)(dst + ((size_t)((b * 4 + head) * 4096 + t)) * 64 + d0) = ov;
                    }
                }
            return;
        }
        if (pn <= 3) {
            bf16_t* dst = (bf16_t*)(ws + WS_V);
#pragma unroll
            for (int ai = 0; ai < 2; ++ai)
#pragma unroll
                for (int m = 0; m < 4; ++m) {
                    const int r = rbase + ai * 128 + m * 16, b = r >> 12, t = r & 4095;
#pragma unroll
                    for (int bj = 0; bj < 2; ++bj) {
                        const f32x4 v0 = acc[ai][bj][m][0], v1 = acc[ai][bj][m][1];
                        const u32x4 o = {pk2(v0[0], v0[1]), pk2(v0[2], v0[3]), pk2(v1[0], v1[1]), pk2(v1[2], v1[3])};
                        const int head = (pn - 2) * 2 + bj;
                        *(u32x4*)(dst + ((size_t)((b * 4 + head) * 4096 + t)) * 128 + cbase) = o;
                    }
                }
            return;
        }
        {
            const int region = (pn - 4) >> 1; const bool is_gelu = (region == 1) || (region == 2);
            bf16_t* dst = (bf16_t*)(ws + WS_GR + (size_t)region * ((size_t)NTOK * 512 * 2));
            const int colb = ((pn - 4) & 1) * 256 + cbase;
#pragma unroll
            for (int ai = 0; ai < 2; ++ai)
#pragma unroll
                for (int m = 0; m < 4; ++m) {
                    const int r = rbase + ai * 128 + m * 16;
#pragma unroll
                    for (int bj = 0; bj < 2; ++bj) {
                        const f32x4 v0 = acc[ai][bj][m][0], v1 = acc[ai][bj][m][1];
                        u32x4 o;
                        if (is_gelu) {
                            const f32x2 a = pg8::gelu_pk((f32x2){v0[0], v0[1]}), bq = pg8::gelu_pk((f32x2){v0[2], v0[3]}), cq = pg8::gelu_pk((f32x2){v1[0], v1[1]}), dq = pg8::gelu_pk((f32x2){v1[2], v1[3]});
                            o = (u32x4){pk2(a.x, a.y), pk2(bq.x, bq.y), pk2(cq.x, cq.y), pk2(dq.x, dq.y)};
                        } else {
                            o = (u32x4){pk2(silu_f(v0[0]), silu_f(v0[1])), pk2(silu_f(v0[2]), silu_f(v0[3])), pk2(silu_f(v1[0]), silu_f(v1[1])), pk2(silu_f(v1[2]), silu_f(v1[3]))};
                        }
                        *(u32x4*)(dst + (size_t)r * 512 + colb + bj * 128) = o;
                    }
                }
        }
    }
};
struct EpiOut {
    static constexpr bool PERM = false, AFTER_DRAIN = false;
    const float* x; const float* mod; float* out;
    DI void operator()(const f32x4 (&acc)[2][2][4][2], const Unit& u, int wr, int wc, int fr, int fq) const {
        const int rbase = u.pm * 256 + wr * 64 + fr, cbase = u.pn * 256 + wc * 32 + 4 * fq;
        const float* gate = mod + (size_t)(rbase >> 12) * 3072 + 2048;
        f32x4 gv[2][2];
#pragma unroll
        for (int bj = 0; bj < 2; ++bj)
#pragma unroll
            for (int n = 0; n < 2; ++n) gv[bj][n] = *(const f32x4*)(gate + cbase + bj * 128 + n * 16);
#pragma unroll
        for (int ai = 0; ai < 2; ++ai)
#pragma unroll
            for (int m = 0; m < 4; ++m) {
                const size_t ro = (size_t)(rbase + ai * 128 + m * 16) * 1024 + cbase;
#pragma unroll
                for (int bj = 0; bj < 2; ++bj)
#pragma unroll
                    for (int n = 0; n < 2; ++n) {
                        const f32x4 xv = *(const f32x4*)(x + ro + bj * 128 + n * 16);
                        *(f32x4*)(out + ro + bj * 128 + n * 16) = xv + gv[bj][n] * acc[ai][bj][m][n];
                    }
            }
    }
};
struct SchedIn {
    pg8::StaticOrder so;
    DI bool next(int i, Unit& u) const {
        long L = (long)i * so.G + so.c;
        if (L < so.nwg) return so.next(i, u);
        L -= so.nwg; if (L >= 24) return false;
        u.pm = 128 + (int)(L / 3); u.pn = 1 + (int)(L % 3); return true;
    }
    DI void a_ready(const Unit&) const {}
    DI void done(const Unit&) const {}
};

DI void phase0(const Args& a, LAS unsigned char* lds) {
    const int tid = threadIdx.x;
    float* mod = (float*)(a.ws + WS_MOD);
    LAS float* red = (LAS float*)lds;
    for (int it = blockIdx.x; it < 1233; it += gridDim.x) {
        if (it < 192) {
            const int c0 = it * 16, f = tid & 3, rg = tid >> 2;
            float acc[9][4];
#pragma unroll
            for (int j = 0; j < 9; ++j)
#pragma unroll
                for (int e = 0; e < 4; ++e) acc[j][e] = 0.f;
#pragma unroll 2
            for (int i = 0; i < 8; ++i) {
                const int r = rg + 128 * i;
                const f32x4 w = *(const f32x4*)(a.w_ada + (size_t)r * 3072 + c0 + f * 4);
#pragma unroll
                for (int j = 0; j < 9; ++j) {
                    const float cv = (j < 8) ? a.c[j * 1024 + r] : a.c_ctx[r];
                    const float s = cv / (1.0f + expf(-cv));
#pragma unroll
                    for (int e = 0; e < 4; ++e) acc[j][e] += s * w[e];
                }
            }
#pragma unroll
            for (int j = 0; j < 9; ++j)
#pragma unroll
                for (int e = 0; e < 4; ++e) red[(j * 4 + e) * 512 + tid] = acc[j][e];
            __syncthreads();
            if (tid < 144) {
                const int j = tid >> 4, cc = tid & 15, ff = cc >> 2, e = cc & 3;
                float s = 0.f;
                for (int q = 0; q < 128; ++q) s += red[(j * 4 + e) * 512 + q * 4 + ff];
                mod[j * 3072 + c0 + cc] = s + a.b_ada[c0 + cc];
            }
            __syncthreads();
        } else if (it < 1216) {
            const bool is_in = it < 960; const int tt = is_in ? it - 192 : it - 960;
            const int nN = is_in ? 48 : 16, NN = is_in ? 3072 : 1024;
            const int k0 = (tt / nN) * 64, n0 = (tt % nN) * 64;
            const float* src = is_in ? a.w_in : a.w_out;
            bf16_t* dst = (bf16_t*)(a.ws + (is_in ? WS_WIN : WS_WOUT));
            const int kr = tid >> 4, n4 = tid & 15;
#pragma unroll
            for (int p = 0; p < 2; ++p) {
                const int k = kr + 32 * p;
                const f32x4 v = *(const f32x4*)(src + (size_t)(k0 + k) * NN + n0 + n4 * 4);
#pragma unroll
                for (int e = 0; e < 4; ++e) red[k * 65 + n4 * 4 + e] = v[e];
            }
            __syncthreads();
            const int n = tid >> 3, k8 = tid & 7;
            float v[8];
#pragma unroll
            for (int j = 0; j < 8; ++j) v[j] = red[(k8 * 8 + j) * 65 + n];
            const u32x4 o = {pk2(v[0], v[1]), pk2(v[2], v[3]), pk2(v[4], v[5]), pk2(v[6], v[7])};
            *(u32x4*)(dst + (size_t)(n0 + n) * 1024 + k0 + k8 * 8) = o;
            __syncthreads();
        } else if (it < 1232) {
            const size_t base = (size_t)(it - 1216) * 4096 + tid * 8;
            const f32x4 v0 = *(const f32x4*)(a.w_s + base), v1 = *(const f32x4*)(a.w_s + base + 4);
            const u32x4 o = {pk2(v0[0], v0[1]), pk2(v0[2], v0[3]), pk2(v1[0], v1[1]), pk2(v1[2], v1[3])};
            *(u32x4*)((bf16_t*)(a.ws + WS_WSB) + base) = o;
        } else {
            float* rc = (float*)(a.ws + WS_ROPE); float* rs = rc + 1024;
            for (int idx = tid; idx < 1024; idx += NTHREADS) {
                const int pos = idx >> 4, fi = idx & 15;
                const float inv = powf(10000.0f, -(float)fi / 16.0f), ang = (float)pos * inv;
                rc[idx] = cosf(ang); rs[idx] = sinf(ang);
            }
        }
    }
}

DI void phase1(const Args& a) {
    const int tid = threadIdx.x, wave = tid >> 6, lane = tid & 63;
    const float* mod = (const float*)(a.ws + WS_MOD);
    bf16_t* H = (bf16_t*)(a.ws + WS_H);
    for (int r = blockIdx.x * 8 + wave; r < NTOK + NCTX; r += gridDim.x * 8) {
        const float* src; int j;
        if (r < NTOK) { src = a.x + (size_t)r * 1024; j = r >> 12; } else { src = a.ctx + (size_t)(r - NTOK) * 1024; j = 8; }
        f32x4 v[4]; float ss = 0.f;
#pragma unroll
        for (int q = 0; q < 4; ++q) { v[q] = *(const f32x4*)(src + q * 256 + lane * 4); ss += v[q][0] * v[q][0] + v[q][1] * v[q][1] + v[q][2] * v[q][2] + v[q][3] * v[q][3]; }
#pragma unroll
        for (int off = 32; off >= 1; off >>= 1) ss += __shfl_xor(ss, off);
        const float rstd = rsqrtf(ss * (1.0f / 1024.0f) + EPS);
        const float* mrow = mod + j * 3072;
#pragma unroll
        for (int q = 0; q < 4; ++q) {
            const int cidx = q * 256 + lane * 4;
            const f32x4 nw = *(const f32x4*)(a.norm_w + cidx), sc = *(const f32x4*)(mrow + 1024 + cidx), sh = *(const f32x4*)(mrow + cidx);
            f32x4 hv;
#pragma unroll
            for (int e = 0; e < 4; ++e) hv[e] = (v[q][e] * rstd * nw[e]) * (1.0f + sc[e]) + sh[e];
            const u32x2 o = {pk2(hv[0], hv[1]), pk2(hv[2], hv[3])};
            *(u32x2*)(H + (size_t)r * 1024 + cidx) = o;
        }
    }
}

constexpr int VS = 272, KS = 144;
DI void gmlp_unit(const Args& a, LAS unsigned char* lds, int b, int c) {
    const int tid = threadIdx.x, lane = tid & 63, w = tid >> 6, i = lane & 15, g = lane >> 4;
    const int r0 = b * 4096 + c * 128;
    const bf16_t* VG = (const bf16_t*)(a.ws + WS_VG); const bf16_t* U = (const bf16_t*)(a.ws + WS_U); const bf16_t* GM = (const bf16_t*)(a.ws + WS_GM);
    const bf16_t* WSB = (const bf16_t*)(a.ws + WS_WSB); bf16_t* Y = (bf16_t*)(a.ws + WS_H);
    constexpr int GSZ = 128 * VS;
    {
        const int row = tid >> 2, q = tid & 3;
        const bf16_t* src = VG + (size_t)(r0 + row) * 512 + q * 128;
        float s = 0.f, s2 = 0.f;
#pragma unroll 4
        for (int p = 0; p < 16; ++p) {
            const u32x4 pc = *(const u32x4*)(src + p * 8);
#pragma unroll
            for (int e = 0; e < 4; ++e) { const float lo = bflo(pc[e]), hi = bfhi(pc[e]); s += lo + hi; s2 += lo * lo + hi * hi; }
        }
        s += __shfl_xor(s, 1); s += __shfl_xor(s, 2); s2 += __shfl_xor(s2, 1); s2 += __shfl_xor(s2, 2);
        const float mean = s * (1.0f / 512.0f);
        const float var = fmaxf(s2 * (1.0f / 512.0f) - mean * mean, 0.f);
        const float rstd = rsqrtf(var + EPS);
        const float* lw = a.ln_w + q * 128;
#pragma unroll 2
        for (int p = 0; p < 16; ++p) {
            const u32x4 pc = *(const u32x4*)(src + p * 8);
            const f32x4 w0 = *(const f32x4*)(lw + p * 8), w1 = *(const f32x4*)(lw + p * 8 + 4);
            u32x4 o;
            o[0] = pk2((bflo(pc[0]) - mean) * rstd * w0[0], (bfhi(pc[0]) - mean) * rstd * w0[1]);
            o[1] = pk2((bflo(pc[1]) - mean) * rstd * w0[2], (bfhi(pc[1]) - mean) * rstd * w0[3]);
            o[2] = pk2((bflo(pc[2]) - mean) * rstd * w1[0], (bfhi(pc[2]) - mean) * rstd * w1[1]);
            o[3] = pk2((bflo(pc[3]) - mean) * rstd * w1[2], (bfhi(pc[3]) - mean) * rstd * w1[3]);
            *(LAS u32x4*)(lds + q * GSZ + row * VS + p * 16) = o;
        }
    }
    __syncthreads();
    const int n = 16 * w + i, r = r0 + n;
#pragma unroll 1
    for (int gq = 0; gq < 4; ++gq) {
        f32x4 acc[8];
#pragma unroll
        for (int et = 0; et < 8; ++et) acc[et] = (f32x4){0.f, 0.f, 0.f, 0.f};
        const bf16_t* wrow = WSB + (size_t)(gq * 128 + n) * 128;
#pragma unroll 1
        for (int s = 0; s < 4; ++s) {
            const bf16x8 bw = frag_rowP(wrow + 32 * s, g);
#pragma unroll
            for (int et = 0; et < 8; ++et) acc[et] = mfma16(frag_tr(lds + gq * GSZ, VS, 32 * s, 16 * et, lane), bw, acc[et]);
        }
        const float bias = a.b_s[gq * 128 + n];
#pragma unroll
        for (int et = 0; et < 8; ++et) {
            const int col = gq * 128 + 16 * et + 4 * g;
            const u32x2 uu = *(const u32x2*)(U + (size_t)r * 512 + col), gg = *(const u32x2*)(GM + (size_t)r * 512 + col);
            const float y0 = bflo(uu.x) * (acc[et][0] + bias) * bflo(gg.x), y1 = bfhi(uu.x) * (acc[et][1] + bias) * bfhi(gg.x);
            const float y2 = bflo(uu.y) * (acc[et][2] + bias) * bflo(gg.y), y3 = bfhi(uu.y) * (acc[et][3] + bias) * bfhi(gg.y);
            const u32x2 o = {pk2(y0, y1), pk2(y2, y3)};
            *(u32x2*)(Y + (size_t)r * 1024 + 512 + col) = o;
        }
    }
    __syncthreads();
}
DI void kv_unit(LAS unsigned char* lds, const bf16_t* Kp, const bf16_t* Vp, float* out, float l2f, float l2b) {
    const int tid = threadIdx.x, lane = tid & 63, w = tid >> 6, i = lane & 15, g = lane >> 4;
    LAS unsigned char* KF = lds; LAS unsigned char* KB = lds + 128 * KS; LAS unsigned char* Vt = lds + 2 * 128 * KS;
#pragma unroll
    for (int q = 0; q < 2; ++q) {
        const int p = tid + 512 * q, m = p >> 3, d8 = p & 7;
        const u32x4 raw = *(const u32x4*)(Kp + m * 64 + d8 * 8);
        const float tf = exp2f((float)(127 - m) * l2f), tb = exp2f((float)m * l2b);
        u32x4 of, ob;
#pragma unroll
        for (int e = 0; e < 4; ++e) { const float lo = bflo(raw[e]), hi = bfhi(raw[e]); of[e] = pk2(lo * tf, hi * tf); ob[e] = pk2(lo * tb, hi * tb); }
        *(LAS u32x4*)(KF + m * KS + d8 * 16) = of; *(LAS u32x4*)(KB + m * KS + d8 * 16) = ob;
    }
#pragma unroll
    for (int q = 0; q < 4; ++q) {
        const int p = tid + 512 * q, m = p >> 4, e8 = p & 15;
        *(LAS u32x4*)(Vt + m * VS + e8 * 16) = *(const u32x4*)(Vp + m * 128 + e8 * 8);
    }
    __syncthreads();
    const int dir = w >> 2, dt = w & 3;
    LAS const unsigned char* Kx = dir ? KB : KF;
    f32x4 acc[8];
#pragma unroll
    for (int et = 0; et < 8; ++et) acc[et] = (f32x4){0.f, 0.f, 0.f, 0.f};
#pragma unroll 1
    for (int s = 0; s < 4; ++s) {
        const bf16x8 bk = frag_tr(Kx, KS, 32 * s, 16 * dt, lane);
#pragma unroll
        for (int et = 0; et < 8; ++et) acc[et] = mfma16(frag_tr(Vt, VS, 32 * s, 16 * et, lane), bk, acc[et]);
    }
    float* o = out + dir * 8192 + (16 * dt + i) * 128 + 4 * g;
#pragma unroll
    for (int et = 0; et < 8; ++et) *(f32x4*)(o + 16 * et) = acc[et];
    __syncthreads();
}
DI void phase3(const Args& a, LAS unsigned char* lds) {
    const bf16_t* Kb = (const bf16_t*)(a.ws + WS_K); const bf16_t* Vb = (const bf16_t*)(a.ws + WS_V);
    const bf16_t* KCb = (const bf16_t*)(a.ws + WS_KC); const bf16_t* VCb = (const bf16_t*)(a.ws + WS_VC);
    float* KV = (float*)(a.ws + WS_KV); float* KVC = (float*)(a.ws + WS_KVC);
    for (int it = blockIdx.x; it < 1344; it += gridDim.x) {
        if (it < 256) { gmlp_unit(a, lds, it >> 5, it & 31); continue; }
        if (it < 1280) {
            const int unit = it - 256, bh = unit >> 5, c = unit & 31, h = bh & 3;
            const float l2f = -expf(a.dec_f[h]) * LOG2E, l2b = -expf(a.dec_b[h]) * LOG2E;
            kv_unit(lds, Kb + ((size_t)bh * 4096 + c * 128) * 64, Vb + ((size_t)bh * 4096 + c * 128) * 128, KV + (size_t)unit * 16384, l2f, l2b);
        } else {
            const int uu = it - 1280, bh = uu >> 1, c2 = uu & 1, h = bh & 3;
            const float l2f = -expf(a.dec_f[h]) * LOG2E, l2b = -expf(a.dec_b[h]) * LOG2E;
            kv_unit(lds, KCb + ((size_t)bh * 256 + c2 * 128) * 64, VCb + ((size_t)bh * 256 + c2 * 128) * 128, KVC + (size_t)uu * 16384, l2f, l2b);
        }
    }
}

DI void phase4(const Args& a) {
    const float* KV = (const float*)(a.ws + WS_KV); const float* KVC = (const float*)(a.ws + WS_KVC);
    bf16_t* ST = (bf16_t*)(a.ws + WS_ST);
    for (int idx = blockIdx.x * NTHREADS + threadIdx.x; idx < 64 * 2048; idx += gridDim.x * NTHREADS) {
        const int chain = idx >> 11, pos = idx & 2047, bh = chain >> 1, dir = chain & 1, h = bh & 3;
        const float lg = -expf(dir ? a.dec_b[h] : a.dec_f[h]), G = expf(128.0f * lg);
        const f32x4 k0 = *(const f32x4*)(KVC + ((size_t)(bh * 2 + 0) * 2 + dir) * 8192 + pos * 4);
        const f32x4 k1 = *(const f32x4*)(KVC + ((size_t)(bh * 2 + 1) * 2 + dir) * 8192 + pos * 4);
        f32x4 S = dir ? (k1 * G + k0) : (k0 * G + k1);
#pragma unroll 8
        for (int step = 0; step < NC; ++step) {
            const int c = dir ? (NC - 1 - step) : step;
            const size_t off = ((size_t)(bh * 32 + c) * 2 + dir) * 8192 + pos * 4;
            const f32x4 kvv = *(const f32x4*)(KV + off);
            const u32x2 o = {pk2(S[0], S[1]), pk2(S[2], S[3])};
            *(u32x2*)(ST + off) = o;
            S = S * G + kvv;
        }
    }
}

DI void ret_unit(const Args& a, LAS unsigned char* lds, int unit) {
    const int tid = threadIdx.x, lane = tid & 63, w = tid >> 6, i = lane & 15, g = lane >> 4;
    const int bh = unit >> 5, c = unit & 31, b = bh >> 2, h = bh & 3;
    const bf16_t* Qp = (const bf16_t*)(a.ws + WS_Q) + ((size_t)bh * 4096 + c * 128) * 64;
    const bf16_t* Kp = (const bf16_t*)(a.ws + WS_K) + ((size_t)bh * 4096 + c * 128) * 64;
    const bf16_t* Vp = (const bf16_t*)(a.ws + WS_V) + ((size_t)bh * 4096 + c * 128) * 128;
    const bf16_t* SFp = (const bf16_t*)(a.ws + WS_ST) + (size_t)unit * 16384; const bf16_t* SBp = SFp + 8192;
    const bf16_t* GR = (const bf16_t*)(a.ws + WS_GR); bf16_t* Y = (bf16_t*)(a.ws + WS_H);
    LAS unsigned char* Kt = lds; LAS unsigned char* Vt = lds + 128 * KS; LAS unsigned char* SF = Vt + 128 * VS; LAS unsigned char* SB = SF + 64 * VS;
#pragma unroll
    for (int q = 0; q < 2; ++q) {
        const int p = tid + 512 * q, m = p >> 3, d8 = p & 7;
        *(LAS u32x4*)(Kt + m * KS + d8 * 16) = *(const u32x4*)(Kp + m * 64 + d8 * 8);
    }
#pragma unroll
    for (int q = 0; q < 4; ++q) {
        const int p = tid + 512 * q, m = p >> 4, e8 = p & 15;
        *(LAS u32x4*)(Vt + m * VS + e8 * 16) = *(const u32x4*)(Vp + m * 128 + e8 * 8);
    }
#pragma unroll
    for (int q = 0; q < 2; ++q) {
        const int p = tid + 512 * q, d = p >> 4, e8 = p & 15;
        *(LAS u32x4*)(SF + d * VS + e8 * 16) = *(const u32x4*)(SFp + d * 128 + e8 * 8);
        *(LAS u32x4*)(SB + d * VS + e8 * 16) = *(const u32x4*)(SBp + d * 128 + e8 * 8);
    }
    const float l2f = -expf(a.dec_f[h]) * LOG2E, l2b = -expf(a.dec_b[h]) * LOG2E;
    const int n = 16 * w + i;
    bf16x8 Qf[2];
#pragma unroll
    for (int s = 0; s < 2; ++s) Qf[s] = frag_rowP(Qp + n * 64 + 32 * s, g);
    __syncthreads();
    f32x4 accS[8];
#pragma unroll
    for (int mt = 0; mt < 8; ++mt) {
        accS[mt] = (f32x4){0.f, 0.f, 0.f, 0.f};
#pragma unroll
        for (int s = 0; s < 2; ++s) accS[mt] = mfma16(frag_rowP_lds(Kt + (16 * mt + i) * KS + 64 * s, g), Qf[s], accS[mt]);
    }
#pragma unroll
    for (int mt = 0; mt < 8; ++mt)
#pragma unroll
        for (int reg = 0; reg < 4; ++reg) {
            const int diff = n - (16 * mt + 4 * g + reg);
            const float dv = diff > 0 ? exp2f((float)diff * l2f) : (diff < 0 ? exp2f((float)(-diff) * l2b) : 2.0f);
            accS[mt][reg] *= dv;
        }
    const float fsf = exp2f((float)(n + 1) * l2f), fsb = exp2f((float)(128 - n) * l2b);
    f32x4 accO[8];
#pragma unroll
    for (int et = 0; et < 8; ++et) accO[et] = (f32x4){0.f, 0.f, 0.f, 0.f};
#pragma unroll
    for (int s = 0; s < 4; ++s) {
        const u32x4 pu = {pk2(accS[2 * s][0], accS[2 * s][1]), pk2(accS[2 * s][2], accS[2 * s][3]), pk2(accS[2 * s + 1][0], accS[2 * s + 1][1]), pk2(accS[2 * s + 1][2], accS[2 * s + 1][3])};
        const bf16x8 Pf = __builtin_bit_cast(bf16x8, pu);
#pragma unroll
        for (int et = 0; et < 8; ++et) accO[et] = mfma16(frag_tr(Vt, VS, 32 * s, 16 * et, lane), Pf, accO[et]);
    }
#pragma unroll
    for (int s = 0; s < 2; ++s) {
        const bf16x8 qsf = scale_frag(Qf[s], fsf), qsb = scale_frag(Qf[s], fsb);
#pragma unroll
        for (int et = 0; et < 8; ++et) {
            accO[et] = mfma16(frag_tr(SF, VS, 32 * s, 16 * et, lane), qsf, accO[et]);
            accO[et] = mfma16(frag_tr(SB, VS, 32 * s, 16 * et, lane), qsb, accO[et]);
        }
    }
    float sm = 0.f;
#pragma unroll
    for (int et = 0; et < 8; ++et) sm += accO[et][0] + accO[et][1] + accO[et][2] + accO[et][3];
    sm += __shfl_xor(sm, 16); sm += __shfl_xor(sm, 32);
    const float mean = sm * (1.0f / 128.0f);
    float v2 = 0.f;
#pragma unroll
    for (int et = 0; et < 8; ++et)
#pragma unroll
        for (int e = 0; e < 4; ++e) { const float d0 = accO[et][e] - mean; v2 += d0 * d0; }
    v2 += __shfl_xor(v2, 16); v2 += __shfl_xor(v2, 32);
    const float rstd = rsqrtf(v2 * (1.0f / 128.0f) + EPS);
    const int r = b * 4096 + c * 128 + n;
#pragma unroll
    for (int et = 0; et < 8; ++et) {
        const int col = h * 128 + 16 * et + 4 * g;
        const f32x4 gw = *(const f32x4*)(a.gn_w + col);
        const u32x2 gg = *(const u32x2*)(GR + (size_t)r * 512 + col);
        const float y0 = (accO[et][0] - mean) * rstd * gw[0] * bflo(gg.x), y1 = (accO[et][1] - mean) * rstd * gw[1] * bfhi(gg.x);
        const float y2 = (accO[et][2] - mean) * rstd * gw[2] * bflo(gg.y), y3 = (accO[et][3] - mean) * rstd * gw[3] * bfhi(gg.y);
        const u32x2 o = {pk2(y0, y1), pk2(y2, y3)};
        *(u32x2*)(Y + (size_t)r * 1024 + col) = o;
    }
    __syncthreads();
}

DI void phase7(const Args& a) {
    const int tid = threadIdx.x, wave = tid >> 6, lane = tid & 63;
    for (int r = blockIdx.x * 8 + wave; r < NTOK; r += gridDim.x * 8) {
        float* row = a.out + (size_t)r * 1024;
        f32x4 v[4]; float ss = 0.f;
#pragma unroll
        for (int q = 0; q < 4; ++q) { v[q] = *(const f32x4*)(row + q * 256 + lane * 4); ss += v[q][0] * v[q][0] + v[q][1] * v[q][1] + v[q][2] * v[q][2] + v[q][3] * v[q][3]; }
#pragma unroll
        for (int off = 32; off >= 1; off >>= 1) ss += __shfl_xor(ss, off);
        const float rstd = rsqrtf(ss * (1.0f / 1024.0f) + EPS);
#pragma unroll
        for (int q = 0; q < 4; ++q) {
            const f32x4 fw = *(const f32x4*)(a.fnorm_w + q * 256 + lane * 4);
            *(f32x4*)(row + q * 256 + lane * 4) = v[q] * rstd * fw;
        }
    }
}

__global__ __launch_bounds__(512, 2) void fwd_megakernel(Args a) {
    extern __shared__ __attribute__((aligned(16))) unsigned char shm[];
    LAS unsigned char* lds = (LAS unsigned char*)shm;
    cg::grid_group grid = cg::this_grid();
#ifndef PHMASK
#define PHMASK 255
#endif
#define PHASE(P, ...) do { if (((PHMASK >> (P)) & 1) && a.ph_lo <= (P) && (P) < a.ph_hi) { __VA_ARGS__; if ((P) + 1 < a.ph_hi) grid.sync(); } } while (0)
    PHASE(0, phase0(a, lds));
    PHASE(1, phase1(a));
    PHASE(2, {
        pg8::Gemm gm{(const bf16_t*)(a.ws + WS_H), (const bf16_t*)(a.ws + WS_WIN), NTOK, NP, D};
        SchedIn S; S.so.init(NTOK, NP, (int)gridDim.x, (int)blockIdx.x);
        EpiIn E{a.ws};
        pg8::gemm_phase<EpiIn, SchedIn, false>(lds, gm, S, E, nullptr);
    });
    PHASE(3, phase3(a, lds));
    PHASE(4, phase4(a));
    PHASE(5, { for (int it = blockIdx.x; it < 1024; it += gridDim.x) ret_unit(a, lds, it); });
    PHASE(6, {
        pg8::Gemm gm{(const bf16_t*)(a.ws + WS_H), (const bf16_t*)(a.ws + WS_WOUT), NTOK, D, D};
        pg8::StaticOrder S; S.init(NTOK, D, (int)gridDim.x, (int)blockIdx.x);
        EpiOut E{a.x, (const float*)(a.ws + WS_MOD), a.out};
        pg8::gemm_phase<EpiOut, pg8::StaticOrder, false>(lds, gm, S, E, nullptr);
    });
    PHASE(7, phase7(a));
#undef PHASE
}

extern "C" void kernel_launch(void* const* d_in, const int* in_sizes, int n_in, void* d_out, int out_size, void* d_ws, size_t ws_size, hipStream_t stream) {
    static int grid = 0;
    if (grid == 0) {
        if (n_in != 16 || out_size != NTOK * D || ws_size < WS_END) { fprintf(stderr, "kernel_launch: unexpected shapes (n_in %d out %d ws %zu need %zu)\n", n_in, out_size, ws_size, (size_t)WS_END); grid = -1; return; }
        int dev = 0, cus = 0, per_cu = 0;
        (void)hipGetDevice(&dev); (void)hipDeviceGetAttribute(&cus, hipDeviceAttributeMultiprocessorCount, dev);
        if (hipFuncSetAttribute((const void*)fwd_megakernel, hipFuncAttributeMaxDynamicSharedMemorySize, LDS_BYTES) != hipSuccess) { fprintf(stderr, "kernel_launch: hipFuncSetAttribute failed\n"); grid = -1; return; }
        if (hipOccupancyMaxActiveBlocksPerMultiprocessor(&per_cu, (const void*)fwd_megakernel, NTHREADS, LDS_BYTES) != hipSuccess || per_cu < 1) { fprintf(stderr, "kernel_launch: occupancy query gives %d\n", per_cu); per_cu = 1; }
        (void)hipGetLastError();
        grid = cus;
    }
    if (grid < 0) return;
    Args a{};
    a.x = (const float*)d_in[0]; a.c = (const float*)d_in[1]; a.ctx = (const float*)d_in[2]; a.c_ctx = (const float*)d_in[3]; a.w_ada = (const float*)d_in[4]; a.b_ada = (const float*)d_in[5];
    a.norm_w = (const float*)d_in[6]; a.w_in = (const float*)d_in[7]; a.dec_f = (const float*)d_in[8]; a.dec_b = (const float*)d_in[9]; a.gn_w = (const float*)d_in[10]; a.ln_w = (const float*)d_in[11];
    a.w_s = (const float*)d_in[12]; a.b_s = (const float*)d_in[13]; a.w_out = (const float*)d_in[14]; a.fnorm_w = (const float*)d_in[15];
    a.out = (float*)d_out; a.ws = (unsigned char*)d_ws;
#if N_LAUNCHES == 1
    a.ph_lo = 0; a.ph_hi = 8;
    void* args[] = {&a};
    hipError_t e = hipLaunchCooperativeKernel((const void*)fwd_megakernel, dim3(grid), dim3(NTHREADS), args, LDS_BYTES, stream);
    if (e != hipSuccess) fprintf(stderr, "cooperative launch failed: %s (grid %d)\n", hipGetErrorString(e), grid);
#else
    for (int p = 0; p < 8; ++p) {
        a.ph_lo = p; a.ph_hi = p + 1;
        hipLaunchKernelGGL(fwd_megakernel, dim3(grid), dim3(NTHREADS), LDS_BYTES, stream, a);
    }
#endif
}
```

```cpp
#include <hip/hip_runtime.h>
#include <hip/hip_cooperative_groups.h>
#include <cstdio>
namespace cg = cooperative_groups;
#ifndef N_LAUNCHES
#define N_LAUNCHES 1
#endif
namespace pg8 {
#define PG8_LAS __attribute__((address_space(3)))
typedef unsigned short bf16_t;
typedef short bf16x8 __attribute__((ext_vector_type(8)));
typedef float f32x4 __attribute__((ext_vector_type(4)));
typedef unsigned u32x4 __attribute__((ext_vector_type(4)));
constexpr int BM = 256, BK = 64, HALF = 128, HTB = HALF * BK * 2  , STAGE_BYTES = 8 * HTB, NXCD = 8, WGM = 8;

__host__ __device__ __forceinline__ int lds_byte(int r, int c) { const int st = (r >> 4) * 2 + (c >> 5), rr = r & 15, cc = c & 31, ob = rr * 64 + cc * 2; return st * 1024 + (ob ^ (((ob >> 9) & 1) << 5)); }
__host__ __device__ __forceinline__ void stage_rc(int b, int& R, int& C) { const int st = b / 1024, sb = b % 1024, swz = sb ^ (((sb >> 9) & 1) << 5); R = (st >> 1) * 16 + swz / 64; C = (st & 1) * 32 + (swz % 64) / 2; }
__host__ __device__ __forceinline__ int perm32(int rho) { const int n = rho >> 4, i = rho & 15; return 8 * (i >> 2) + 4 * n + (i & 3); }

struct Unit { int pm, pn; };
struct Gemm { const bf16_t* A; const bf16_t* Bt; int M, N, K; };

struct StaticOrder {
    int nM, nN, nwg, G, c;
    __host__ __device__ void init(int M, int N, int G_, int c_) { nM = M / BM; nN = N / BM; nwg = nM * nN; G = G_; c = c_; }
    __host__ __device__ bool next(int i, Unit& u) const {
        const long L = (long)i * G + c; if (L >= nwg) return false;
        int wgid = (int)L; { const int q = nwg / NXCD, r = nwg % NXCD, xcd = wgid % NXCD, off = wgid / NXCD; wgid = (xcd < r ? xcd * (q + 1) : r * (q + 1) + (xcd - r) * q) + off; }
        const int nig = WGM * nN, gid = wgid / nig, fm = gid * WGM, gsz = (nM - fm) < WGM ? (nM - fm) : WGM;
        u.pm = fm + ((wgid % nig) % gsz); u.pn = (wgid % nig) / gsz; return true;
    }
    __device__ __forceinline__ void a_ready(const Unit&) const {}
    __device__ __forceinline__ void done(const Unit&) const {}
};
struct CountedOrder : StaticOrder {
    const unsigned* ready; unsigned need; unsigned* tmo;
    __device__ __forceinline__ void a_ready(const Unit& u) const {
        if (threadIdx.x < 64) {
            const unsigned long long t0 = __builtin_amdgcn_s_memrealtime(); unsigned polls = 0;
            while ((unsigned)__builtin_amdgcn_readfirstlane(__hip_atomic_load(ready + 64 * u.pm, __ATOMIC_RELAXED, __HIP_MEMORY_SCOPE_AGENT)) < need) {
                if ((++polls & 255u) == 0u && __builtin_amdgcn_readfirstlane(__hip_atomic_load(tmo, __ATOMIC_RELAXED, __HIP_MEMORY_SCOPE_AGENT)) != 0u) break;
                if (__builtin_amdgcn_s_memrealtime() - t0 > 2000000ull) {
                    if (threadIdx.x == 0) { unsigned expect = 0u; __hip_atomic_compare_exchange_strong(tmo + 1, &expect, 0x600u | (unsigned)(u.pm & 0xff), __ATOMIC_RELAXED, __ATOMIC_RELAXED, __HIP_MEMORY_SCOPE_AGENT); __hip_atomic_store(tmo, 1u, __ATOMIC_RELAXED, __HIP_MEMORY_SCOPE_AGENT); }
                    break; }
                __builtin_amdgcn_s_sleep(2); }
            __builtin_amdgcn_fence(__ATOMIC_ACQUIRE, "agent");
            asm volatile("s_waitcnt vmcnt(0)" ::: "memory");
        }
#if !defined(BROKEN_HOOK_NO_BARRIER)
        asm volatile("" ::: "memory"); __builtin_amdgcn_s_barrier(); asm volatile("" ::: "memory");
#endif
    }
};

__device__ __forceinline__ unsigned cvt_pk_bf16(float lo, float hi) { unsigned r; asm volatile("v_cvt_pk_bf16_f32 %0, %1, %2" : "=v"(r) : "v"(lo), "v"(hi)); return r; }
typedef float f32x2 __attribute__((ext_vector_type(2)));
__device__ __forceinline__ f32x2 gelu_pk(f32x2 v) {
    const f32x2 av = __builtin_elementwise_abs(v), d = av * 0.2316418882f + 1.0f;
    f32x2 t; t.x = __builtin_amdgcn_rcpf(d.x); t.y = __builtin_amdgcn_rcpf(d.y);
    f32x2 q = t * 0.5307027145f + (-0.7265760135f); q = q * t + 0.7107068705f; q = q * t + (-0.142248368f); q = q * t + 0.127414796f; q = q * t;
    const f32x2 s = (v * v) * (-0.72134752044f);
    f32x2 e; e.x = __builtin_amdgcn_exp2f(s.x); e.y = __builtin_amdgcn_exp2f(s.y);
    const f32x2 m = v * (q * e), r = v - m;
    f32x2 o; o.x = v.x < 0.f ? m.x : r.x; o.y = v.y < 0.f ? m.y : r.y; return o;
}
template <class Epi, class Sched, bool STAMP = false>
__device__ __forceinline__ void gemm_phase(PG8_LAS unsigned char* lds, const Gemm g, const Sched& S, const Epi& E, unsigned long long* stamps) {
    const int tid = threadIdx.x, wid = __builtin_amdgcn_readfirstlane(tid >> 6), lane = tid & 63, wr = wid >> 2, wc = wid & 3, fr = lane & 15, fq = lane >> 4;
    const int K = g.K, nt = K / BK;
    int ts_lo = 0, ts_hi = 0, nts = 0; const unsigned long long rt_entry = STAMP ? (unsigned long long)wall_clock64() : 0ull;
#define PG8_STAMP() do { if (STAMP && wid == 0 && nts < 64) { const unsigned long long _c = (unsigned long long)clock64(); \
        ts_lo = (lane == nts) ? (int)(unsigned)_c : ts_lo; ts_hi = (lane == nts) ? (int)(unsigned)(_c >> 32) : ts_hi; ++nts; } } while (0)
    PG8_STAMP();
    unsigned voffA[2], voffB[2];
#pragma unroll
    for (int i = 0; i < 2; ++i) { int R, C; stage_rc(tid * 16 + i * 8192, R, C); const int Rb = Epi::PERM ? ((R & ~31) + perm32(R & 31)) : R;
        voffA[i] = (unsigned)(R * K + C) * 2u; voffB[i] = (unsigned)(Rb * K + C) * 2u; }
    const size_t kstep = (size_t)(BK * 2);
    const size_t hstep = (size_t)HALF * K * 2;
    const size_t tstep = 2 * hstep;
    const unsigned ldsw = (unsigned)wid * 1024u;
    const int aoff = lds_byte(wr * 64 + fr, fq * 8), boff = lds_byte(wc * 32 + fr, fq * 8);
#define PG8_SA(b, h) (((b) * 2 + (h)) * HTB)
#define PG8_SB(b, h) ((4 + (b) * 2 + (h)) * HTB)
#define PG8_STAGE(bufoff, gbase, voff) do { _Pragma("unroll") for (int _i = 0; _i < 2; ++_i) \
        __builtin_amdgcn_global_load_lds((const unsigned*)((const char*)(gbase) + (voff)[_i]), (PG8_LAS unsigned*)(lds + (bufoff) + ldsw + _i * 8192), 16, 0, 0); } while (0)
#define PG8_LDA(dst, b, h) do { _Pragma("unroll") for (int m = 0; m < 4; ++m) _Pragma("unroll") for (int k = 0; k < 2; ++k) dst[m][k] = *(const PG8_LAS bf16x8*)(lds + PG8_SA(b, h) + aoff + m * 2048 + k * 1024); } while (0)
#define PG8_LDB(dst, b, h) do { _Pragma("unroll") for (int n = 0; n < 2; ++n) _Pragma("unroll") for (int k = 0; k < 2; ++k) dst[n][k] = *(const PG8_LAS bf16x8*)(lds + PG8_SB(b, h) + boff + n * 2048 + k * 1024); } while (0)
#define PG8_MMA(ai, bj, At, Bt) do { __builtin_amdgcn_s_setprio(1); _Pragma("unroll") for (int m = 0; m < 4; ++m) _Pragma("unroll") for (int n = 0; n < 2; ++n) _Pragma("unroll") for (int k = 0; k < 2; ++k) \
        acc[ai][bj][m][n] = __builtin_amdgcn_mfma_f32_16x16x32_bf16(Bt[n][k], At[m][k], acc[ai][bj][m][n], 0, 0, 0); __builtin_amdgcn_s_setprio(0); } while (0)
#define PG8_WAIT_V(n) asm volatile("s_waitcnt vmcnt(" #n ")" ::: "memory")
#define PG8_WAIT_L(n) asm volatile("s_waitcnt lgkmcnt(" #n ")" ::: "memory")
#define PG8_BAR __builtin_amdgcn_s_barrier()
#define PG8_SCHED __builtin_amdgcn_sched_barrier(0)
    Unit cur, nxt; int ui = 0;
    if (!S.next(0, cur)) return;
    f32x4 acc[2][2][4][2];
#pragma unroll
    for (int a = 0; a < 2; ++a)
#pragma unroll
        for (int b = 0; b < 2; ++b)
#pragma unroll
            for (int m = 0; m < 4; ++m)
#pragma unroll
                for (int n = 0; n < 2; ++n) acc[a][b][m][n] = (f32x4){0.f, 0.f, 0.f, 0.f};
    bf16x8 At[4][2], B0[2][2], B1[2][2];
    const char* cA = (const char*)g.A + (size_t)cur.pm * tstep; const char* cB = (const char*)g.Bt + (size_t)cur.pn * tstep;
    S.a_ready(cur);
    PG8_STAGE(PG8_SB(0, 0), cB, voffB); PG8_STAGE(PG8_SA(0, 0), cA, voffA); PG8_STAGE(PG8_SB(0, 1), cB + hstep, voffB); PG8_STAGE(PG8_SA(0, 1), cA + hstep, voffA);
    if (wr == 1) PG8_BAR;
    PG8_WAIT_V(4); PG8_BAR;
    PG8_STAGE(PG8_SB(1, 0), cB + kstep, voffB); PG8_STAGE(PG8_SA(1, 0), cA + kstep, voffA); PG8_STAGE(PG8_SB(1, 1), cB + hstep + kstep, voffB);
    PG8_WAIT_V(6); PG8_BAR;
    PG8_STAMP();
    for (;;) {
        const bool has_next = S.next(ui + 1, nxt);
        const char* nA = has_next ? (const char*)g.A + (size_t)nxt.pm * tstep : cA; const char* nB = has_next ? (const char*)g.Bt + (size_t)nxt.pn * tstep : cB;
        for (int t = 0; t < nt; t += 2) {
            const bool last = (t == nt - 2);
            const char* a1 = cA + (size_t)(t + 1) * kstep;
            const char* a2 = last ? nA : cA + (size_t)(t + 2) * kstep; const char* b2 = last ? nB : cB + (size_t)(t + 2) * kstep;
            const char* a3 = a2 + kstep; const char* b3 = b2 + kstep;
            if (last && has_next) S.a_ready(nxt);
            PG8_LDB(B0, 0, 0); PG8_SCHED; PG8_LDA(At, 0, 0); PG8_STAGE(PG8_SA(1, 1), a1 + hstep, voffA);
            PG8_WAIT_L(8); PG8_BAR; PG8_WAIT_L(0); PG8_MMA(0, 0, At, B0); PG8_BAR; PG8_SCHED;
            PG8_LDB(B1, 0, 1); PG8_STAGE(PG8_SB(0, 0), b2, voffB);
            PG8_BAR; PG8_WAIT_L(0); PG8_MMA(0, 1, At, B1); PG8_BAR;
            PG8_LDA(At, 0, 1); PG8_STAGE(PG8_SA(0, 0), a2, voffA);
            PG8_BAR; PG8_WAIT_L(0); PG8_MMA(1, 0, At, B0); PG8_BAR; PG8_SCHED;
            PG8_STAGE(PG8_SB(0, 1), b2 + hstep, voffB);
            PG8_WAIT_V(6); PG8_BAR; PG8_MMA(1, 1, At, B1); PG8_BAR;
            PG8_LDB(B0, 1, 0); PG8_SCHED; PG8_LDA(At, 1, 0); PG8_STAGE(PG8_SA(0, 1), a2 + hstep, voffA);
            PG8_WAIT_L(8); PG8_BAR; PG8_WAIT_L(0); PG8_MMA(0, 0, At, B0); PG8_BAR; PG8_SCHED;
            PG8_LDB(B1, 1, 1); PG8_STAGE(PG8_SB(1, 0), b3, voffB);
            PG8_BAR; PG8_WAIT_L(0); PG8_MMA(0, 1, At, B1); PG8_BAR;
            PG8_LDA(At, 1, 1); PG8_STAGE(PG8_SA(1, 0), a3, voffA);
            PG8_BAR; PG8_WAIT_L(0); PG8_MMA(1, 0, At, B0); PG8_BAR; PG8_SCHED;
            PG8_STAGE(PG8_SB(1, 1), b3 + hstep, voffB);
            PG8_WAIT_V(6); PG8_BAR; PG8_MMA(1, 1, At, B1); PG8_BAR;
        }
        PG8_STAMP();
        if constexpr (!Epi::AFTER_DRAIN) {
            if constexpr (Epi::REALIGN) { if (wr == 0) PG8_BAR; }
            E(acc, cur, wr, wc, fr, fq); S.done(cur);
            if constexpr (Epi::REALIGN) { if (wr == 1) PG8_BAR; }
        }
        PG8_STAMP();
        if (!has_next) break;
#pragma unroll
        for (int a = 0; a < 2; ++a)
#pragma unroll
            for (int b = 0; b < 2; ++b)
#pragma unroll
                for (int m = 0; m < 4; ++m)
#pragma unroll
                    for (int n = 0; n < 2; ++n) acc[a][b][m][n] = (f32x4){0.f, 0.f, 0.f, 0.f};
        cur = nxt; cA = nA; cB = nB; ++ui;
    }
    PG8_WAIT_V(0);
    if (wr == 0) PG8_BAR;
    PG8_BAR;
    if constexpr (Epi::AFTER_DRAIN) { E.fused(acc, cur, wr, wc, fr, fq, lds, wid, lane); S.done(cur); }
    PG8_STAMP();
    if (STAMP && wid == 0) { stamps[lane] = lane < nts ? (((unsigned long long)(unsigned)ts_hi << 32) | (unsigned)ts_lo) : 0ull;
        if (lane == 62) stamps[62] = rt_entry; if (lane == 63) stamps[63] = (unsigned long long)wall_clock64(); }
#undef PG8_STAMP
#undef PG8_SA
#undef PG8_SB
#undef PG8_STAGE
#undef PG8_LDA
#undef PG8_LDB
#undef PG8_MMA
#undef PG8_WAIT_V
#undef PG8_WAIT_L
#undef PG8_BAR
#undef PG8_SCHED
}
}
#define LAS __attribute__((address_space(3)))
#define XB_TMO      128
#define XB_XCNT(j)  (256  + 64 * (j))
#define XB_XSUB(j)  (1280 + 64 * (j))
#define XB_XGEN(j)  (2304 + 64 * (j))
#define XB_TOP      3328
#define XB_TOPGEN   3392
#define XCD_BAR_WORDS 3456
#define XB_SPIN_CAP (1u << 18)

__device__ __forceinline__ unsigned xb_ld(unsigned* p)              { return __hip_atomic_load(p, __ATOMIC_RELAXED, __HIP_MEMORY_SCOPE_AGENT); }
__device__ __forceinline__ unsigned xb_add(unsigned* p, unsigned v) { return __hip_atomic_fetch_add(p, v, __ATOMIC_RELAXED, __HIP_MEMORY_SCOPE_AGENT); }
__device__ __forceinline__ unsigned xb_xcc_id() { return (unsigned)__builtin_amdgcn_s_getreg((3 << 11) | 20) & 0xFu; }
#define XB_SPIN(cond, bar) do { unsigned _sp = 0; while (cond) { __builtin_amdgcn_s_sleep(1); \
    if ((++_sp & 255u) == 0u) { if (xb_ld(&(bar)[XB_TMO])) break; if (_sp > XB_SPIN_CAP) { atomicAdd(&(bar)[XB_TMO], 1u); break; } } } } while (0)

struct XcdBarrier {
    unsigned* bar; unsigned x;
    volatile LAS unsigned* st;
};

__device__ __forceinline__ XcdBarrier xcd_barrier_post(unsigned* bar, volatile LAS unsigned* st) {
    XcdBarrier b; b.bar = bar; b.x = xb_xcc_id(); b.st = st;
    if (threadIdx.x == 0) (void)xb_add(&bar[XB_XCNT(b.x)], 1u);
    return b;
}
__device__ __forceinline__ void xcd_barrier_complete(unsigned* bar, unsigned x, unsigned& nloc, unsigned& nx) {
    const unsigned G = gridDim.x * gridDim.y * gridDim.z;
    unsigned sum, cnt, mine, sp = 0u;
    for (;;) {
        sum = 0u; cnt = 0u; mine = 0u;
#pragma unroll
        for (unsigned j = 0; j < 16; ++j) { const unsigned c = xb_ld(&bar[XB_XCNT(j)]); sum += c; cnt += (c > 0u) ? 1u : 0u; mine = (j == x) ? c : mine; }
        if (sum == G) break;
        __builtin_amdgcn_s_sleep(1);
        if ((++sp & 255u) == 0u) { if (xb_ld(&bar[XB_TMO])) break; if (sp > XB_SPIN_CAP) { atomicAdd(&bar[XB_TMO], 1u); break; } }
    }
    nloc = mine > 0u ? mine : 1u; nx = cnt > 0u ? cnt : 1u;
}

__device__ __forceinline__ void xcd_barrier(const XcdBarrier& b) {
    asm volatile("s_waitcnt vmcnt(0)" ::: "memory");
    __syncthreads();
    if (threadIdx.x == 0) {
        unsigned* bar = b.bar;
        __builtin_amdgcn_s_waitcnt(0);
        unsigned nloc = b.st[0], nx = b.st[1];
        if (nloc == 0u) { xcd_barrier_complete(bar, b.x, nloc, nx); b.st[0] = nloc; b.st[1] = nx; }
        const unsigned old = xb_add(&bar[XB_XSUB(b.x)], 1u);
        const unsigned gen = old / nloc;
        if (old + 1u == (gen + 1u) * nloc) {
            __builtin_amdgcn_fence(__ATOMIC_RELEASE, "agent");
            asm volatile("s_waitcnt vmcnt(0)" ::: "memory");
            const unsigned og = xb_add(&bar[XB_TOP], 1u);
            const unsigned tg = og / nx;
            if (og + 1u == (tg + 1u) * nx) xb_add(&bar[XB_TOPGEN], 1u);
            else XB_SPIN(xb_ld(&bar[XB_TOPGEN]) == tg, bar);
            __builtin_amdgcn_fence(__ATOMIC_ACQUIRE, "agent");
            xb_add(&bar[XB_XGEN(b.x)], 1u);
            asm volatile("s_waitcnt vmcnt(0)" ::: "memory");
        } else {
            XB_SPIN(xb_ld(&bar[XB_XGEN(b.x)]) == gen, bar);
            __builtin_amdgcn_fence(__ATOMIC_ACQUIRE, "agent");
            asm volatile("s_waitcnt vmcnt(0)" ::: "memory");
        }
    }
    __syncthreads();
}


#define DI __device__ __forceinline__

using pg8::bf16_t; using pg8::bf16x8; using pg8::f32x4; using pg8::f32x2; using pg8::u32x4; using pg8::Unit;
typedef unsigned u32x2 __attribute__((ext_vector_type(2)));
typedef short s16x4 __attribute__((ext_vector_type(4)));
typedef __bf16 bf2_t __attribute__((ext_vector_type(2)));

constexpr int NB = 8, T = 4096, D = 1024, NTOK = NB * T, CTXL = 256, NCTX = NB * CTXL, NP = 3072, NC = 32;
constexpr int NTHREADS = 512;
constexpr int LDS_BYTES = 147456 + 256;
constexpr float EPS = 1e-6f, LOG2E = 1.4426950408889634f;

constexpr size_t al256(size_t x) { return (x + 255) & ~(size_t)255; }
constexpr size_t WS_MOD  = 0;
constexpr size_t WS_ROPE = WS_MOD + al256(9 * 3072 * 4);
constexpr size_t WS_WIN  = WS_ROPE + 8192;
constexpr size_t WS_WOUT = WS_WIN + (size_t)3072 * 1024 * 2;
constexpr size_t WS_WSB  = WS_WOUT + (size_t)1024 * 1024 * 2;
constexpr size_t WS_H    = WS_WSB + (size_t)4 * 128 * 128 * 2;
constexpr size_t WS_Q    = WS_H + (size_t)(NTOK + NCTX) * 1024 * 2;
constexpr size_t WS_K    = WS_Q + (size_t)NTOK * 256 * 2;
constexpr size_t WS_V    = WS_K + (size_t)NTOK * 256 * 2;
constexpr size_t WS_GR   = WS_V + (size_t)NTOK * 512 * 2;
constexpr size_t WS_U    = WS_GR + (size_t)NTOK * 512 * 2;
constexpr size_t WS_VG   = WS_U + (size_t)NTOK * 512 * 2;
constexpr size_t WS_GM   = WS_VG + (size_t)NTOK * 512 * 2;
constexpr size_t WS_KC   = WS_GM + (size_t)NTOK * 512 * 2;
constexpr size_t WS_VC   = WS_KC + (size_t)NCTX * 256 * 2;
constexpr size_t WS_KV   = WS_VC + (size_t)NCTX * 512 * 2;
constexpr size_t WS_KVC  = WS_KV + (size_t)1024 * 2 * 8192 * 4;
constexpr size_t WS_ST   = WS_KVC + (size_t)64 * 2 * 8192 * 4;
constexpr size_t WS_BAR  = WS_ST + (size_t)1024 * 2 * 8192 * 2;
constexpr size_t WS_CNT  = WS_BAR + (size_t)XCD_BAR_WORDS * 4;
constexpr size_t WS_SLOT = WS_CNT + 32768;
constexpr size_t WS_END  = WS_SLOT + (size_t)NTOK * 16 * 4;

struct Args {
    const float* x; const float* c; const float* ctx; const float* c_ctx; const float* w_ada; const float* b_ada; const float* norm_w; const float* w_in;
    const float* dec_f; const float* dec_b; const float* gn_w; const float* ln_w; const float* w_s; const float* b_s; const float* w_out; const float* fnorm_w;
    float* out; unsigned char* ws; int ph_lo, ph_hi;
};

DI unsigned pk2(float lo, float hi) { f32x2 v = {lo, hi}; bf2_t r = __builtin_convertvector(v, bf2_t); return __builtin_bit_cast(unsigned, r); }
DI f32x4 ldnt_f4(const float* p) { return __builtin_nontemporal_load((const f32x4*)p); }
DI u32x4 ldnt_u4(const void* p) { return __builtin_nontemporal_load((const u32x4*)p); }
DI u32x2 ldnt_u2(const void* p) { return __builtin_nontemporal_load((const u32x2*)p); }
DI float bflo(unsigned w) { return __uint_as_float(w << 16); }
DI float bfhi(unsigned w) { return __uint_as_float(w & 0xffff0000u); }
DI float silu_f(float v) { return v * __builtin_amdgcn_rcpf(1.0f + __expf(-v)); }
DI void lds_barrier() { asm volatile("s_waitcnt lgkmcnt(0)" ::: "memory"); __builtin_amdgcn_s_barrier(); asm volatile("" ::: "memory"); }
DI f32x4 mfma16(bf16x8 a, bf16x8 b, f32x4 c) { return __builtin_amdgcn_mfma_f32_16x16x32_bf16(a, b, c, 0, 0, 0); }

DI bf16x8 frag_tr(LAS const unsigned char* base, int S, int k0, int n0, int lane) {
    const int i = lane & 15, g = lane >> 4;
    LAS const unsigned char* p = base + (k0 + 4 * g + (i >> 2)) * S + (n0 + 4 * (i & 3)) * 2;
    const s16x4 lo = __builtin_amdgcn_ds_read_tr16_b64_v4i16((LAS s16x4*)p);
    const s16x4 hi = __builtin_amdgcn_ds_read_tr16_b64_v4i16((LAS s16x4*)(p + 16 * S));
    return __builtin_shufflevector(lo, hi, 0, 1, 2, 3, 4, 5, 6, 7);
}
DI bf16x8 frag_rowP(const bf16_t* rowk0, int g) {
    const u32x2 lo = *(const u32x2*)(rowk0 + 4 * g), hi = *(const u32x2*)(rowk0 + 16 + 4 * g);
    const u32x4 v = {lo.x, lo.y, hi.x, hi.y}; return __builtin_bit_cast(bf16x8, v);
}
DI bf16x8 frag_rowP_lds(LAS const unsigned char* rowk0, int g) {
    const u32x2 lo = *(LAS const u32x2*)(rowk0 + 8 * g), hi = *(LAS const u32x2*)(rowk0 + 32 + 8 * g);
    const u32x4 v = {lo.x, lo.y, hi.x, hi.y}; return __builtin_bit_cast(bf16x8, v);
}
DI bf16x8 scale_frag(bf16x8 f, float s) {
    const u32x4 u = __builtin_bit_cast(u32x4, f); u32x4 r;
#pragma unroll
    for (int q = 0; q < 4; ++q) r[q] = pk2(bflo(u[q]) * s, bfhi(u[q]) * s);
    return __builtin_bit_cast(bf16x8, r);
}

struct EpiIn {
    static constexpr bool PERM = true, AFTER_DRAIN = false, REALIGN = false;
    unsigned char* ws;
    DI void operator()(const f32x4 (&acc)[2][2][4][2], const Unit& u, int wr, int wc, int fr, int fq) const {
        const int pn = u.pn, rbase = u.pm * 256 + wr * 64 + fr, cbase = wc * 32 + 8 * fq;
        if (u.pm >= 128) {
            bf16_t* dst = (bf16_t*)(ws + (pn == 1 ? WS_KC : WS_VC));
            const float scl = pn == 1 ? 0.125f : 1.0f;
#pragma unroll
            for (int ai = 0; ai < 2; ++ai)
#pragma unroll
                for (int m = 0; m < 4; ++m) {
                    const int rc = rbase + ai * 128 + m * 16 - NTOK, b = rc >> 8, t = rc & 255;
#pragma unroll
                    for (int bj = 0; bj < 2; ++bj) {
                        const f32x4 v0 = acc[ai][bj][m][0] * scl, v1 = acc[ai][bj][m][1] * scl;
                        const u32x4 o = {pk2(v0[0], v0[1]), pk2(v0[2], v0[3]), pk2(v1[0], v1[1]), pk2(v1[2], v1[3])};
                        size_t off;
                        if (pn == 1) { const int head = bj * 2 + (wc >> 1), d0 = (wc & 1) * 32 + 8 * fq; off = ((size_t)((b * 4 + head) * 256 + t)) * 64 + d0; }
                        else { const int head = (pn - 2) * 2 + bj; off = ((size_t)((b * 4 + head) * 256 + t)) * 128 + cbase; }
                        *(u32x4*)(dst + off) = o;
                    }
                }
            return;
        }
        if (pn <= 1) {
            bf16_t* dst = (bf16_t*)(ws + (pn == 0 ? WS_Q : WS_K));
            const float scl = pn == 0 ? 1.0f : 0.125f;
            const float* rc = (const float*)(ws + WS_ROPE); const float* rs = rc + 1024;
            const int hh = wc & 1, fi0 = 8 * (fq & 1); const bool second = fq >= 2;
#pragma unroll
            for (int ai = 0; ai < 2; ++ai)
#pragma unroll
                for (int m = 0; m < 4; ++m) {
                    const int r = rbase + ai * 128 + m * 16, b = r >> 12, t = r & 4095, pos = hh ? (t & 63) : (t >> 6);
                    const f32x4 c0 = *(const f32x4*)(rc + pos * 16 + fi0), c1 = *(const f32x4*)(rc + pos * 16 + fi0 + 4);
                    const f32x4 s0 = *(const f32x4*)(rs + pos * 16 + fi0), s1 = *(const f32x4*)(rs + pos * 16 + fi0 + 4);
#pragma unroll
                    for (int bj = 0; bj < 2; ++bj) {
                        const f32x4 v0 = acc[ai][bj][m][0], v1 = acc[ai][bj][m][1];
                        float o[8];
#pragma unroll
                        for (int j = 0; j < 4; ++j) {
                            const float xa = v0[j], xb = v1[j], pa = __shfl_xor(xa, 32), pb = __shfl_xor(xb, 32);
                            o[j]     = (second ? (pa * s0[j] + xa * c0[j]) : (xa * c0[j] - pa * s0[j])) * scl;
                            o[4 + j] = (second ? (pb * s1[j] + xb * c1[j]) : (xb * c1[j] - pb * s1[j])) * scl;
                        }
                        const u32x4 ov = {pk2(o[0], o[1]), pk2(o[2], o[3]), pk2(o[4], o[5]), pk2(o[6], o[7])};
                        const int head = bj * 2 + (wc >> 1), d0 = hh * 32 + 8 * fq;
                        *(u32x4*)(dst + ((size_t)((b * 4 + head) * 4096 + t)) * 64 + d0) = ov;
                    }
                }
            return;
        }
        if (pn <= 3) {
            bf16_t* dst = (bf16_t*)(ws + WS_V);
#pragma unroll
            for (int ai = 0; ai < 2; ++ai)
#pragma unroll
                for (int m = 0; m < 4; ++m) {
                    const int r = rbase + ai * 128 + m * 16, b = r >> 12, t = r & 4095;
#pragma unroll
                    for (int bj = 0; bj < 2; ++bj) {
                        const f32x4 v0 = acc[ai][bj][m][0], v1 = acc[ai][bj][m][1];
                        const u32x4 o = {pk2(v0[0], v0[1]), pk2(v0[2], v0[3]), pk2(v1[0], v1[1]), pk2(v1[2], v1[3])};
                        const int head = (pn - 2) * 2 + bj;
                        *(u32x4*)(dst + ((size_t)((b * 4 + head) * 4096 + t)) * 128 + cbase) = o;
                    }
                }
            return;
        }
        if (pn == 6 || pn == 7 || pn >= 10) {
            const int t = pn == 6 ? 0 : (pn == 7 ? 1 : (pn == 10 ? 2 : 3));
            bf16_t* dst = (bf16_t*)(ws + WS_U);
#pragma unroll
            for (int ai = 0; ai < 2; ++ai)
#pragma unroll
                for (int m = 0; m < 4; ++m) {
                    const int r = rbase + ai * 128 + m * 16;
                    const f32x4 u0 = acc[ai][0][m][0], u1 = acc[ai][0][m][1], g0 = acc[ai][1][m][0], g1 = acc[ai][1][m][1];
                    const f32x2 a0 = pg8::gelu_pk((f32x2){u0[0], u0[1]}), a1 = pg8::gelu_pk((f32x2){u0[2], u0[3]}), a2 = pg8::gelu_pk((f32x2){u1[0], u1[1]}), a3 = pg8::gelu_pk((f32x2){u1[2], u1[3]});
                    const u32x4 o = {pk2(a0.x * silu_f(g0[0]), a0.y * silu_f(g0[1])), pk2(a1.x * silu_f(g0[2]), a1.y * silu_f(g0[3])),
                                     pk2(a2.x * silu_f(g1[0]), a2.y * silu_f(g1[1])), pk2(a3.x * silu_f(g1[2]), a3.y * silu_f(g1[3]))};
                    *(u32x4*)(dst + (size_t)r * 512 + 128 * t + cbase) = o;
                }
            return;
        }
        {
            const int region = (pn - 4) >> 1; const bool is_gelu = (region == 1) || (region == 2);
            bf16_t* dst = (bf16_t*)(ws + WS_GR + (size_t)region * ((size_t)NTOK * 512 * 2));
            const int colb = ((pn - 4) & 1) * 256 + cbase;
#pragma unroll
            for (int ai = 0; ai < 2; ++ai)
#pragma unroll
                for (int m = 0; m < 4; ++m) {
                    const int r = rbase + ai * 128 + m * 16;
#pragma unroll
                    for (int bj = 0; bj < 2; ++bj) {
                        const f32x4 v0 = acc[ai][bj][m][0], v1 = acc[ai][bj][m][1];
                        u32x4 o;
                        if (is_gelu) {
                            const f32x2 a = pg8::gelu_pk((f32x2){v0[0], v0[1]}), bq = pg8::gelu_pk((f32x2){v0[2], v0[3]}), cq = pg8::gelu_pk((f32x2){v1[0], v1[1]}), dq = pg8::gelu_pk((f32x2){v1[2], v1[3]});
                            o = (u32x4){pk2(a.x, a.y), pk2(bq.x, bq.y), pk2(cq.x, cq.y), pk2(dq.x, dq.y)};
                        } else {
                            o = (u32x4){pk2(silu_f(v0[0]), silu_f(v0[1])), pk2(silu_f(v0[2]), silu_f(v0[3])), pk2(silu_f(v1[0]), silu_f(v1[1])), pk2(silu_f(v1[2]), silu_f(v1[3]))};
                        }
                        *(u32x4*)(dst + (size_t)r * 512 + colb + bj * 128) = o;
                    }
                }
        }
    }
};
struct EpiOut {
    static constexpr bool PERM = false, AFTER_DRAIN = false, REALIGN = true;
    const float* x; const float* mod; const float* fw; float* out; float* slots; unsigned* cnt;
    DI void operator()(const f32x4 (&acc_)[2][2][4][2], const Unit& u, int wr, int wc, int fr, int fq) const {
        f32x4 (&acc)[2][2][4][2] = const_cast<f32x4 (&)[2][2][4][2]>(acc_);
        const int rbase = u.pm * 256 + wr * 64 + fr, cbase = u.pn * 256 + wc * 32 + 4 * fq;
        const float* gate = mod + (size_t)(rbase >> 12) * 3072 + 2048;
        f32x4 gv[2][2];
#pragma unroll
        for (int bj = 0; bj < 2; ++bj)
#pragma unroll
            for (int n = 0; n < 2; ++n) gv[bj][n] = *(const f32x4*)(gate + cbase + bj * 128 + n * 16);
        f32x4 xv[2][4]; float ss[8];
#pragma unroll
        for (int q = 0; q < 4; ++q) xv[0][q] = ldnt_f4(x + (size_t)rbase * 1024 + cbase + (q >> 1) * 128 + (q & 1) * 16);
#pragma unroll
        for (int k = 0; k < 8; ++k) {
            const int ai = k >> 2, m = k & 3;
            if (k + 1 < 8) {
                const size_t ro = (size_t)(rbase + ((k + 1) >> 2) * 128 + ((k + 1) & 3) * 16) * 1024 + cbase;
#pragma unroll
                for (int q = 0; q < 4; ++q) xv[(k + 1) & 1][q] = ldnt_f4(x + ro + (q >> 1) * 128 + (q & 1) * 16);
            }
            float sk = 0.f;
#pragma unroll
            for (int q = 0; q < 4; ++q) {
                const int bj = q >> 1, n = q & 1;
                const f32x4 v = xv[k & 1][q] + gv[bj][n] * acc[ai][bj][m][n];
                acc[ai][bj][m][n] = v;
                sk += v[0] * v[0] + v[1] * v[1] + v[2] * v[2] + v[3] * v[3];
            }
            ss[k] = sk;
        }
#pragma unroll
        for (int k = 0; k < 8; ++k) { ss[k] += __shfl_xor(ss[k], 16); ss[k] += __shfl_xor(ss[k], 32); }
        if (fq == 0) {
#pragma unroll
            for (int k = 0; k < 8; ++k)
                __hip_atomic_store(slots + (size_t)(rbase + (k >> 2) * 128 + (k & 3) * 16) * 16 + u.pn * 4 + wc, ss[k], __ATOMIC_RELAXED, __HIP_MEMORY_SCOPE_AGENT);
        }
        asm volatile("s_waitcnt vmcnt(0)" ::: "memory");
        if ((threadIdx.x & 63) == 0) {
            __hip_atomic_fetch_add(cnt + u.pm * 64, 1u, __ATOMIC_RELAXED, __HIP_MEMORY_SCOPE_AGENT);
            unsigned spins = 0;
            while (__hip_atomic_load(cnt + u.pm * 64, __ATOMIC_RELAXED, __HIP_MEMORY_SCOPE_AGENT) < 32u) { __builtin_amdgcn_s_sleep(8); if (++spins > (1u << 22)) break; }
        }
        __builtin_amdgcn_fence(__ATOMIC_ACQUIRE, "agent");
        asm volatile("s_waitcnt vmcnt(0)" ::: "memory");
        f32x4 sl[8];
#pragma unroll
        for (int k = 0; k < 8; ++k) sl[k] = *(const f32x4*)(slots + (size_t)(rbase + (k >> 2) * 128 + (k & 3) * 16) * 16 + fq * 4);
        f32x4 fv[2][2];
#pragma unroll
        for (int bj = 0; bj < 2; ++bj)
#pragma unroll
            for (int n = 0; n < 2; ++n) fv[bj][n] = *(const f32x4*)(fw + cbase + bj * 128 + n * 16);
        float rs[8];
#pragma unroll
        for (int k = 0; k < 8; ++k) {
            float t = (sl[k][0] + sl[k][1]) + (sl[k][2] + sl[k][3]);
            t += __shfl_xor(t, 16); t += __shfl_xor(t, 32);
            rs[k] = rsqrtf(t * (1.0f / 1024.0f) + EPS);
        }
#pragma unroll
        for (int k = 0; k < 8; ++k) {
            const int ai = k >> 2, m = k & 3;
            const size_t ro = (size_t)(rbase + ai * 128 + m * 16) * 1024 + cbase;
#pragma unroll
            for (int bj = 0; bj < 2; ++bj)
#pragma unroll
                for (int n = 0; n < 2; ++n) __builtin_nontemporal_store(acc[ai][bj][m][n] * rs[k] * fv[bj][n], (f32x4*)(out + ro + bj * 128 + n * 16));
        }
    }
};
struct SchedIn {
    pg8::StaticOrder so;
    DI bool next(int i, Unit& u) const {
        if (so.G == 256) {
            const int x = so.c & 7, j = so.c >> 3;
            if (j < 3) {
                if (i == 0) { u.pm = 128 + x; u.pn = 1 + j; return true; }
                if (i > 6) return false;
                const int q = 6 * j + (i - 1);
                u.pm = 16 * x + (q >> 2); u.pn = q & 3; return true;
            }
            if (i > 5) return false;
            const int e = (j - 3) + 29 * i;
            if (e < 64) { u.pm = 16 * x + (e >> 2); u.pn = 6 + (e & 3); }
            else if (e < 128) { const int t = e & 3; u.pm = 16 * x + ((e - 64) >> 2); u.pn = t < 2 ? 4 + t : 8 + t; }
            else { const int q = 18 + (e - 128); u.pm = 16 * x + (q >> 2); u.pn = q & 3; }
            return true;
        }
        long L = (long)i * so.G + so.c;
        if (L < so.nwg) return so.next(i, u);
        L -= so.nwg; if (L >= 24) return false;
        u.pm = 128 + (int)(L / 3); u.pn = 1 + (int)(L % 3); return true;
    }
    DI void a_ready(const Unit&) const {}
    DI void done(const Unit&) const {}
};

DI void phase0(const Args& a, LAS unsigned char* lds) {
    const int tid = threadIdx.x;
    float* mod = (float*)(a.ws + WS_MOD);
    LAS float* red = (LAS float*)lds;
    for (int it = blockIdx.x; it < 1233; it += gridDim.x) {
        if (it < 192) {
            const int c0 = it * 16, f = tid & 3, rg = tid >> 2;
            LAS float* scv = red + 36 * 512;
            for (int q = tid; q < 9 * 1024; q += NTHREADS) { const float cv = (q < 8192) ? a.c[q] : a.c_ctx[q - 8192]; scv[q] = cv / (1.0f + expf(-cv)); }
            __syncthreads();
            float acc[9][4];
#pragma unroll
            for (int j = 0; j < 9; ++j)
#pragma unroll
                for (int e = 0; e < 4; ++e) acc[j][e] = 0.f;
            f32x4 wv[8];
#pragma unroll
            for (int i = 0; i < 8; ++i) wv[i] = ldnt_f4(a.w_ada + (size_t)(rg + 128 * i) * 3072 + c0 + f * 4);
#pragma unroll
            for (int i = 0; i < 8; ++i) {
                const int r = rg + 128 * i;
#pragma unroll
                for (int j = 0; j < 9; ++j) {
                    const float sv = scv[j * 1024 + r];
#pragma unroll
                    for (int e = 0; e < 4; ++e) acc[j][e] += sv * wv[i][e];
                }
            }
#pragma unroll
            for (int j = 0; j < 9; ++j)
#pragma unroll
                for (int e = 0; e < 4; ++e) red[(j * 4 + e) * 512 + tid] = acc[j][e];
            __syncthreads();
            if (tid < 144) {
                const int j = tid >> 4, cc = tid & 15, ff = cc >> 2, e = cc & 3;
                float s = 0.f;
                for (int q = 0; q < 128; ++q) s += red[(j * 4 + e) * 512 + q * 4 + ff];
                mod[j * 3072 + c0 + cc] = s + a.b_ada[c0 + cc];
            }
            __syncthreads();
        } else if (it < 1216) {
            const bool is_in = it < 960; const int tt = is_in ? it - 192 : it - 960;
            const int nN = is_in ? 48 : 16, NN = is_in ? 3072 : 1024;
            const int k0 = (tt / nN) * 64, n0 = (tt % nN) * 64;
            int ns = n0;
            if (is_in && ((n0 >= 1536 && n0 < 2048) || n0 >= 2560)) {
                const int base = n0 >= 2560 ? 2560 : 1536, t = (n0 >= 2560 ? 2 : 0) + (n0 - base) / 256, w = (n0 - base) % 256;
                ns = (w < 128 ? 1536 : 2560 - 128) + 128 * t + w;
            }
            const float* src = is_in ? a.w_in : a.w_out;
            bf16_t* dst = (bf16_t*)(a.ws + (is_in ? WS_WIN : WS_WOUT));
            const int kr = tid >> 4, n4 = tid & 15;
#pragma unroll
            for (int p = 0; p < 2; ++p) {
                const int k = kr + 32 * p;
                const f32x4 v = ldnt_f4(src + (size_t)(k0 + k) * NN + ns + n4 * 4);
#pragma unroll
                for (int e = 0; e < 4; ++e) red[k * 65 + n4 * 4 + e] = v[e];
            }
            __syncthreads();
            const int n = tid >> 3, k8 = tid & 7;
            float v[8];
#pragma unroll
            for (int j = 0; j < 8; ++j) v[j] = red[(k8 * 8 + j) * 65 + n];
            const u32x4 o = {pk2(v[0], v[1]), pk2(v[2], v[3]), pk2(v[4], v[5]), pk2(v[6], v[7])};
            *(u32x4*)(dst + (size_t)(n0 + n) * 1024 + k0 + k8 * 8) = o;
            __syncthreads();
        } else if (it < 1232) {
            const size_t base = (size_t)(it - 1216) * 4096 + tid * 8;
            const f32x4 v0 = *(const f32x4*)(a.w_s + base), v1 = *(const f32x4*)(a.w_s + base + 4);
            const u32x4 o = {pk2(v0[0], v0[1]), pk2(v0[2], v0[3]), pk2(v1[0], v1[1]), pk2(v1[2], v1[3])};
            *(u32x4*)((bf16_t*)(a.ws + WS_WSB) + base) = o;
        } else {
            float* rc = (float*)(a.ws + WS_ROPE); float* rs = rc + 1024;
            for (int idx = tid; idx < 1024; idx += NTHREADS) {
                const int pos = idx >> 4, fi = idx & 15;
                const float inv = powf(10000.0f, -(float)fi / 16.0f), ang = (float)pos * inv;
                rc[idx] = cosf(ang); rs[idx] = sinf(ang);
            }
        }
    }
}

template <int R> DI void norm_rows(const Args& a, const float* mod, bf16_t* H, const int (&rows)[R], int lane) {
    f32x4 v[R][4]; const float* mrow[R];
#pragma unroll
    for (int k = 0; k < R; ++k) {
        const int r = rows[k]; const float* src; int j;
        if (r < NTOK) { src = a.x + (size_t)r * 1024; j = r >> 12; } else { src = a.ctx + (size_t)(r - NTOK) * 1024; j = 8; }
        mrow[k] = mod + j * 3072;
#pragma unroll
        for (int q = 0; q < 4; ++q) v[k][q] = ldnt_f4(src + q * 256 + lane * 4);
    }
#pragma unroll
    for (int k = 0; k < R; ++k) {
        float ss = 0.f;
#pragma unroll
        for (int q = 0; q < 4; ++q) ss += v[k][q][0] * v[k][q][0] + v[k][q][1] * v[k][q][1] + v[k][q][2] * v[k][q][2] + v[k][q][3] * v[k][q][3];
#pragma unroll
        for (int off = 32; off >= 1; off >>= 1) ss += __shfl_xor(ss, off);
        const float rstd = rsqrtf(ss * (1.0f / 1024.0f) + EPS);
#pragma unroll
        for (int q = 0; q < 4; ++q) {
            const int cidx = q * 256 + lane * 4;
            const f32x4 nw = *(const f32x4*)(a.norm_w + cidx), sc = *(const f32x4*)(mrow[k] + 1024 + cidx), sh = *(const f32x4*)(mrow[k] + cidx);
            f32x4 hv;
#pragma unroll
            for (int e = 0; e < 4; ++e) hv[e] = (v[k][q][e] * rstd * nw[e]) * (1.0f + sc[e]) + sh[e];
            const u32x2 o = {pk2(hv[0], hv[1]), pk2(hv[2], hv[3])};
            *(u32x2*)(H + (size_t)rows[k] * 1024 + cidx) = o;
        }
    }
}
DI void norm_row(const Args& a, const float* mod, bf16_t* H, int r, int lane) { const int rows[1] = {r}; norm_rows<1>(a, mod, H, rows, lane); }
DI void phase1(const Args& a) {
    const int tid = threadIdx.x, wave = tid >> 6, lane = tid & 63, blk = blockIdx.x, G = gridDim.x;
    const float* mod = (const float*)(a.ws + WS_MOD);
    bf16_t* H = (bf16_t*)(a.ws + WS_H);
    constexpr int NCH = (NTOK + NCTX) / 8;
    int ch = blk;
    for (; ch + 3 * G < NCH; ch += 4 * G) { const int rows[4] = {ch * 8 + wave, (ch + G) * 8 + wave, (ch + 2 * G) * 8 + wave, (ch + 3 * G) * 8 + wave}; norm_rows<4>(a, mod, H, rows, lane); }
    for (; ch < NCH; ch += G) norm_row(a, mod, H, ch * 8 + wave, lane);
}

constexpr int VS = 288, KS = 144, KS2 = 160;
DI void gmlp_unit(const Args& a, LAS unsigned char* lds, int b, int c) {
    const int tid = threadIdx.x, lane = tid & 63, w = tid >> 6, i = lane & 15, g = lane >> 4;
    const int r0 = b * 4096 + c * 128;
    const bf16_t* VG = (const bf16_t*)(a.ws + WS_VG); const bf16_t* U = (const bf16_t*)(a.ws + WS_U);
    const bf16_t* WSB = (const bf16_t*)(a.ws + WS_WSB); bf16_t* Y = (bf16_t*)(a.ws + WS_H);
    constexpr int GSZ = 128 * VS;
    {
        const int row = tid >> 2, q = tid & 3;
        const bf16_t* src = VG + (size_t)(r0 + row) * 512 + q * 128;
        float s = 0.f, s2 = 0.f;
#pragma unroll 8
        for (int p = 0; p < 16; ++p) {
            const u32x4 pc = *(const u32x4*)(src + p * 8);
#pragma unroll
            for (int e = 0; e < 4; ++e) { const float lo = bflo(pc[e]), hi = bfhi(pc[e]); s += lo + hi; s2 += lo * lo + hi * hi; }
        }
        s += __shfl_xor(s, 1); s += __shfl_xor(s, 2); s2 += __shfl_xor(s2, 1); s2 += __shfl_xor(s2, 2);
        const float mean = s * (1.0f / 512.0f);
        const float var = fmaxf(s2 * (1.0f / 512.0f) - mean * mean, 0.f);
        const float rstd = rsqrtf(var + EPS);
        const float* lw = a.ln_w + q * 128;
#pragma unroll 4
        for (int p = 0; p < 16; ++p) {
            const u32x4 pc = *(const u32x4*)(src + p * 8);
            const f32x4 w0 = *(const f32x4*)(lw + p * 8), w1 = *(const f32x4*)(lw + p * 8 + 4);
            u32x4 o;
            o[0] = pk2((bflo(pc[0]) - mean) * rstd * w0[0], (bfhi(pc[0]) - mean) * rstd * w0[1]);
            o[1] = pk2((bflo(pc[1]) - mean) * rstd * w0[2], (bfhi(pc[1]) - mean) * rstd * w0[3]);
            o[2] = pk2((bflo(pc[2]) - mean) * rstd * w1[0], (bfhi(pc[2]) - mean) * rstd * w1[1]);
            o[3] = pk2((bflo(pc[3]) - mean) * rstd * w1[2], (bfhi(pc[3]) - mean) * rstd * w1[3]);
            *(LAS u32x4*)(lds + q * GSZ + row * VS + p * 16) = o;
        }
    }
    __syncthreads();
    const int n = 16 * w + i, r = r0 + n;
#pragma unroll 1
    for (int gq = 0; gq < 4; ++gq) {
        f32x4 acc[8];
#pragma unroll
        for (int et = 0; et < 8; ++et) acc[et] = (f32x4){0.f, 0.f, 0.f, 0.f};
        const bf16_t* wrow = WSB + (size_t)(gq * 128 + n) * 128;
        bf16x8 bw[4];
#pragma unroll
        for (int s = 0; s < 4; ++s) bw[s] = frag_rowP(wrow + 32 * s, g);
#pragma unroll
        for (int s = 0; s < 4; ++s) {
#pragma unroll
            for (int et = 0; et < 8; ++et) acc[et] = mfma16(frag_tr(lds + gq * GSZ, VS, 32 * s, 16 * et, lane), bw[s], acc[et]);
        }
        const float bias = a.b_s[gq * 128 + n];
#pragma unroll
        for (int et = 0; et < 8; ++et) {
            const int col = gq * 128 + 16 * et + 4 * g;
            const u32x2 uu = *(const u32x2*)(U + (size_t)r * 512 + col);
            const float y0 = bflo(uu.x) * (acc[et][0] + bias), y1 = bfhi(uu.x) * (acc[et][1] + bias);
            const float y2 = bflo(uu.y) * (acc[et][2] + bias), y3 = bfhi(uu.y) * (acc[et][3] + bias);
            const u32x2 o = {pk2(y0, y1), pk2(y2, y3)};
            *(u32x2*)(Y + (size_t)r * 1024 + 512 + col) = o;
        }
    }
    __syncthreads();
}
struct ChStage { u32x4 kf[2], kb[2], v; };
DI void chain_load(const Args& a, int bh, int es, int it, ChStage& st) {
    const int tid = threadIdx.x;
    const bf16_t *Kf, *Kb, *Vf, *Vb;
    if (it < 2) {
        const size_t of = (size_t)bh * 256 + it * 128, ob = (size_t)bh * 256 + (1 - it) * 128;
        Kf = (const bf16_t*)(a.ws + WS_KC) + of * 64; Vf = (const bf16_t*)(a.ws + WS_VC) + of * 128; Kb = (const bf16_t*)(a.ws + WS_KC) + ob * 64; Vb = (const bf16_t*)(a.ws + WS_VC) + ob * 128;
    } else {
        const size_t of = (size_t)bh * 4096 + (it - 2) * 128, ob = (size_t)bh * 4096 + (33 - it) * 128;
        Kf = (const bf16_t*)(a.ws + WS_K) + of * 64; Vf = (const bf16_t*)(a.ws + WS_V) + of * 128; Kb = (const bf16_t*)(a.ws + WS_K) + ob * 64; Vb = (const bf16_t*)(a.ws + WS_V) + ob * 128;
    }
#pragma unroll
    for (int q = 0; q < 2; ++q) { const int p = tid + 512 * q; st.kf[q] = *(const u32x4*)(Kf + (p >> 3) * 64 + (p & 7) * 8); st.kb[q] = *(const u32x4*)(Kb + (p >> 3) * 64 + (p & 7) * 8); }
    const int t = tid & 255; const bf16_t* Vx = (tid < 256) ? Vf : Vb;
    st.v = *(const u32x4*)(Vx + (t >> 1) * 128 + es * 16 + (t & 1) * 8);
}
DI void chain_item(const Args& a, LAS unsigned char* lds, int item) {
    const int tid = threadIdx.x, lane = tid & 63, w = tid >> 6, i = lane & 15, g = lane >> 4;
    const int bh = item >> 3, es = item & 7, h = bh & 3, dirw = w >> 2, dt = w & 3;
    const float l2f = -expf(a.dec_f[h]) * LOG2E, l2b = -expf(a.dec_b[h]) * LOG2E;
    const float G = exp2f(128.0f * (dirw ? l2b : l2f));
    constexpr int BUFSZ = 2 * 128 * KS2 + 2 * 128 * 32;
    float tf[2], tb[2];
#pragma unroll
    for (int q = 0; q < 2; ++q) { const int m = (tid >> 3) + 64 * q; tf[q] = exp2f((float)(127 - m) * l2f); tb[q] = exp2f((float)m * l2b); }
    bf16_t* ST = (bf16_t*)(a.ws + WS_ST);
    f32x4 S = {0.f, 0.f, 0.f, 0.f};
    ChStage st0, st1, st2, st3;
    chain_load(a, bh, es, 0, st0); chain_load(a, bh, es, 1, st1); chain_load(a, bh, es, 2, st2);
#define CH_STEP(IT, CUR, NXT, STORE) do { const int it = (IT); { \
        LAS unsigned char* buf = lds + (it & 1) * BUFSZ; \
        LAS unsigned char* KFs = buf; LAS unsigned char* KBs = buf + 128 * KS2; LAS unsigned char* VFs = buf + 2 * 128 * KS2; LAS unsigned char* VBs = VFs + 128 * 32; \
        _Pragma("unroll") for (int q = 0; q < 2; ++q) { \
            const int p = tid + 512 * q, m = p >> 3, d8 = p & 7; \
            u32x4 of, ob; \
            _Pragma("unroll") for (int e = 0; e < 4; ++e) { of[e] = pk2(bflo(CUR.kf[q][e]) * tf[q], bfhi(CUR.kf[q][e]) * tf[q]); ob[e] = pk2(bflo(CUR.kb[q][e]) * tb[q], bfhi(CUR.kb[q][e]) * tb[q]); } \
            *(LAS u32x4*)(KFs + m * KS2 + d8 * 16) = of; *(LAS u32x4*)(KBs + m * KS2 + d8 * 16) = ob; \
        } \
        { const int t = tid & 255; *(LAS u32x4*)((tid < 256 ? VFs : VBs) + (t >> 1) * 32 + (t & 1) * 16) = CUR.v; } \
        lds_barrier(); \
        chain_load(a, bh, es, (it + 3 < 34) ? it + 3 : 33, NXT);                  \
        LAS const unsigned char* Kx = dirw ? KBs : KFs; LAS const unsigned char* Vx = dirw ? VBs : VFs; \
        f32x4 kv = {0.f, 0.f, 0.f, 0.f}; \
        _Pragma("unroll") for (int s = 0; s < 4; ++s) kv = mfma16(frag_tr(Vx, 32, 32 * s, 0, lane), frag_tr(Kx, KS2, 32 * s, 16 * dt, lane), kv); \
        if (STORE) {                                                              \
            const int c = dirw ? 33 - it : it - 2; \
            const u32x2 o = {pk2(S[0], S[1]), pk2(S[2], S[3])}; \
            *(u32x2*)(ST + (((size_t)(bh * 32 + c) * 2 + dirw) * 64 + 16 * dt + i) * 128 + es * 16 + 4 * g) = o; \
        } \
        S = S * G + kv; } } while (0)
    CH_STEP(0, st0, st3, false); CH_STEP(1, st1, st0, false);
#pragma unroll 1
    for (int it4 = 2; it4 < 34; it4 += 4) {
        CH_STEP(it4, st2, st1, true); CH_STEP(it4 + 1, st3, st2, true); CH_STEP(it4 + 2, st0, st3, true); CH_STEP(it4 + 3, st1, st0, true);
    }
#undef CH_STEP
    __syncthreads();
}
DI void phase3(const Args& a, LAS unsigned char* lds) {
    for (int it = blockIdx.x; it < 256; it += gridDim.x) gmlp_unit(a, lds, it >> 5, it & 31);
    for (int it = blockIdx.x; it < 256; it += gridDim.x) { const int j = it >> 3; chain_item(a, lds, (((it & 7) * 4 + (j >> 3)) << 3) + (j & 7)); }
}

DI void phase4(const Args& a) {
    const float* KV = (const float*)(a.ws + WS_KV); const float* KVC = (const float*)(a.ws + WS_KVC);
    bf16_t* ST = (bf16_t*)(a.ws + WS_ST);
    for (int idx = blockIdx.x * NTHREADS + threadIdx.x; idx < 64 * 2048; idx += gridDim.x * NTHREADS) {
        const int chain = idx >> 11, pos = idx & 2047, bh = chain >> 1, dir = chain & 1, h = bh & 3;
        const float lg = -expf(dir ? a.dec_b[h] : a.dec_f[h]), G = expf(128.0f * lg);
        const f32x4 k0 = *(const f32x4*)(KVC + ((size_t)(bh * 2 + 0) * 2 + dir) * 8192 + pos * 4);
        const f32x4 k1 = *(const f32x4*)(KVC + ((size_t)(bh * 2 + 1) * 2 + dir) * 8192 + pos * 4);
        f32x4 S = dir ? (k1 * G + k0) : (k0 * G + k1);
#pragma unroll 8
        for (int step = 0; step < NC; ++step) {
            const int c = dir ? (NC - 1 - step) : step;
            const size_t off = ((size_t)(bh * 32 + c) * 2 + dir) * 8192 + pos * 4;
            const f32x4 kvv = *(const f32x4*)(KV + off);
            const u32x2 o = {pk2(S[0], S[1]), pk2(S[2], S[3])};
            *(u32x2*)(ST + off) = o;
            S = S * G + kvv;
        }
    }
}

struct RetStage { u32x4 k[2], v[4], sf[2], sb[2]; bf16x8 q[2]; };
DI void ret_load(const Args& a, int unit, RetStage& st) {
    const int tid = threadIdx.x, lane = tid & 63, w = tid >> 6, i = lane & 15, g = lane >> 4;
    const int bh = unit >> 5, c = unit & 31;
    const bf16_t* Qp = (const bf16_t*)(a.ws + WS_Q) + ((size_t)bh * 4096 + c * 128) * 64;
    const bf16_t* Kp = (const bf16_t*)(a.ws + WS_K) + ((size_t)bh * 4096 + c * 128) * 64;
    const bf16_t* Vp = (const bf16_t*)(a.ws + WS_V) + ((size_t)bh * 4096 + c * 128) * 128;
    const bf16_t* SFp = (const bf16_t*)(a.ws + WS_ST) + (size_t)unit * 16384; const bf16_t* SBp = SFp + 8192;
#pragma unroll
    for (int q = 0; q < 2; ++q) { const int p = tid + 512 * q; st.k[q] = *(const u32x4*)(Kp + (p >> 3) * 64 + (p & 7) * 8); }
#pragma unroll
    for (int q = 0; q < 4; ++q) { const int p = tid + 512 * q; st.v[q] = *(const u32x4*)(Vp + (p >> 4) * 128 + (p & 15) * 8); }
#pragma unroll
    for (int q = 0; q < 2; ++q) { const int p = tid + 512 * q; st.sf[q] = *(const u32x4*)(SFp + (p >> 4) * 128 + (p & 15) * 8); st.sb[q] = *(const u32x4*)(SBp + (p >> 4) * 128 + (p & 15) * 8); }
#pragma unroll
    for (int s = 0; s < 2; ++s) st.q[s] = frag_rowP(Qp + (16 * w + i) * 64 + 32 * s, g);
}
DI void ret_unit(const Args& a, LAS unsigned char* lds, int unit, RetStage& st, int next_unit) {
    const int tid = threadIdx.x, lane = tid & 63, w = tid >> 6, i = lane & 15, g = lane >> 4;
    const int bh = unit >> 5, c = unit & 31, b = bh >> 2, h = bh & 3;
    const bf16_t* GR = (const bf16_t*)(a.ws + WS_GR); bf16_t* Y = (bf16_t*)(a.ws + WS_H);
    LAS unsigned char* Kt = lds; LAS unsigned char* Vt = lds + 128 * KS; LAS unsigned char* SF = Vt + 128 * VS; LAS unsigned char* SB = SF + 64 * VS;
#pragma unroll
    for (int q = 0; q < 2; ++q) { const int p = tid + 512 * q; *(LAS u32x4*)(Kt + (p >> 3) * KS + (p & 7) * 16) = st.k[q]; }
#pragma unroll
    for (int q = 0; q < 4; ++q) { const int p = tid + 512 * q; *(LAS u32x4*)(Vt + (p >> 4) * VS + (p & 15) * 16) = st.v[q]; }
#pragma unroll
    for (int q = 0; q < 2; ++q) { const int p = tid + 512 * q; *(LAS u32x4*)(SF + (p >> 4) * VS + (p & 15) * 16) = st.sf[q]; *(LAS u32x4*)(SB + (p >> 4) * VS + (p & 15) * 16) = st.sb[q]; }
    bf16x8 Qf[2];
#pragma unroll
    for (int s = 0; s < 2; ++s) Qf[s] = st.q[s];
    lds_barrier();
    if (next_unit >= 0) ret_load(a, next_unit, st);
    const float l2f = -expf(a.dec_f[h]) * LOG2E, l2b = -expf(a.dec_b[h]) * LOG2E;
    const int n = 16 * w + i;

    f32x4 accS[8];
#pragma unroll
    for (int mt = 0; mt < 8; ++mt) {
        accS[mt] = (f32x4){0.f, 0.f, 0.f, 0.f};
#pragma unroll
        for (int s = 0; s < 2; ++s) accS[mt] = mfma16(frag_rowP_lds(Kt + (16 * mt + i) * KS + 64 * s, g), Qf[s], accS[mt]);
    }
#pragma unroll
    for (int mt = 0; mt < 8; ++mt)
#pragma unroll
        for (int reg = 0; reg < 4; ++reg) {
            const int diff = n - (16 * mt + 4 * g + reg);
            const float ex = __builtin_amdgcn_exp2f(diff > 0 ? (float)diff * l2f : (float)(-diff) * l2b);
            accS[mt][reg] *= (diff == 0 ? 2.0f : ex);
        }
    const float fsf = __builtin_amdgcn_exp2f((float)(n + 1) * l2f), fsb = __builtin_amdgcn_exp2f((float)(128 - n) * l2b);
    f32x4 accO[8];
#pragma unroll
    for (int et = 0; et < 8; ++et) accO[et] = (f32x4){0.f, 0.f, 0.f, 0.f};
#pragma unroll
    for (int s = 0; s < 4; ++s) {
        const u32x4 pu = {pk2(accS[2 * s][0], accS[2 * s][1]), pk2(accS[2 * s][2], accS[2 * s][3]), pk2(accS[2 * s + 1][0], accS[2 * s + 1][1]), pk2(accS[2 * s + 1][2], accS[2 * s + 1][3])};
        const bf16x8 Pf = __builtin_bit_cast(bf16x8, pu);
#pragma unroll
        for (int et = 0; et < 8; ++et) accO[et] = mfma16(frag_tr(Vt, VS, 32 * s, 16 * et, lane), Pf, accO[et]);
        __builtin_amdgcn_sched_barrier(0);
    }
#pragma unroll
    for (int s = 0; s < 2; ++s) {
        const bf16x8 qsf = scale_frag(Qf[s], fsf), qsb = scale_frag(Qf[s], fsb);
#pragma unroll
        for (int et = 0; et < 8; ++et) {
            accO[et] = mfma16(frag_tr(SF, VS, 32 * s, 16 * et, lane), qsf, accO[et]);
            accO[et] = mfma16(frag_tr(SB, VS, 32 * s, 16 * et, lane), qsb, accO[et]);
        }
        __builtin_amdgcn_sched_barrier(0);
    }
    float sm = 0.f;
#pragma unroll
    for (int et = 0; et < 8; ++et) sm += accO[et][0] + accO[et][1] + accO[et][2] + accO[et][3];
    sm += __shfl_xor(sm, 16); sm += __shfl_xor(sm, 32);
    const float mean = sm * (1.0f / 128.0f);
    float v2 = 0.f;
#pragma unroll
    for (int et = 0; et < 8; ++et)
#pragma unroll
        for (int e = 0; e < 4; ++e) { const float d0 = accO[et][e] - mean; v2 += d0 * d0; }
    v2 += __shfl_xor(v2, 16); v2 += __shfl_xor(v2, 32);
    const float rstd = rsqrtf(v2 * (1.0f / 128.0f) + EPS);
    const int r = b * 4096 + c * 128 + n;
#pragma unroll
    for (int et = 0; et < 8; ++et) {
        const int col = h * 128 + 16 * et + 4 * g;
        const f32x4 gw = *(const f32x4*)(a.gn_w + col);
        const u32x2 gg = *(const u32x2*)(GR + (size_t)r * 512 + col);
        const float y0 = (accO[et][0] - mean) * rstd * gw[0] * bflo(gg.x), y1 = (accO[et][1] - mean) * rstd * gw[1] * bfhi(gg.x);
        const float y2 = (accO[et][2] - mean) * rstd * gw[2] * bflo(gg.y), y3 = (accO[et][3] - mean) * rstd * gw[3] * bfhi(gg.y);
        const u32x2 o = {pk2(y0, y1), pk2(y2, y3)};
        *(u32x2*)(Y + (size_t)r * 1024 + col) = o;
    }
    lds_barrier();
}

DI void phase7(const Args& a) {
    const int tid = threadIdx.x, wave = tid >> 6, lane = tid & 63;
    for (int r = blockIdx.x * 8 + wave; r < NTOK; r += gridDim.x * 8) {
        float* row = a.out + (size_t)r * 1024;
        f32x4 v[4]; float ss = 0.f;
#pragma unroll
        for (int q = 0; q < 4; ++q) { v[q] = *(const f32x4*)(row + q * 256 + lane * 4); ss += v[q][0] * v[q][0] + v[q][1] * v[q][1] + v[q][2] * v[q][2] + v[q][3] * v[q][3]; }
#pragma unroll
        for (int off = 32; off >= 1; off >>= 1) ss += __shfl_xor(ss, off);
        const float rstd = rsqrtf(ss * (1.0f / 1024.0f) + EPS);
#pragma unroll
        for (int q = 0; q < 4; ++q) {
            const f32x4 fw = *(const f32x4*)(a.fnorm_w + q * 256 + lane * 4);
            *(f32x4*)(row + q * 256 + lane * 4) = v[q] * rstd * fw;
        }
    }
}

__global__ __launch_bounds__(512, 2) void fwd_megakernel(Args a) {
    extern __shared__ __attribute__((aligned(16))) unsigned char shm[];
    LAS unsigned char* lds = (LAS unsigned char*)shm;
    cg::grid_group grid = cg::this_grid();
    volatile LAS unsigned* st = (volatile LAS unsigned*)(lds + LDS_BYTES - 16);
    if (threadIdx.x == 0) { st[0] = 0u; st[1] = 0u; }
    __syncthreads();
    const XcdBarrier xb = xcd_barrier_post((unsigned*)(a.ws + WS_BAR), st);
    if (a.ph_hi > 7) grid.sync();
#ifndef PHMASK
#define PHMASK 255
#endif
#ifndef REPMASK
#define REPMASK 0
#endif
#ifndef EXTRA_SYNCS
#define EXTRA_SYNCS 0
#endif
#define GSYNC() xcd_barrier(xb)
    for (int xs = 0; xs < EXTRA_SYNCS; ++xs) GSYNC();
#define PHASE(P, ...) do { if (((PHMASK >> (P)) & 1) && a.ph_lo <= (P) && (P) < a.ph_hi) { if ((REPMASK >> (P)) & 1) { __VA_ARGS__; GSYNC(); } __VA_ARGS__; if ((P) + 1 < a.ph_hi) GSYNC(); } } while (0)
    PHASE(0, phase0(a, lds));
    PHASE(1, phase1(a));
    PHASE(2, {
        pg8::Gemm gm{(const bf16_t*)(a.ws + WS_H), (const bf16_t*)(a.ws + WS_WIN), NTOK, NP, D};
        SchedIn S; S.so.init(NTOK, NP, (int)gridDim.x, (int)blockIdx.x);
        EpiIn E{a.ws};
        pg8::gemm_phase<EpiIn, SchedIn, false>(lds, gm, S, E, nullptr);
    });
    PHASE(3, phase3(a, lds));
    PHASE(5, { int it = blockIdx.x; if (it < 1024) { RetStage st; ret_load(a, it, st); for (;;) { const int nx = it + (int)gridDim.x; ret_unit(a, lds, it, st, nx < 1024 ? nx : -1); if (nx >= 1024) break; it = nx; } } });
    PHASE(6, {
        pg8::Gemm gm{(const bf16_t*)(a.ws + WS_H), (const bf16_t*)(a.ws + WS_WOUT), NTOK, D, D};
        pg8::StaticOrder S; S.init(NTOK, D, (int)gridDim.x, (int)blockIdx.x);
        EpiOut E{a.x, (const float*)(a.ws + WS_MOD), a.fnorm_w, a.out, (float*)(a.ws + WS_SLOT), (unsigned*)(a.ws + WS_CNT)};
        pg8::gemm_phase<EpiOut, pg8::StaticOrder, false>(lds, gm, S, E, nullptr);
    });
#undef PHASE
}

extern "C" void kernel_launch(void* const* d_in, const int* in_sizes, int n_in, void* d_out, int out_size, void* d_ws, size_t ws_size, hipStream_t stream) {
    static int grid = 0;
    if (grid == 0) {
        if (n_in != 16 || out_size != NTOK * D || ws_size < WS_END) { fprintf(stderr, "kernel_launch: unexpected shapes (n_in %d out %d ws %zu need %zu)\n", n_in, out_size, ws_size, (size_t)WS_END); grid = -1; return; }
        int dev = 0, cus = 0, per_cu = 0;
        (void)hipGetDevice(&dev); (void)hipDeviceGetAttribute(&cus, hipDeviceAttributeMultiprocessorCount, dev);
        if (hipFuncSetAttribute((const void*)fwd_megakernel, hipFuncAttributeMaxDynamicSharedMemorySize, LDS_BYTES) != hipSuccess) { fprintf(stderr, "kernel_launch: hipFuncSetAttribute failed\n"); grid = -1; return; }
        if (hipOccupancyMaxActiveBlocksPerMultiprocessor(&per_cu, (const void*)fwd_megakernel, NTHREADS, LDS_BYTES) != hipSuccess || per_cu < 1) { fprintf(stderr, "kernel_launch: occupancy query gives %d\n", per_cu); per_cu = 1; }
        (void)hipGetLastError();
        grid = cus;
    }
    if (grid < 0) return;
    Args a{};
    a.x = (const float*)d_in[0]; a.c = (const float*)d_in[1]; a.ctx = (const float*)d_in[2]; a.c_ctx = (const float*)d_in[3]; a.w_ada = (const float*)d_in[4]; a.b_ada = (const float*)d_in[5];
    a.norm_w = (const float*)d_in[6]; a.w_in = (const float*)d_in[7]; a.dec_f = (const float*)d_in[8]; a.dec_b = (const float*)d_in[9]; a.gn_w = (const float*)d_in[10]; a.ln_w = (const float*)d_in[11];
    a.w_s = (const float*)d_in[12]; a.b_s = (const float*)d_in[13]; a.w_out = (const float*)d_in[14]; a.fnorm_w = (const float*)d_in[15];
    a.out = (float*)d_out; a.ws = (unsigned char*)d_ws;
    (void)hipMemsetAsync((unsigned char*)d_ws + WS_BAR, 0, (size_t)XCD_BAR_WORDS * 4 + 32768, stream);
#if N_LAUNCHES == 1
    a.ph_lo = 0; a.ph_hi = 7;
    void* args[] = {&a};
    hipError_t e = hipLaunchCooperativeKernel((const void*)fwd_megakernel, dim3(grid), dim3(NTHREADS), args, LDS_BYTES, stream);
    if (e != hipSuccess) fprintf(stderr, "cooperative launch failed: %s (grid %d)\n", hipGetErrorString(e), grid);
#else
    for (int p = 0; p < 7; ++p) {
        a.ph_lo = p; a.ph_hi = p + 1;
        hipLaunchKernelGGL(fwd_megakernel, dim3(grid), dim3(NTHREADS), LDS_BYTES, stream, a);
    }
#endif
}
```

```cpp
#include <hip/hip_runtime.h>
#include <hip/hip_cooperative_groups.h>
#include <cstdio>
namespace cg = cooperative_groups;
#ifndef N_LAUNCHES
#define N_LAUNCHES 1
#endif
namespace pg8 {
#define PG8_LAS __attribute__((address_space(3)))
typedef unsigned short bf16_t;
typedef short bf16x8 __attribute__((ext_vector_type(8)));
typedef float f32x4 __attribute__((ext_vector_type(4)));
typedef unsigned u32x4 __attribute__((ext_vector_type(4)));
constexpr int BM = 256, BK = 64, HALF = 128, HTB = HALF * BK * 2  , STAGE_BYTES = 8 * HTB, NXCD = 8, WGM = 8;

__host__ __device__ __forceinline__ int lds_byte(int r, int c) { const int st = (r >> 4) * 2 + (c >> 5), rr = r & 15, cc = c & 31, ob = rr * 64 + cc * 2; return st * 1024 + (ob ^ (((ob >> 9) & 1) << 5)); }
__host__ __device__ __forceinline__ void stage_rc(int b, int& R, int& C) { const int st = b / 1024, sb = b % 1024, swz = sb ^ (((sb >> 9) & 1) << 5); R = (st >> 1) * 16 + swz / 64; C = (st & 1) * 32 + (swz % 64) / 2; }
__host__ __device__ __forceinline__ int perm32(int rho) { const int n = rho >> 4, i = rho & 15; return 8 * (i >> 2) + 4 * n + (i & 3); }

struct Unit { int pm, pn; };
struct Gemm { const bf16_t* A; const bf16_t* Bt; int M, N, K; };

struct StaticOrder {
    int nM, nN, nwg, G, c;
    __host__ __device__ void init(int M, int N, int G_, int c_) { nM = M / BM; nN = N / BM; nwg = nM * nN; G = G_; c = c_; }
    __host__ __device__ bool next(int i, Unit& u) const {
        const long L = (long)i * G + c; if (L >= nwg) return false;
        int wgid = (int)L; { const int q = nwg / NXCD, r = nwg % NXCD, xcd = wgid % NXCD, off = wgid / NXCD; wgid = (xcd < r ? xcd * (q + 1) : r * (q + 1) + (xcd - r) * q) + off; }
        const int nig = WGM * nN, gid = wgid / nig, fm = gid * WGM, gsz = (nM - fm) < WGM ? (nM - fm) : WGM;
        u.pm = fm + ((wgid % nig) % gsz); u.pn = (wgid % nig) / gsz; return true;
    }
    __device__ __forceinline__ void a_ready(const Unit&) const {}
    __device__ __forceinline__ void done(const Unit&) const {}
};
struct CountedOrder : StaticOrder {
    const unsigned* ready; unsigned need; unsigned* tmo;
    __device__ __forceinline__ void a_ready(const Unit& u) const {
        if (threadIdx.x < 64) {
            const unsigned long long t0 = __builtin_amdgcn_s_memrealtime(); unsigned polls = 0;
            while ((unsigned)__builtin_amdgcn_readfirstlane(__hip_atomic_load(ready + 64 * u.pm, __ATOMIC_RELAXED, __HIP_MEMORY_SCOPE_AGENT)) < need) {
                if ((++polls & 255u) == 0u && __builtin_amdgcn_readfirstlane(__hip_atomic_load(tmo, __ATOMIC_RELAXED, __HIP_MEMORY_SCOPE_AGENT)) != 0u) break;
                if (__builtin_amdgcn_s_memrealtime() - t0 > 2000000ull) {
                    if (threadIdx.x == 0) { unsigned expect = 0u; __hip_atomic_compare_exchange_strong(tmo + 1, &expect, 0x600u | (unsigned)(u.pm & 0xff), __ATOMIC_RELAXED, __ATOMIC_RELAXED, __HIP_MEMORY_SCOPE_AGENT); __hip_atomic_store(tmo, 1u, __ATOMIC_RELAXED, __HIP_MEMORY_SCOPE_AGENT); }
                    break; }
                __builtin_amdgcn_s_sleep(2); }
            __builtin_amdgcn_fence(__ATOMIC_ACQUIRE, "agent");
            asm volatile("s_waitcnt vmcnt(0)" ::: "memory");
        }
#if !defined(BROKEN_HOOK_NO_BARRIER)
        asm volatile("" ::: "memory"); __builtin_amdgcn_s_barrier(); asm volatile("" ::: "memory");
#endif
    }
};

__device__ __forceinline__ unsigned cvt_pk_bf16(float lo, float hi) { unsigned r; asm volatile("v_cvt_pk_bf16_f32 %0, %1, %2" : "=v"(r) : "v"(lo), "v"(hi)); return r; }
typedef float f32x2 __attribute__((ext_vector_type(2)));
__device__ __forceinline__ f32x2 gelu_pk(f32x2 v) {
    const f32x2 av = __builtin_elementwise_abs(v), d = av * 0.2316418882f + 1.0f;
    f32x2 t; t.x = __builtin_amdgcn_rcpf(d.x); t.y = __builtin_amdgcn_rcpf(d.y);
    f32x2 q = t * 0.5307027145f + (-0.7265760135f); q = q * t + 0.7107068705f; q = q * t + (-0.142248368f); q = q * t + 0.127414796f; q = q * t;
    const f32x2 s = (v * v) * (-0.72134752044f);
    f32x2 e; e.x = __builtin_amdgcn_exp2f(s.x); e.y = __builtin_amdgcn_exp2f(s.y);
    const f32x2 m = v * (q * e), r = v - m;
    f32x2 o; o.x = v.x < 0.f ? m.x : r.x; o.y = v.y < 0.f ? m.y : r.y; return o;
}
template <class Epi, class Sched, bool STAMP = false>
__device__ __forceinline__ void gemm_phase(PG8_LAS unsigned char* lds, const Gemm g, const Sched& S, const Epi& E, unsigned long long* stamps) {
    const int tid = threadIdx.x, wid = __builtin_amdgcn_readfirstlane(tid >> 6), lane = tid & 63, wr = wid >> 2, wc = wid & 3, fr = lane & 15, fq = lane >> 4;
    const int K = g.K, nt = K / BK;
    int ts_lo = 0, ts_hi = 0, nts = 0; const unsigned long long rt_entry = STAMP ? (unsigned long long)wall_clock64() : 0ull;
#define PG8_STAMP() do { if (STAMP && wid == 0 && nts < 64) { const unsigned long long _c = (unsigned long long)clock64(); \
        ts_lo = (lane == nts) ? (int)(unsigned)_c : ts_lo; ts_hi = (lane == nts) ? (int)(unsigned)(_c >> 32) : ts_hi; ++nts; } } while (0)
    PG8_STAMP();
    unsigned voffA[2], voffB[2];
#pragma unroll
    for (int i = 0; i < 2; ++i) { int R, C; stage_rc(tid * 16 + i * 8192, R, C); const int Rb = Epi::PERM ? ((R & ~31) + perm32(R & 31)) : R;
        voffA[i] = (unsigned)(R * K + C) * 2u; voffB[i] = (unsigned)(Rb * K + C) * 2u; }
    const size_t kstep = (size_t)(BK * 2);
    const size_t hstep = (size_t)HALF * K * 2;
    const size_t tstep = 2 * hstep;
    const unsigned ldsw = (unsigned)wid * 1024u;
    const int aoff = lds_byte(wr * 64 + fr, fq * 8), boff = lds_byte(wc * 32 + fr, fq * 8);
#define PG8_SA(b, h) (((b) * 2 + (h)) * HTB)
#define PG8_SB(b, h) ((4 + (b) * 2 + (h)) * HTB)
#define PG8_STAGE(bufoff, gbase, voff) do { _Pragma("unroll") for (int _i = 0; _i < 2; ++_i) \
        __builtin_amdgcn_global_load_lds((const unsigned*)((const char*)(gbase) + (voff)[_i]), (PG8_LAS unsigned*)(lds + (bufoff) + ldsw + _i * 8192), 16, 0, 0); } while (0)
#define PG8_LDA(dst, b, h) do { _Pragma("unroll") for (int m = 0; m < 4; ++m) _Pragma("unroll") for (int k = 0; k < 2; ++k) dst[m][k] = *(const PG8_LAS bf16x8*)(lds + PG8_SA(b, h) + aoff + m * 2048 + k * 1024); } while (0)
#define PG8_LDB(dst, b, h) do { _Pragma("unroll") for (int n = 0; n < 2; ++n) _Pragma("unroll") for (int k = 0; k < 2; ++k) dst[n][k] = *(const PG8_LAS bf16x8*)(lds + PG8_SB(b, h) + boff + n * 2048 + k * 1024); } while (0)
#define PG8_MMA(ai, bj, At, Bt) do { __builtin_amdgcn_s_setprio(1); _Pragma("unroll") for (int m = 0; m < 4; ++m) _Pragma("unroll") for (int n = 0; n < 2; ++n) _Pragma("unroll") for (int k = 0; k < 2; ++k) \
        acc[ai][bj][m][n] = __builtin_amdgcn_mfma_f32_16x16x32_bf16(Bt[n][k], At[m][k], acc[ai][bj][m][n], 0, 0, 0); __builtin_amdgcn_s_setprio(0); } while (0)
#define PG8_WAIT_V(n) asm volatile("s_waitcnt vmcnt(" #n ")" ::: "memory")
#define PG8_WAIT_L(n) asm volatile("s_waitcnt lgkmcnt(" #n ")" ::: "memory")
#define PG8_BAR __builtin_amdgcn_s_barrier()
#define PG8_SCHED __builtin_amdgcn_sched_barrier(0)
    Unit cur, nxt; int ui = 0;
    if (!S.next(0, cur)) return;
    f32x4 acc[2][2][4][2];
#pragma unroll
    for (int a = 0; a < 2; ++a)
#pragma unroll
        for (int b = 0; b < 2; ++b)
#pragma unroll
            for (int m = 0; m < 4; ++m)
#pragma unroll
                for (int n = 0; n < 2; ++n) acc[a][b][m][n] = (f32x4){0.f, 0.f, 0.f, 0.f};
    bf16x8 At[4][2], B0[2][2], B1[2][2];
    const char* cA = (const char*)g.A + (size_t)cur.pm * tstep; const char* cB = (const char*)g.Bt + (size_t)cur.pn * tstep;
    S.a_ready(cur);
    PG8_STAGE(PG8_SB(0, 0), cB, voffB); PG8_STAGE(PG8_SA(0, 0), cA, voffA); PG8_STAGE(PG8_SB(0, 1), cB + hstep, voffB); PG8_STAGE(PG8_SA(0, 1), cA + hstep, voffA);
    if (wr == 1) PG8_BAR;
    PG8_WAIT_V(4); PG8_BAR;
    PG8_STAGE(PG8_SB(1, 0), cB + kstep, voffB); PG8_STAGE(PG8_SA(1, 0), cA + kstep, voffA); PG8_STAGE(PG8_SB(1, 1), cB + hstep + kstep, voffB);
    PG8_WAIT_V(6); PG8_BAR;
    PG8_STAMP();
    for (;;) {
        const bool has_next = S.next(ui + 1, nxt);
        const char* nA = has_next ? (const char*)g.A + (size_t)nxt.pm * tstep : cA; const char* nB = has_next ? (const char*)g.Bt + (size_t)nxt.pn * tstep : cB;
        for (int t = 0; t < nt; t += 2) {
            const bool last = (t == nt - 2);
            const char* a1 = cA + (size_t)(t + 1) * kstep;
            const char* a2 = last ? nA : cA + (size_t)(t + 2) * kstep; const char* b2 = last ? nB : cB + (size_t)(t + 2) * kstep;
            const char* a3 = a2 + kstep; const char* b3 = b2 + kstep;
            if (last && has_next) S.a_ready(nxt);
            PG8_LDB(B0, 0, 0); PG8_SCHED; PG8_LDA(At, 0, 0); PG8_STAGE(PG8_SA(1, 1), a1 + hstep, voffA);
            PG8_WAIT_L(8); PG8_BAR; PG8_WAIT_L(0); PG8_MMA(0, 0, At, B0); PG8_BAR; PG8_SCHED;
            PG8_LDB(B1, 0, 1); PG8_STAGE(PG8_SB(0, 0), b2, voffB);
            PG8_BAR; PG8_WAIT_L(0); PG8_MMA(0, 1, At, B1); PG8_BAR;
            PG8_LDA(At, 0, 1); PG8_STAGE(PG8_SA(0, 0), a2, voffA);
            PG8_BAR; PG8_WAIT_L(0); PG8_MMA(1, 0, At, B0); PG8_BAR; PG8_SCHED;
            PG8_STAGE(PG8_SB(0, 1), b2 + hstep, voffB);
            PG8_WAIT_V(6); PG8_BAR; PG8_MMA(1, 1, At, B1); PG8_BAR;
            PG8_LDB(B0, 1, 0); PG8_SCHED; PG8_LDA(At, 1, 0); PG8_STAGE(PG8_SA(0, 1), a2 + hstep, voffA);
            PG8_WAIT_L(8); PG8_BAR; PG8_WAIT_L(0); PG8_MMA(0, 0, At, B0); PG8_BAR; PG8_SCHED;
            PG8_LDB(B1, 1, 1); PG8_STAGE(PG8_SB(1, 0), b3, voffB);
            PG8_BAR; PG8_WAIT_L(0); PG8_MMA(0, 1, At, B1); PG8_BAR;
            PG8_LDA(At, 1, 1); PG8_STAGE(PG8_SA(1, 0), a3, voffA);
            PG8_BAR; PG8_WAIT_L(0); PG8_MMA(1, 0, At, B0); PG8_BAR; PG8_SCHED;
            PG8_STAGE(PG8_SB(1, 1), b3 + hstep, voffB);
            PG8_WAIT_V(6); PG8_BAR; PG8_MMA(1, 1, At, B1); PG8_BAR;
        }
        PG8_STAMP();
        if constexpr (!Epi::AFTER_DRAIN) {
            if constexpr (Epi::REALIGN) { if (wr == 0) PG8_BAR; }
            E(acc, cur, wr, wc, fr, fq); S.done(cur);
            if constexpr (Epi::REALIGN) { if (wr == 1) PG8_BAR; }
        }
        PG8_STAMP();
        if (!has_next) break;
#pragma unroll
        for (int a = 0; a < 2; ++a)
#pragma unroll
            for (int b = 0; b < 2; ++b)
#pragma unroll
                for (int m = 0; m < 4; ++m)
#pragma unroll
                    for (int n = 0; n < 2; ++n) acc[a][b][m][n] = (f32x4){0.f, 0.f, 0.f, 0.f};
        cur = nxt; cA = nA; cB = nB; ++ui;
    }
    PG8_WAIT_V(0);
    if (wr == 0) PG8_BAR;
    PG8_BAR;
    if constexpr (Epi::AFTER_DRAIN) { E.fused(acc, cur, wr, wc, fr, fq, lds, wid, lane); S.done(cur); }
    PG8_STAMP();
    if (STAMP && wid == 0) { stamps[lane] = lane < nts ? (((unsigned long long)(unsigned)ts_hi << 32) | (unsigned)ts_lo) : 0ull;
        if (lane == 62) stamps[62] = rt_entry; if (lane == 63) stamps[63] = (unsigned long long)wall_clock64(); }
#undef PG8_STAMP
#undef PG8_SA
#undef PG8_SB
#undef PG8_STAGE
#undef PG8_LDA
#undef PG8_LDB
#undef PG8_MMA
#undef PG8_WAIT_V
#undef PG8_WAIT_L
#undef PG8_BAR
#undef PG8_SCHED
}
}
#define LAS __attribute__((address_space(3)))
#define XB_TMO      128
#define XB_XCNT(j)  (256  + 64 * (j))
#define XB_XSUB(j)  (1280 + 64 * (j))
#define XB_XGEN(j)  (2304 + 64 * (j))
#define XB_TOP      3328
#define XB_TOPGEN   3392
#define XCD_BAR_WORDS 3456
#define XB_SPIN_CAP (1u << 18)

__device__ __forceinline__ unsigned xb_ld(unsigned* p)              { return __hip_atomic_load(p, __ATOMIC_RELAXED, __HIP_MEMORY_SCOPE_AGENT); }
__device__ __forceinline__ unsigned xb_add(unsigned* p, unsigned v) { return __hip_atomic_fetch_add(p, v, __ATOMIC_RELAXED, __HIP_MEMORY_SCOPE_AGENT); }
__device__ __forceinline__ unsigned xb_xcc_id() { return (unsigned)__builtin_amdgcn_s_getreg((3 << 11) | 20) & 0xFu; }
#define XB_SPIN(cond, bar) do { unsigned _sp = 0; while (cond) { __builtin_amdgcn_s_sleep(1); \
    if ((++_sp & 255u) == 0u) { if (xb_ld(&(bar)[XB_TMO])) break; if (_sp > XB_SPIN_CAP) { atomicAdd(&(bar)[XB_TMO], 1u); break; } } } } while (0)

struct XcdBarrier {
    unsigned* bar; unsigned x;
    volatile LAS unsigned* st;
};

__device__ __forceinline__ XcdBarrier xcd_barrier_post(unsigned* bar, volatile LAS unsigned* st) {
    XcdBarrier b; b.bar = bar; b.x = xb_xcc_id(); b.st = st;
    if (threadIdx.x == 0) (void)xb_add(&bar[XB_XCNT(b.x)], 1u);
    return b;
}
__device__ __forceinline__ void xcd_barrier_complete(unsigned* bar, unsigned x, unsigned& nloc, unsigned& nx) {
    const unsigned G = gridDim.x * gridDim.y * gridDim.z;
    unsigned sum, cnt, mine, sp = 0u;
    for (;;) {
        sum = 0u; cnt = 0u; mine = 0u;
#pragma unroll
        for (unsigned j = 0; j < 16; ++j) { const unsigned c = xb_ld(&bar[XB_XCNT(j)]); sum += c; cnt += (c > 0u) ? 1u : 0u; mine = (j == x) ? c : mine; }
        if (sum == G) break;
        __builtin_amdgcn_s_sleep(1);
        if ((++sp & 255u) == 0u) { if (xb_ld(&bar[XB_TMO])) break; if (sp > XB_SPIN_CAP) { atomicAdd(&bar[XB_TMO], 1u); break; } }
    }
    nloc = mine > 0u ? mine : 1u; nx = cnt > 0u ? cnt : 1u;
}

__device__ __forceinline__ void xcd_barrier(const XcdBarrier& b) {
    asm volatile("s_waitcnt vmcnt(0)" ::: "memory");
    __syncthreads();
    if (threadIdx.x == 0) {
        unsigned* bar = b.bar;
        __builtin_amdgcn_s_waitcnt(0);
        unsigned nloc = b.st[0], nx = b.st[1];
        if (nloc == 0u) { xcd_barrier_complete(bar, b.x, nloc, nx); b.st[0] = nloc; b.st[1] = nx; }
        const unsigned old = xb_add(&bar[XB_XSUB(b.x)], 1u);
        const unsigned gen = old / nloc;
        if (old + 1u == (gen + 1u) * nloc) {
            __builtin_amdgcn_fence(__ATOMIC_RELEASE, "agent");
            asm volatile("s_waitcnt vmcnt(0)" ::: "memory");
            const unsigned og = xb_add(&bar[XB_TOP], 1u);
            const unsigned tg = og / nx;
            if (og + 1u == (tg + 1u) * nx) xb_add(&bar[XB_TOPGEN], 1u);
            else XB_SPIN(xb_ld(&bar[XB_TOPGEN]) == tg, bar);
            __builtin_amdgcn_fence(__ATOMIC_ACQUIRE, "agent");
            xb_add(&bar[XB_XGEN(b.x)], 1u);
            asm volatile("s_waitcnt vmcnt(0)" ::: "memory");
        } else {
            XB_SPIN(xb_ld(&bar[XB_XGEN(b.x)]) == gen, bar);
            __builtin_amdgcn_fence(__ATOMIC_ACQUIRE, "agent");
            asm volatile("s_waitcnt vmcnt(0)" ::: "memory");
        }
    }
    __syncthreads();
}


#define DI __device__ __forceinline__

using pg8::bf16_t; using pg8::bf16x8; using pg8::f32x4; using pg8::f32x2; using pg8::u32x4; using pg8::Unit;
typedef unsigned u32x2 __attribute__((ext_vector_type(2)));
typedef short s16x4 __attribute__((ext_vector_type(4)));
typedef __bf16 bf2_t __attribute__((ext_vector_type(2)));

constexpr int NB = 8, T = 4096, D = 1024, NTOK = NB * T, CTXL = 256, NCTX = NB * CTXL, NP = 3072, NC = 32;
constexpr int NTHREADS = 512;
constexpr int LDS_BYTES = 147456 + 256;
constexpr float EPS = 1e-6f, LOG2E = 1.4426950408889634f;

constexpr size_t al256(size_t x) { return (x + 255) & ~(size_t)255; }
constexpr size_t WS_MOD  = 0;
constexpr size_t WS_ROPE = WS_MOD + al256(9 * 3072 * 4);
constexpr size_t WS_WIN  = WS_ROPE + 8192;
constexpr size_t WS_WOUT = WS_WIN + (size_t)3072 * 1024 * 2;
constexpr size_t WS_WSB  = WS_WOUT + (size_t)1024 * 1024 * 2;
constexpr size_t WS_H    = WS_WSB + (size_t)4 * 128 * 128 * 2;
constexpr size_t WS_Q    = WS_H + (size_t)(NTOK + NCTX) * 1024 * 2;
constexpr size_t WS_K    = WS_Q + (size_t)NTOK * 256 * 2;
constexpr size_t WS_V    = WS_K + (size_t)NTOK * 256 * 2;
constexpr size_t WS_GR   = WS_V + (size_t)NTOK * 512 * 2;
constexpr size_t WS_U    = WS_GR + (size_t)NTOK * 512 * 2;
constexpr size_t WS_VG   = WS_U + (size_t)NTOK * 512 * 2;
constexpr size_t WS_GM   = WS_VG + (size_t)NTOK * 512 * 2;
constexpr size_t WS_KC   = WS_GM + (size_t)NTOK * 512 * 2;
constexpr size_t WS_VC   = WS_KC + (size_t)NCTX * 256 * 2;
constexpr size_t WS_KV   = WS_VC + (size_t)NCTX * 512 * 2;
constexpr size_t WS_KVC  = WS_KV + (size_t)1024 * 2 * 8192 * 4;
constexpr size_t WS_ST   = WS_KVC + (size_t)64 * 2 * 8192 * 4;
constexpr size_t WS_BAR  = WS_ST + (size_t)1024 * 2 * 8192 * 2;
constexpr size_t WS_CNT  = WS_BAR + (size_t)XCD_BAR_WORDS * 4;
constexpr size_t WS_SLOT = WS_CNT + 32768;
constexpr size_t WS_END  = WS_SLOT + (size_t)NTOK * 16 * 4;

struct Args {
    const float* x; const float* c; const float* ctx; const float* c_ctx; const float* w_ada; const float* b_ada; const float* norm_w; const float* w_in;
    const float* dec_f; const float* dec_b; const float* gn_w; const float* ln_w; const float* w_s; const float* b_s; const float* w_out; const float* fnorm_w;
    float* out; unsigned char* ws; int ph_lo, ph_hi;
};

DI unsigned pk2(float lo, float hi) { f32x2 v = {lo, hi}; bf2_t r = __builtin_convertvector(v, bf2_t); return __builtin_bit_cast(unsigned, r); }
DI f32x4 ldnt_f4(const float* p) { return __builtin_nontemporal_load((const f32x4*)p); }
DI u32x4 ldnt_u4(const void* p) { return __builtin_nontemporal_load((const u32x4*)p); }
DI u32x2 ldnt_u2(const void* p) { return __builtin_nontemporal_load((const u32x2*)p); }
DI float bflo(unsigned w) { return __uint_as_float(w << 16); }
DI float bfhi(unsigned w) { return __uint_as_float(w & 0xffff0000u); }
DI float silu_f(float v) { return v * __builtin_amdgcn_rcpf(1.0f + __expf(-v)); }
DI void lds_barrier() { asm volatile("s_waitcnt lgkmcnt(0)" ::: "memory"); __builtin_amdgcn_s_barrier(); asm volatile("" ::: "memory"); }
DI f32x4 mfma16(bf16x8 a, bf16x8 b, f32x4 c) { return __builtin_amdgcn_mfma_f32_16x16x32_bf16(a, b, c, 0, 0, 0); }

DI bf16x8 frag_tr(LAS const unsigned char* base, int S, int k0, int n0, int lane) {
    const int i = lane & 15, g = lane >> 4;
    LAS const unsigned char* p = base + (k0 + 4 * g + (i >> 2)) * S + (n0 + 4 * (i & 3)) * 2;
    const s16x4 lo = __builtin_amdgcn_ds_read_tr16_b64_v4i16((LAS s16x4*)p);
    const s16x4 hi = __builtin_amdgcn_ds_read_tr16_b64_v4i16((LAS s16x4*)(p + 16 * S));
    return __builtin_shufflevector(lo, hi, 0, 1, 2, 3, 4, 5, 6, 7);
}
DI bf16x8 frag_rowP(const bf16_t* rowk0, int g) {
    const u32x2 lo = *(const u32x2*)(rowk0 + 4 * g), hi = *(const u32x2*)(rowk0 + 16 + 4 * g);
    const u32x4 v = {lo.x, lo.y, hi.x, hi.y}; return __builtin_bit_cast(bf16x8, v);
}
DI bf16x8 frag_rowP_lds(LAS const unsigned char* rowk0, int g) {
    const u32x2 lo = *(LAS const u32x2*)(rowk0 + 8 * g), hi = *(LAS const u32x2*)(rowk0 + 32 + 8 * g);
    const u32x4 v = {lo.x, lo.y, hi.x, hi.y}; return __builtin_bit_cast(bf16x8, v);
}
DI bf16x8 scale_frag(bf16x8 f, float s) {
    const u32x4 u = __builtin_bit_cast(u32x4, f); u32x4 r;
#pragma unroll
    for (int q = 0; q < 4; ++q) r[q] = pk2(bflo(u[q]) * s, bfhi(u[q]) * s);
    return __builtin_bit_cast(bf16x8, r);
}

struct EpiIn {
    static constexpr bool PERM = true, AFTER_DRAIN = false, REALIGN = false;
    unsigned char* ws;
    DI void operator()(const f32x4 (&acc)[2][2][4][2], const Unit& u, int wr, int wc, int fr, int fq) const {
        const int pn = u.pn, rbase = u.pm * 256 + wr * 64 + fr, cbase = wc * 32 + 8 * fq;
        if (u.pm >= 128) {
            bf16_t* dst = (bf16_t*)(ws + (pn == 1 ? WS_KC : WS_VC));
            const float scl = pn == 1 ? 0.125f : 1.0f;
#pragma unroll
            for (int ai = 0; ai < 2; ++ai)
#pragma unroll
                for (int m = 0; m < 4; ++m) {
                    const int rc = rbase + ai * 128 + m * 16 - NTOK, b = rc >> 8, t = rc & 255;
#pragma unroll
                    for (int bj = 0; bj < 2; ++bj) {
                        const f32x4 v0 = acc[ai][bj][m][0] * scl, v1 = acc[ai][bj][m][1] * scl;
                        const u32x4 o = {pk2(v0[0], v0[1]), pk2(v0[2], v0[3]), pk2(v1[0], v1[1]), pk2(v1[2], v1[3])};
                        size_t off;
                        if (pn == 1) { const int head = bj * 2 + (wc >> 1), d0 = (wc & 1) * 32 + 8 * fq; off = ((size_t)((b * 4 + head) * 256 + t)) * 64 + d0; }
                        else { const int head = (pn - 2) * 2 + bj; off = ((size_t)((b * 4 + head) * 256 + t)) * 128 + cbase; }
                        *(u32x4*)(dst + off) = o;
                    }
                }
            return;
        }
        if (pn <= 1) {
            bf16_t* dst = (bf16_t*)(ws + (pn == 0 ? WS_Q : WS_K));
            const float scl = pn == 0 ? 1.0f : 0.125f;
            const float* rc = (const float*)(ws + WS_ROPE); const float* rs = rc + 1024;
            const int hh = wc & 1, fi0 = 8 * (fq & 1); const bool second = fq >= 2;
#pragma unroll
            for (int ai = 0; ai < 2; ++ai)
#pragma unroll
                for (int m = 0; m < 4; ++m) {
                    const int r = rbase + ai * 128 + m * 16, b = r >> 12, t = r & 4095, pos = hh ? (t & 63) : (t >> 6);
                    const f32x4 c0 = *(const f32x4*)(rc + pos * 16 + fi0), c1 = *(const f32x4*)(rc + pos * 16 + fi0 + 4);
                    const f32x4 s0 = *(const f32x4*)(rs + pos * 16 + fi0), s1 = *(const f32x4*)(rs + pos * 16 + fi0 + 4);
#pragma unroll
                    for (int bj = 0; bj < 2; ++bj) {
                        const f32x4 v0 = acc[ai][bj][m][0], v1 = acc[ai][bj][m][1];
                        float o[8];
#pragma unroll
                        for (int j = 0; j < 4; ++j) {
                            const float xa = v0[j], xb = v1[j], pa = __shfl_xor(xa, 32), pb = __shfl_xor(xb, 32);
                            o[j]     = (second ? (pa * s0[j] + xa * c0[j]) : (xa * c0[j] - pa * s0[j])) * scl;
                            o[4 + j] = (second ? (pb * s1[j] + xb * c1[j]) : (xb * c1[j] - pb * s1[j])) * scl;
                        }
                        const u32x4 ov = {pk2(o[0], o[1]), pk2(o[2], o[3]), pk2(o[4], o[5]), pk2(o[6], o[7])};
                        const int head = bj * 2 + (wc >> 1), d0 = hh * 32 + 8 * fq;
                        *(u32x4*)(dst + ((size_t)((b * 4 + head) * 4096 + t)) * 64 + d0) = ov;
                    }
                }
            return;
        }
        if (pn <= 3) {
            bf16_t* dst = (bf16_t*)(ws + WS_V);
#pragma unroll
            for (int ai = 0; ai < 2; ++ai)
#pragma unroll
                for (int m = 0; m < 4; ++m) {
                    const int r = rbase + ai * 128 + m * 16, b = r >> 12, t = r & 4095;
#pragma unroll
                    for (int bj = 0; bj < 2; ++bj) {
                        const f32x4 v0 = acc[ai][bj][m][0], v1 = acc[ai][bj][m][1];
                        const u32x4 o = {pk2(v0[0], v0[1]), pk2(v0[2], v0[3]), pk2(v1[0], v1[1]), pk2(v1[2], v1[3])};
                        const int head = (pn - 2) * 2 + bj;
                        *(u32x4*)(dst + ((size_t)((b * 4 + head) * 4096 + t)) * 128 + cbase) = o;
                    }
                }
            return;
        }
        if (pn == 6 || pn == 7 || pn >= 10) {
            const int t = pn == 6 ? 0 : (pn == 7 ? 1 : (pn == 10 ? 2 : 3));
            bf16_t* dst = (bf16_t*)(ws + WS_U);
#pragma unroll
            for (int ai = 0; ai < 2; ++ai)
#pragma unroll
                for (int m = 0; m < 4; ++m) {
                    const int r = rbase + ai * 128 + m * 16;
                    const f32x4 u0 = acc[ai][0][m][0], u1 = acc[ai][0][m][1], g0 = acc[ai][1][m][0], g1 = acc[ai][1][m][1];
                    const f32x2 a0 = pg8::gelu_pk((f32x2){u0[0], u0[1]}), a1 = pg8::gelu_pk((f32x2){u0[2], u0[3]}), a2 = pg8::gelu_pk((f32x2){u1[0], u1[1]}), a3 = pg8::gelu_pk((f32x2){u1[2], u1[3]});
                    const u32x4 o = {pk2(a0.x * silu_f(g0[0]), a0.y * silu_f(g0[1])), pk2(a1.x * silu_f(g0[2]), a1.y * silu_f(g0[3])),
                                     pk2(a2.x * silu_f(g1[0]), a2.y * silu_f(g1[1])), pk2(a3.x * silu_f(g1[2]), a3.y * silu_f(g1[3]))};
                    *(u32x4*)(dst + (size_t)r * 512 + 128 * t + cbase) = o;
                }
            return;
        }
        {
            const int region = (pn - 4) >> 1; const bool is_gelu = (region == 1) || (region == 2);
            bf16_t* dst = (bf16_t*)(ws + WS_GR + (size_t)region * ((size_t)NTOK * 512 * 2));
            const int colb = ((pn - 4) & 1) * 256 + cbase;
#pragma unroll
            for (int ai = 0; ai < 2; ++ai)
#pragma unroll
                for (int m = 0; m < 4; ++m) {
                    const int r = rbase + ai * 128 + m * 16;
#pragma unroll
                    for (int bj = 0; bj < 2; ++bj) {
                        const f32x4 v0 = acc[ai][bj][m][0], v1 = acc[ai][bj][m][1];
                        u32x4 o;
                        if (is_gelu) {
                            const f32x2 a = pg8::gelu_pk((f32x2){v0[0], v0[1]}), bq = pg8::gelu_pk((f32x2){v0[2], v0[3]}), cq = pg8::gelu_pk((f32x2){v1[0], v1[1]}), dq = pg8::gelu_pk((f32x2){v1[2], v1[3]});
                            o = (u32x4){pk2(a.x, a.y), pk2(bq.x, bq.y), pk2(cq.x, cq.y), pk2(dq.x, dq.y)};
                        } else {
                            o = (u32x4){pk2(silu_f(v0[0]), silu_f(v0[1])), pk2(silu_f(v0[2]), silu_f(v0[3])), pk2(silu_f(v1[0]), silu_f(v1[1])), pk2(silu_f(v1[2]), silu_f(v1[3]))};
                        }
                        *(u32x4*)(dst + (size_t)r * 512 + colb + bj * 128) = o;
                    }
                }
        }
    }
};
struct EpiOut {
    static constexpr bool PERM = false, AFTER_DRAIN = false, REALIGN = true;
    const float* x; const float* mod; const float* fw; float* out; float* slots; unsigned* cnt;
    DI void operator()(const f32x4 (&acc_)[2][2][4][2], const Unit& u, int wr, int wc, int fr, int fq) const {
        f32x4 (&acc)[2][2][4][2] = const_cast<f32x4 (&)[2][2][4][2]>(acc_);
        const int rbase = u.pm * 256 + wr * 64 + fr, cbase = u.pn * 256 + wc * 32 + 4 * fq;
        const float* gate = mod + (size_t)(rbase >> 12) * 3072 + 2048;
        f32x4 gv[2][2];
#pragma unroll
        for (int bj = 0; bj < 2; ++bj)
#pragma unroll
            for (int n = 0; n < 2; ++n) gv[bj][n] = *(const f32x4*)(gate + cbase + bj * 128 + n * 16);
        f32x4 xv[2][4]; float ss[8];
#pragma unroll
        for (int q = 0; q < 4; ++q) xv[0][q] = ldnt_f4(x + (size_t)rbase * 1024 + cbase + (q >> 1) * 128 + (q & 1) * 16);
#pragma unroll
        for (int k = 0; k < 8; ++k) {
            const int ai = k >> 2, m = k & 3;
            if (k + 1 < 8) {
                const size_t ro = (size_t)(rbase + ((k + 1) >> 2) * 128 + ((k + 1) & 3) * 16) * 1024 + cbase;
#pragma unroll
                for (int q = 0; q < 4; ++q) xv[(k + 1) & 1][q] = ldnt_f4(x + ro + (q >> 1) * 128 + (q & 1) * 16);
            }
            float sk = 0.f;
#pragma unroll
            for (int q = 0; q < 4; ++q) {
                const int bj = q >> 1, n = q & 1;
                const f32x4 v = xv[k & 1][q] + gv[bj][n] * acc[ai][bj][m][n];
                acc[ai][bj][m][n] = v;
                sk += v[0] * v[0] + v[1] * v[1] + v[2] * v[2] + v[3] * v[3];
            }
            ss[k] = sk;
        }
#pragma unroll
        for (int k = 0; k < 8; ++k) { ss[k] += __shfl_xor(ss[k], 16); ss[k] += __shfl_xor(ss[k], 32); }
        if (fq == 0) {
#pragma unroll
            for (int k = 0; k < 8; ++k)
                __hip_atomic_store(slots + (size_t)(rbase + (k >> 2) * 128 + (k & 3) * 16) * 16 + u.pn * 4 + wc, ss[k], __ATOMIC_RELAXED, __HIP_MEMORY_SCOPE_AGENT);
        }
        asm volatile("s_waitcnt vmcnt(0)" ::: "memory");
        if ((threadIdx.x & 63) == 0) {
            __hip_atomic_fetch_add(cnt + u.pm * 64, 1u, __ATOMIC_RELAXED, __HIP_MEMORY_SCOPE_AGENT);
            unsigned spins = 0;
            while (__hip_atomic_load(cnt + u.pm * 64, __ATOMIC_RELAXED, __HIP_MEMORY_SCOPE_AGENT) < 32u) { __builtin_amdgcn_s_sleep(8); if (++spins > (1u << 22)) break; }
        }
        __builtin_amdgcn_fence(__ATOMIC_ACQUIRE, "agent");
        asm volatile("s_waitcnt vmcnt(0)" ::: "memory");
        f32x4 sl[8];
#pragma unroll
        for (int k = 0; k < 8; ++k) sl[k] = *(const f32x4*)(slots + (size_t)(rbase + (k >> 2) * 128 + (k & 3) * 16) * 16 + fq * 4);
        f32x4 fv[2][2];
#pragma unroll
        for (int bj = 0; bj < 2; ++bj)
#pragma unroll
            for (int n = 0; n < 2; ++n) fv[bj][n] = *(const f32x4*)(fw + cbase + bj * 128 + n * 16);
        float rs[8];
#pragma unroll
        for (int k = 0; k < 8; ++k) {
            float t = (sl[k][0] + sl[k][1]) + (sl[k][2] + sl[k][3]);
            t += __shfl_xor(t, 16); t += __shfl_xor(t, 32);
            rs[k] = rsqrtf(t * (1.0f / 1024.0f) + EPS);
        }
#pragma unroll
        for (int k = 0; k < 8; ++k) {
            const int ai = k >> 2, m = k & 3;
            const size_t ro = (size_t)(rbase + ai * 128 + m * 16) * 1024 + cbase;
#pragma unroll
            for (int bj = 0; bj < 2; ++bj)
#pragma unroll
                for (int n = 0; n < 2; ++n) __builtin_nontemporal_store(acc[ai][bj][m][n] * rs[k] * fv[bj][n], (f32x4*)(out + ro + bj * 128 + n * 16));
        }
    }
};
struct SchedIn {
    pg8::StaticOrder so;
    DI bool next(int i, Unit& u) const {
        if (so.G == 256) {
            const int x = so.c & 7, j = so.c >> 3;
            if (j < 3) {
                if (i == 0) { u.pm = 128 + x; u.pn = 1 + j; return true; }
                if (i > 6) return false;
                const int q = 6 * j + (i - 1);
                u.pm = 16 * x + (q >> 2); u.pn = q & 3; return true;
            }
            if (i > 5) return false;
            const int e = (j - 3) + 29 * i;
            if (e < 64) { u.pm = 16 * x + (e >> 2); u.pn = 6 + (e & 3); }
            else if (e < 128) { const int t = e & 3; u.pm = 16 * x + ((e - 64) >> 2); u.pn = t < 2 ? 4 + t : 8 + t; }
            else { const int q = 18 + (e - 128); u.pm = 16 * x + (q >> 2); u.pn = q & 3; }
            return true;
        }
        long L = (long)i * so.G + so.c;
        if (L < so.nwg) return so.next(i, u);
        L -= so.nwg; if (L >= 24) return false;
        u.pm = 128 + (int)(L / 3); u.pn = 1 + (int)(L % 3); return true;
    }
    DI void a_ready(const Unit&) const {}
    DI void done(const Unit&) const {}
};

DI void phase0(const Args& a, LAS unsigned char* lds) {
    const int tid = threadIdx.x;
    float* mod = (float*)(a.ws + WS_MOD);
    LAS float* red = (LAS float*)lds;
    for (int it = blockIdx.x; it < 1233; it += gridDim.x) {
        if (it < 192) {
            const int c0 = it * 16, f = tid & 3, rg = tid >> 2;
            LAS float* scv = red + 36 * 512;
            for (int q = tid; q < 9 * 1024; q += NTHREADS) { const float cv = (q < 8192) ? a.c[q] : a.c_ctx[q - 8192]; scv[q] = cv / (1.0f + expf(-cv)); }
            __syncthreads();
            float acc[9][4];
#pragma unroll
            for (int j = 0; j < 9; ++j)
#pragma unroll
                for (int e = 0; e < 4; ++e) acc[j][e] = 0.f;
            f32x4 wv[8];
#pragma unroll
            for (int i = 0; i < 8; ++i) wv[i] = ldnt_f4(a.w_ada + (size_t)(rg + 128 * i) * 3072 + c0 + f * 4);
#pragma unroll
            for (int i = 0; i < 8; ++i) {
                const int r = rg + 128 * i;
#pragma unroll
                for (int j = 0; j < 9; ++j) {
                    const float sv = scv[j * 1024 + r];
#pragma unroll
                    for (int e = 0; e < 4; ++e) acc[j][e] += sv * wv[i][e];
                }
            }
#pragma unroll
            for (int j = 0; j < 9; ++j)
#pragma unroll
                for (int e = 0; e < 4; ++e) red[(j * 4 + e) * 512 + tid] = acc[j][e];
            __syncthreads();
            if (tid < 144) {
                const int j = tid >> 4, cc = tid & 15, ff = cc >> 2, e = cc & 3;
                float s = 0.f;
                for (int q = 0; q < 128; ++q) s += red[(j * 4 + e) * 512 + q * 4 + ff];
                mod[j * 3072 + c0 + cc] = s + a.b_ada[c0 + cc];
            }
            __syncthreads();
        } else if (it < 1216) {
            const bool is_in = it < 960; const int tt = is_in ? it - 192 : it - 960;
            const int nN = is_in ? 48 : 16, NN = is_in ? 3072 : 1024;
            const int k0 = (tt / nN) * 64, n0 = (tt % nN) * 64;
            int ns = n0;
            if (is_in && ((n0 >= 1536 && n0 < 2048) || n0 >= 2560)) {
                const int base = n0 >= 2560 ? 2560 : 1536, t = (n0 >= 2560 ? 2 : 0) + (n0 - base) / 256, w = (n0 - base) % 256;
                ns = (w < 128 ? 1536 : 2560 - 128) + 128 * t + w;
            }
            const float* src = is_in ? a.w_in : a.w_out;
            bf16_t* dst = (bf16_t*)(a.ws + (is_in ? WS_WIN : WS_WOUT));
            const int kr = tid >> 4, n4 = tid & 15;
#pragma unroll
            for (int p = 0; p < 2; ++p) {
                const int k = kr + 32 * p;
                const f32x4 v = ldnt_f4(src + (size_t)(k0 + k) * NN + ns + n4 * 4);
#pragma unroll
                for (int e = 0; e < 4; ++e) red[k * 65 + n4 * 4 + e] = v[e];
            }
            __syncthreads();
            const int n = tid >> 3, k8 = tid & 7;
            float v[8];
#pragma unroll
            for (int j = 0; j < 8; ++j) v[j] = red[(k8 * 8 + j) * 65 + n];
            const u32x4 o = {pk2(v[0], v[1]), pk2(v[2], v[3]), pk2(v[4], v[5]), pk2(v[6], v[7])};
            *(u32x4*)(dst + (size_t)(n0 + n) * 1024 + k0 + k8 * 8) = o;
            __syncthreads();
        } else if (it < 1232) {
            const size_t base = (size_t)(it - 1216) * 4096 + tid * 8;
            const f32x4 v0 = *(const f32x4*)(a.w_s + base), v1 = *(const f32x4*)(a.w_s + base + 4);
            const u32x4 o = {pk2(v0[0], v0[1]), pk2(v0[2], v0[3]), pk2(v1[0], v1[1]), pk2(v1[2], v1[3])};
            *(u32x4*)((bf16_t*)(a.ws + WS_WSB) + base) = o;
        } else {
            float* rc = (float*)(a.ws + WS_ROPE); float* rs = rc + 1024;
            for (int idx = tid; idx < 1024; idx += NTHREADS) {
                const int pos = idx >> 4, fi = idx & 15;
                const float inv = powf(10000.0f, -(float)fi / 16.0f), ang = (float)pos * inv;
                rc[idx] = cosf(ang); rs[idx] = sinf(ang);
            }
        }
    }
}

template <int R> DI void norm_rows(const Args& a, const float* mod, bf16_t* H, const int (&rows)[R], int lane) {
    f32x4 v[R][4]; const float* mrow[R];
#pragma unroll
    for (int k = 0; k < R; ++k) {
        const int r = rows[k]; const float* src; int j;
        if (r < NTOK) { src = a.x + (size_t)r * 1024; j = r >> 12; } else { src = a.ctx + (size_t)(r - NTOK) * 1024; j = 8; }
        mrow[k] = mod + j * 3072;
#pragma unroll
        for (int q = 0; q < 4; ++q) v[k][q] = ldnt_f4(src + q * 256 + lane * 4);
    }
#pragma unroll
    for (int k = 0; k < R; ++k) {
        float ss = 0.f;
#pragma unroll
        for (int q = 0; q < 4; ++q) ss += v[k][q][0] * v[k][q][0] + v[k][q][1] * v[k][q][1] + v[k][q][2] * v[k][q][2] + v[k][q][3] * v[k][q][3];
#pragma unroll
        for (int off = 32; off >= 1; off >>= 1) ss += __shfl_xor(ss, off);
        const float rstd = rsqrtf(ss * (1.0f / 1024.0f) + EPS);
#pragma unroll
        for (int q = 0; q < 4; ++q) {
            const int cidx = q * 256 + lane * 4;
            const f32x4 nw = *(const f32x4*)(a.norm_w + cidx), sc = *(const f32x4*)(mrow[k] + 1024 + cidx), sh = *(const f32x4*)(mrow[k] + cidx);
            f32x4 hv;
#pragma unroll
            for (int e = 0; e < 4; ++e) hv[e] = (v[k][q][e] * rstd * nw[e]) * (1.0f + sc[e]) + sh[e];
            const u32x2 o = {pk2(hv[0], hv[1]), pk2(hv[2], hv[3])};
            *(u32x2*)(H + (size_t)rows[k] * 1024 + cidx) = o;
        }
    }
}
DI void norm_row(const Args& a, const float* mod, bf16_t* H, int r, int lane) { const int rows[1] = {r}; norm_rows<1>(a, mod, H, rows, lane); }
DI void phase1(const Args& a) {
    const int tid = threadIdx.x, wave = tid >> 6, lane = tid & 63, blk = blockIdx.x, G = gridDim.x;
    const float* mod = (const float*)(a.ws + WS_MOD);
    bf16_t* H = (bf16_t*)(a.ws + WS_H);
    constexpr int NCH = (NTOK + NCTX) / 8;
    int ch = blk;
    for (; ch + 3 * G < NCH; ch += 4 * G) { const int rows[4] = {ch * 8 + wave, (ch + G) * 8 + wave, (ch + 2 * G) * 8 + wave, (ch + 3 * G) * 8 + wave}; norm_rows<4>(a, mod, H, rows, lane); }
    for (; ch < NCH; ch += G) norm_row(a, mod, H, ch * 8 + wave, lane);
}

constexpr int VS = 288, KS = 144, KS2 = 160;
DI void gmlp_unit(const Args& a, LAS unsigned char* lds, int b, int c) {
    const int tid = threadIdx.x, lane = tid & 63, w = tid >> 6, i = lane & 15, g = lane >> 4;
    const int r0 = b * 4096 + c * 128;
    const bf16_t* VG = (const bf16_t*)(a.ws + WS_VG); const bf16_t* U = (const bf16_t*)(a.ws + WS_U);
    const bf16_t* WSB = (const bf16_t*)(a.ws + WS_WSB); bf16_t* Y = (bf16_t*)(a.ws + WS_H);
    constexpr int GSZ = 128 * VS;
    {
        const int row = tid >> 2, q = tid & 3;
        const bf16_t* src = VG + (size_t)(r0 + row) * 512 + q * 128;
        float s = 0.f, s2 = 0.f;
#pragma unroll 8
        for (int p = 0; p < 16; ++p) {
            const u32x4 pc = *(const u32x4*)(src + p * 8);
#pragma unroll
            for (int e = 0; e < 4; ++e) { const float lo = bflo(pc[e]), hi = bfhi(pc[e]); s += lo + hi; s2 += lo * lo + hi * hi; }
        }
        s += __shfl_xor(s, 1); s += __shfl_xor(s, 2); s2 += __shfl_xor(s2, 1); s2 += __shfl_xor(s2, 2);
        const float mean = s * (1.0f / 512.0f);
        const float var = fmaxf(s2 * (1.0f / 512.0f) - mean * mean, 0.f);
        const float rstd = rsqrtf(var + EPS);
        const float* lw = a.ln_w + q * 128;
#pragma unroll 4
        for (int p = 0; p < 16; ++p) {
            const u32x4 pc = *(const u32x4*)(src + p * 8);
            const f32x4 w0 = *(const f32x4*)(lw + p * 8), w1 = *(const f32x4*)(lw + p * 8 + 4);
            u32x4 o;
            o[0] = pk2((bflo(pc[0]) - mean) * rstd * w0[0], (bfhi(pc[0]) - mean) * rstd * w0[1]);
            o[1] = pk2((bflo(pc[1]) - mean) * rstd * w0[2], (bfhi(pc[1]) - mean) * rstd * w0[3]);
            o[2] = pk2((bflo(pc[2]) - mean) * rstd * w1[0], (bfhi(pc[2]) - mean) * rstd * w1[1]);
            o[3] = pk2((bflo(pc[3]) - mean) * rstd * w1[2], (bfhi(pc[3]) - mean) * rstd * w1[3]);
            *(LAS u32x4*)(lds + q * GSZ + row * VS + p * 16) = o;
        }
    }
    __syncthreads();
    const int n = 16 * w + i, r = r0 + n;
#pragma unroll 1
    for (int gq = 0; gq < 4; ++gq) {
        f32x4 acc[8];
#pragma unroll
        for (int et = 0; et < 8; ++et) acc[et] = (f32x4){0.f, 0.f, 0.f, 0.f};
        const bf16_t* wrow = WSB + (size_t)(gq * 128 + n) * 128;
        bf16x8 bw[4];
#pragma unroll
        for (int s = 0; s < 4; ++s) bw[s] = frag_rowP(wrow + 32 * s, g);
#pragma unroll
        for (int s = 0; s < 4; ++s) {
#pragma unroll
            for (int et = 0; et < 8; ++et) acc[et] = mfma16(frag_tr(lds + gq * GSZ, VS, 32 * s, 16 * et, lane), bw[s], acc[et]);
        }
        const float bias = a.b_s[gq * 128 + n];
#pragma unroll
        for (int et = 0; et < 8; et += 2) {
            const int colw = gq * 128 + 16 * (et + (g & 1)) + 8 * (g >> 1);
            const u32x4 uw = *(const u32x4*)(U + (size_t)r * 512 + colw);
            const u32x2 ux = __builtin_amdgcn_permlane16_swap(uw[0], uw[2], false, false), uy = __builtin_amdgcn_permlane16_swap(uw[1], uw[3], false, false);
            const u32x2 ua = {ux[0], uy[0]}, ub = {ux[1], uy[1]};
            const u32x2 oa = {pk2(bflo(ua.x) * (acc[et][0] + bias), bfhi(ua.x) * (acc[et][1] + bias)), pk2(bflo(ua.y) * (acc[et][2] + bias), bfhi(ua.y) * (acc[et][3] + bias))};
            const u32x2 ob = {pk2(bflo(ub.x) * (acc[et + 1][0] + bias), bfhi(ub.x) * (acc[et + 1][1] + bias)), pk2(bflo(ub.y) * (acc[et + 1][2] + bias), bfhi(ub.y) * (acc[et + 1][3] + bias))};
            const u32x2 wx = __builtin_amdgcn_permlane16_swap(oa.x, ob.x, false, false), wy = __builtin_amdgcn_permlane16_swap(oa.y, ob.y, false, false);
            const u32x4 ow = {wx[0], wy[0], wx[1], wy[1]};
            *(u32x4*)(Y + (size_t)r * 1024 + 512 + colw) = ow;
        }
    }
    __syncthreads();
}
struct ChStage { u32x4 kf[2], kb[2], v; };
DI void chain_load(const Args& a, int bh, int es, int it, ChStage& st) {
    const int tid = threadIdx.x;
    const bf16_t *Kf, *Kb, *Vf, *Vb;
    if (it < 2) {
        const size_t of = (size_t)bh * 256 + it * 128, ob = (size_t)bh * 256 + (1 - it) * 128;
        Kf = (const bf16_t*)(a.ws + WS_KC) + of * 64; Vf = (const bf16_t*)(a.ws + WS_VC) + of * 128; Kb = (const bf16_t*)(a.ws + WS_KC) + ob * 64; Vb = (const bf16_t*)(a.ws + WS_VC) + ob * 128;
    } else {
        const size_t of = (size_t)bh * 4096 + (it - 2) * 128, ob = (size_t)bh * 4096 + (33 - it) * 128;
        Kf = (const bf16_t*)(a.ws + WS_K) + of * 64; Vf = (const bf16_t*)(a.ws + WS_V) + of * 128; Kb = (const bf16_t*)(a.ws + WS_K) + ob * 64; Vb = (const bf16_t*)(a.ws + WS_V) + ob * 128;
    }
#pragma unroll
    for (int q = 0; q < 2; ++q) { const int p = tid + 512 * q; st.kf[q] = *(const u32x4*)(Kf + (p >> 3) * 64 + (p & 7) * 8); st.kb[q] = *(const u32x4*)(Kb + (p >> 3) * 64 + (p & 7) * 8); }
    const int t = tid & 255; const bf16_t* Vx = (tid < 256) ? Vf : Vb;
    st.v = *(const u32x4*)(Vx + (t >> 1) * 128 + es * 16 + (t & 1) * 8);
}
DI void chain_item(const Args& a, LAS unsigned char* lds, int item) {
    const int tid = threadIdx.x, lane = tid & 63, w = tid >> 6, i = lane & 15, g = lane >> 4;
    const int bh = item >> 3, es = item & 7, h = bh & 3, dirw = w >> 2, dt = w & 3;
    const float l2f = -expf(a.dec_f[h]) * LOG2E, l2b = -expf(a.dec_b[h]) * LOG2E;
    const float G = exp2f(128.0f * (dirw ? l2b : l2f));
    constexpr int BUFSZ = 2 * 128 * KS2 + 2 * 128 * 32;
    float tf[2], tb[2];
#pragma unroll
    for (int q = 0; q < 2; ++q) { const int m = (tid >> 3) + 64 * q; tf[q] = exp2f((float)(127 - m) * l2f); tb[q] = exp2f((float)m * l2b); }
    bf16_t* ST = (bf16_t*)(a.ws + WS_ST);
    f32x4 S = {0.f, 0.f, 0.f, 0.f};
    ChStage st0, st1, st2, st3;
    chain_load(a, bh, es, 0, st0); chain_load(a, bh, es, 1, st1); chain_load(a, bh, es, 2, st2);
#define CH_STEP(IT, CUR, NXT, STORE) do { const int it = (IT); { \
        LAS unsigned char* buf = lds + (it & 1) * BUFSZ; \
        LAS unsigned char* KFs = buf; LAS unsigned char* KBs = buf + 128 * KS2; LAS unsigned char* VFs = buf + 2 * 128 * KS2; LAS unsigned char* VBs = VFs + 128 * 32; \
        _Pragma("unroll") for (int q = 0; q < 2; ++q) { \
            const int p = tid + 512 * q, m = p >> 3, d8 = p & 7; \
            u32x4 of, ob; \
            _Pragma("unroll") for (int e = 0; e < 4; ++e) { of[e] = pk2(bflo(CUR.kf[q][e]) * tf[q], bfhi(CUR.kf[q][e]) * tf[q]); ob[e] = pk2(bflo(CUR.kb[q][e]) * tb[q], bfhi(CUR.kb[q][e]) * tb[q]); } \
            *(LAS u32x4*)(KFs + m * KS2 + d8 * 16) = of; *(LAS u32x4*)(KBs + m * KS2 + d8 * 16) = ob; \
        } \
        { const int t = tid & 255; *(LAS u32x4*)((tid < 256 ? VFs : VBs) + (t >> 1) * 32 + (t & 1) * 16) = CUR.v; } \
        lds_barrier(); \
        chain_load(a, bh, es, (it + 3 < 34) ? it + 3 : 33, NXT);                  \
        LAS const unsigned char* Kx = dirw ? KBs : KFs; LAS const unsigned char* Vx = dirw ? VBs : VFs; \
        f32x4 kv = {0.f, 0.f, 0.f, 0.f}; \
        _Pragma("unroll") for (int s = 0; s < 4; ++s) kv = mfma16(frag_tr(Vx, 32, 32 * s, 0, lane), frag_tr(Kx, KS2, 32 * s, 16 * dt, lane), kv); \
        if (STORE) {                                                              \
            const int c = dirw ? 33 - it : it - 2; \
            const u32x2 o = {pk2(S[0], S[1]), pk2(S[2], S[3])}; \
            *(u32x2*)(ST + (((size_t)(bh * 32 + c) * 2 + dirw) * 64 + 16 * dt + i) * 128 + es * 16 + 4 * g) = o; \
        } \
        S = S * G + kv; } } while (0)
    CH_STEP(0, st0, st3, false); CH_STEP(1, st1, st0, false);
#pragma unroll 1
    for (int it4 = 2; it4 < 34; it4 += 4) {
        CH_STEP(it4, st2, st1, true); CH_STEP(it4 + 1, st3, st2, true); CH_STEP(it4 + 2, st0, st3, true); CH_STEP(it4 + 3, st1, st0, true);
    }
#undef CH_STEP
    __syncthreads();
}
DI void phase3(const Args& a, LAS unsigned char* lds) {
    for (int it = blockIdx.x; it < 256; it += gridDim.x) gmlp_unit(a, lds, it >> 5, it & 31);
    for (int it = blockIdx.x; it < 256; it += gridDim.x) { const int j = it >> 3; chain_item(a, lds, (((it & 7) * 4 + (j >> 3)) << 3) + (j & 7)); }
}

DI void phase4(const Args& a) {
    const float* KV = (const float*)(a.ws + WS_KV); const float* KVC = (const float*)(a.ws + WS_KVC);
    bf16_t* ST = (bf16_t*)(a.ws + WS_ST);
    for (int idx = blockIdx.x * NTHREADS + threadIdx.x; idx < 64 * 2048; idx += gridDim.x * NTHREADS) {
        const int chain = idx >> 11, pos = idx & 2047, bh = chain >> 1, dir = chain & 1, h = bh & 3;
        const float lg = -expf(dir ? a.dec_b[h] : a.dec_f[h]), G = expf(128.0f * lg);
        const f32x4 k0 = *(const f32x4*)(KVC + ((size_t)(bh * 2 + 0) * 2 + dir) * 8192 + pos * 4);
        const f32x4 k1 = *(const f32x4*)(KVC + ((size_t)(bh * 2 + 1) * 2 + dir) * 8192 + pos * 4);
        f32x4 S = dir ? (k1 * G + k0) : (k0 * G + k1);
#pragma unroll 8
        for (int step = 0; step < NC; ++step) {
            const int c = dir ? (NC - 1 - step) : step;
            const size_t off = ((size_t)(bh * 32 + c) * 2 + dir) * 8192 + pos * 4;
            const f32x4 kvv = *(const f32x4*)(KV + off);
            const u32x2 o = {pk2(S[0], S[1]), pk2(S[2], S[3])};
            *(u32x2*)(ST + off) = o;
            S = S * G + kvv;
        }
    }
}

struct RetStage { u32x4 k[2], v[4], sf[2], sb[2]; bf16x8 q[2]; };
DI void ret_load(const Args& a, int unit, RetStage& st) {
    const int tid = threadIdx.x, lane = tid & 63, w = tid >> 6, i = lane & 15, g = lane >> 4;
    const int bh = unit >> 5, c = unit & 31;
    const bf16_t* Qp = (const bf16_t*)(a.ws + WS_Q) + ((size_t)bh * 4096 + c * 128) * 64;
    const bf16_t* Kp = (const bf16_t*)(a.ws + WS_K) + ((size_t)bh * 4096 + c * 128) * 64;
    const bf16_t* Vp = (const bf16_t*)(a.ws + WS_V) + ((size_t)bh * 4096 + c * 128) * 128;
    const bf16_t* SFp = (const bf16_t*)(a.ws + WS_ST) + (size_t)unit * 16384; const bf16_t* SBp = SFp + 8192;
#pragma unroll
    for (int q = 0; q < 2; ++q) { const int p = tid + 512 * q; st.k[q] = *(const u32x4*)(Kp + (p >> 3) * 64 + (p & 7) * 8); }
#pragma unroll
    for (int q = 0; q < 4; ++q) { const int p = tid + 512 * q; st.v[q] = *(const u32x4*)(Vp + (p >> 4) * 128 + (p & 15) * 8); }
#pragma unroll
    for (int q = 0; q < 2; ++q) { const int p = tid + 512 * q; st.sf[q] = *(const u32x4*)(SFp + (p >> 4) * 128 + (p & 15) * 8); st.sb[q] = *(const u32x4*)(SBp + (p >> 4) * 128 + (p & 15) * 8); }
#pragma unroll
    for (int s = 0; s < 2; ++s) st.q[s] = frag_rowP(Qp + (16 * w + i) * 64 + 32 * s, g);
}
DI void ret_unit(const Args& a, LAS unsigned char* lds, int unit, RetStage& st, int next_unit) {
    const int tid = threadIdx.x, lane = tid & 63, w = tid >> 6, i = lane & 15, g = lane >> 4;
    const int bh = unit >> 5, c = unit & 31, b = bh >> 2, h = bh & 3;
    const bf16_t* GR = (const bf16_t*)(a.ws + WS_GR); bf16_t* Y = (bf16_t*)(a.ws + WS_H);
    LAS unsigned char* Kt = lds; LAS unsigned char* Vt = lds + 128 * KS; LAS unsigned char* SF = Vt + 128 * VS; LAS unsigned char* SB = SF + 64 * VS;
#pragma unroll
    for (int q = 0; q < 2; ++q) { const int p = tid + 512 * q; *(LAS u32x4*)(Kt + (p >> 3) * KS + (p & 7) * 16) = st.k[q]; }
#pragma unroll
    for (int q = 0; q < 4; ++q) { const int p = tid + 512 * q; *(LAS u32x4*)(Vt + (p >> 4) * VS + (p & 15) * 16) = st.v[q]; }
#pragma unroll
    for (int q = 0; q < 2; ++q) { const int p = tid + 512 * q; *(LAS u32x4*)(SF + (p >> 4) * VS + (p & 15) * 16) = st.sf[q]; *(LAS u32x4*)(SB + (p >> 4) * VS + (p & 15) * 16) = st.sb[q]; }
    bf16x8 Qf[2];
#pragma unroll
    for (int s = 0; s < 2; ++s) Qf[s] = st.q[s];
    lds_barrier();
    if (next_unit >= 0) ret_load(a, next_unit, st);
    const float l2f = -expf(a.dec_f[h]) * LOG2E, l2b = -expf(a.dec_b[h]) * LOG2E;
    const int n = 16 * w + i;

    f32x4 accS[8];
#pragma unroll
    for (int mt = 0; mt < 8; ++mt) {
        accS[mt] = (f32x4){0.f, 0.f, 0.f, 0.f};
#pragma unroll
        for (int s = 0; s < 2; ++s) accS[mt] = mfma16(frag_rowP_lds(Kt + (16 * mt + i) * KS + 64 * s, g), Qf[s], accS[mt]);
    }
#pragma unroll
    for (int mt = 0; mt < 8; ++mt)
#pragma unroll
        for (int reg = 0; reg < 4; ++reg) {
            const int diff = n - (16 * mt + 4 * g + reg);
            const float ex = __builtin_amdgcn_exp2f(diff > 0 ? (float)diff * l2f : (float)(-diff) * l2b);
            accS[mt][reg] *= (diff == 0 ? 2.0f : ex);
        }
    const float fsf = __builtin_amdgcn_exp2f((float)(n + 1) * l2f), fsb = __builtin_amdgcn_exp2f((float)(128 - n) * l2b);
    f32x4 accO[8];
#pragma unroll
    for (int et = 0; et < 8; ++et) accO[et] = (f32x4){0.f, 0.f, 0.f, 0.f};
#pragma unroll
    for (int s = 0; s < 4; ++s) {
        const u32x4 pu = {pk2(accS[2 * s][0], accS[2 * s][1]), pk2(accS[2 * s][2], accS[2 * s][3]), pk2(accS[2 * s + 1][0], accS[2 * s + 1][1]), pk2(accS[2 * s + 1][2], accS[2 * s + 1][3])};
        const bf16x8 Pf = __builtin_bit_cast(bf16x8, pu);
#pragma unroll
        for (int et = 0; et < 8; ++et) accO[et] = mfma16(frag_tr(Vt, VS, 32 * s, 16 * et, lane), Pf, accO[et]);
        __builtin_amdgcn_sched_barrier(0);
    }
#pragma unroll
    for (int s = 0; s < 2; ++s) {
        const bf16x8 qsf = scale_frag(Qf[s], fsf), qsb = scale_frag(Qf[s], fsb);
#pragma unroll
        for (int et = 0; et < 8; ++et) {
            accO[et] = mfma16(frag_tr(SF, VS, 32 * s, 16 * et, lane), qsf, accO[et]);
            accO[et] = mfma16(frag_tr(SB, VS, 32 * s, 16 * et, lane), qsb, accO[et]);
        }
        __builtin_amdgcn_sched_barrier(0);
    }
    float sm = 0.f;
#pragma unroll
    for (int et = 0; et < 8; ++et) sm += accO[et][0] + accO[et][1] + accO[et][2] + accO[et][3];
    sm += __shfl_xor(sm, 16); sm += __shfl_xor(sm, 32);
    const float mean = sm * (1.0f / 128.0f);
    float v2 = 0.f;
#pragma unroll
    for (int et = 0; et < 8; ++et)
#pragma unroll
        for (int e = 0; e < 4; ++e) { const float d0 = accO[et][e] - mean; v2 += d0 * d0; }
    v2 += __shfl_xor(v2, 16); v2 += __shfl_xor(v2, 32);
    const float rstd = rsqrtf(v2 * (1.0f / 128.0f) + EPS);
    const int r = b * 4096 + c * 128 + n;
#pragma unroll
    for (int et = 0; et < 8; et += 2) {
        const int colw = h * 128 + 16 * (et + (g & 1)) + 8 * (g >> 1);
        const u32x4 gww = *(const u32x4*)(GR + (size_t)r * 512 + colw);
        const u32x2 gx = __builtin_amdgcn_permlane16_swap(gww[0], gww[2], false, false), gy = __builtin_amdgcn_permlane16_swap(gww[1], gww[3], false, false);
        const u32x2 ga = {gx[0], gy[0]}, gb = {gx[1], gy[1]};
        const f32x4 wa = *(const f32x4*)(a.gn_w + h * 128 + 16 * et + 4 * g), wb = *(const f32x4*)(a.gn_w + h * 128 + 16 * (et + 1) + 4 * g);
        const u32x2 oa = {pk2((accO[et][0] - mean) * rstd * wa[0] * bflo(ga.x), (accO[et][1] - mean) * rstd * wa[1] * bfhi(ga.x)),
                          pk2((accO[et][2] - mean) * rstd * wa[2] * bflo(ga.y), (accO[et][3] - mean) * rstd * wa[3] * bfhi(ga.y))};
        const u32x2 ob = {pk2((accO[et + 1][0] - mean) * rstd * wb[0] * bflo(gb.x), (accO[et + 1][1] - mean) * rstd * wb[1] * bfhi(gb.x)),
                          pk2((accO[et + 1][2] - mean) * rstd * wb[2] * bflo(gb.y), (accO[et + 1][3] - mean) * rstd * wb[3] * bfhi(gb.y))};
        const u32x2 wx = __builtin_amdgcn_permlane16_swap(oa.x, ob.x, false, false), wy = __builtin_amdgcn_permlane16_swap(oa.y, ob.y, false, false);
        const u32x4 ow = {wx[0], wy[0], wx[1], wy[1]};
        *(u32x4*)(Y + (size_t)r * 1024 + colw) = ow;
    }
    lds_barrier();
}

DI void phase7(const Args& a) {
    const int tid = threadIdx.x, wave = tid >> 6, lane = tid & 63;
    for (int r = blockIdx.x * 8 + wave; r < NTOK; r += gridDim.x * 8) {
        float* row = a.out + (size_t)r * 1024;
        f32x4 v[4]; float ss = 0.f;
#pragma unroll
        for (int q = 0; q < 4; ++q) { v[q] = *(const f32x4*)(row + q * 256 + lane * 4); ss += v[q][0] * v[q][0] + v[q][1] * v[q][1] + v[q][2] * v[q][2] + v[q][3] * v[q][3]; }
#pragma unroll
        for (int off = 32; off >= 1; off >>= 1) ss += __shfl_xor(ss, off);
        const float rstd = rsqrtf(ss * (1.0f / 1024.0f) + EPS);
#pragma unroll
        for (int q = 0; q < 4; ++q) {
            const f32x4 fw = *(const f32x4*)(a.fnorm_w + q * 256 + lane * 4);
            *(f32x4*)(row + q * 256 + lane * 4) = v[q] * rstd * fw;
        }
    }
}

__global__ __launch_bounds__(512, 2) void fwd_megakernel(Args a) {
    extern __shared__ __attribute__((aligned(16))) unsigned char shm[];
    LAS unsigned char* lds = (LAS unsigned char*)shm;
    cg::grid_group grid = cg::this_grid();
    volatile LAS unsigned* st = (volatile LAS unsigned*)(lds + LDS_BYTES - 16);
    if (threadIdx.x == 0) { st[0] = 0u; st[1] = 0u; }
    __syncthreads();
    const XcdBarrier xb = xcd_barrier_post((unsigned*)(a.ws + WS_BAR), st);
    if (a.ph_hi > 7) grid.sync();
#ifndef PHMASK
#define PHMASK 255
#endif
#ifndef REPMASK
#define REPMASK 0
#endif
#ifndef EXTRA_SYNCS
#define EXTRA_SYNCS 0
#endif
#define GSYNC() xcd_barrier(xb)
    for (int xs = 0; xs < EXTRA_SYNCS; ++xs) GSYNC();
#define PHASE(P, ...) do { if (((PHMASK >> (P)) & 1) && a.ph_lo <= (P) && (P) < a.ph_hi) { if ((REPMASK >> (P)) & 1) { __VA_ARGS__; GSYNC(); } __VA_ARGS__; if ((P) + 1 < a.ph_hi) GSYNC(); } } while (0)
    PHASE(0, phase0(a, lds));
    PHASE(1, phase1(a));
    PHASE(2, {
        pg8::Gemm gm{(const bf16_t*)(a.ws + WS_H), (const bf16_t*)(a.ws + WS_WIN), NTOK, NP, D};
        SchedIn S; S.so.init(NTOK, NP, (int)gridDim.x, (int)blockIdx.x);
        EpiIn E{a.ws};
        pg8::gemm_phase<EpiIn, SchedIn, false>(lds, gm, S, E, nullptr);
    });
    PHASE(3, phase3(a, lds));
    PHASE(5, { int it = blockIdx.x; if (it < 1024) { RetStage st; ret_load(a, it, st); for (;;) { const int nx = it + (int)gridDim.x; ret_unit(a, lds, it, st, nx < 1024 ? nx : -1); if (nx >= 1024) break; it = nx; } } });
    PHASE(6, {
        pg8::Gemm gm{(const bf16_t*)(a.ws + WS_H), (const bf16_t*)(a.ws + WS_WOUT), NTOK, D, D};
        pg8::StaticOrder S; S.init(NTOK, D, (int)gridDim.x, (int)blockIdx.x);
        EpiOut E{a.x, (const float*)(a.ws + WS_MOD), a.fnorm_w, a.out, (float*)(a.ws + WS_SLOT), (unsigned*)(a.ws + WS_CNT)};
        pg8::gemm_phase<EpiOut, pg8::StaticOrder, false>(lds, gm, S, E, nullptr);
    });
#undef PHASE
}

extern "C" void kernel_launch(void* const* d_in, const int* in_sizes, int n_in, void* d_out, int out_size, void* d_ws, size_t ws_size, hipStream_t stream) {
    static int grid = 0;
    if (grid == 0) {
        if (n_in != 16 || out_size != NTOK * D || ws_size < WS_END) { fprintf(stderr, "kernel_launch: unexpected shapes (n_in %d out %d ws %zu need %zu)\n", n_in, out_size, ws_size, (size_t)WS_END); grid = -1; return; }
        int dev = 0, cus = 0, per_cu = 0;
        (void)hipGetDevice(&dev); (void)hipDeviceGetAttribute(&cus, hipDeviceAttributeMultiprocessorCount, dev);
        if (hipFuncSetAttribute((const void*)fwd_megakernel, hipFuncAttributeMaxDynamicSharedMemorySize, LDS_BYTES) != hipSuccess) { fprintf(stderr, "kernel_launch: hipFuncSetAttribute failed\n"); grid = -1; return; }
        if (hipOccupancyMaxActiveBlocksPerMultiprocessor(&per_cu, (const void*)fwd_megakernel, NTHREADS, LDS_BYTES) != hipSuccess || per_cu < 1) { fprintf(stderr, "kernel_launch: occupancy query gives %d\n", per_cu); per_cu = 1; }
        (void)hipGetLastError();
        grid = cus;
    }
    if (grid < 0) return;
    Args a{};
    a.x = (const float*)d_in[0]; a.c = (const float*)d_in[1]; a.ctx = (const float*)d_in[2]; a.c_ctx = (const float*)d_in[3]; a.w_ada = (const float*)d_in[4]; a.b_ada = (const float*)d_in[5];
    a.norm_w = (const float*)d_in[6]; a.w_in = (const float*)d_in[7]; a.dec_f = (const float*)d_in[8]; a.dec_b = (const float*)d_in[9]; a.gn_w = (const float*)d_in[10]; a.ln_w = (const float*)d_in[11];
    a.w_s = (const float*)d_in[12]; a.b_s = (const float*)d_in[13]; a.w_out = (const float*)d_in[14]; a.fnorm_w = (const float*)d_in[15];
    a.out = (float*)d_out; a.ws = (unsigned char*)d_ws;
    (void)hipMemsetAsync((unsigned char*)d_ws + WS_BAR, 0, (size_t)XCD_BAR_WORDS * 4 + 32768, stream);
#if N_LAUNCHES == 1
    a.ph_lo = 0; a.ph_hi = 7;
    void* args[] = {&a};
    hipError_t e = hipLaunchCooperativeKernel((const void*)fwd_megakernel, dim3(grid), dim3(NTHREADS), args, LDS_BYTES, stream);
    if (e != hipSuccess) fprintf(stderr, "cooperative launch failed: %s (grid %d)\n", hipGetErrorString(e), grid);
#else
    for (int p = 0; p < 7; ++p) {
        a.ph_lo = p; a.ph_hi = p + 1;
        hipLaunchKernelGGL(fwd_megakernel, dim3(grid), dim3(NTHREADS), LDS_BYTES, stream, a);
    }
#endif
}
```

```cpp
#include <hip/hip_runtime.h>
#include <hip/hip_cooperative_groups.h>
#include <cstdio>
namespace cg = cooperative_groups;
#ifndef N_LAUNCHES
#define N_LAUNCHES 1
#endif
namespace pg8 {
#define PG8_LAS __attribute__((address_space(3)))
typedef unsigned short bf16_t;
typedef short bf16x8 __attribute__((ext_vector_type(8)));
typedef float f32x4 __attribute__((ext_vector_type(4)));
typedef unsigned u32x4 __attribute__((ext_vector_type(4)));
constexpr int BM = 256, BK = 64, HALF = 128, HTB = HALF * BK * 2  , STAGE_BYTES = 8 * HTB, NXCD = 8, WGM = 8;

__host__ __device__ __forceinline__ int lds_byte(int r, int c) { const int st = (r >> 4) * 2 + (c >> 5), rr = r & 15, cc = c & 31, ob = rr * 64 + cc * 2; return st * 1024 + (ob ^ (((ob >> 9) & 1) << 5)); }
__host__ __device__ __forceinline__ void stage_rc(int b, int& R, int& C) { const int st = b / 1024, sb = b % 1024, swz = sb ^ (((sb >> 9) & 1) << 5); R = (st >> 1) * 16 + swz / 64; C = (st & 1) * 32 + (swz % 64) / 2; }
__host__ __device__ __forceinline__ int perm32(int rho) { const int n = rho >> 4, i = rho & 15; return 8 * (i >> 2) + 4 * n + (i & 3); }

struct Unit { int pm, pn; };
struct Gemm { const bf16_t* A; const bf16_t* Bt; int M, N, K; };

struct StaticOrder {
    int nM, nN, nwg, G, c;
    __host__ __device__ void init(int M, int N, int G_, int c_) { nM = M / BM; nN = N / BM; nwg = nM * nN; G = G_; c = c_; }
    __host__ __device__ bool next(int i, Unit& u) const {
        const long L = (long)i * G + c; if (L >= nwg) return false;
        int wgid = (int)L; { const int q = nwg / NXCD, r = nwg % NXCD, xcd = wgid % NXCD, off = wgid / NXCD; wgid = (xcd < r ? xcd * (q + 1) : r * (q + 1) + (xcd - r) * q) + off; }
        const int nig = WGM * nN, gid = wgid / nig, fm = gid * WGM, gsz = (nM - fm) < WGM ? (nM - fm) : WGM;
        u.pm = fm + ((wgid % nig) % gsz); u.pn = (wgid % nig) / gsz; return true;
    }
    __device__ __forceinline__ void a_ready(const Unit&) const {}
    __device__ __forceinline__ void done(const Unit&) const {}
};
struct CountedOrder : StaticOrder {
    const unsigned* ready; unsigned need; unsigned* tmo;
    __device__ __forceinline__ void a_ready(const Unit& u) const {
        if (threadIdx.x < 64) {
            const unsigned long long t0 = __builtin_amdgcn_s_memrealtime(); unsigned polls = 0;
            while ((unsigned)__builtin_amdgcn_readfirstlane(__hip_atomic_load(ready + 64 * u.pm, __ATOMIC_RELAXED, __HIP_MEMORY_SCOPE_AGENT)) < need) {
                if ((++polls & 255u) == 0u && __builtin_amdgcn_readfirstlane(__hip_atomic_load(tmo, __ATOMIC_RELAXED, __HIP_MEMORY_SCOPE_AGENT)) != 0u) break;
                if (__builtin_amdgcn_s_memrealtime() - t0 > 2000000ull) {
                    if (threadIdx.x == 0) { unsigned expect = 0u; __hip_atomic_compare_exchange_strong(tmo + 1, &expect, 0x600u | (unsigned)(u.pm & 0xff), __ATOMIC_RELAXED, __ATOMIC_RELAXED, __HIP_MEMORY_SCOPE_AGENT); __hip_atomic_store(tmo, 1u, __ATOMIC_RELAXED, __HIP_MEMORY_SCOPE_AGENT); }
                    break; }
                __builtin_amdgcn_s_sleep(2); }
            __builtin_amdgcn_fence(__ATOMIC_ACQUIRE, "agent");
            asm volatile("s_waitcnt vmcnt(0)" ::: "memory");
        }
#if !defined(BROKEN_HOOK_NO_BARRIER)
        asm volatile("" ::: "memory"); __builtin_amdgcn_s_barrier(); asm volatile("" ::: "memory");
#endif
    }
};

__device__ __forceinline__ unsigned cvt_pk_bf16(float lo, float hi) { unsigned r; asm volatile("v_cvt_pk_bf16_f32 %0, %1, %2" : "=v"(r) : "v"(lo), "v"(hi)); return r; }
typedef float f32x2 __attribute__((ext_vector_type(2)));
__device__ __forceinline__ f32x2 gelu_pk(f32x2 v) {
    const f32x2 av = __builtin_elementwise_abs(v), d = av * 0.2316418882f + 1.0f;
    f32x2 t; t.x = __builtin_amdgcn_rcpf(d.x); t.y = __builtin_amdgcn_rcpf(d.y);
    f32x2 q = t * 0.5307027145f + (-0.7265760135f); q = q * t + 0.7107068705f; q = q * t + (-0.142248368f); q = q * t + 0.127414796f; q = q * t;
    const f32x2 s = (v * v) * (-0.72134752044f);
    f32x2 e; e.x = __builtin_amdgcn_exp2f(s.x); e.y = __builtin_amdgcn_exp2f(s.y);
    const f32x2 m = v * (q * e), r = v - m;
    f32x2 o; o.x = v.x < 0.f ? m.x : r.x; o.y = v.y < 0.f ? m.y : r.y; return o;
}
template <class Epi, class Sched, bool STAMP = false>
__device__ __forceinline__ void gemm_phase(PG8_LAS unsigned char* lds, const Gemm g, const Sched& S, const Epi& E, unsigned long long* stamps) {
    const int tid = threadIdx.x, wid = __builtin_amdgcn_readfirstlane(tid >> 6), lane = tid & 63, wr = wid >> 2, wc = wid & 3, fr = lane & 15, fq = lane >> 4;
    const int K = g.K, nt = K / BK;
    int ts_lo = 0, ts_hi = 0, nts = 0; const unsigned long long rt_entry = STAMP ? (unsigned long long)wall_clock64() : 0ull;
#define PG8_STAMP() do { if (STAMP && wid == 0 && nts < 64) { const unsigned long long _c = (unsigned long long)clock64(); \
        ts_lo = (lane == nts) ? (int)(unsigned)_c : ts_lo; ts_hi = (lane == nts) ? (int)(unsigned)(_c >> 32) : ts_hi; ++nts; } } while (0)
    PG8_STAMP();
    unsigned voffA[2], voffB[2];
#pragma unroll
    for (int i = 0; i < 2; ++i) { int R, C; stage_rc(tid * 16 + i * 8192, R, C); const int Rb = Epi::PERM ? ((R & ~31) + perm32(R & 31)) : R;
        voffA[i] = (unsigned)(R * K + C) * 2u; voffB[i] = (unsigned)(Rb * K + C) * 2u; }
    const size_t kstep = (size_t)(BK * 2);
    const size_t hstep = (size_t)HALF * K * 2;
    const size_t tstep = 2 * hstep;
    const unsigned ldsw = (unsigned)wid * 1024u;
    const int aoff = lds_byte(wr * 64 + fr, fq * 8), boff = lds_byte(wc * 32 + fr, fq * 8);
#define PG8_SA(b, h) (((b) * 2 + (h)) * HTB)
#define PG8_SB(b, h) ((4 + (b) * 2 + (h)) * HTB)
#define PG8_STAGE(bufoff, gbase, voff) do { _Pragma("unroll") for (int _i = 0; _i < 2; ++_i) \
        __builtin_amdgcn_global_load_lds((const unsigned*)((const char*)(gbase) + (voff)[_i]), (PG8_LAS unsigned*)(lds + (bufoff) + ldsw + _i * 8192), 16, 0, 0); } while (0)
#define PG8_LDA(dst, b, h) do { _Pragma("unroll") for (int m = 0; m < 4; ++m) _Pragma("unroll") for (int k = 0; k < 2; ++k) dst[m][k] = *(const PG8_LAS bf16x8*)(lds + PG8_SA(b, h) + aoff + m * 2048 + k * 1024); } while (0)
#define PG8_LDB(dst, b, h) do { _Pragma("unroll") for (int n = 0; n < 2; ++n) _Pragma("unroll") for (int k = 0; k < 2; ++k) dst[n][k] = *(const PG8_LAS bf16x8*)(lds + PG8_SB(b, h) + boff + n * 2048 + k * 1024); } while (0)
#define PG8_MMA(ai, bj, At, Bt) do { __builtin_amdgcn_s_setprio(1); _Pragma("unroll") for (int m = 0; m < 4; ++m) _Pragma("unroll") for (int n = 0; n < 2; ++n) _Pragma("unroll") for (int k = 0; k < 2; ++k) \
        acc[ai][bj][m][n] = __builtin_amdgcn_mfma_f32_16x16x32_bf16(Bt[n][k], At[m][k], acc[ai][bj][m][n], 0, 0, 0); __builtin_amdgcn_s_setprio(0); } while (0)
#define PG8_WAIT_V(n) asm volatile("s_waitcnt vmcnt(" #n ")" ::: "memory")
#define PG8_WAIT_L(n) asm volatile("s_waitcnt lgkmcnt(" #n ")" ::: "memory")
#define PG8_BAR __builtin_amdgcn_s_barrier()
#define PG8_SCHED __builtin_amdgcn_sched_barrier(0)
    Unit cur, nxt; int ui = 0;
    if (!S.next(0, cur)) return;
    f32x4 acc[2][2][4][2];
#pragma unroll
    for (int a = 0; a < 2; ++a)
#pragma unroll
        for (int b = 0; b < 2; ++b)
#pragma unroll
            for (int m = 0; m < 4; ++m)
#pragma unroll
                for (int n = 0; n < 2; ++n) acc[a][b][m][n] = (f32x4){0.f, 0.f, 0.f, 0.f};
    bf16x8 At[4][2], B0[2][2], B1[2][2];
    const char* cA = (const char*)g.A + (size_t)cur.pm * tstep; const char* cB = (const char*)g.Bt + (size_t)cur.pn * tstep;
    S.a_ready(cur);
    PG8_STAGE(PG8_SB(0, 0), cB, voffB); PG8_STAGE(PG8_SA(0, 0), cA, voffA); PG8_STAGE(PG8_SB(0, 1), cB + hstep, voffB); PG8_STAGE(PG8_SA(0, 1), cA + hstep, voffA);
    if (wr == 1) PG8_BAR;
    PG8_WAIT_V(4); PG8_BAR;
    PG8_STAGE(PG8_SB(1, 0), cB + kstep, voffB); PG8_STAGE(PG8_SA(1, 0), cA + kstep, voffA); PG8_STAGE(PG8_SB(1, 1), cB + hstep + kstep, voffB);
    PG8_WAIT_V(6); PG8_BAR;
    PG8_STAMP();
    for (;;) {
        const bool has_next = S.next(ui + 1, nxt);
        const char* nA = has_next ? (const char*)g.A + (size_t)nxt.pm * tstep : cA; const char* nB = has_next ? (const char*)g.Bt + (size_t)nxt.pn * tstep : cB;
        for (int t = 0; t < nt; t += 2) {
            const bool last = (t == nt - 2);
            const char* a1 = cA + (size_t)(t + 1) * kstep;
            const char* a2 = last ? nA : cA + (size_t)(t + 2) * kstep; const char* b2 = last ? nB : cB + (size_t)(t + 2) * kstep;
            const char* a3 = a2 + kstep; const char* b3 = b2 + kstep;
            if (last && has_next) S.a_ready(nxt);
            PG8_LDB(B0, 0, 0); PG8_SCHED; PG8_LDA(At, 0, 0); PG8_STAGE(PG8_SA(1, 1), a1 + hstep, voffA);
            PG8_WAIT_L(8); PG8_BAR; PG8_WAIT_L(0); PG8_MMA(0, 0, At, B0); PG8_BAR; PG8_SCHED;
            PG8_LDB(B1, 0, 1); PG8_STAGE(PG8_SB(0, 0), b2, voffB);
            PG8_BAR; PG8_WAIT_L(0); PG8_MMA(0, 1, At, B1); PG8_BAR;
            PG8_LDA(At, 0, 1); PG8_STAGE(PG8_SA(0, 0), a2, voffA);
            PG8_BAR; PG8_WAIT_L(0); PG8_MMA(1, 0, At, B0); PG8_BAR; PG8_SCHED;
            PG8_STAGE(PG8_SB(0, 1), b2 + hstep, voffB);
            PG8_WAIT_V(6); PG8_BAR; PG8_MMA(1, 1, At, B1); PG8_BAR;
            PG8_LDB(B0, 1, 0); PG8_SCHED; PG8_LDA(At, 1, 0); PG8_STAGE(PG8_SA(0, 1), a2 + hstep, voffA);
            PG8_WAIT_L(8); PG8_BAR; PG8_WAIT_L(0); PG8_MMA(0, 0, At, B0); PG8_BAR; PG8_SCHED;
            PG8_LDB(B1, 1, 1); PG8_STAGE(PG8_SB(1, 0), b3, voffB);
            PG8_BAR; PG8_WAIT_L(0); PG8_MMA(0, 1, At, B1); PG8_BAR;
            PG8_LDA(At, 1, 1); PG8_STAGE(PG8_SA(1, 0), a3, voffA);
            PG8_BAR; PG8_WAIT_L(0); PG8_MMA(1, 0, At, B0); PG8_BAR; PG8_SCHED;
            PG8_STAGE(PG8_SB(1, 1), b3 + hstep, voffB);
            PG8_WAIT_V(6); PG8_BAR; PG8_MMA(1, 1, At, B1); PG8_BAR;
        }
        PG8_STAMP();
        if constexpr (!Epi::AFTER_DRAIN) {
            if constexpr (Epi::REALIGN) { if (wr == 0) PG8_BAR; }
            E(acc, cur, wr, wc, fr, fq); S.done(cur);
            if constexpr (Epi::REALIGN) { if (wr == 1) PG8_BAR; }
        }
        PG8_STAMP();
        if (!has_next) break;
#pragma unroll
        for (int a = 0; a < 2; ++a)
#pragma unroll
            for (int b = 0; b < 2; ++b)
#pragma unroll
                for (int m = 0; m < 4; ++m)
#pragma unroll
                    for (int n = 0; n < 2; ++n) acc[a][b][m][n] = (f32x4){0.f, 0.f, 0.f, 0.f};
        cur = nxt; cA = nA; cB = nB; ++ui;
    }
    PG8_WAIT_V(0);
    if (wr == 0) PG8_BAR;
    PG8_BAR;
    if constexpr (Epi::AFTER_DRAIN) { E.fused(acc, cur, wr, wc, fr, fq, lds, wid, lane); S.done(cur); }
    PG8_STAMP();
    if (STAMP && wid == 0) { stamps[lane] = lane < nts ? (((unsigned long long)(unsigned)ts_hi << 32) | (unsigned)ts_lo) : 0ull;
        if (lane == 62) stamps[62] = rt_entry; if (lane == 63) stamps[63] = (unsigned long long)wall_clock64(); }
#undef PG8_STAMP
#undef PG8_SA
#undef PG8_SB
#undef PG8_STAGE
#undef PG8_LDA
#undef PG8_LDB
#undef PG8_MMA
#undef PG8_WAIT_V
#undef PG8_WAIT_L
#undef PG8_BAR
#undef PG8_SCHED
}
}
#define LAS __attribute__((address_space(3)))
#define XB_TMO      128
#define XB_XCNT(j)  (256  + 64 * (j))
#define XB_XSUB(j)  (1280 + 64 * (j))
#define XB_XGEN(j)  (2304 + 64 * (j))
#define XB_TOP      3328
#define XB_TOPGEN   3392
#define XCD_BAR_WORDS 3456
#define XB_SPIN_CAP (1u << 18)

__device__ __forceinline__ unsigned xb_ld(unsigned* p)              { return __hip_atomic_load(p, __ATOMIC_RELAXED, __HIP_MEMORY_SCOPE_AGENT); }
__device__ __forceinline__ unsigned xb_add(unsigned* p, unsigned v) { return __hip_atomic_fetch_add(p, v, __ATOMIC_RELAXED, __HIP_MEMORY_SCOPE_AGENT); }
__device__ __forceinline__ unsigned xb_xcc_id() { return (unsigned)__builtin_amdgcn_s_getreg((3 << 11) | 20) & 0xFu; }
#define XB_SPIN(cond, bar) do { unsigned _sp = 0; while (cond) { __builtin_amdgcn_s_sleep(1); \
    if ((++_sp & 255u) == 0u) { if (xb_ld(&(bar)[XB_TMO])) break; if (_sp > XB_SPIN_CAP) { atomicAdd(&(bar)[XB_TMO], 1u); break; } } } } while (0)

struct XcdBarrier {
    unsigned* bar; unsigned x;
    volatile LAS unsigned* st;
};

__device__ __forceinline__ XcdBarrier xcd_barrier_post(unsigned* bar, volatile LAS unsigned* st) {
    XcdBarrier b; b.bar = bar; b.x = xb_xcc_id(); b.st = st;
    if (threadIdx.x == 0) (void)xb_add(&bar[XB_XCNT(b.x)], 1u);
    return b;
}
__device__ __forceinline__ void xcd_barrier_complete(unsigned* bar, unsigned x, unsigned& nloc, unsigned& nx) {
    const unsigned G = gridDim.x * gridDim.y * gridDim.z;
    unsigned sum, cnt, mine, sp = 0u;
    for (;;) {
        sum = 0u; cnt = 0u; mine = 0u;
#pragma unroll
        for (unsigned j = 0; j < 16; ++j) { const unsigned c = xb_ld(&bar[XB_XCNT(j)]); sum += c; cnt += (c > 0u) ? 1u : 0u; mine = (j == x) ? c : mine; }
        if (sum == G) break;
        __builtin_amdgcn_s_sleep(1);
        if ((++sp & 255u) == 0u) { if (xb_ld(&bar[XB_TMO])) break; if (sp > XB_SPIN_CAP) { atomicAdd(&bar[XB_TMO], 1u); break; } }
    }
    nloc = mine > 0u ? mine : 1u; nx = cnt > 0u ? cnt : 1u;
}

__device__ __forceinline__ void xcd_barrier(const XcdBarrier& b) {
    asm volatile("s_waitcnt vmcnt(0)" ::: "memory");
    __syncthreads();
    if (threadIdx.x == 0) {
        unsigned* bar = b.bar;
        __builtin_amdgcn_s_waitcnt(0);
        unsigned nloc = b.st[0], nx = b.st[1];
        if (nloc == 0u) { xcd_barrier_complete(bar, b.x, nloc, nx); b.st[0] = nloc; b.st[1] = nx; }
        const unsigned old = xb_add(&bar[XB_XSUB(b.x)], 1u);
        const unsigned gen = old / nloc;
        if (old + 1u == (gen + 1u) * nloc) {
            __builtin_amdgcn_fence(__ATOMIC_RELEASE, "agent");
            asm volatile("s_waitcnt vmcnt(0)" ::: "memory");
            const unsigned og = xb_add(&bar[XB_TOP], 1u);
            const unsigned tg = og / nx;
            if (og + 1u == (tg + 1u) * nx) xb_add(&bar[XB_TOPGEN], 1u);
            else XB_SPIN(xb_ld(&bar[XB_TOPGEN]) == tg, bar);
            __builtin_amdgcn_fence(__ATOMIC_ACQUIRE, "agent");
            xb_add(&bar[XB_XGEN(b.x)], 1u);
            asm volatile("s_waitcnt vmcnt(0)" ::: "memory");
        } else {
            XB_SPIN(xb_ld(&bar[XB_XGEN(b.x)]) == gen, bar);
            __builtin_amdgcn_fence(__ATOMIC_ACQUIRE, "agent");
            asm volatile("s_waitcnt vmcnt(0)" ::: "memory");
        }
    }
    __syncthreads();
}


#define DI __device__ __forceinline__

using pg8::bf16_t; using pg8::bf16x8; using pg8::f32x4; using pg8::f32x2; using pg8::u32x4; using pg8::Unit;
typedef unsigned u32x2 __attribute__((ext_vector_type(2)));
typedef short s16x4 __attribute__((ext_vector_type(4)));
typedef __bf16 bf2_t __attribute__((ext_vector_type(2)));

constexpr int NB = 8, T = 4096, D = 1024, NTOK = NB * T, CTXL = 256, NCTX = NB * CTXL, NP = 3072, NC = 32;
constexpr int NTHREADS = 512;
constexpr int LDS_BYTES = 147456 + 256;
constexpr float EPS = 1e-6f, LOG2E = 1.4426950408889634f;

constexpr size_t al256(size_t x) { return (x + 255) & ~(size_t)255; }
constexpr size_t WS_MOD  = 0;
constexpr size_t WS_ROPE = WS_MOD + al256(9 * 3072 * 4);
constexpr size_t WS_WIN  = WS_ROPE + 8192;
constexpr size_t WS_WOUT = WS_WIN + (size_t)3072 * 1024 * 2;
constexpr size_t WS_WSB  = WS_WOUT + (size_t)1024 * 1024 * 2;
constexpr size_t WS_H    = WS_WSB + (size_t)4 * 128 * 128 * 2;
constexpr size_t WS_Q    = WS_H + (size_t)(NTOK + NCTX) * 1024 * 2;
constexpr size_t WS_K    = WS_Q + (size_t)NTOK * 256 * 2;
constexpr size_t WS_V    = WS_K + (size_t)NTOK * 256 * 2;
constexpr size_t WS_GR   = WS_V + (size_t)NTOK * 512 * 2;
constexpr size_t WS_U    = WS_GR + (size_t)NTOK * 512 * 2;
constexpr size_t WS_VG   = WS_U + (size_t)NTOK * 512 * 2;
constexpr size_t WS_GM   = WS_VG + (size_t)NTOK * 512 * 2;
constexpr size_t WS_KC   = WS_GM + (size_t)NTOK * 512 * 2;
constexpr size_t WS_VC   = WS_KC + (size_t)NCTX * 256 * 2;
constexpr size_t WS_KV   = WS_VC + (size_t)NCTX * 512 * 2;
constexpr size_t WS_KVC  = WS_KV + (size_t)1024 * 2 * 8192 * 4;
constexpr size_t WS_ST   = WS_KVC + (size_t)64 * 2 * 8192 * 4;
constexpr size_t WS_BAR  = WS_ST + (size_t)1024 * 2 * 8192 * 2;
constexpr size_t WS_CNT  = WS_BAR + (size_t)XCD_BAR_WORDS * 4;
constexpr size_t WS_SLOT = WS_CNT + 32768;
constexpr size_t WS_END  = WS_SLOT + (size_t)NTOK * 16 * 4;

struct Args {
    const float* x; const float* c; const float* ctx; const float* c_ctx; const float* w_ada; const float* b_ada; const float* norm_w; const float* w_in;
    const float* dec_f; const float* dec_b; const float* gn_w; const float* ln_w; const float* w_s; const float* b_s; const float* w_out; const float* fnorm_w;
    float* out; unsigned char* ws; int ph_lo, ph_hi;
};

DI unsigned pk2(float lo, float hi) { f32x2 v = {lo, hi}; bf2_t r = __builtin_convertvector(v, bf2_t); return __builtin_bit_cast(unsigned, r); }
DI f32x4 ldnt_f4(const float* p) { return __builtin_nontemporal_load((const f32x4*)p); }
DI u32x4 ldnt_u4(const void* p) { return __builtin_nontemporal_load((const u32x4*)p); }
DI u32x2 ldnt_u2(const void* p) { return __builtin_nontemporal_load((const u32x2*)p); }
DI float bflo(unsigned w) { return __uint_as_float(w << 16); }
DI float bfhi(unsigned w) { return __uint_as_float(w & 0xffff0000u); }
DI float silu_f(float v) { return v * __builtin_amdgcn_rcpf(1.0f + __expf(-v)); }
DI void lds_barrier() { asm volatile("s_waitcnt lgkmcnt(0)" ::: "memory"); __builtin_amdgcn_s_barrier(); asm volatile("" ::: "memory"); }
DI f32x4 mfma16(bf16x8 a, bf16x8 b, f32x4 c) { return __builtin_amdgcn_mfma_f32_16x16x32_bf16(a, b, c, 0, 0, 0); }

DI bf16x8 frag_tr(LAS const unsigned char* base, int S, int k0, int n0, int lane) {
    const int i = lane & 15, g = lane >> 4;
    LAS const unsigned char* p = base + (k0 + 4 * g + (i >> 2)) * S + (n0 + 4 * (i & 3)) * 2;
    const s16x4 lo = __builtin_amdgcn_ds_read_tr16_b64_v4i16((LAS s16x4*)p);
    const s16x4 hi = __builtin_amdgcn_ds_read_tr16_b64_v4i16((LAS s16x4*)(p + 16 * S));
    return __builtin_shufflevector(lo, hi, 0, 1, 2, 3, 4, 5, 6, 7);
}
DI bf16x8 frag_rowP(const bf16_t* rowk0, int g) {
    const u32x2 lo = *(const u32x2*)(rowk0 + 4 * g), hi = *(const u32x2*)(rowk0 + 16 + 4 * g);
    const u32x4 v = {lo.x, lo.y, hi.x, hi.y}; return __builtin_bit_cast(bf16x8, v);
}
DI bf16x8 frag_rowP_lds(LAS const unsigned char* rowk0, int g) {
    const u32x2 lo = *(LAS const u32x2*)(rowk0 + 8 * g), hi = *(LAS const u32x2*)(rowk0 + 32 + 8 * g);
    const u32x4 v = {lo.x, lo.y, hi.x, hi.y}; return __builtin_bit_cast(bf16x8, v);
}
DI bf16x8 scale_frag(bf16x8 f, float s) {
    const u32x4 u = __builtin_bit_cast(u32x4, f); u32x4 r;
#pragma unroll
    for (int q = 0; q < 4; ++q) r[q] = pk2(bflo(u[q]) * s, bfhi(u[q]) * s);
    return __builtin_bit_cast(bf16x8, r);
}

struct EpiIn {
    static constexpr bool PERM = true, AFTER_DRAIN = false, REALIGN = false;
    unsigned char* ws;
    DI void operator()(const f32x4 (&acc)[2][2][4][2], const Unit& u, int wr, int wc, int fr, int fq) const {
        const int pn = u.pn, rbase = u.pm * 256 + wr * 64 + fr, cbase = wc * 32 + 8 * fq;
        if (u.pm >= 128) {
            bf16_t* dst = (bf16_t*)(ws + (pn == 1 ? WS_KC : WS_VC));
            const float scl = pn == 1 ? 0.125f : 1.0f;
#pragma unroll
            for (int ai = 0; ai < 2; ++ai)
#pragma unroll
                for (int m = 0; m < 4; ++m) {
                    const int rc = rbase + ai * 128 + m * 16 - NTOK, b = rc >> 8, t = rc & 255;
#pragma unroll
                    for (int bj = 0; bj < 2; ++bj) {
                        const f32x4 v0 = acc[ai][bj][m][0] * scl, v1 = acc[ai][bj][m][1] * scl;
                        const u32x4 o = {pk2(v0[0], v0[1]), pk2(v0[2], v0[3]), pk2(v1[0], v1[1]), pk2(v1[2], v1[3])};
                        size_t off;
                        if (pn == 1) { const int head = bj * 2 + (wc >> 1), d0 = (wc & 1) * 32 + 8 * fq; off = ((size_t)((b * 4 + head) * 256 + t)) * 64 + d0; }
                        else { const int head = (pn - 2) * 2 + bj; off = ((size_t)((b * 4 + head) * 256 + t)) * 128 + cbase; }
                        *(u32x4*)(dst + off) = o;
                    }
                }
            return;
        }
        if (pn <= 1) {
            bf16_t* dst = (bf16_t*)(ws + (pn == 0 ? WS_Q : WS_K));
            const float scl = pn == 0 ? 1.0f : 0.125f;
            const float* rc = (const float*)(ws + WS_ROPE); const float* rs = rc + 1024;
            const int hh = wc & 1, fi0 = 8 * (fq & 1); const bool second = fq >= 2;
#pragma unroll
            for (int ai = 0; ai < 2; ++ai)
#pragma unroll
                for (int m = 0; m < 4; ++m) {
                    const int r = rbase + ai * 128 + m * 16, b = r >> 12, t = r & 4095, pos = hh ? (t & 63) : (t >> 6);
                    const f32x4 c0 = *(const f32x4*)(rc + pos * 16 + fi0), c1 = *(const f32x4*)(rc + pos * 16 + fi0 + 4);
                    const f32x4 s0 = *(const f32x4*)(rs + pos * 16 + fi0), s1 = *(const f32x4*)(rs + pos * 16 + fi0 + 4);
#pragma unroll
                    for (int bj = 0; bj < 2; ++bj) {
                        const f32x4 v0 = acc[ai][bj][m][0], v1 = acc[ai][bj][m][1];
                        float o[8];
#pragma unroll
                        for (int j = 0; j < 4; ++j) {
                            const float xa = v0[j], xb = v1[j], pa = __shfl_xor(xa, 32), pb = __shfl_xor(xb, 32);
                            o[j]     = (second ? (pa * s0[j] + xa * c0[j]) : (xa * c0[j] - pa * s0[j])) * scl;
                            o[4 + j] = (second ? (pb * s1[j] + xb * c1[j]) : (xb * c1[j] - pb * s1[j])) * scl;
                        }
                        const u32x4 ov = {pk2(o[0], o[1]), pk2(o[2], o[3]), pk2(o[4], o[5]), pk2(o[6], o[7])};
                        const int head = bj * 2 + (wc >> 1), d0 = hh * 32 + 8 * fq;
                        *(u32x4*)(dst + ((size_t)((b * 4 + head) * 4096 + t)) * 64 + d0) = ov;
                    }
                }
            return;
        }
        if (pn <= 3) {
            bf16_t* dst = (bf16_t*)(ws + WS_V);
#pragma unroll
            for (int ai = 0; ai < 2; ++ai)
#pragma unroll
                for (int m = 0; m < 4; ++m) {
                    const int r = rbase + ai * 128 + m * 16, b = r >> 12, t = r & 4095;
#pragma unroll
                    for (int bj = 0; bj < 2; ++bj) {
                        const f32x4 v0 = acc[ai][bj][m][0], v1 = acc[ai][bj][m][1];
                        const u32x4 o = {pk2(v0[0], v0[1]), pk2(v0[2], v0[3]), pk2(v1[0], v1[1]), pk2(v1[2], v1[3])};
                        const int head = (pn - 2) * 2 + bj;
                        *(u32x4*)(dst + ((size_t)((b * 4 + head) * 4096 + t)) * 128 + cbase) = o;
                    }
                }
            return;
        }
        if (pn == 6 || pn == 7 || pn >= 10) {
            const int t = pn == 6 ? 0 : (pn == 7 ? 1 : (pn == 10 ? 2 : 3));
            bf16_t* dst = (bf16_t*)(ws + WS_U);
#pragma unroll
            for (int ai = 0; ai < 2; ++ai)
#pragma unroll
                for (int m = 0; m < 4; ++m) {
                    const int r = rbase + ai * 128 + m * 16;
                    const f32x4 u0 = acc[ai][0][m][0], u1 = acc[ai][0][m][1], g0 = acc[ai][1][m][0], g1 = acc[ai][1][m][1];
                    const f32x2 a0 = pg8::gelu_pk((f32x2){u0[0], u0[1]}), a1 = pg8::gelu_pk((f32x2){u0[2], u0[3]}), a2 = pg8::gelu_pk((f32x2){u1[0], u1[1]}), a3 = pg8::gelu_pk((f32x2){u1[2], u1[3]});
                    const u32x4 o = {pk2(a0.x * silu_f(g0[0]), a0.y * silu_f(g0[1])), pk2(a1.x * silu_f(g0[2]), a1.y * silu_f(g0[3])),
                                     pk2(a2.x * silu_f(g1[0]), a2.y * silu_f(g1[1])), pk2(a3.x * silu_f(g1[2]), a3.y * silu_f(g1[3]))};
                    *(u32x4*)(dst + (size_t)r * 512 + 128 * t + cbase) = o;
                }
            return;
        }
        {
            const int region = (pn - 4) >> 1; const bool is_gelu = (region == 1) || (region == 2);
            bf16_t* dst = (bf16_t*)(ws + WS_GR + (size_t)region * ((size_t)NTOK * 512 * 2));
            const int colb = ((pn - 4) & 1) * 256 + cbase;
#pragma unroll
            for (int ai = 0; ai < 2; ++ai)
#pragma unroll
                for (int m = 0; m < 4; ++m) {
                    const int r = rbase + ai * 128 + m * 16;
#pragma unroll
                    for (int bj = 0; bj < 2; ++bj) {
                        const f32x4 v0 = acc[ai][bj][m][0], v1 = acc[ai][bj][m][1];
                        u32x4 o;
                        if (is_gelu) {
                            const f32x2 a = pg8::gelu_pk((f32x2){v0[0], v0[1]}), bq = pg8::gelu_pk((f32x2){v0[2], v0[3]}), cq = pg8::gelu_pk((f32x2){v1[0], v1[1]}), dq = pg8::gelu_pk((f32x2){v1[2], v1[3]});
                            o = (u32x4){pk2(a.x, a.y), pk2(bq.x, bq.y), pk2(cq.x, cq.y), pk2(dq.x, dq.y)};
                        } else {
                            o = (u32x4){pk2(silu_f(v0[0]), silu_f(v0[1])), pk2(silu_f(v0[2]), silu_f(v0[3])), pk2(silu_f(v1[0]), silu_f(v1[1])), pk2(silu_f(v1[2]), silu_f(v1[3]))};
                        }
                        *(u32x4*)(dst + (size_t)r * 512 + colb + bj * 128) = o;
                    }
                }
        }
    }
};
struct EpiOut {
    static constexpr bool PERM = false, AFTER_DRAIN = false, REALIGN = true;
    const float* x; const float* mod; const float* fw; float* out; float* slots; unsigned* cnt;
    DI void operator()(const f32x4 (&acc_)[2][2][4][2], const Unit& u, int wr, int wc, int fr, int fq) const {
        f32x4 (&acc)[2][2][4][2] = const_cast<f32x4 (&)[2][2][4][2]>(acc_);
        const int rbase = u.pm * 256 + wr * 64 + fr, cbase = u.pn * 256 + wc * 32 + 4 * fq;
        const float* gate = mod + (size_t)(rbase >> 12) * 3072 + 2048;
        f32x4 gv[2][2];
#pragma unroll
        for (int bj = 0; bj < 2; ++bj)
#pragma unroll
            for (int n = 0; n < 2; ++n) gv[bj][n] = *(const f32x4*)(gate + cbase + bj * 128 + n * 16);
        f32x4 xv[2][4]; float ss[8];
#pragma unroll
        for (int q = 0; q < 4; ++q) xv[0][q] = ldnt_f4(x + (size_t)rbase * 1024 + cbase + (q >> 1) * 128 + (q & 1) * 16);
#pragma unroll
        for (int k = 0; k < 8; ++k) {
            const int ai = k >> 2, m = k & 3;
            if (k + 1 < 8) {
                const size_t ro = (size_t)(rbase + ((k + 1) >> 2) * 128 + ((k + 1) & 3) * 16) * 1024 + cbase;
#pragma unroll
                for (int q = 0; q < 4; ++q) xv[(k + 1) & 1][q] = ldnt_f4(x + ro + (q >> 1) * 128 + (q & 1) * 16);
            }
            float sk = 0.f;
#pragma unroll
            for (int q = 0; q < 4; ++q) {
                const int bj = q >> 1, n = q & 1;
                const f32x4 v = xv[k & 1][q] + gv[bj][n] * acc[ai][bj][m][n];
                acc[ai][bj][m][n] = v;
                sk += v[0] * v[0] + v[1] * v[1] + v[2] * v[2] + v[3] * v[3];
            }
            ss[k] = sk;
        }
#pragma unroll
        for (int k = 0; k < 8; ++k) { ss[k] += __shfl_xor(ss[k], 16); ss[k] += __shfl_xor(ss[k], 32); }
        if (fq == 0) {
#pragma unroll
            for (int k = 0; k < 8; ++k)
                __hip_atomic_store(slots + (size_t)(rbase + (k >> 2) * 128 + (k & 3) * 16) * 16 + u.pn * 4 + wc, ss[k], __ATOMIC_RELAXED, __HIP_MEMORY_SCOPE_AGENT);
        }
        asm volatile("s_waitcnt vmcnt(0)" ::: "memory");
        if ((threadIdx.x & 63) == 0) {
            __hip_atomic_fetch_add(cnt + u.pm * 64, 1u, __ATOMIC_RELAXED, __HIP_MEMORY_SCOPE_AGENT);
            unsigned spins = 0;
            while (__hip_atomic_load(cnt + u.pm * 64, __ATOMIC_RELAXED, __HIP_MEMORY_SCOPE_AGENT) < 32u) { __builtin_amdgcn_s_sleep(8); if (++spins > (1u << 22)) break; }
        }
        __builtin_amdgcn_fence(__ATOMIC_ACQUIRE, "agent");
        asm volatile("s_waitcnt vmcnt(0)" ::: "memory");
        f32x4 sl[8];
#pragma unroll
        for (int k = 0; k < 8; ++k) sl[k] = *(const f32x4*)(slots + (size_t)(rbase + (k >> 2) * 128 + (k & 3) * 16) * 16 + fq * 4);
        f32x4 fv[2][2];
#pragma unroll
        for (int bj = 0; bj < 2; ++bj)
#pragma unroll
            for (int n = 0; n < 2; ++n) fv[bj][n] = *(const f32x4*)(fw + cbase + bj * 128 + n * 16);
        float rs[8];
#pragma unroll
        for (int k = 0; k < 8; ++k) {
            float t = (sl[k][0] + sl[k][1]) + (sl[k][2] + sl[k][3]);
            t += __shfl_xor(t, 16); t += __shfl_xor(t, 32);
            rs[k] = rsqrtf(t * (1.0f / 1024.0f) + EPS);
        }
#pragma unroll
        for (int k = 0; k < 8; ++k) {
            const int ai = k >> 2, m = k & 3;
            const size_t ro = (size_t)(rbase + ai * 128 + m * 16) * 1024 + cbase;
#pragma unroll
            for (int bj = 0; bj < 2; ++bj)
#pragma unroll
                for (int n = 0; n < 2; ++n) __builtin_nontemporal_store(acc[ai][bj][m][n] * rs[k] * fv[bj][n], (f32x4*)(out + ro + bj * 128 + n * 16));
        }
    }
};
struct SchedIn {
    pg8::StaticOrder so;
    DI bool next(int i, Unit& u) const {
        if (so.G == 256) {
            const int x = so.c & 7, j = so.c >> 3;
            if (j < 3) {
                if (i == 0) { u.pm = 128 + x; u.pn = 1 + j; return true; }
                if (i > 6) return false;
                const int q = 6 * j + (i - 1);
                u.pm = 16 * x + (q >> 2); u.pn = q & 3; return true;
            }
            if (i > 5) return false;
            const int e = (j - 3) + 29 * i;
            if (e < 64) { u.pm = 16 * x + (e >> 2); u.pn = 6 + (e & 3); }
            else if (e < 128) { const int t = e & 3; u.pm = 16 * x + ((e - 64) >> 2); u.pn = t < 2 ? 4 + t : 8 + t; }
            else { const int q = 18 + (e - 128); u.pm = 16 * x + (q >> 2); u.pn = q & 3; }
            return true;
        }
        long L = (long)i * so.G + so.c;
        if (L < so.nwg) return so.next(i, u);
        L -= so.nwg; if (L >= 24) return false;
        u.pm = 128 + (int)(L / 3); u.pn = 1 + (int)(L % 3); return true;
    }
    DI void a_ready(const Unit&) const {}
    DI void done(const Unit&) const {}
};

DI void phase0(const Args& a, LAS unsigned char* lds) {
    const int tid = threadIdx.x;
    float* mod = (float*)(a.ws + WS_MOD);
    LAS float* red = (LAS float*)lds;
    for (int it = blockIdx.x; it < 1233; it += gridDim.x) {
        if (it < 192) {
            const int c0 = it * 16, f = tid & 3, rg = tid >> 2;
            LAS float* scv = red + 36 * 512;
            for (int q = tid; q < 9 * 1024; q += NTHREADS) { const float cv = (q < 8192) ? a.c[q] : a.c_ctx[q - 8192]; scv[q] = cv / (1.0f + expf(-cv)); }
            __syncthreads();
            float acc[9][4];
#pragma unroll
            for (int j = 0; j < 9; ++j)
#pragma unroll
                for (int e = 0; e < 4; ++e) acc[j][e] = 0.f;
            f32x4 wv[8];
#pragma unroll
            for (int i = 0; i < 8; ++i) wv[i] = ldnt_f4(a.w_ada + (size_t)(rg + 128 * i) * 3072 + c0 + f * 4);
#pragma unroll
            for (int i = 0; i < 8; ++i) {
                const int r = rg + 128 * i;
#pragma unroll
                for (int j = 0; j < 9; ++j) {
                    const float sv = scv[j * 1024 + r];
#pragma unroll
                    for (int e = 0; e < 4; ++e) acc[j][e] += sv * wv[i][e];
                }
            }
#pragma unroll
            for (int j = 0; j < 9; ++j)
#pragma unroll
                for (int e = 0; e < 4; ++e) red[(j * 4 + e) * 512 + tid] = acc[j][e];
            __syncthreads();
            if (tid < 144) {
                const int j = tid >> 4, cc = tid & 15, ff = cc >> 2, e = cc & 3;
                float s = 0.f;
                for (int q = 0; q < 128; ++q) s += red[(j * 4 + e) * 512 + q * 4 + ff];
                mod[j * 3072 + c0 + cc] = s + a.b_ada[c0 + cc];
            }
            __syncthreads();
        } else if (it < 1216) {
            const bool is_in = it < 960; const int tt = is_in ? it - 192 : it - 960;
            const int nN = is_in ? 48 : 16, NN = is_in ? 3072 : 1024;
            const int k0 = (tt / nN) * 64, n0 = (tt % nN) * 64;
            int ns = n0;
            if (is_in && ((n0 >= 1536 && n0 < 2048) || n0 >= 2560)) {
                const int base = n0 >= 2560 ? 2560 : 1536, t = (n0 >= 2560 ? 2 : 0) + (n0 - base) / 256, w = (n0 - base) % 256;
                ns = (w < 128 ? 1536 : 2560 - 128) + 128 * t + w;
            }
            const float* src = is_in ? a.w_in : a.w_out;
            bf16_t* dst = (bf16_t*)(a.ws + (is_in ? WS_WIN : WS_WOUT));
            const int kr = tid >> 4, n4 = tid & 15;
#pragma unroll
            for (int p = 0; p < 2; ++p) {
                const int k = kr + 32 * p;
                const f32x4 v = ldnt_f4(src + (size_t)(k0 + k) * NN + ns + n4 * 4);
#pragma unroll
                for (int e = 0; e < 4; ++e) red[k * 65 + n4 * 4 + e] = v[e];
            }
            __syncthreads();
            const int n = tid >> 3, k8 = tid & 7;
            float v[8];
#pragma unroll
            for (int j = 0; j < 8; ++j) v[j] = red[(k8 * 8 + j) * 65 + n];
            const u32x4 o = {pk2(v[0], v[1]), pk2(v[2], v[3]), pk2(v[4], v[5]), pk2(v[6], v[7])};
            *(u32x4*)(dst + (size_t)(n0 + n) * 1024 + k0 + k8 * 8) = o;
            __syncthreads();
        } else if (it < 1232) {
            const size_t base = (size_t)(it - 1216) * 4096 + tid * 8;
            const f32x4 v0 = *(const f32x4*)(a.w_s + base), v1 = *(const f32x4*)(a.w_s + base + 4);
            const u32x4 o = {pk2(v0[0], v0[1]), pk2(v0[2], v0[3]), pk2(v1[0], v1[1]), pk2(v1[2], v1[3])};
            *(u32x4*)((bf16_t*)(a.ws + WS_WSB) + base) = o;
        } else {
            float* rc = (float*)(a.ws + WS_ROPE); float* rs = rc + 1024;
            for (int idx = tid; idx < 1024; idx += NTHREADS) {
                const int pos = idx >> 4, fi = idx & 15;
                const float inv = powf(10000.0f, -(float)fi / 16.0f), ang = (float)pos * inv;
                rc[idx] = cosf(ang); rs[idx] = sinf(ang);
            }
        }
    }
}

template <int R> DI void norm_rows(const Args& a, const float* mod, bf16_t* H, const int (&rows)[R], int lane) {
    f32x4 v[R][4]; const float* mrow[R];
#pragma unroll
    for (int k = 0; k < R; ++k) {
        const int r = rows[k]; const float* src; int j;
        if (r < NTOK) { src = a.x + (size_t)r * 1024; j = r >> 12; } else { src = a.ctx + (size_t)(r - NTOK) * 1024; j = 8; }
        mrow[k] = mod + j * 3072;
#pragma unroll
        for (int q = 0; q < 4; ++q) v[k][q] = ldnt_f4(src + q * 256 + lane * 4);
    }
#pragma unroll
    for (int k = 0; k < R; ++k) {
        float ss = 0.f;
#pragma unroll
        for (int q = 0; q < 4; ++q) ss += v[k][q][0] * v[k][q][0] + v[k][q][1] * v[k][q][1] + v[k][q][2] * v[k][q][2] + v[k][q][3] * v[k][q][3];
#pragma unroll
        for (int off = 32; off >= 1; off >>= 1) ss += __shfl_xor(ss, off);
        const float rstd = rsqrtf(ss * (1.0f / 1024.0f) + EPS);
#pragma unroll
        for (int q = 0; q < 4; ++q) {
            const int cidx = q * 256 + lane * 4;
            const f32x4 nw = *(const f32x4*)(a.norm_w + cidx), sc = *(const f32x4*)(mrow[k] + 1024 + cidx), sh = *(const f32x4*)(mrow[k] + cidx);
            f32x4 hv;
#pragma unroll
            for (int e = 0; e < 4; ++e) hv[e] = (v[k][q][e] * rstd * nw[e]) * (1.0f + sc[e]) + sh[e];
            const u32x2 o = {pk2(hv[0], hv[1]), pk2(hv[2], hv[3])};
            *(u32x2*)(H + (size_t)rows[k] * 1024 + cidx) = o;
        }
    }
}
DI void norm_row(const Args& a, const float* mod, bf16_t* H, int r, int lane) { const int rows[1] = {r}; norm_rows<1>(a, mod, H, rows, lane); }
DI void phase1(const Args& a) {
    const int tid = threadIdx.x, wave = tid >> 6, lane = tid & 63, blk = blockIdx.x, G = gridDim.x;
    const float* mod = (const float*)(a.ws + WS_MOD);
    bf16_t* H = (bf16_t*)(a.ws + WS_H);
    constexpr int NCH = (NTOK + NCTX) / 8;
    int ch = blk;
    for (; ch + 3 * G < NCH; ch += 4 * G) { const int rows[4] = {ch * 8 + wave, (ch + G) * 8 + wave, (ch + 2 * G) * 8 + wave, (ch + 3 * G) * 8 + wave}; norm_rows<4>(a, mod, H, rows, lane); }
    for (; ch < NCH; ch += G) norm_row(a, mod, H, ch * 8 + wave, lane);
}

constexpr int VS = 288, KS = 144, KS2 = 160;
DI void gmlp_unit(const Args& a, LAS unsigned char* lds, int b, int c) {
    const int tid = threadIdx.x, lane = tid & 63, w = tid >> 6, i = lane & 15, g = lane >> 4;
    const int r0 = b * 4096 + c * 128;
    const bf16_t* VG = (const bf16_t*)(a.ws + WS_VG); const bf16_t* U = (const bf16_t*)(a.ws + WS_U);
    const bf16_t* WSB = (const bf16_t*)(a.ws + WS_WSB); bf16_t* Y = (bf16_t*)(a.ws + WS_H);
    constexpr int GSZ = 128 * VS;
    {
        const int row = tid >> 2, q = tid & 3;
        const bf16_t* src = VG + (size_t)(r0 + row) * 512 + q * 8;
        float s = 0.f, s2 = 0.f;
#pragma unroll 8
        for (int p = 0; p < 16; ++p) {
            const u32x4 pc = *(const u32x4*)(src + p * 32);
#pragma unroll
            for (int e = 0; e < 4; ++e) { const float lo = bflo(pc[e]), hi = bfhi(pc[e]); s += lo + hi; s2 += lo * lo + hi * hi; }
        }
        s += __shfl_xor(s, 1); s += __shfl_xor(s, 2); s2 += __shfl_xor(s2, 1); s2 += __shfl_xor(s2, 2);
        const float mean = s * (1.0f / 512.0f);
        const float var = fmaxf(s2 * (1.0f / 512.0f) - mean * mean, 0.f);
        const float rstd = rsqrtf(var + EPS);
        const float* lw = a.ln_w + q * 8;
#pragma unroll 4
        for (int p = 0; p < 16; ++p) {
            const u32x4 pc = *(const u32x4*)(src + p * 32);
            const f32x4 w0 = *(const f32x4*)(lw + p * 32), w1 = *(const f32x4*)(lw + p * 32 + 4);
            u32x4 o;
            o[0] = pk2((bflo(pc[0]) - mean) * rstd * w0[0], (bfhi(pc[0]) - mean) * rstd * w0[1]);
            o[1] = pk2((bflo(pc[1]) - mean) * rstd * w0[2], (bfhi(pc[1]) - mean) * rstd * w0[3]);
            o[2] = pk2((bflo(pc[2]) - mean) * rstd * w1[0], (bfhi(pc[2]) - mean) * rstd * w1[1]);
            o[3] = pk2((bflo(pc[3]) - mean) * rstd * w1[2], (bfhi(pc[3]) - mean) * rstd * w1[3]);
            *(LAS u32x4*)(lds + (p >> 2) * GSZ + row * VS + ((p & 3) * 4 + q) * 16) = o;
        }
    }
    __syncthreads();
    const int n = 16 * w + i, r = r0 + n;
#pragma unroll 1
    for (int gq = 0; gq < 4; ++gq) {
        f32x4 acc[8];
#pragma unroll
        for (int et = 0; et < 8; ++et) acc[et] = (f32x4){0.f, 0.f, 0.f, 0.f};
        const bf16_t* wrow = WSB + (size_t)(gq * 128 + n) * 128;
        bf16x8 bw[4];
#pragma unroll
        for (int s = 0; s < 4; ++s) bw[s] = frag_rowP(wrow + 32 * s, g);
#pragma unroll
        for (int s = 0; s < 4; ++s) {
#pragma unroll
            for (int et = 0; et < 8; ++et) acc[et] = mfma16(frag_tr(lds + gq * GSZ, VS, 32 * s, 16 * et, lane), bw[s], acc[et]);
        }
        const float bias = a.b_s[gq * 128 + n];
#pragma unroll
        for (int et = 0; et < 8; et += 2) {
            const int colw = gq * 128 + 16 * (et + (g & 1)) + 8 * (g >> 1);
            const u32x4 uw = *(const u32x4*)(U + (size_t)r * 512 + colw);
            const u32x2 ux = __builtin_amdgcn_permlane16_swap(uw[0], uw[2], false, false), uy = __builtin_amdgcn_permlane16_swap(uw[1], uw[3], false, false);
            const u32x2 ua = {ux[0], uy[0]}, ub = {ux[1], uy[1]};
            const u32x2 oa = {pk2(bflo(ua.x) * (acc[et][0] + bias), bfhi(ua.x) * (acc[et][1] + bias)), pk2(bflo(ua.y) * (acc[et][2] + bias), bfhi(ua.y) * (acc[et][3] + bias))};
            const u32x2 ob = {pk2(bflo(ub.x) * (acc[et + 1][0] + bias), bfhi(ub.x) * (acc[et + 1][1] + bias)), pk2(bflo(ub.y) * (acc[et + 1][2] + bias), bfhi(ub.y) * (acc[et + 1][3] + bias))};
            const u32x2 wx = __builtin_amdgcn_permlane16_swap(oa.x, ob.x, false, false), wy = __builtin_amdgcn_permlane16_swap(oa.y, ob.y, false, false);
            const u32x4 ow = {wx[0], wy[0], wx[1], wy[1]};
            *(u32x4*)(Y + (size_t)r * 1024 + 512 + colw) = ow;
        }
    }
    __syncthreads();
}
struct ChStage { u32x4 kf[2], kb[2], v; };
DI void chain_load(const Args& a, int bh, int es, int it, ChStage& st) {
    const int tid = threadIdx.x;
    const bf16_t *Kf, *Kb, *Vf, *Vb;
    if (it < 2) {
        const size_t of = (size_t)bh * 256 + it * 128, ob = (size_t)bh * 256 + (1 - it) * 128;
        Kf = (const bf16_t*)(a.ws + WS_KC) + of * 64; Vf = (const bf16_t*)(a.ws + WS_VC) + of * 128; Kb = (const bf16_t*)(a.ws + WS_KC) + ob * 64; Vb = (const bf16_t*)(a.ws + WS_VC) + ob * 128;
    } else {
        const size_t of = (size_t)bh * 4096 + (it - 2) * 128, ob = (size_t)bh * 4096 + (33 - it) * 128;
        Kf = (const bf16_t*)(a.ws + WS_K) + of * 64; Vf = (const bf16_t*)(a.ws + WS_V) + of * 128; Kb = (const bf16_t*)(a.ws + WS_K) + ob * 64; Vb = (const bf16_t*)(a.ws + WS_V) + ob * 128;
    }
#pragma unroll
    for (int q = 0; q < 2; ++q) { const int p = tid + 512 * q; st.kf[q] = *(const u32x4*)(Kf + (p >> 3) * 64 + (p & 7) * 8); st.kb[q] = *(const u32x4*)(Kb + (p >> 3) * 64 + (p & 7) * 8); }
    const int t = tid & 255; const bf16_t* Vx = (tid < 256) ? Vf : Vb;
    st.v = *(const u32x4*)(Vx + (t >> 1) * 128 + es * 16 + (t & 1) * 8);
}
DI void chain_item(const Args& a, LAS unsigned char* lds, int item) {
    const int tid = threadIdx.x, lane = tid & 63, w = tid >> 6, i = lane & 15, g = lane >> 4;
    const int bh = item >> 3, es = item & 7, h = bh & 3, dirw = w >> 2, dt = w & 3;
    const float l2f = -expf(a.dec_f[h]) * LOG2E, l2b = -expf(a.dec_b[h]) * LOG2E;
    const float G = exp2f(128.0f * (dirw ? l2b : l2f));
    constexpr int BUFSZ = 2 * 128 * KS2 + 2 * 128 * 32;
    float tf[2], tb[2];
#pragma unroll
    for (int q = 0; q < 2; ++q) { const int m = (tid >> 3) + 64 * q; tf[q] = exp2f((float)(127 - m) * l2f); tb[q] = exp2f((float)m * l2b); }
    bf16_t* ST = (bf16_t*)(a.ws + WS_ST);
    f32x4 S = {0.f, 0.f, 0.f, 0.f};
    ChStage st0, st1, st2, st3;
    chain_load(a, bh, es, 0, st0); chain_load(a, bh, es, 1, st1); chain_load(a, bh, es, 2, st2);
#define CH_STEP(IT, CUR, NXT, STORE) do { const int it = (IT); { \
        LAS unsigned char* buf = lds + (it & 1) * BUFSZ; \
        LAS unsigned char* KFs = buf; LAS unsigned char* KBs = buf + 128 * KS2; LAS unsigned char* VFs = buf + 2 * 128 * KS2; LAS unsigned char* VBs = VFs + 128 * 32; \
        _Pragma("unroll") for (int q = 0; q < 2; ++q) { \
            const int p = tid + 512 * q, m = p >> 3, d8 = p & 7; \
            u32x4 of, ob; \
            _Pragma("unroll") for (int e = 0; e < 4; ++e) { of[e] = pk2(bflo(CUR.kf[q][e]) * tf[q], bfhi(CUR.kf[q][e]) * tf[q]); ob[e] = pk2(bflo(CUR.kb[q][e]) * tb[q], bfhi(CUR.kb[q][e]) * tb[q]); } \
            *(LAS u32x4*)(KFs + m * KS2 + d8 * 16) = of; *(LAS u32x4*)(KBs + m * KS2 + d8 * 16) = ob; \
        } \
        { const int t = tid & 255; *(LAS u32x4*)((tid < 256 ? VFs : VBs) + (t >> 1) * 32 + (t & 1) * 16) = CUR.v; } \
        lds_barrier(); \
        chain_load(a, bh, es, (it + 3 < 34) ? it + 3 : 33, NXT);                  \
        LAS const unsigned char* Kx = dirw ? KBs : KFs; LAS const unsigned char* Vx = dirw ? VBs : VFs; \
        f32x4 kv = {0.f, 0.f, 0.f, 0.f}; \
        _Pragma("unroll") for (int s = 0; s < 4; ++s) kv = mfma16(frag_tr(Vx, 32, 32 * s, 0, lane), frag_tr(Kx, KS2, 32 * s, 16 * dt, lane), kv); \
        if (STORE) {                                                              \
            const int c = dirw ? 33 - it : it - 2; \
            const u32x2 o = {pk2(S[0], S[1]), pk2(S[2], S[3])}; \
            *(u32x2*)(ST + (((size_t)(bh * 32 + c) * 2 + dirw) * 64 + 16 * dt + i) * 128 + es * 16 + 4 * g) = o; \
        } \
        S = S * G + kv; } } while (0)
    CH_STEP(0, st0, st3, false); CH_STEP(1, st1, st0, false);
#pragma unroll 1
    for (int it4 = 2; it4 < 34; it4 += 4) {
        CH_STEP(it4, st2, st1, true); CH_STEP(it4 + 1, st3, st2, true); CH_STEP(it4 + 2, st0, st3, true); CH_STEP(it4 + 3, st1, st0, true);
    }
#undef CH_STEP
    __syncthreads();
}
DI void phase3(const Args& a, LAS unsigned char* lds) {
    for (int it = blockIdx.x; it < 256; it += gridDim.x) gmlp_unit(a, lds, it >> 5, it & 31);
    for (int it = blockIdx.x; it < 256; it += gridDim.x) { const int j = it >> 3; chain_item(a, lds, (((it & 7) * 4 + (j >> 3)) << 3) + (j & 7)); }
}

DI void phase4(const Args& a) {
    const float* KV = (const float*)(a.ws + WS_KV); const float* KVC = (const float*)(a.ws + WS_KVC);
    bf16_t* ST = (bf16_t*)(a.ws + WS_ST);
    for (int idx = blockIdx.x * NTHREADS + threadIdx.x; idx < 64 * 2048; idx += gridDim.x * NTHREADS) {
        const int chain = idx >> 11, pos = idx & 2047, bh = chain >> 1, dir = chain & 1, h = bh & 3;
        const float lg = -expf(dir ? a.dec_b[h] : a.dec_f[h]), G = expf(128.0f * lg);
        const f32x4 k0 = *(const f32x4*)(KVC + ((size_t)(bh * 2 + 0) * 2 + dir) * 8192 + pos * 4);
        const f32x4 k1 = *(const f32x4*)(KVC + ((size_t)(bh * 2 + 1) * 2 + dir) * 8192 + pos * 4);
        f32x4 S = dir ? (k1 * G + k0) : (k0 * G + k1);
#pragma unroll 8
        for (int step = 0; step < NC; ++step) {
            const int c = dir ? (NC - 1 - step) : step;
            const size_t off = ((size_t)(bh * 32 + c) * 2 + dir) * 8192 + pos * 4;
            const f32x4 kvv = *(const f32x4*)(KV + off);
            const u32x2 o = {pk2(S[0], S[1]), pk2(S[2], S[3])};
            *(u32x2*)(ST + off) = o;
            S = S * G + kvv;
        }
    }
}

struct RetStage { u32x4 k[2], v[4], sf[2], sb[2]; bf16x8 q[2]; };
DI void ret_load(const Args& a, int unit, RetStage& st) {
    const int tid = threadIdx.x, lane = tid & 63, w = tid >> 6, i = lane & 15, g = lane >> 4;
    const int bh = unit >> 5, c = unit & 31;
    const bf16_t* Qp = (const bf16_t*)(a.ws + WS_Q) + ((size_t)bh * 4096 + c * 128) * 64;
    const bf16_t* Kp = (const bf16_t*)(a.ws + WS_K) + ((size_t)bh * 4096 + c * 128) * 64;
    const bf16_t* Vp = (const bf16_t*)(a.ws + WS_V) + ((size_t)bh * 4096 + c * 128) * 128;
    const bf16_t* SFp = (const bf16_t*)(a.ws + WS_ST) + (size_t)unit * 16384; const bf16_t* SBp = SFp + 8192;
#pragma unroll
    for (int q = 0; q < 2; ++q) { const int p = tid + 512 * q; st.k[q] = *(const u32x4*)(Kp + (p >> 3) * 64 + (p & 7) * 8); }
#pragma unroll
    for (int q = 0; q < 4; ++q) { const int p = tid + 512 * q; st.v[q] = *(const u32x4*)(Vp + (p >> 4) * 128 + (p & 15) * 8); }
#pragma unroll
    for (int q = 0; q < 2; ++q) { const int p = tid + 512 * q; st.sf[q] = *(const u32x4*)(SFp + (p >> 4) * 128 + (p & 15) * 8); st.sb[q] = *(const u32x4*)(SBp + (p >> 4) * 128 + (p & 15) * 8); }
#pragma unroll
    for (int s = 0; s < 2; ++s) st.q[s] = frag_rowP(Qp + (16 * w + i) * 64 + 32 * s, g);
}
DI void ret_unit(const Args& a, LAS unsigned char* lds, int unit, RetStage& st, int next_unit) {
    const int tid = threadIdx.x, lane = tid & 63, w = tid >> 6, i = lane & 15, g = lane >> 4;
    const int bh = unit >> 5, c = unit & 31, b = bh >> 2, h = bh & 3;
    const bf16_t* GR = (const bf16_t*)(a.ws + WS_GR); bf16_t* Y = (bf16_t*)(a.ws + WS_H);
    LAS unsigned char* Kt = lds; LAS unsigned char* Vt = lds + 128 * KS; LAS unsigned char* SF = Vt + 128 * VS; LAS unsigned char* SB = SF + 64 * VS;
#pragma unroll
    for (int q = 0; q < 2; ++q) { const int p = tid + 512 * q; *(LAS u32x4*)(Kt + (p >> 3) * KS + (p & 7) * 16) = st.k[q]; }
#pragma unroll
    for (int q = 0; q < 4; ++q) { const int p = tid + 512 * q; *(LAS u32x4*)(Vt + (p >> 4) * VS + (p & 15) * 16) = st.v[q]; }
#pragma unroll
    for (int q = 0; q < 2; ++q) { const int p = tid + 512 * q; *(LAS u32x4*)(SF + (p >> 4) * VS + (p & 15) * 16) = st.sf[q]; *(LAS u32x4*)(SB + (p >> 4) * VS + (p & 15) * 16) = st.sb[q]; }
    bf16x8 Qf[2];
#pragma unroll
    for (int s = 0; s < 2; ++s) Qf[s] = st.q[s];
    lds_barrier();
    if (next_unit >= 0) ret_load(a, next_unit, st);
    const float l2f = -expf(a.dec_f[h]) * LOG2E, l2b = -expf(a.dec_b[h]) * LOG2E;
    const int n = 16 * w + i;

    f32x4 accS[8];
#pragma unroll
    for (int mt = 0; mt < 8; ++mt) {
        accS[mt] = (f32x4){0.f, 0.f, 0.f, 0.f};
#pragma unroll
        for (int s = 0; s < 2; ++s) accS[mt] = mfma16(frag_rowP_lds(Kt + (16 * mt + i) * KS + 64 * s, g), Qf[s], accS[mt]);
    }
#pragma unroll
    for (int mt = 0; mt < 8; ++mt)
#pragma unroll
        for (int reg = 0; reg < 4; ++reg) {
            const int diff = n - (16 * mt + 4 * g + reg);
            const float ex = __builtin_amdgcn_exp2f(diff > 0 ? (float)diff * l2f : (float)(-diff) * l2b);
            accS[mt][reg] *= (diff == 0 ? 2.0f : ex);
        }
    const float fsf = __builtin_amdgcn_exp2f((float)(n + 1) * l2f), fsb = __builtin_amdgcn_exp2f((float)(128 - n) * l2b);
    f32x4 accO[8];
#pragma unroll
    for (int et = 0; et < 8; ++et) accO[et] = (f32x4){0.f, 0.f, 0.f, 0.f};
#pragma unroll
    for (int s = 0; s < 4; ++s) {
        const u32x4 pu = {pk2(accS[2 * s][0], accS[2 * s][1]), pk2(accS[2 * s][2], accS[2 * s][3]), pk2(accS[2 * s + 1][0], accS[2 * s + 1][1]), pk2(accS[2 * s + 1][2], accS[2 * s + 1][3])};
        const bf16x8 Pf = __builtin_bit_cast(bf16x8, pu);
#pragma unroll
        for (int et = 0; et < 8; ++et) accO[et] = mfma16(frag_tr(Vt, VS, 32 * s, 16 * et, lane), Pf, accO[et]);
        __builtin_amdgcn_sched_barrier(0);
    }
#pragma unroll
    for (int s = 0; s < 2; ++s) {
        const bf16x8 qsf = scale_frag(Qf[s], fsf), qsb = scale_frag(Qf[s], fsb);
#pragma unroll
        for (int et = 0; et < 8; ++et) {
            accO[et] = mfma16(frag_tr(SF, VS, 32 * s, 16 * et, lane), qsf, accO[et]);
            accO[et] = mfma16(frag_tr(SB, VS, 32 * s, 16 * et, lane), qsb, accO[et]);
        }
        __builtin_amdgcn_sched_barrier(0);
    }
    float sm = 0.f;
#pragma unroll
    for (int et = 0; et < 8; ++et) sm += accO[et][0] + accO[et][1] + accO[et][2] + accO[et][3];
    sm += __shfl_xor(sm, 16); sm += __shfl_xor(sm, 32);
    const float mean = sm * (1.0f / 128.0f);
    float v2 = 0.f;
#pragma unroll
    for (int et = 0; et < 8; ++et)
#pragma unroll
        for (int e = 0; e < 4; ++e) { const float d0 = accO[et][e] - mean; v2 += d0 * d0; }
    v2 += __shfl_xor(v2, 16); v2 += __shfl_xor(v2, 32);
    const float rstd = rsqrtf(v2 * (1.0f / 128.0f) + EPS);
    const int r = b * 4096 + c * 128 + n;
#pragma unroll
    for (int et = 0; et < 8; et += 2) {
        const int colw = h * 128 + 16 * (et + (g & 1)) + 8 * (g >> 1);
        const u32x4 gww = *(const u32x4*)(GR + (size_t)r * 512 + colw);
        const u32x2 gx = __builtin_amdgcn_permlane16_swap(gww[0], gww[2], false, false), gy = __builtin_amdgcn_permlane16_swap(gww[1], gww[3], false, false);
        const u32x2 ga = {gx[0], gy[0]}, gb = {gx[1], gy[1]};
        const f32x4 wa = *(const f32x4*)(a.gn_w + h * 128 + 16 * et + 4 * g), wb = *(const f32x4*)(a.gn_w + h * 128 + 16 * (et + 1) + 4 * g);
        const u32x2 oa = {pk2((accO[et][0] - mean) * rstd * wa[0] * bflo(ga.x), (accO[et][1] - mean) * rstd * wa[1] * bfhi(ga.x)),
                          pk2((accO[et][2] - mean) * rstd * wa[2] * bflo(ga.y), (accO[et][3] - mean) * rstd * wa[3] * bfhi(ga.y))};
        const u32x2 ob = {pk2((accO[et + 1][0] - mean) * rstd * wb[0] * bflo(gb.x), (accO[et + 1][1] - mean) * rstd * wb[1] * bfhi(gb.x)),
                          pk2((accO[et + 1][2] - mean) * rstd * wb[2] * bflo(gb.y), (accO[et + 1][3] - mean) * rstd * wb[3] * bfhi(gb.y))};
        const u32x2 wx = __builtin_amdgcn_permlane16_swap(oa.x, ob.x, false, false), wy = __builtin_amdgcn_permlane16_swap(oa.y, ob.y, false, false);
        const u32x4 ow = {wx[0], wy[0], wx[1], wy[1]};
        *(u32x4*)(Y + (size_t)r * 1024 + colw) = ow;
    }
    lds_barrier();
}

DI void phase7(const Args& a) {
    const int tid = threadIdx.x, wave = tid >> 6, lane = tid & 63;
    for (int r = blockIdx.x * 8 + wave; r < NTOK; r += gridDim.x * 8) {
        float* row = a.out + (size_t)r * 1024;
        f32x4 v[4]; float ss = 0.f;
#pragma unroll
        for (int q = 0; q < 4; ++q) { v[q] = *(const f32x4*)(row + q * 256 + lane * 4); ss += v[q][0] * v[q][0] + v[q][1] * v[q][1] + v[q][2] * v[q][2] + v[q][3] * v[q][3]; }
#pragma unroll
        for (int off = 32; off >= 1; off >>= 1) ss += __shfl_xor(ss, off);
        const float rstd = rsqrtf(ss * (1.0f / 1024.0f) + EPS);
#pragma unroll
        for (int q = 0; q < 4; ++q) {
            const f32x4 fw = *(const f32x4*)(a.fnorm_w + q * 256 + lane * 4);
            *(f32x4*)(row + q * 256 + lane * 4) = v[q] * rstd * fw;
        }
    }
}

__global__ __launch_bounds__(512, 2) void fwd_megakernel(Args a) {
    extern __shared__ __attribute__((aligned(16))) unsigned char shm[];
    LAS unsigned char* lds = (LAS unsigned char*)shm;
    cg::grid_group grid = cg::this_grid();
    volatile LAS unsigned* st = (volatile LAS unsigned*)(lds + LDS_BYTES - 16);
    if (threadIdx.x == 0) { st[0] = 0u; st[1] = 0u; }
    __syncthreads();
    const XcdBarrier xb = xcd_barrier_post((unsigned*)(a.ws + WS_BAR), st);
    if (a.ph_hi > 7) grid.sync();
#ifndef PHMASK
#define PHMASK 255
#endif
#ifndef REPMASK
#define REPMASK 0
#endif
#ifndef EXTRA_SYNCS
#define EXTRA_SYNCS 0
#endif
#define GSYNC() xcd_barrier(xb)
    for (int xs = 0; xs < EXTRA_SYNCS; ++xs) GSYNC();
#define PHASE(P, ...) do { if (((PHMASK >> (P)) & 1) && a.ph_lo <= (P) && (P) < a.ph_hi) { if ((REPMASK >> (P)) & 1) { __VA_ARGS__; GSYNC(); } __VA_ARGS__; if ((P) + 1 < a.ph_hi) GSYNC(); } } while (0)
    PHASE(0, phase0(a, lds));
    PHASE(1, phase1(a));
    PHASE(2, {
        pg8::Gemm gm{(const bf16_t*)(a.ws + WS_H), (const bf16_t*)(a.ws + WS_WIN), NTOK, NP, D};
        SchedIn S; S.so.init(NTOK, NP, (int)gridDim.x, (int)blockIdx.x);
        EpiIn E{a.ws};
        pg8::gemm_phase<EpiIn, SchedIn, false>(lds, gm, S, E, nullptr);
    });
    PHASE(3, phase3(a, lds));
    PHASE(5, { int it = blockIdx.x; if (it < 1024) { RetStage st; ret_load(a, it, st); for (;;) { const int nx = it + (int)gridDim.x; ret_unit(a, lds, it, st, nx < 1024 ? nx : -1); if (nx >= 1024) break; it = nx; } } });
    PHASE(6, {
        pg8::Gemm gm{(const bf16_t*)(a.ws + WS_H), (const bf16_t*)(a.ws + WS_WOUT), NTOK, D, D};
        pg8::StaticOrder S; S.init(NTOK, D, (int)gridDim.x, (int)blockIdx.x);
        EpiOut E{a.x, (const float*)(a.ws + WS_MOD), a.fnorm_w, a.out, (float*)(a.ws + WS_SLOT), (unsigned*)(a.ws + WS_CNT)};
        pg8::gemm_phase<EpiOut, pg8::StaticOrder, false>(lds, gm, S, E, nullptr);
    });
#undef PHASE
}

extern "C" void kernel_launch(void* const* d_in, const int* in_sizes, int n_in, void* d_out, int out_size, void* d_ws, size_t ws_size, hipStream_t stream) {
    static int grid = 0;
    if (grid == 0) {
        if (n_in != 16 || out_size != NTOK * D || ws_size < WS_END) { fprintf(stderr, "kernel_launch: unexpected shapes (n_in %d out %d ws %zu need %zu)\n", n_in, out_size, ws_size, (size_t)WS_END); grid = -1; return; }
        int dev = 0, cus = 0, per_cu = 0;
        (void)hipGetDevice(&dev); (void)hipDeviceGetAttribute(&cus, hipDeviceAttributeMultiprocessorCount, dev);
        if (hipFuncSetAttribute((const void*)fwd_megakernel, hipFuncAttributeMaxDynamicSharedMemorySize, LDS_BYTES) != hipSuccess) { fprintf(stderr, "kernel_launch: hipFuncSetAttribute failed\n"); grid = -1; return; }
        if (hipOccupancyMaxActiveBlocksPerMultiprocessor(&per_cu, (const void*)fwd_megakernel, NTHREADS, LDS_BYTES) != hipSuccess || per_cu < 1) { fprintf(stderr, "kernel_launch: occupancy query gives %d\n", per_cu); per_cu = 1; }
        (void)hipGetLastError();
        grid = cus;
    }
    if (grid < 0) return;
    Args a{};
    a.x = (const float*)d_in[0]; a.c = (const float*)d_in[1]; a.ctx = (const float*)d_in[2]; a.c_ctx = (const float*)d_in[3]; a.w_ada = (const float*)d_in[4]; a.b_ada = (const float*)d_in[5];
    a.norm_w = (const float*)d_in[6]; a.w_in = (const float*)d_in[7]; a.dec_f = (const float*)d_in[8]; a.dec_b = (const float*)d_in[9]; a.gn_w = (const float*)d_in[10]; a.ln_w = (const float*)d_in[11];
    a.w_s = (const float*)d_in[12]; a.b_s = (const float*)d_in[13]; a.w_out = (const float*)d_in[14]; a.fnorm_w = (const float*)d_in[15];
    a.out = (float*)d_out; a.ws = (unsigned char*)d_ws;
    (void)hipMemsetAsync((unsigned char*)d_ws + WS_BAR, 0, (size_t)XCD_BAR_WORDS * 4 + 32768, stream);
#if N_LAUNCHES == 1
    a.ph_lo = 0; a.ph_hi = 7;
    void* args[] = {&a};
    hipError_t e = hipLaunchCooperativeKernel((const void*)fwd_megakernel, dim3(grid), dim3(NTHREADS), args, LDS_BYTES, stream);
    if (e != hipSuccess) fprintf(stderr, "cooperative launch failed: %s (grid %d)\n", hipGetErrorString(e), grid);
#else
    for (int p = 0; p < 7; ++p) {
        a.ph_lo = p; a.ph_hi = p + 1;
        hipLaunchKernelGGL(fwd_megakernel, dim3(grid), dim3(NTHREADS), LDS_BYTES, stream, a);
    }
#endif
}
```

```cpp
#include <hip/hip_runtime.h>
#include <hip/hip_cooperative_groups.h>
#include <cstdio>
namespace cg = cooperative_groups;
#ifndef N_LAUNCHES
#define N_LAUNCHES 1
#endif
namespace pg8 {
#define PG8_LAS __attribute__((address_space(3)))
typedef unsigned short bf16_t;
typedef short bf16x8 __attribute__((ext_vector_type(8)));
typedef float f32x4 __attribute__((ext_vector_type(4)));
typedef unsigned u32x4 __attribute__((ext_vector_type(4)));
constexpr int BM = 256, BK = 64, HALF = 128, HTB = HALF * BK * 2  , STAGE_BYTES = 8 * HTB, NXCD = 8, WGM = 8;

__host__ __device__ __forceinline__ int lds_byte(int r, int c) { const int st = (r >> 4) * 2 + (c >> 5), rr = r & 15, cc = c & 31, ob = rr * 64 + cc * 2; return st * 1024 + (ob ^ (((ob >> 9) & 1) << 5)); }
__host__ __device__ __forceinline__ void stage_rc(int b, int& R, int& C) { const int st = b / 1024, sb = b % 1024, swz = sb ^ (((sb >> 9) & 1) << 5); R = (st >> 1) * 16 + swz / 64; C = (st & 1) * 32 + (swz % 64) / 2; }
__host__ __device__ __forceinline__ int perm32(int rho) { const int n = rho >> 4, i = rho & 15; return 8 * (i >> 2) + 4 * n + (i & 3); }

struct Unit { int pm, pn; };
struct Gemm { const bf16_t* A; const bf16_t* Bt; int M, N, K; };

struct StaticOrder {
    int nM, nN, nwg, G, c;
    __host__ __device__ void init(int M, int N, int G_, int c_) { nM = M / BM; nN = N / BM; nwg = nM * nN; G = G_; c = c_; }
    __host__ __device__ bool next(int i, Unit& u) const {
        const long L = (long)i * G + c; if (L >= nwg) return false;
        int wgid = (int)L; { const int q = nwg / NXCD, r = nwg % NXCD, xcd = wgid % NXCD, off = wgid / NXCD; wgid = (xcd < r ? xcd * (q + 1) : r * (q + 1) + (xcd - r) * q) + off; }
        const int nig = WGM * nN, gid = wgid / nig, fm = gid * WGM, gsz = (nM - fm) < WGM ? (nM - fm) : WGM;
        u.pm = fm + ((wgid % nig) % gsz); u.pn = (wgid % nig) / gsz; return true;
    }
    __device__ __forceinline__ void a_ready(const Unit&) const {}
    __device__ __forceinline__ void done(const Unit&) const {}
};
struct CountedOrder : StaticOrder {
    const unsigned* ready; unsigned need; unsigned* tmo;
    __device__ __forceinline__ void a_ready(const Unit& u) const {
        if (threadIdx.x < 64) {
            const unsigned long long t0 = __builtin_amdgcn_s_memrealtime(); unsigned polls = 0;
            while ((unsigned)__builtin_amdgcn_readfirstlane(__hip_atomic_load(ready + 64 * u.pm, __ATOMIC_RELAXED, __HIP_MEMORY_SCOPE_AGENT)) < need) {
                if ((++polls & 255u) == 0u && __builtin_amdgcn_readfirstlane(__hip_atomic_load(tmo, __ATOMIC_RELAXED, __HIP_MEMORY_SCOPE_AGENT)) != 0u) break;
                if (__builtin_amdgcn_s_memrealtime() - t0 > 2000000ull) {
                    if (threadIdx.x == 0) { unsigned expect = 0u; __hip_atomic_compare_exchange_strong(tmo + 1, &expect, 0x600u | (unsigned)(u.pm & 0xff), __ATOMIC_RELAXED, __ATOMIC_RELAXED, __HIP_MEMORY_SCOPE_AGENT); __hip_atomic_store(tmo, 1u, __ATOMIC_RELAXED, __HIP_MEMORY_SCOPE_AGENT); }
                    break; }
                __builtin_amdgcn_s_sleep(2); }
            __builtin_amdgcn_fence(__ATOMIC_ACQUIRE, "agent");
            asm volatile("s_waitcnt vmcnt(0)" ::: "memory");
        }
#if !defined(BROKEN_HOOK_NO_BARRIER)
        asm volatile("" ::: "memory"); __builtin_amdgcn_s_barrier(); asm volatile("" ::: "memory");
#endif
    }
};

__device__ __forceinline__ unsigned cvt_pk_bf16(float lo, float hi) { unsigned r; asm volatile("v_cvt_pk_bf16_f32 %0, %1, %2" : "=v"(r) : "v"(lo), "v"(hi)); return r; }
typedef float f32x2 __attribute__((ext_vector_type(2)));
__device__ __forceinline__ f32x2 gelu_pk(f32x2 v) {
    const f32x2 av = __builtin_elementwise_abs(v), d = av * 0.2316418882f + 1.0f;
    f32x2 t; t.x = __builtin_amdgcn_rcpf(d.x); t.y = __builtin_amdgcn_rcpf(d.y);
    f32x2 q = t * 0.5307027145f + (-0.7265760135f); q = q * t + 0.7107068705f; q = q * t + (-0.142248368f); q = q * t + 0.127414796f; q = q * t;
    const f32x2 s = (v * v) * (-0.72134752044f);
    f32x2 e; e.x = __builtin_amdgcn_exp2f(s.x); e.y = __builtin_amdgcn_exp2f(s.y);
    const f32x2 m = v * (q * e), r = v - m;
    f32x2 o; o.x = v.x < 0.f ? m.x : r.x; o.y = v.y < 0.f ? m.y : r.y; return o;
}
template <class Epi, class Sched, bool STAMP = false>
__device__ __forceinline__ void gemm_phase(PG8_LAS unsigned char* lds, const Gemm g, const Sched& S, const Epi& E, unsigned long long* stamps) {
    const int tid = threadIdx.x, wid = __builtin_amdgcn_readfirstlane(tid >> 6), lane = tid & 63, wr = wid >> 2, wc = wid & 3, fr = lane & 15, fq = lane >> 4;
    const int K = g.K, nt = K / BK;
    int ts_lo = 0, ts_hi = 0, nts = 0; const unsigned long long rt_entry = STAMP ? (unsigned long long)wall_clock64() : 0ull;
#define PG8_STAMP() do { if (STAMP && wid == 0 && nts < 64) { const unsigned long long _c = (unsigned long long)clock64(); \
        ts_lo = (lane == nts) ? (int)(unsigned)_c : ts_lo; ts_hi = (lane == nts) ? (int)(unsigned)(_c >> 32) : ts_hi; ++nts; } } while (0)
    PG8_STAMP();
    unsigned voffA[2], voffB[2];
#pragma unroll
    for (int i = 0; i < 2; ++i) { int R, C; stage_rc(tid * 16 + i * 8192, R, C); const int Rb = Epi::PERM ? ((R & ~31) + perm32(R & 31)) : R;
        voffA[i] = (unsigned)(R * K + C) * 2u; voffB[i] = (unsigned)(Rb * K + C) * 2u; }
    const size_t kstep = (size_t)(BK * 2);
    const size_t hstep = (size_t)HALF * K * 2;
    const size_t tstep = 2 * hstep;
    const unsigned ldsw = (unsigned)wid * 1024u;
    const int aoff = lds_byte(wr * 64 + fr, fq * 8), boff = lds_byte(wc * 32 + fr, fq * 8);
#define PG8_SA(b, h) (((b) * 2 + (h)) * HTB)
#define PG8_SB(b, h) ((4 + (b) * 2 + (h)) * HTB)
#define PG8_STAGE(bufoff, gbase, voff) do { _Pragma("unroll") for (int _i = 0; _i < 2; ++_i) \
        __builtin_amdgcn_global_load_lds((const unsigned*)((const char*)(gbase) + (voff)[_i]), (PG8_LAS unsigned*)(lds + (bufoff) + ldsw + _i * 8192), 16, 0, 0); } while (0)
#define PG8_LDA(dst, b, h) do { _Pragma("unroll") for (int m = 0; m < 4; ++m) _Pragma("unroll") for (int k = 0; k < 2; ++k) dst[m][k] = *(const PG8_LAS bf16x8*)(lds + PG8_SA(b, h) + aoff + m * 2048 + k * 1024); } while (0)
#define PG8_LDB(dst, b, h) do { _Pragma("unroll") for (int n = 0; n < 2; ++n) _Pragma("unroll") for (int k = 0; k < 2; ++k) dst[n][k] = *(const PG8_LAS bf16x8*)(lds + PG8_SB(b, h) + boff + n * 2048 + k * 1024); } while (0)
#define PG8_MMA(ai, bj, At, Bt) do { __builtin_amdgcn_s_setprio(1); _Pragma("unroll") for (int m = 0; m < 4; ++m) _Pragma("unroll") for (int n = 0; n < 2; ++n) _Pragma("unroll") for (int k = 0; k < 2; ++k) \
        acc[ai][bj][m][n] = __builtin_amdgcn_mfma_f32_16x16x32_bf16(Bt[n][k], At[m][k], acc[ai][bj][m][n], 0, 0, 0); __builtin_amdgcn_s_setprio(0); } while (0)
#define PG8_WAIT_V(n) asm volatile("s_waitcnt vmcnt(" #n ")" ::: "memory")
#define PG8_WAIT_L(n) asm volatile("s_waitcnt lgkmcnt(" #n ")" ::: "memory")
#define PG8_BAR __builtin_amdgcn_s_barrier()
#define PG8_SCHED __builtin_amdgcn_sched_barrier(0)
    Unit cur, nxt; int ui = 0;
    if (!S.next(0, cur)) return;
    f32x4 acc[2][2][4][2];
#pragma unroll
    for (int a = 0; a < 2; ++a)
#pragma unroll
        for (int b = 0; b < 2; ++b)
#pragma unroll
            for (int m = 0; m < 4; ++m)
#pragma unroll
                for (int n = 0; n < 2; ++n) acc[a][b][m][n] = (f32x4){0.f, 0.f, 0.f, 0.f};
    bf16x8 At[4][2], B0[2][2], B1[2][2];
    const char* cA = (const char*)g.A + (size_t)cur.pm * tstep; const char* cB = (const char*)g.Bt + (size_t)cur.pn * tstep;
    S.a_ready(cur);
    PG8_STAGE(PG8_SB(0, 0), cB, voffB); PG8_STAGE(PG8_SA(0, 0), cA, voffA); PG8_STAGE(PG8_SB(0, 1), cB + hstep, voffB); PG8_STAGE(PG8_SA(0, 1), cA + hstep, voffA);
    if (wr == 1) PG8_BAR;
    PG8_WAIT_V(4); PG8_BAR;
    PG8_STAGE(PG8_SB(1, 0), cB + kstep, voffB); PG8_STAGE(PG8_SA(1, 0), cA + kstep, voffA); PG8_STAGE(PG8_SB(1, 1), cB + hstep + kstep, voffB);
    PG8_WAIT_V(6); PG8_BAR;
    PG8_STAMP();
    for (;;) {
        const bool has_next = S.next(ui + 1, nxt);
        const char* nA = has_next ? (const char*)g.A + (size_t)nxt.pm * tstep : cA; const char* nB = has_next ? (const char*)g.Bt + (size_t)nxt.pn * tstep : cB;
        for (int t = 0; t < nt; t += 2) {
            const bool last = (t == nt - 2);
            const char* a1 = cA + (size_t)(t + 1) * kstep;
            const char* a2 = last ? nA : cA + (size_t)(t + 2) * kstep; const char* b2 = last ? nB : cB + (size_t)(t + 2) * kstep;
            const char* a3 = a2 + kstep; const char* b3 = b2 + kstep;
            if (last && has_next) S.a_ready(nxt);
            PG8_LDB(B0, 0, 0); PG8_SCHED; PG8_LDA(At, 0, 0); PG8_STAGE(PG8_SA(1, 1), a1 + hstep, voffA);
            PG8_WAIT_L(8); PG8_BAR; PG8_WAIT_L(0); PG8_MMA(0, 0, At, B0); PG8_BAR; PG8_SCHED;
            PG8_LDB(B1, 0, 1); PG8_STAGE(PG8_SB(0, 0), b2, voffB);
            PG8_BAR; PG8_WAIT_L(0); PG8_MMA(0, 1, At, B1); PG8_BAR;
            PG8_LDA(At, 0, 1); PG8_STAGE(PG8_SA(0, 0), a2, voffA);
            PG8_BAR; PG8_WAIT_L(0); PG8_MMA(1, 0, At, B0); PG8_BAR; PG8_SCHED;
            PG8_STAGE(PG8_SB(0, 1), b2 + hstep, voffB);
            PG8_WAIT_V(6); PG8_BAR; PG8_MMA(1, 1, At, B1); PG8_BAR;
            PG8_LDB(B0, 1, 0); PG8_SCHED; PG8_LDA(At, 1, 0); PG8_STAGE(PG8_SA(0, 1), a2 + hstep, voffA);
            PG8_WAIT_L(8); PG8_BAR; PG8_WAIT_L(0); PG8_MMA(0, 0, At, B0); PG8_BAR; PG8_SCHED;
            PG8_LDB(B1, 1, 1); PG8_STAGE(PG8_SB(1, 0), b3, voffB);
            PG8_BAR; PG8_WAIT_L(0); PG8_MMA(0, 1, At, B1); PG8_BAR;
            PG8_LDA(At, 1, 1); PG8_STAGE(PG8_SA(1, 0), a3, voffA);
            PG8_BAR; PG8_WAIT_L(0); PG8_MMA(1, 0, At, B0); PG8_BAR; PG8_SCHED;
            PG8_STAGE(PG8_SB(1, 1), b3 + hstep, voffB);
            PG8_WAIT_V(6); PG8_BAR; PG8_MMA(1, 1, At, B1); PG8_BAR;
        }
        PG8_STAMP();
        if constexpr (!Epi::AFTER_DRAIN) {
            if constexpr (Epi::REALIGN) { if (wr == 0) PG8_BAR; }
            E(acc, cur, wr, wc, fr, fq); S.done(cur);
            if constexpr (Epi::REALIGN) { if (wr == 1) PG8_BAR; }
        }
        PG8_STAMP();
        if (!has_next) break;
#pragma unroll
        for (int a = 0; a < 2; ++a)
#pragma unroll
            for (int b = 0; b < 2; ++b)
#pragma unroll
                for (int m = 0; m < 4; ++m)
#pragma unroll
                    for (int n = 0; n < 2; ++n) acc[a][b][m][n] = (f32x4){0.f, 0.f, 0.f, 0.f};
        cur = nxt; cA = nA; cB = nB; ++ui;
    }
    PG8_WAIT_V(0);
    if (wr == 0) PG8_BAR;
    PG8_BAR;
    if constexpr (Epi::AFTER_DRAIN) { E.fused(acc, cur, wr, wc, fr, fq, lds, wid, lane); S.done(cur); }
    PG8_STAMP();
    if (STAMP && wid == 0) { stamps[lane] = lane < nts ? (((unsigned long long)(unsigned)ts_hi << 32) | (unsigned)ts_lo) : 0ull;
        if (lane == 62) stamps[62] = rt_entry; if (lane == 63) stamps[63] = (unsigned long long)wall_clock64(); }
#undef PG8_STAMP
#undef PG8_SA
#undef PG8_SB
#undef PG8_STAGE
#undef PG8_LDA
#undef PG8_LDB
#undef PG8_MMA
#undef PG8_WAIT_V
#undef PG8_WAIT_L
#undef PG8_BAR
#undef PG8_SCHED
}
}
#define LAS __attribute__((address_space(3)))
#define XB_TMO      128
#define XB_XCNT(j)  (256  + 64 * (j))
#define XB_XSUB(j)  (1280 + 64 * (j))
#define XB_XGEN(j)  (2304 + 64 * (j))
#define XB_TOP      3328
#define XB_TOPGEN   3392
#define XCD_BAR_WORDS 3456
#define XB_SPIN_CAP (1u << 18)

__device__ __forceinline__ unsigned xb_ld(unsigned* p)              { return __hip_atomic_load(p, __ATOMIC_RELAXED, __HIP_MEMORY_SCOPE_AGENT); }
__device__ __forceinline__ unsigned xb_add(unsigned* p, unsigned v) { return __hip_atomic_fetch_add(p, v, __ATOMIC_RELAXED, __HIP_MEMORY_SCOPE_AGENT); }
__device__ __forceinline__ unsigned xb_xcc_id() { return (unsigned)__builtin_amdgcn_s_getreg((3 << 11) | 20) & 0xFu; }
#define XB_SPIN(cond, bar) do { unsigned _sp = 0; while (cond) { __builtin_amdgcn_s_sleep(1); \
    if ((++_sp & 255u) == 0u) { if (xb_ld(&(bar)[XB_TMO])) break; if (_sp > XB_SPIN_CAP) { atomicAdd(&(bar)[XB_TMO], 1u); break; } } } } while (0)

struct XcdBarrier {
    unsigned* bar; unsigned x;
    volatile LAS unsigned* st;
};

__device__ __forceinline__ XcdBarrier xcd_barrier_post(unsigned* bar, volatile LAS unsigned* st) {
    XcdBarrier b; b.bar = bar; b.x = xb_xcc_id(); b.st = st;
    if (threadIdx.x == 0) (void)xb_add(&bar[XB_XCNT(b.x)], 1u);
    return b;
}
__device__ __forceinline__ void xcd_barrier_complete(unsigned* bar, unsigned x, unsigned& nloc, unsigned& nx) {
    const unsigned G = gridDim.x * gridDim.y * gridDim.z;
    unsigned sum, cnt, mine, sp = 0u;
    for (;;) {
        sum = 0u; cnt = 0u; mine = 0u;
#pragma unroll
        for (unsigned j = 0; j < 16; ++j) { const unsigned c = xb_ld(&bar[XB_XCNT(j)]); sum += c; cnt += (c > 0u) ? 1u : 0u; mine = (j == x) ? c : mine; }
        if (sum == G) break;
        __builtin_amdgcn_s_sleep(1);
        if ((++sp & 255u) == 0u) { if (xb_ld(&bar[XB_TMO])) break; if (sp > XB_SPIN_CAP) { atomicAdd(&bar[XB_TMO], 1u); break; } }
    }
    nloc = mine > 0u ? mine : 1u; nx = cnt > 0u ? cnt : 1u;
}

__device__ __forceinline__ void xcd_barrier(const XcdBarrier& b) {
    asm volatile("s_waitcnt vmcnt(0)" ::: "memory");
    __syncthreads();
    if (threadIdx.x == 0) {
        unsigned* bar = b.bar;
        __builtin_amdgcn_s_waitcnt(0);
        unsigned nloc = b.st[0], nx = b.st[1];
        if (nloc == 0u) { xcd_barrier_complete(bar, b.x, nloc, nx); b.st[0] = nloc; b.st[1] = nx; }
        const unsigned old = xb_add(&bar[XB_XSUB(b.x)], 1u);
        const unsigned gen = old / nloc;
        if (old + 1u == (gen + 1u) * nloc) {
            __builtin_amdgcn_fence(__ATOMIC_RELEASE, "agent");
            asm volatile("s_waitcnt vmcnt(0)" ::: "memory");
            const unsigned og = xb_add(&bar[XB_TOP], 1u);
            const unsigned tg = og / nx;
            if (og + 1u == (tg + 1u) * nx) xb_add(&bar[XB_TOPGEN], 1u);
            else XB_SPIN(xb_ld(&bar[XB_TOPGEN]) == tg, bar);
            __builtin_amdgcn_fence(__ATOMIC_ACQUIRE, "agent");
            xb_add(&bar[XB_XGEN(b.x)], 1u);
            asm volatile("s_waitcnt vmcnt(0)" ::: "memory");
        } else {
            XB_SPIN(xb_ld(&bar[XB_XGEN(b.x)]) == gen, bar);
            __builtin_amdgcn_fence(__ATOMIC_ACQUIRE, "agent");
            asm volatile("s_waitcnt vmcnt(0)" ::: "memory");
        }
    }
    __syncthreads();
}


#define DI __device__ __forceinline__

using pg8::bf16_t; using pg8::bf16x8; using pg8::f32x4; using pg8::f32x2; using pg8::u32x4; using pg8::Unit;
typedef unsigned u32x2 __attribute__((ext_vector_type(2)));
typedef short s16x4 __attribute__((ext_vector_type(4)));
typedef __bf16 bf2_t __attribute__((ext_vector_type(2)));

constexpr int NB = 8, T = 4096, D = 1024, NTOK = NB * T, CTXL = 256, NCTX = NB * CTXL, NP = 3072, NC = 32;
constexpr int NTHREADS = 512;
constexpr int LDS_BYTES = 147456 + 256;
constexpr float EPS = 1e-6f, LOG2E = 1.4426950408889634f;

constexpr size_t al256(size_t x) { return (x + 255) & ~(size_t)255; }
constexpr size_t WS_MOD  = 0;
constexpr size_t WS_ROPE = WS_MOD + al256(9 * 3072 * 4);
constexpr size_t WS_WIN  = WS_ROPE + 8192;
constexpr size_t WS_WOUT = WS_WIN + (size_t)3072 * 1024 * 2;
constexpr size_t WS_WSB  = WS_WOUT + (size_t)1024 * 1024 * 2;
constexpr size_t WS_H    = WS_WSB + (size_t)4 * 128 * 128 * 2;
constexpr size_t WS_Q    = WS_H + (size_t)(NTOK + NCTX) * 1024 * 2;
constexpr size_t WS_K    = WS_Q + (size_t)NTOK * 256 * 2;
constexpr size_t WS_V    = WS_K + (size_t)NTOK * 256 * 2;
constexpr size_t WS_GR   = WS_V + (size_t)NTOK * 512 * 2;
constexpr size_t WS_U    = WS_GR + (size_t)NTOK * 512 * 2;
constexpr size_t WS_VG   = WS_U + (size_t)NTOK * 512 * 2;
constexpr size_t WS_GM   = WS_VG + (size_t)NTOK * 512 * 2;
constexpr size_t WS_KC   = WS_GM + (size_t)NTOK * 512 * 2;
constexpr size_t WS_VC   = WS_KC + (size_t)NCTX * 256 * 2;
constexpr size_t WS_KV   = WS_VC + (size_t)NCTX * 512 * 2;
constexpr size_t WS_KVC  = WS_KV + (size_t)1024 * 2 * 8192 * 4;
constexpr size_t WS_ST   = WS_KVC + (size_t)64 * 2 * 8192 * 4;
constexpr size_t WS_BAR  = WS_ST + (size_t)1024 * 2 * 8192 * 2;
constexpr size_t WS_CNT  = WS_BAR + (size_t)XCD_BAR_WORDS * 4;
constexpr size_t WS_SLOT = WS_CNT + 32768;
constexpr size_t WS_END  = WS_SLOT + (size_t)NTOK * 16 * 4;

struct Args {
    const float* x; const float* c; const float* ctx; const float* c_ctx; const float* w_ada; const float* b_ada; const float* norm_w; const float* w_in;
    const float* dec_f; const float* dec_b; const float* gn_w; const float* ln_w; const float* w_s; const float* b_s; const float* w_out; const float* fnorm_w;
    float* out; unsigned char* ws; int ph_lo, ph_hi;
};

DI unsigned pk2(float lo, float hi) { f32x2 v = {lo, hi}; bf2_t r = __builtin_convertvector(v, bf2_t); return __builtin_bit_cast(unsigned, r); }
DI f32x4 ldnt_f4(const float* p) { return __builtin_nontemporal_load((const f32x4*)p); }
DI u32x4 ldnt_u4(const void* p) { return __builtin_nontemporal_load((const u32x4*)p); }
DI u32x2 ldnt_u2(const void* p) { return __builtin_nontemporal_load((const u32x2*)p); }
DI float bflo(unsigned w) { return __uint_as_float(w << 16); }
DI float bfhi(unsigned w) { return __uint_as_float(w & 0xffff0000u); }
DI float silu_f(float v) { return v * __builtin_amdgcn_rcpf(1.0f + __expf(-v)); }
DI void lds_barrier() { asm volatile("s_waitcnt lgkmcnt(0)" ::: "memory"); __builtin_amdgcn_s_barrier(); asm volatile("" ::: "memory"); }
DI f32x4 mfma16(bf16x8 a, bf16x8 b, f32x4 c) { return __builtin_amdgcn_mfma_f32_16x16x32_bf16(a, b, c, 0, 0, 0); }

DI bf16x8 frag_tr(LAS const unsigned char* base, int S, int k0, int n0, int lane) {
    const int i = lane & 15, g = lane >> 4;
    LAS const unsigned char* p = base + (k0 + 4 * g + (i >> 2)) * S + (n0 + 4 * (i & 3)) * 2;
    const s16x4 lo = __builtin_amdgcn_ds_read_tr16_b64_v4i16((LAS s16x4*)p);
    const s16x4 hi = __builtin_amdgcn_ds_read_tr16_b64_v4i16((LAS s16x4*)(p + 16 * S));
    return __builtin_shufflevector(lo, hi, 0, 1, 2, 3, 4, 5, 6, 7);
}
DI bf16x8 frag_rowP(const bf16_t* rowk0, int g) {
    const u32x2 lo = *(const u32x2*)(rowk0 + 4 * g), hi = *(const u32x2*)(rowk0 + 16 + 4 * g);
    const u32x4 v = {lo.x, lo.y, hi.x, hi.y}; return __builtin_bit_cast(bf16x8, v);
}
DI bf16x8 frag_rowP_lds(LAS const unsigned char* rowk0, int g) {
    const u32x2 lo = *(LAS const u32x2*)(rowk0 + 8 * g), hi = *(LAS const u32x2*)(rowk0 + 32 + 8 * g);
    const u32x4 v = {lo.x, lo.y, hi.x, hi.y}; return __builtin_bit_cast(bf16x8, v);
}
DI bf16x8 scale_frag(bf16x8 f, float s) {
    const u32x4 u = __builtin_bit_cast(u32x4, f); u32x4 r;
#pragma unroll
    for (int q = 0; q < 4; ++q) r[q] = pk2(bflo(u[q]) * s, bfhi(u[q]) * s);
    return __builtin_bit_cast(bf16x8, r);
}

struct EpiIn {
    static constexpr bool PERM = true, AFTER_DRAIN = false, REALIGN = false;
    unsigned char* ws;
    DI void operator()(const f32x4 (&acc)[2][2][4][2], const Unit& u, int wr, int wc, int fr, int fq) const {
        const int pn = u.pn, rbase = u.pm * 256 + wr * 64 + fr, cbase = wc * 32 + 8 * fq;
        if (u.pm >= 128) {
            bf16_t* dst = (bf16_t*)(ws + (pn == 1 ? WS_KC : WS_VC));
            const float scl = pn == 1 ? 0.125f : 1.0f;
#pragma unroll
            for (int ai = 0; ai < 2; ++ai)
#pragma unroll
                for (int m = 0; m < 4; ++m) {
                    const int rc = rbase + ai * 128 + m * 16 - NTOK, b = rc >> 8, t = rc & 255;
#pragma unroll
                    for (int bj = 0; bj < 2; ++bj) {
                        const f32x4 v0 = acc[ai][bj][m][0] * scl, v1 = acc[ai][bj][m][1] * scl;
                        const u32x4 o = {pk2(v0[0], v0[1]), pk2(v0[2], v0[3]), pk2(v1[0], v1[1]), pk2(v1[2], v1[3])};
                        size_t off;
                        if (pn == 1) { const int head = bj * 2 + (wc >> 1), d0 = (wc & 1) * 32 + 8 * fq; off = ((size_t)((b * 4 + head) * 256 + t)) * 64 + d0; }
                        else { const int head = (pn - 2) * 2 + bj; off = ((size_t)((b * 4 + head) * 256 + t)) * 128 + cbase; }
                        *(u32x4*)(dst + off) = o;
                    }
                }
            return;
        }
        if (pn <= 1) {
            bf16_t* dst = (bf16_t*)(ws + (pn == 0 ? WS_Q : WS_K));
            const float scl = pn == 0 ? 1.0f : 0.125f;
            const float* rc = (const float*)(ws + WS_ROPE); const float* rs = rc + 1024;
            const int hh = wc & 1, fi0 = 8 * (fq & 1); const bool second = fq >= 2;
#pragma unroll
            for (int ai = 0; ai < 2; ++ai)
#pragma unroll
                for (int m = 0; m < 4; ++m) {
                    const int r = rbase + ai * 128 + m * 16, b = r >> 12, t = r & 4095, pos = hh ? (t & 63) : (t >> 6);
                    const f32x4 c0 = *(const f32x4*)(rc + pos * 16 + fi0), c1 = *(const f32x4*)(rc + pos * 16 + fi0 + 4);
                    const f32x4 s0 = *(const f32x4*)(rs + pos * 16 + fi0), s1 = *(const f32x4*)(rs + pos * 16 + fi0 + 4);
#pragma unroll
                    for (int bj = 0; bj < 2; ++bj) {
                        const f32x4 v0 = acc[ai][bj][m][0], v1 = acc[ai][bj][m][1];
                        float o[8];
#pragma unroll
                        for (int j = 0; j < 4; ++j) {
                            const float xa = v0[j], xb = v1[j], pa = __shfl_xor(xa, 32), pb = __shfl_xor(xb, 32);
                            o[j]     = (second ? (pa * s0[j] + xa * c0[j]) : (xa * c0[j] - pa * s0[j])) * scl;
                            o[4 + j] = (second ? (pb * s1[j] + xb * c1[j]) : (xb * c1[j] - pb * s1[j])) * scl;
                        }
                        const u32x4 ov = {pk2(o[0], o[1]), pk2(o[2], o[3]), pk2(o[4], o[5]), pk2(o[6], o[7])};
                        const int head = bj * 2 + (wc >> 1), d0 = hh * 32 + 8 * fq;
                        *(u32x4*)(dst + ((size_t)((b * 4 + head) * 4096 + t)) * 64 + d0) = ov;
                    }
                }
            return;
        }
        if (pn <= 3) {
            bf16_t* dst = (bf16_t*)(ws + WS_V);
#pragma unroll
            for (int ai = 0; ai < 2; ++ai)
#pragma unroll
                for (int m = 0; m < 4; ++m) {
                    const int r = rbase + ai * 128 + m * 16, b = r >> 12, t = r & 4095;
#pragma unroll
                    for (int bj = 0; bj < 2; ++bj) {
                        const f32x4 v0 = acc[ai][bj][m][0], v1 = acc[ai][bj][m][1];
                        const u32x4 o = {pk2(v0[0], v0[1]), pk2(v0[2], v0[3]), pk2(v1[0], v1[1]), pk2(v1[2], v1[3])};
                        const int head = (pn - 2) * 2 + bj;
                        *(u32x4*)(dst + ((size_t)((b * 4 + head) * 4096 + t)) * 128 + cbase) = o;
                    }
                }
            return;
        }
        if (pn == 6 || pn == 7 || pn >= 10) {
            const int t = pn == 6 ? 0 : (pn == 7 ? 1 : (pn == 10 ? 2 : 3));
            bf16_t* dst = (bf16_t*)(ws + WS_U);
#pragma unroll
            for (int ai = 0; ai < 2; ++ai)
#pragma unroll
                for (int m = 0; m < 4; ++m) {
                    const int r = rbase + ai * 128 + m * 16;
                    const f32x4 u0 = acc[ai][0][m][0], u1 = acc[ai][0][m][1], g0 = acc[ai][1][m][0], g1 = acc[ai][1][m][1];
                    const f32x2 a0 = pg8::gelu_pk((f32x2){u0[0], u0[1]}), a1 = pg8::gelu_pk((f32x2){u0[2], u0[3]}), a2 = pg8::gelu_pk((f32x2){u1[0], u1[1]}), a3 = pg8::gelu_pk((f32x2){u1[2], u1[3]});
                    const u32x4 o = {pk2(a0.x * silu_f(g0[0]), a0.y * silu_f(g0[1])), pk2(a1.x * silu_f(g0[2]), a1.y * silu_f(g0[3])),
                                     pk2(a2.x * silu_f(g1[0]), a2.y * silu_f(g1[1])), pk2(a3.x * silu_f(g1[2]), a3.y * silu_f(g1[3]))};
                    *(u32x4*)(dst + (size_t)r * 512 + 128 * t + cbase) = o;
                }
            return;
        }
        {
            const int region = (pn - 4) >> 1; const bool is_gelu = (region == 1) || (region == 2);
            bf16_t* dst = (bf16_t*)(ws + WS_GR + (size_t)region * ((size_t)NTOK * 512 * 2));
            const int colb = ((pn - 4) & 1) * 256 + cbase;
#pragma unroll
            for (int ai = 0; ai < 2; ++ai)
#pragma unroll
                for (int m = 0; m < 4; ++m) {
                    const int r = rbase + ai * 128 + m * 16;
#pragma unroll
                    for (int bj = 0; bj < 2; ++bj) {
                        const f32x4 v0 = acc[ai][bj][m][0], v1 = acc[ai][bj][m][1];
                        u32x4 o;
                        if (is_gelu) {
                            const f32x2 a = pg8::gelu_pk((f32x2){v0[0], v0[1]}), bq = pg8::gelu_pk((f32x2){v0[2], v0[3]}), cq = pg8::gelu_pk((f32x2){v1[0], v1[1]}), dq = pg8::gelu_pk((f32x2){v1[2], v1[3]});
                            o = (u32x4){pk2(a.x, a.y), pk2(bq.x, bq.y), pk2(cq.x, cq.y), pk2(dq.x, dq.y)};
                        } else {
                            o = (u32x4){pk2(silu_f(v0[0]), silu_f(v0[1])), pk2(silu_f(v0[2]), silu_f(v0[3])), pk2(silu_f(v1[0]), silu_f(v1[1])), pk2(silu_f(v1[2]), silu_f(v1[3]))};
                        }
                        *(u32x4*)(dst + (size_t)r * 512 + colb + bj * 128) = o;
                    }
                }
        }
    }
};
struct EpiOut {
    static constexpr bool PERM = false, AFTER_DRAIN = false, REALIGN = true;
    const float* x; const float* mod; const float* fw; float* out; float* slots; unsigned* cnt;
    DI void operator()(const f32x4 (&acc_)[2][2][4][2], const Unit& u, int wr, int wc, int fr, int fq) const {
        f32x4 (&acc)[2][2][4][2] = const_cast<f32x4 (&)[2][2][4][2]>(acc_);
        const int rbase = u.pm * 256 + wr * 64 + fr, cbase = u.pn * 256 + wc * 32 + 4 * fq;
        const float* gate = mod + (size_t)(rbase >> 12) * 3072 + 2048;
        f32x4 gv[2][2];
#pragma unroll
        for (int bj = 0; bj < 2; ++bj)
#pragma unroll
            for (int n = 0; n < 2; ++n) gv[bj][n] = *(const f32x4*)(gate + cbase + bj * 128 + n * 16);
        f32x4 xv[2][4]; float ss[8];
#pragma unroll
        for (int q = 0; q < 4; ++q) xv[0][q] = ldnt_f4(x + (size_t)rbase * 1024 + cbase + (q >> 1) * 128 + (q & 1) * 16);
#pragma unroll
        for (int k = 0; k < 8; ++k) {
            const int ai = k >> 2, m = k & 3;
            if (k + 1 < 8) {
                const size_t ro = (size_t)(rbase + ((k + 1) >> 2) * 128 + ((k + 1) & 3) * 16) * 1024 + cbase;
#pragma unroll
                for (int q = 0; q < 4; ++q) xv[(k + 1) & 1][q] = ldnt_f4(x + ro + (q >> 1) * 128 + (q & 1) * 16);
            }
            float sk = 0.f;
#pragma unroll
            for (int q = 0; q < 4; ++q) {
                const int bj = q >> 1, n = q & 1;
                const f32x4 v = xv[k & 1][q] + gv[bj][n] * acc[ai][bj][m][n];
                acc[ai][bj][m][n] = v;
                sk += v[0] * v[0] + v[1] * v[1] + v[2] * v[2] + v[3] * v[3];
            }
            ss[k] = sk;
        }
#pragma unroll
        for (int k = 0; k < 8; ++k) { ss[k] += __shfl_xor(ss[k], 16); ss[k] += __shfl_xor(ss[k], 32); }
        if (fq == 0) {
#pragma unroll
            for (int k = 0; k < 8; ++k)
                __hip_atomic_store(slots + (size_t)(rbase + (k >> 2) * 128 + (k & 3) * 16) * 16 + u.pn * 4 + wc, ss[k], __ATOMIC_RELAXED, __HIP_MEMORY_SCOPE_AGENT);
        }
        asm volatile("s_waitcnt vmcnt(0)" ::: "memory");
        if ((threadIdx.x & 63) == 0) {
            __hip_atomic_fetch_add(cnt + u.pm * 64, 1u, __ATOMIC_RELAXED, __HIP_MEMORY_SCOPE_AGENT);
            unsigned spins = 0;
            while (__hip_atomic_load(cnt + u.pm * 64, __ATOMIC_RELAXED, __HIP_MEMORY_SCOPE_AGENT) < 32u) { __builtin_amdgcn_s_sleep(8); if (++spins > (1u << 22)) break; }
        }
        __builtin_amdgcn_fence(__ATOMIC_ACQUIRE, "agent");
        asm volatile("s_waitcnt vmcnt(0)" ::: "memory");
        f32x4 sl[8];
#pragma unroll
        for (int k = 0; k < 8; ++k) sl[k] = *(const f32x4*)(slots + (size_t)(rbase + (k >> 2) * 128 + (k & 3) * 16) * 16 + fq * 4);
        f32x4 fv[2][2];
#pragma unroll
        for (int bj = 0; bj < 2; ++bj)
#pragma unroll
            for (int n = 0; n < 2; ++n) fv[bj][n] = *(const f32x4*)(fw + cbase + bj * 128 + n * 16);
        float rs[8];
#pragma unroll
        for (int k = 0; k < 8; ++k) {
            float t = (sl[k][0] + sl[k][1]) + (sl[k][2] + sl[k][3]);
            t += __shfl_xor(t, 16); t += __shfl_xor(t, 32);
            rs[k] = rsqrtf(t * (1.0f / 1024.0f) + EPS);
        }
#pragma unroll
        for (int k = 0; k < 8; ++k) {
            const int ai = k >> 2, m = k & 3;
            const size_t ro = (size_t)(rbase + ai * 128 + m * 16) * 1024 + cbase;
#pragma unroll
            for (int bj = 0; bj < 2; ++bj)
#pragma unroll
                for (int n = 0; n < 2; ++n) __builtin_nontemporal_store(acc[ai][bj][m][n] * rs[k] * fv[bj][n], (f32x4*)(out + ro + bj * 128 + n * 16));
        }
    }
};
struct SchedIn {
    pg8::StaticOrder so;
    DI bool next(int i, Unit& u) const {
        if (so.G == 256) {
            const int x = so.c & 7, j = so.c >> 3;
            if (j < 3) {
                if (i == 0) { u.pm = 128 + x; u.pn = 1 + j; return true; }
                if (i > 6) return false;
                const int q = 6 * j + (i - 1);
                u.pm = 16 * x + (q >> 2); u.pn = q & 3; return true;
            }
            if (i > 5) return false;
            const int e = (j - 3) + 29 * i;
            if (e < 64) { u.pm = 16 * x + (e >> 2); u.pn = 6 + (e & 3); }
            else if (e < 128) { const int t = e & 3; u.pm = 16 * x + ((e - 64) >> 2); u.pn = t < 2 ? 4 + t : 8 + t; }
            else { const int q = 18 + (e - 128); u.pm = 16 * x + (q >> 2); u.pn = q & 3; }
            return true;
        }
        long L = (long)i * so.G + so.c;
        if (L < so.nwg) return so.next(i, u);
        L -= so.nwg; if (L >= 24) return false;
        u.pm = 128 + (int)(L / 3); u.pn = 1 + (int)(L % 3); return true;
    }
    DI void a_ready(const Unit&) const {}
    DI void done(const Unit&) const {}
};

DI void phase0(const Args& a, LAS unsigned char* lds) {
    const int tid = threadIdx.x;
    float* mod = (float*)(a.ws + WS_MOD);
    LAS float* red = (LAS float*)lds;
    for (int it = blockIdx.x; it < 1233; it += gridDim.x) {
        if (it < 192) {
            const int c0 = it * 16, f = tid & 3, rg = tid >> 2;
            LAS float* scv = red + 36 * 512;
            for (int q = tid; q < 9 * 1024; q += NTHREADS) { const float cv = (q < 8192) ? a.c[q] : a.c_ctx[q - 8192]; scv[q] = cv / (1.0f + expf(-cv)); }
            __syncthreads();
            float acc[9][4];
#pragma unroll
            for (int j = 0; j < 9; ++j)
#pragma unroll
                for (int e = 0; e < 4; ++e) acc[j][e] = 0.f;
            f32x4 wv[8];
#pragma unroll
            for (int i = 0; i < 8; ++i) wv[i] = ldnt_f4(a.w_ada + (size_t)(rg + 128 * i) * 3072 + c0 + f * 4);
#pragma unroll
            for (int i = 0; i < 8; ++i) {
                const int r = rg + 128 * i;
#pragma unroll
                for (int j = 0; j < 9; ++j) {
                    const float sv = scv[j * 1024 + r];
#pragma unroll
                    for (int e = 0; e < 4; ++e) acc[j][e] += sv * wv[i][e];
                }
            }
#pragma unroll
            for (int j = 0; j < 9; ++j)
#pragma unroll
                for (int e = 0; e < 4; ++e) red[(j * 4 + e) * 512 + tid] = acc[j][e];
            __syncthreads();
            if (tid < 144) {
                const int j = tid >> 4, cc = tid & 15, ff = cc >> 2, e = cc & 3;
                float s = 0.f;
                for (int q = 0; q < 128; ++q) s += red[(j * 4 + e) * 512 + q * 4 + ff];
                mod[j * 3072 + c0 + cc] = s + a.b_ada[c0 + cc];
            }
            __syncthreads();
        } else if (it < 1216) {
            const bool is_in = it < 960; const int tt = is_in ? it - 192 : it - 960;
            const int nN = is_in ? 48 : 16, NN = is_in ? 3072 : 1024;
            const int k0 = (tt / nN) * 64, n0 = (tt % nN) * 64;
            int ns = n0;
            if (is_in && ((n0 >= 1536 && n0 < 2048) || n0 >= 2560)) {
                const int base = n0 >= 2560 ? 2560 : 1536, t = (n0 >= 2560 ? 2 : 0) + (n0 - base) / 256, w = (n0 - base) % 256;
                ns = (w < 128 ? 1536 : 2560 - 128) + 128 * t + w;
            }
            const float* src = is_in ? a.w_in : a.w_out;
            bf16_t* dst = (bf16_t*)(a.ws + (is_in ? WS_WIN : WS_WOUT));
            const int kr = tid >> 4, n4 = tid & 15;
#pragma unroll
            for (int p = 0; p < 2; ++p) {
                const int k = kr + 32 * p;
                const f32x4 v = ldnt_f4(src + (size_t)(k0 + k) * NN + ns + n4 * 4);
#pragma unroll
                for (int e = 0; e < 4; ++e) red[k * 65 + n4 * 4 + e] = v[e];
            }
            __syncthreads();
            const int n = tid >> 3, k8 = tid & 7;
            float v[8];
#pragma unroll
            for (int j = 0; j < 8; ++j) v[j] = red[(k8 * 8 + j) * 65 + n];
            const u32x4 o = {pk2(v[0], v[1]), pk2(v[2], v[3]), pk2(v[4], v[5]), pk2(v[6], v[7])};
            *(u32x4*)(dst + (size_t)(n0 + n) * 1024 + k0 + k8 * 8) = o;
            __syncthreads();
        } else if (it < 1232) {
            const size_t base = (size_t)(it - 1216) * 4096 + tid * 8;
            const f32x4 v0 = *(const f32x4*)(a.w_s + base), v1 = *(const f32x4*)(a.w_s + base + 4);
            const u32x4 o = {pk2(v0[0], v0[1]), pk2(v0[2], v0[3]), pk2(v1[0], v1[1]), pk2(v1[2], v1[3])};
            *(u32x4*)((bf16_t*)(a.ws + WS_WSB) + base) = o;
        } else {
            float* rc = (float*)(a.ws + WS_ROPE); float* rs = rc + 1024;
            for (int idx = tid; idx < 1024; idx += NTHREADS) {
                const int pos = idx >> 4, fi = idx & 15;
                const float inv = powf(10000.0f, -(float)fi / 16.0f), ang = (float)pos * inv;
                rc[idx] = cosf(ang); rs[idx] = sinf(ang);
            }
        }
    }
}

template <int R> DI void norm_rows(const Args& a, const float* mod, bf16_t* H, const int (&rows)[R], int lane) {
    f32x4 v[R][4]; const float* mrow[R];
#pragma unroll
    for (int k = 0; k < R; ++k) {
        const int r = rows[k]; const float* src; int j;
        if (r < NTOK) { src = a.x + (size_t)r * 1024; j = r >> 12; } else { src = a.ctx + (size_t)(r - NTOK) * 1024; j = 8; }
        mrow[k] = mod + j * 3072;
#pragma unroll
        for (int q = 0; q < 4; ++q) v[k][q] = ldnt_f4(src + q * 256 + lane * 4);
    }
#pragma unroll
    for (int k = 0; k < R; ++k) {
        float ss = 0.f;
#pragma unroll
        for (int q = 0; q < 4; ++q) ss += v[k][q][0] * v[k][q][0] + v[k][q][1] * v[k][q][1] + v[k][q][2] * v[k][q][2] + v[k][q][3] * v[k][q][3];
#pragma unroll
        for (int off = 32; off >= 1; off >>= 1) ss += __shfl_xor(ss, off);
        const float rstd = rsqrtf(ss * (1.0f / 1024.0f) + EPS);
#pragma unroll
        for (int q = 0; q < 4; ++q) {
            const int cidx = q * 256 + lane * 4;
            const f32x4 nw = *(const f32x4*)(a.norm_w + cidx), sc = *(const f32x4*)(mrow[k] + 1024 + cidx), sh = *(const f32x4*)(mrow[k] + cidx);
            f32x4 hv;
#pragma unroll
            for (int e = 0; e < 4; ++e) hv[e] = (v[k][q][e] * rstd * nw[e]) * (1.0f + sc[e]) + sh[e];
            const u32x2 o = {pk2(hv[0], hv[1]), pk2(hv[2], hv[3])};
            *(u32x2*)(H + (size_t)rows[k] * 1024 + cidx) = o;
        }
    }
}
DI void norm_row(const Args& a, const float* mod, bf16_t* H, int r, int lane) { const int rows[1] = {r}; norm_rows<1>(a, mod, H, rows, lane); }
DI void phase1(const Args& a) {
    const int tid = threadIdx.x, wave = tid >> 6, lane = tid & 63, blk = blockIdx.x, G = gridDim.x;
    const float* mod = (const float*)(a.ws + WS_MOD);
    bf16_t* H = (bf16_t*)(a.ws + WS_H);
    constexpr int NCH = (NTOK + NCTX) / 8;
    int ch = blk;
    for (; ch + 3 * G < NCH; ch += 4 * G) { const int rows[4] = {ch * 8 + wave, (ch + G) * 8 + wave, (ch + 2 * G) * 8 + wave, (ch + 3 * G) * 8 + wave}; norm_rows<4>(a, mod, H, rows, lane); }
    for (; ch < NCH; ch += G) norm_row(a, mod, H, ch * 8 + wave, lane);
}

constexpr int VS = 288, KS = 144, KS2 = 160;
DI void gmlp_unit(const Args& a, LAS unsigned char* lds, int b, int c) {
    const int tid = threadIdx.x, lane = tid & 63, w = tid >> 6, i = lane & 15, g = lane >> 4;
    const int r0 = b * 4096 + c * 128;
    const bf16_t* VG = (const bf16_t*)(a.ws + WS_VG); const bf16_t* U = (const bf16_t*)(a.ws + WS_U);
    const bf16_t* WSB = (const bf16_t*)(a.ws + WS_WSB); bf16_t* Y = (bf16_t*)(a.ws + WS_H);
    constexpr int GSZ = 128 * VS;
    {
        const int row = tid >> 2, q = tid & 3;
        const bf16_t* src = VG + (size_t)(r0 + row) * 512 + q * 8;
        float s = 0.f, s2 = 0.f;
#pragma unroll 8
        for (int p = 0; p < 16; ++p) {
            const u32x4 pc = *(const u32x4*)(src + p * 32);
#pragma unroll
            for (int e = 0; e < 4; ++e) { const float lo = bflo(pc[e]), hi = bfhi(pc[e]); s += lo + hi; s2 += lo * lo + hi * hi; }
        }
        s += __shfl_xor(s, 1); s += __shfl_xor(s, 2); s2 += __shfl_xor(s2, 1); s2 += __shfl_xor(s2, 2);
        const float mean = s * (1.0f / 512.0f);
        const float var = fmaxf(s2 * (1.0f / 512.0f) - mean * mean, 0.f);
        const float rstd = rsqrtf(var + EPS);
        const float* lw = a.ln_w + q * 8;
#pragma unroll 4
        for (int p = 0; p < 16; ++p) {
            const u32x4 pc = *(const u32x4*)(src + p * 32);
            const f32x4 w0 = *(const f32x4*)(lw + p * 32), w1 = *(const f32x4*)(lw + p * 32 + 4);
            u32x4 o;
            o[0] = pk2((bflo(pc[0]) - mean) * rstd * w0[0], (bfhi(pc[0]) - mean) * rstd * w0[1]);
            o[1] = pk2((bflo(pc[1]) - mean) * rstd * w0[2], (bfhi(pc[1]) - mean) * rstd * w0[3]);
            o[2] = pk2((bflo(pc[2]) - mean) * rstd * w1[0], (bfhi(pc[2]) - mean) * rstd * w1[1]);
            o[3] = pk2((bflo(pc[3]) - mean) * rstd * w1[2], (bfhi(pc[3]) - mean) * rstd * w1[3]);
            *(LAS u32x4*)(lds + (p >> 2) * GSZ + row * VS + ((p & 3) * 4 + q) * 16) = o;
        }
    }
    __syncthreads();
    const int n = 16 * w + i, r = r0 + n;
#pragma unroll 1
    for (int gq = 0; gq < 4; ++gq) {
        f32x4 acc[8];
#pragma unroll
        for (int et = 0; et < 8; ++et) acc[et] = (f32x4){0.f, 0.f, 0.f, 0.f};
        const bf16_t* wrow = WSB + (size_t)(gq * 128 + n) * 128;
        bf16x8 bw[4];
#pragma unroll
        for (int s = 0; s < 4; ++s) bw[s] = frag_rowP(wrow + 32 * s, g);
#pragma unroll
        for (int s = 0; s < 4; ++s) {
#pragma unroll
            for (int et = 0; et < 8; ++et) acc[et] = mfma16(frag_tr(lds + gq * GSZ, VS, 32 * s, 16 * et, lane), bw[s], acc[et]);
        }
        const float bias = a.b_s[gq * 128 + n];
#pragma unroll
        for (int et = 0; et < 8; et += 2) {
            const int colw = gq * 128 + 16 * (et + (g & 1)) + 8 * (g >> 1);
            const u32x4 uw = *(const u32x4*)(U + (size_t)r * 512 + colw);
            const u32x2 ux = __builtin_amdgcn_permlane16_swap(uw[0], uw[2], false, false), uy = __builtin_amdgcn_permlane16_swap(uw[1], uw[3], false, false);
            const u32x2 ua = {ux[0], uy[0]}, ub = {ux[1], uy[1]};
            const u32x2 oa = {pk2(bflo(ua.x) * (acc[et][0] + bias), bfhi(ua.x) * (acc[et][1] + bias)), pk2(bflo(ua.y) * (acc[et][2] + bias), bfhi(ua.y) * (acc[et][3] + bias))};
            const u32x2 ob = {pk2(bflo(ub.x) * (acc[et + 1][0] + bias), bfhi(ub.x) * (acc[et + 1][1] + bias)), pk2(bflo(ub.y) * (acc[et + 1][2] + bias), bfhi(ub.y) * (acc[et + 1][3] + bias))};
            const u32x2 wx = __builtin_amdgcn_permlane16_swap(oa.x, ob.x, false, false), wy = __builtin_amdgcn_permlane16_swap(oa.y, ob.y, false, false);
            const u32x4 ow = {wx[0], wy[0], wx[1], wy[1]};
            __builtin_nontemporal_store(ow, (u32x4*)(Y + (size_t)r * 1024 + 512 + colw));
        }
    }
    __syncthreads();
}
struct ChStage { u32x4 kf[2], kb[2], v; };
DI void chain_load(const Args& a, int bh, int es, int it, ChStage& st) {
    const int tid = threadIdx.x;
    const bf16_t *Kf, *Kb, *Vf, *Vb;
    if (it < 2) {
        const size_t of = (size_t)bh * 256 + it * 128, ob = (size_t)bh * 256 + (1 - it) * 128;
        Kf = (const bf16_t*)(a.ws + WS_KC) + of * 64; Vf = (const bf16_t*)(a.ws + WS_VC) + of * 128; Kb = (const bf16_t*)(a.ws + WS_KC) + ob * 64; Vb = (const bf16_t*)(a.ws + WS_VC) + ob * 128;
    } else {
        const size_t of = (size_t)bh * 4096 + (it - 2) * 128, ob = (size_t)bh * 4096 + (33 - it) * 128;
        Kf = (const bf16_t*)(a.ws + WS_K) + of * 64; Vf = (const bf16_t*)(a.ws + WS_V) + of * 128; Kb = (const bf16_t*)(a.ws + WS_K) + ob * 64; Vb = (const bf16_t*)(a.ws + WS_V) + ob * 128;
    }
#pragma unroll
    for (int q = 0; q < 2; ++q) { const int p = tid + 512 * q; st.kf[q] = *(const u32x4*)(Kf + (p >> 3) * 64 + (p & 7) * 8); st.kb[q] = *(const u32x4*)(Kb + (p >> 3) * 64 + (p & 7) * 8); }
    const int t = tid & 255; const bf16_t* Vx = (tid < 256) ? Vf : Vb;
    st.v = *(const u32x4*)(Vx + (t >> 1) * 128 + es * 16 + (t & 1) * 8);
}
DI void chain_item(const Args& a, LAS unsigned char* lds, int item) {
    const int tid = threadIdx.x, lane = tid & 63, w = tid >> 6, i = lane & 15, g = lane >> 4;
    const int bh = item >> 3, es = item & 7, h = bh & 3, dirw = w >> 2, dt = w & 3;
    const float l2f = -expf(a.dec_f[h]) * LOG2E, l2b = -expf(a.dec_b[h]) * LOG2E;
    const float G = exp2f(128.0f * (dirw ? l2b : l2f));
    constexpr int BUFSZ = 2 * 128 * KS2 + 2 * 128 * 32;
    float tf[2], tb[2];
#pragma unroll
    for (int q = 0; q < 2; ++q) { const int m = (tid >> 3) + 64 * q; tf[q] = exp2f((float)(127 - m) * l2f); tb[q] = exp2f((float)m * l2b); }
    bf16_t* ST = (bf16_t*)(a.ws + WS_ST);
    f32x4 S = {0.f, 0.f, 0.f, 0.f};
    ChStage st0, st1, st2, st3;
    chain_load(a, bh, es, 0, st0); chain_load(a, bh, es, 1, st1); chain_load(a, bh, es, 2, st2);
#define CH_STEP(IT, CUR, NXT, STORE) do { const int it = (IT); { \
        LAS unsigned char* buf = lds + (it & 1) * BUFSZ; \
        LAS unsigned char* KFs = buf; LAS unsigned char* KBs = buf + 128 * KS2; LAS unsigned char* VFs = buf + 2 * 128 * KS2; LAS unsigned char* VBs = VFs + 128 * 32; \
        _Pragma("unroll") for (int q = 0; q < 2; ++q) { \
            const int p = tid + 512 * q, m = p >> 3, d8 = p & 7; \
            u32x4 of, ob; \
            _Pragma("unroll") for (int e = 0; e < 4; ++e) { of[e] = pk2(bflo(CUR.kf[q][e]) * tf[q], bfhi(CUR.kf[q][e]) * tf[q]); ob[e] = pk2(bflo(CUR.kb[q][e]) * tb[q], bfhi(CUR.kb[q][e]) * tb[q]); } \
            *(LAS u32x4*)(KFs + m * KS2 + d8 * 16) = of; *(LAS u32x4*)(KBs + m * KS2 + d8 * 16) = ob; \
        } \
        { const int t = tid & 255; *(LAS u32x4*)((tid < 256 ? VFs : VBs) + (t >> 1) * 32 + (t & 1) * 16) = CUR.v; } \
        lds_barrier(); \
        chain_load(a, bh, es, (it + 3 < 34) ? it + 3 : 33, NXT);                  \
        LAS const unsigned char* Kx = dirw ? KBs : KFs; LAS const unsigned char* Vx = dirw ? VBs : VFs; \
        f32x4 kv = {0.f, 0.f, 0.f, 0.f}; \
        _Pragma("unroll") for (int s = 0; s < 4; ++s) kv = mfma16(frag_tr(Vx, 32, 32 * s, 0, lane), frag_tr(Kx, KS2, 32 * s, 16 * dt, lane), kv); \
        if (STORE) {                                                              \
            const int c = dirw ? 33 - it : it - 2; \
            const u32x2 o = {pk2(S[0], S[1]), pk2(S[2], S[3])}; \
            *(u32x2*)(ST + (((size_t)(bh * 32 + c) * 2 + dirw) * 64 + 16 * dt + i) * 128 + es * 16 + 4 * g) = o; \
        } \
        S = S * G + kv; } } while (0)
    CH_STEP(0, st0, st3, false); CH_STEP(1, st1, st0, false);
#pragma unroll 1
    for (int it4 = 2; it4 < 34; it4 += 4) {
        CH_STEP(it4, st2, st1, true); CH_STEP(it4 + 1, st3, st2, true); CH_STEP(it4 + 2, st0, st3, true); CH_STEP(it4 + 3, st1, st0, true);
    }
#undef CH_STEP
    __syncthreads();
}
DI void phase3(const Args& a, LAS unsigned char* lds) {
    for (int it = blockIdx.x; it < 256; it += gridDim.x) gmlp_unit(a, lds, it >> 5, it & 31);
    for (int it = blockIdx.x; it < 256; it += gridDim.x) { const int j = it >> 3; chain_item(a, lds, (((it & 7) * 4 + (j >> 3)) << 3) + (j & 7)); }
}

DI void phase4(const Args& a) {
    const float* KV = (const float*)(a.ws + WS_KV); const float* KVC = (const float*)(a.ws + WS_KVC);
    bf16_t* ST = (bf16_t*)(a.ws + WS_ST);
    for (int idx = blockIdx.x * NTHREADS + threadIdx.x; idx < 64 * 2048; idx += gridDim.x * NTHREADS) {
        const int chain = idx >> 11, pos = idx & 2047, bh = chain >> 1, dir = chain & 1, h = bh & 3;
        const float lg = -expf(dir ? a.dec_b[h] : a.dec_f[h]), G = expf(128.0f * lg);
        const f32x4 k0 = *(const f32x4*)(KVC + ((size_t)(bh * 2 + 0) * 2 + dir) * 8192 + pos * 4);
        const f32x4 k1 = *(const f32x4*)(KVC + ((size_t)(bh * 2 + 1) * 2 + dir) * 8192 + pos * 4);
        f32x4 S = dir ? (k1 * G + k0) : (k0 * G + k1);
#pragma unroll 8
        for (int step = 0; step < NC; ++step) {
            const int c = dir ? (NC - 1 - step) : step;
            const size_t off = ((size_t)(bh * 32 + c) * 2 + dir) * 8192 + pos * 4;
            const f32x4 kvv = *(const f32x4*)(KV + off);
            const u32x2 o = {pk2(S[0], S[1]), pk2(S[2], S[3])};
            *(u32x2*)(ST + off) = o;
            S = S * G + kvv;
        }
    }
}

struct RetStage { u32x4 k[2], v[4], sf[2], sb[2]; bf16x8 q[2]; };
DI void ret_load(const Args& a, int unit, RetStage& st) {
    const int tid = threadIdx.x, lane = tid & 63, w = tid >> 6, i = lane & 15, g = lane >> 4;
    const int bh = unit >> 5, c = unit & 31;
    const bf16_t* Qp = (const bf16_t*)(a.ws + WS_Q) + ((size_t)bh * 4096 + c * 128) * 64;
    const bf16_t* Kp = (const bf16_t*)(a.ws + WS_K) + ((size_t)bh * 4096 + c * 128) * 64;
    const bf16_t* Vp = (const bf16_t*)(a.ws + WS_V) + ((size_t)bh * 4096 + c * 128) * 128;
    const bf16_t* SFp = (const bf16_t*)(a.ws + WS_ST) + (size_t)unit * 16384; const bf16_t* SBp = SFp + 8192;
#pragma unroll
    for (int q = 0; q < 2; ++q) { const int p = tid + 512 * q; st.k[q] = *(const u32x4*)(Kp + (p >> 3) * 64 + (p & 7) * 8); }
#pragma unroll
    for (int q = 0; q < 4; ++q) { const int p = tid + 512 * q; st.v[q] = *(const u32x4*)(Vp + (p >> 4) * 128 + (p & 15) * 8); }
#pragma unroll
    for (int q = 0; q < 2; ++q) { const int p = tid + 512 * q; st.sf[q] = *(const u32x4*)(SFp + (p >> 4) * 128 + (p & 15) * 8); st.sb[q] = *(const u32x4*)(SBp + (p >> 4) * 128 + (p & 15) * 8); }
#pragma unroll
    for (int s = 0; s < 2; ++s) st.q[s] = frag_rowP(Qp + (16 * w + i) * 64 + 32 * s, g);
}
DI void ret_unit(const Args& a, LAS unsigned char* lds, int unit, RetStage& st, int next_unit) {
    const int tid = threadIdx.x, lane = tid & 63, w = tid >> 6, i = lane & 15, g = lane >> 4;
    const int bh = unit >> 5, c = unit & 31, b = bh >> 2, h = bh & 3;
    const bf16_t* GR = (const bf16_t*)(a.ws + WS_GR); bf16_t* Y = (bf16_t*)(a.ws + WS_H);
    LAS unsigned char* Kt = lds; LAS unsigned char* Vt = lds + 128 * KS; LAS unsigned char* SF = Vt + 128 * VS; LAS unsigned char* SB = SF + 64 * VS;
#pragma unroll
    for (int q = 0; q < 2; ++q) { const int p = tid + 512 * q; *(LAS u32x4*)(Kt + (p >> 3) * KS + (p & 7) * 16) = st.k[q]; }
#pragma unroll
    for (int q = 0; q < 4; ++q) { const int p = tid + 512 * q; *(LAS u32x4*)(Vt + (p >> 4) * VS + (p & 15) * 16) = st.v[q]; }
#pragma unroll
    for (int q = 0; q < 2; ++q) { const int p = tid + 512 * q; *(LAS u32x4*)(SF + (p >> 4) * VS + (p & 15) * 16) = st.sf[q]; *(LAS u32x4*)(SB + (p >> 4) * VS + (p & 15) * 16) = st.sb[q]; }
    bf16x8 Qf[2];
#pragma unroll
    for (int s = 0; s < 2; ++s) Qf[s] = st.q[s];
    lds_barrier();
    if (next_unit >= 0) ret_load(a, next_unit, st);
    const float l2f = -expf(a.dec_f[h]) * LOG2E, l2b = -expf(a.dec_b[h]) * LOG2E;
    const int n = 16 * w + i;

    f32x4 accS[8];
#pragma unroll
    for (int mt = 0; mt < 8; ++mt) {
        accS[mt] = (f32x4){0.f, 0.f, 0.f, 0.f};
#pragma unroll
        for (int s = 0; s < 2; ++s) accS[mt] = mfma16(frag_rowP_lds(Kt + (16 * mt + i) * KS + 64 * s, g), Qf[s], accS[mt]);
    }
#pragma unroll
    for (int mt = 0; mt < 8; ++mt)
#pragma unroll
        for (int reg = 0; reg < 4; ++reg) {
            const int diff = n - (16 * mt + 4 * g + reg);
            const float ex = __builtin_amdgcn_exp2f(diff > 0 ? (float)diff * l2f : (float)(-diff) * l2b);
            accS[mt][reg] *= (diff == 0 ? 2.0f : ex);
        }
    const float fsf = __builtin_amdgcn_exp2f((float)(n + 1) * l2f), fsb = __builtin_amdgcn_exp2f((float)(128 - n) * l2b);
    f32x4 accO[8];
#pragma unroll
    for (int et = 0; et < 8; ++et) accO[et] = (f32x4){0.f, 0.f, 0.f, 0.f};
#pragma unroll
    for (int s = 0; s < 4; ++s) {
        const u32x4 pu = {pk2(accS[2 * s][0], accS[2 * s][1]), pk2(accS[2 * s][2], accS[2 * s][3]), pk2(accS[2 * s + 1][0], accS[2 * s + 1][1]), pk2(accS[2 * s + 1][2], accS[2 * s + 1][3])};
        const bf16x8 Pf = __builtin_bit_cast(bf16x8, pu);
#pragma unroll
        for (int et = 0; et < 8; ++et) accO[et] = mfma16(frag_tr(Vt, VS, 32 * s, 16 * et, lane), Pf, accO[et]);
        __builtin_amdgcn_sched_barrier(0);
    }
#pragma unroll
    for (int s = 0; s < 2; ++s) {
        const bf16x8 qsf = scale_frag(Qf[s], fsf), qsb = scale_frag(Qf[s], fsb);
#pragma unroll
        for (int et = 0; et < 8; ++et) {
            accO[et] = mfma16(frag_tr(SF, VS, 32 * s, 16 * et, lane), qsf, accO[et]);
            accO[et] = mfma16(frag_tr(SB, VS, 32 * s, 16 * et, lane), qsb, accO[et]);
        }
        __builtin_amdgcn_sched_barrier(0);
    }
    float sm = 0.f;
#pragma unroll
    for (int et = 0; et < 8; ++et) sm += accO[et][0] + accO[et][1] + accO[et][2] + accO[et][3];
    sm += __shfl_xor(sm, 16); sm += __shfl_xor(sm, 32);
    const float mean = sm * (1.0f / 128.0f);
    float v2 = 0.f;
#pragma unroll
    for (int et = 0; et < 8; ++et)
#pragma unroll
        for (int e = 0; e < 4; ++e) { const float d0 = accO[et][e] - mean; v2 += d0 * d0; }
    v2 += __shfl_xor(v2, 16); v2 += __shfl_xor(v2, 32);
    const float rstd = rsqrtf(v2 * (1.0f / 128.0f) + EPS);
    const int r = b * 4096 + c * 128 + n;
#pragma unroll
    for (int et = 0; et < 8; et += 2) {
        const int colw = h * 128 + 16 * (et + (g & 1)) + 8 * (g >> 1);
        const u32x4 gww = *(const u32x4*)(GR + (size_t)r * 512 + colw);
        const u32x2 gx = __builtin_amdgcn_permlane16_swap(gww[0], gww[2], false, false), gy = __builtin_amdgcn_permlane16_swap(gww[1], gww[3], false, false);
        const u32x2 ga = {gx[0], gy[0]}, gb = {gx[1], gy[1]};
        const f32x4 wa = *(const f32x4*)(a.gn_w + h * 128 + 16 * et + 4 * g), wb = *(const f32x4*)(a.gn_w + h * 128 + 16 * (et + 1) + 4 * g);
        const u32x2 oa = {pk2((accO[et][0] - mean) * rstd * wa[0] * bflo(ga.x), (accO[et][1] - mean) * rstd * wa[1] * bfhi(ga.x)),
                          pk2((accO[et][2] - mean) * rstd * wa[2] * bflo(ga.y), (accO[et][3] - mean) * rstd * wa[3] * bfhi(ga.y))};
        const u32x2 ob = {pk2((accO[et + 1][0] - mean) * rstd * wb[0] * bflo(gb.x), (accO[et + 1][1] - mean) * rstd * wb[1] * bfhi(gb.x)),
                          pk2((accO[et + 1][2] - mean) * rstd * wb[2] * bflo(gb.y), (accO[et + 1][3] - mean) * rstd * wb[3] * bfhi(gb.y))};
        const u32x2 wx = __builtin_amdgcn_permlane16_swap(oa.x, ob.x, false, false), wy = __builtin_amdgcn_permlane16_swap(oa.y, ob.y, false, false);
        const u32x4 ow = {wx[0], wy[0], wx[1], wy[1]};
        *(u32x4*)(Y + (size_t)r * 1024 + colw) = ow;
    }
    lds_barrier();
}

DI void phase7(const Args& a) {
    const int tid = threadIdx.x, wave = tid >> 6, lane = tid & 63;
    for (int r = blockIdx.x * 8 + wave; r < NTOK; r += gridDim.x * 8) {
        float* row = a.out + (size_t)r * 1024;
        f32x4 v[4]; float ss = 0.f;
#pragma unroll
        for (int q = 0; q < 4; ++q) { v[q] = *(const f32x4*)(row + q * 256 + lane * 4); ss += v[q][0] * v[q][0] + v[q][1] * v[q][1] + v[q][2] * v[q][2] + v[q][3] * v[q][3]; }
#pragma unroll
        for (int off = 32; off >= 1; off >>= 1) ss += __shfl_xor(ss, off);
        const float rstd = rsqrtf(ss * (1.0f / 1024.0f) + EPS);
#pragma unroll
        for (int q = 0; q < 4; ++q) {
            const f32x4 fw = *(const f32x4*)(a.fnorm_w + q * 256 + lane * 4);
            *(f32x4*)(row + q * 256 + lane * 4) = v[q] * rstd * fw;
        }
    }
}

__global__ __launch_bounds__(512, 2) void fwd_megakernel(Args a) {
    extern __shared__ __attribute__((aligned(16))) unsigned char shm[];
    LAS unsigned char* lds = (LAS unsigned char*)shm;
    cg::grid_group grid = cg::this_grid();
    volatile LAS unsigned* st = (volatile LAS unsigned*)(lds + LDS_BYTES - 16);
    if (threadIdx.x == 0) { st[0] = 0u; st[1] = 0u; }
    __syncthreads();
    const XcdBarrier xb = xcd_barrier_post((unsigned*)(a.ws + WS_BAR), st);
    if (a.ph_hi > 7) grid.sync();
#ifndef PHMASK
#define PHMASK 255
#endif
#ifndef REPMASK
#define REPMASK 0
#endif
#ifndef EXTRA_SYNCS
#define EXTRA_SYNCS 0
#endif
#define GSYNC() xcd_barrier(xb)
    for (int xs = 0; xs < EXTRA_SYNCS; ++xs) GSYNC();
#define PHASE(P, ...) do { if (((PHMASK >> (P)) & 1) && a.ph_lo <= (P) && (P) < a.ph_hi) { if ((REPMASK >> (P)) & 1) { __VA_ARGS__; GSYNC(); } __VA_ARGS__; if ((P) + 1 < a.ph_hi) GSYNC(); } } while (0)
    PHASE(0, phase0(a, lds));
    PHASE(1, phase1(a));
    PHASE(2, {
        pg8::Gemm gm{(const bf16_t*)(a.ws + WS_H), (const bf16_t*)(a.ws + WS_WIN), NTOK, NP, D};
        SchedIn S; S.so.init(NTOK, NP, (int)gridDim.x, (int)blockIdx.x);
        EpiIn E{a.ws};
        pg8::gemm_phase<EpiIn, SchedIn, false>(lds, gm, S, E, nullptr);
    });
    PHASE(3, phase3(a, lds));
    PHASE(5, { int it = blockIdx.x; if (it < 1024) { RetStage st; ret_load(a, it, st); for (;;) { const int nx = it + (int)gridDim.x; ret_unit(a, lds, it, st, nx < 1024 ? nx : -1); if (nx >= 1024) break; it = nx; } } });
    PHASE(6, {
        pg8::Gemm gm{(const bf16_t*)(a.ws + WS_H), (const bf16_t*)(a.ws + WS_WOUT), NTOK, D, D};
        pg8::StaticOrder S; S.init(NTOK, D, (int)gridDim.x, (int)blockIdx.x);
        EpiOut E{a.x, (const float*)(a.ws + WS_MOD), a.fnorm_w, a.out, (float*)(a.ws + WS_SLOT), (unsigned*)(a.ws + WS_CNT)};
        pg8::gemm_phase<EpiOut, pg8::StaticOrder, false>(lds, gm, S, E, nullptr);
    });
#undef PHASE
}

extern "C" void kernel_launch(void* const* d_in, const int* in_sizes, int n_in, void* d_out, int out_size, void* d_ws, size_t ws_size, hipStream_t stream) {
    static int grid = 0;
    if (grid == 0) {
        if (n_in != 16 || out_size != NTOK * D || ws_size < WS_END) { fprintf(stderr, "kernel_launch: unexpected shapes (n_in %d out %d ws %zu need %zu)\n", n_in, out_size, ws_size, (size_t)WS_END); grid = -1; return; }
        int dev = 0, cus = 0, per_cu = 0;
        (void)hipGetDevice(&dev); (void)hipDeviceGetAttribute(&cus, hipDeviceAttributeMultiprocessorCount, dev);
        if (hipFuncSetAttribute((const void*)fwd_megakernel, hipFuncAttributeMaxDynamicSharedMemorySize, LDS_BYTES) != hipSuccess) { fprintf(stderr, "kernel_launch: hipFuncSetAttribute failed\n"); grid = -1; return; }
        if (hipOccupancyMaxActiveBlocksPerMultiprocessor(&per_cu, (const void*)fwd_megakernel, NTHREADS, LDS_BYTES) != hipSuccess || per_cu < 1) { fprintf(stderr, "kernel_launch: occupancy query gives %d\n", per_cu); per_cu = 1; }
        (void)hipGetLastError();
        grid = cus;
    }
    if (grid < 0) return;
    Args a{};
    a.x = (const float*)d_in[0]; a.c = (const float*)d_in[1]; a.ctx = (const float*)d_in[2]; a.c_ctx = (const float*)d_in[3]; a.w_ada = (const float*)d_in[4]; a.b_ada = (const float*)d_in[5];
    a.norm_w = (const float*)d_in[6]; a.w_in = (const float*)d_in[7]; a.dec_f = (const float*)d_in[8]; a.dec_b = (const float*)d_in[9]; a.gn_w = (const float*)d_in[10]; a.ln_w = (const float*)d_in[11];
    a.w_s = (const float*)d_in[12]; a.b_s = (const float*)d_in[13]; a.w_out = (const float*)d_in[14]; a.fnorm_w = (const float*)d_in[15];
    a.out = (float*)d_out; a.ws = (unsigned char*)d_ws;
    (void)hipMemsetAsync((unsigned char*)d_ws + WS_BAR, 0, (size_t)XCD_BAR_WORDS * 4 + 32768, stream);
#if N_LAUNCHES == 1
    a.ph_lo = 0; a.ph_hi = 7;
    void* args[] = {&a};
    hipError_t e = hipLaunchCooperativeKernel((const void*)fwd_megakernel, dim3(grid), dim3(NTHREADS), args, LDS_BYTES, stream);
    if (e != hipSuccess) fprintf(stderr, "cooperative launch failed: %s (grid %d)\n", hipGetErrorString(e), grid);
#else
    for (int p = 0; p < 7; ++p) {
        a.ph_lo = p; a.ph_hi = p + 1;
        hipLaunchKernelGGL(fwd_megakernel, dim3(grid), dim3(NTHREADS), LDS_BYTES, stream, a);
    }
#endif
}
```

```cpp
#include <hip/hip_runtime.h>
#include <hip/hip_cooperative_groups.h>
#include <cstdio>
namespace cg = cooperative_groups;
#ifndef N_LAUNCHES
#define N_LAUNCHES 1
#endif
namespace pg8 {
#define PG8_LAS __attribute__((address_space(3)))
typedef unsigned short bf16_t;
typedef short bf16x8 __attribute__((ext_vector_type(8)));
typedef float f32x4 __attribute__((ext_vector_type(4)));
typedef unsigned u32x4 __attribute__((ext_vector_type(4)));
constexpr int BM = 256, BK = 64, HALF = 128, HTB = HALF * BK * 2  , STAGE_BYTES = 8 * HTB, NXCD = 8, WGM = 8;

__host__ __device__ __forceinline__ int lds_byte(int r, int c) { const int st = (r >> 4) * 2 + (c >> 5), rr = r & 15, cc = c & 31, ob = rr * 64 + cc * 2; return st * 1024 + (ob ^ (((ob >> 9) & 1) << 5)); }
__host__ __device__ __forceinline__ void stage_rc(int b, int& R, int& C) { const int st = b / 1024, sb = b % 1024, swz = sb ^ (((sb >> 9) & 1) << 5); R = (st >> 1) * 16 + swz / 64; C = (st & 1) * 32 + (swz % 64) / 2; }
__host__ __device__ __forceinline__ int perm32(int rho) { const int n = rho >> 4, i = rho & 15; return 8 * (i >> 2) + 4 * n + (i & 3); }

struct Unit { int pm, pn; };
struct Gemm { const bf16_t* A; const bf16_t* Bt; int M, N, K; };

struct StaticOrder {
    int nM, nN, nwg, G, c;
    __host__ __device__ void init(int M, int N, int G_, int c_) { nM = M / BM; nN = N / BM; nwg = nM * nN; G = G_; c = c_; }
    __host__ __device__ bool next(int i, Unit& u) const {
        const long L = (long)i * G + c; if (L >= nwg) return false;
        int wgid = (int)L; { const int q = nwg / NXCD, r = nwg % NXCD, xcd = wgid % NXCD, off = wgid / NXCD; wgid = (xcd < r ? xcd * (q + 1) : r * (q + 1) + (xcd - r) * q) + off; }
        const int nig = WGM * nN, gid = wgid / nig, fm = gid * WGM, gsz = (nM - fm) < WGM ? (nM - fm) : WGM;
        u.pm = fm + ((wgid % nig) % gsz); u.pn = (wgid % nig) / gsz; return true;
    }
    __device__ __forceinline__ void a_ready(const Unit&) const {}
    __device__ __forceinline__ void done(const Unit&) const {}
};
struct CountedOrder : StaticOrder {
    const unsigned* ready; unsigned need; unsigned* tmo;
    __device__ __forceinline__ void a_ready(const Unit& u) const {
        if (threadIdx.x < 64) {
            const unsigned long long t0 = __builtin_amdgcn_s_memrealtime(); unsigned polls = 0;
            while ((unsigned)__builtin_amdgcn_readfirstlane(__hip_atomic_load(ready + 64 * u.pm, __ATOMIC_RELAXED, __HIP_MEMORY_SCOPE_AGENT)) < need) {
                if ((++polls & 255u) == 0u && __builtin_amdgcn_readfirstlane(__hip_atomic_load(tmo, __ATOMIC_RELAXED, __HIP_MEMORY_SCOPE_AGENT)) != 0u) break;
                if (__builtin_amdgcn_s_memrealtime() - t0 > 2000000ull) {
                    if (threadIdx.x == 0) { unsigned expect = 0u; __hip_atomic_compare_exchange_strong(tmo + 1, &expect, 0x600u | (unsigned)(u.pm & 0xff), __ATOMIC_RELAXED, __ATOMIC_RELAXED, __HIP_MEMORY_SCOPE_AGENT); __hip_atomic_store(tmo, 1u, __ATOMIC_RELAXED, __HIP_MEMORY_SCOPE_AGENT); }
                    break; }
                __builtin_amdgcn_s_sleep(2); }
            __builtin_amdgcn_fence(__ATOMIC_ACQUIRE, "agent");
            asm volatile("s_waitcnt vmcnt(0)" ::: "memory");
        }
#if !defined(BROKEN_HOOK_NO_BARRIER)
        asm volatile("" ::: "memory"); __builtin_amdgcn_s_barrier(); asm volatile("" ::: "memory");
#endif
    }
};

__device__ __forceinline__ unsigned cvt_pk_bf16(float lo, float hi) { unsigned r; asm volatile("v_cvt_pk_bf16_f32 %0, %1, %2" : "=v"(r) : "v"(lo), "v"(hi)); return r; }
typedef float f32x2 __attribute__((ext_vector_type(2)));
__device__ __forceinline__ f32x2 gelu_pk(f32x2 v) {
    const f32x2 av = __builtin_elementwise_abs(v), d = av * 0.2316418882f + 1.0f;
    f32x2 t; t.x = __builtin_amdgcn_rcpf(d.x); t.y = __builtin_amdgcn_rcpf(d.y);
    f32x2 q = t * 0.5307027145f + (-0.7265760135f); q = q * t + 0.7107068705f; q = q * t + (-0.142248368f); q = q * t + 0.127414796f; q = q * t;
    const f32x2 s = (v * v) * (-0.72134752044f);
    f32x2 e; e.x = __builtin_amdgcn_exp2f(s.x); e.y = __builtin_amdgcn_exp2f(s.y);
    const f32x2 m = v * (q * e), r = v - m;
    f32x2 o; o.x = v.x < 0.f ? m.x : r.x; o.y = v.y < 0.f ? m.y : r.y; return o;
}
template <class Epi, class Sched, bool STAMP = false>
__device__ __forceinline__ void gemm_phase(PG8_LAS unsigned char* lds, const Gemm g, const Sched& S, const Epi& E, unsigned long long* stamps) {
    const int tid = threadIdx.x, wid = __builtin_amdgcn_readfirstlane(tid >> 6), lane = tid & 63, wr = wid >> 2, wc = wid & 3, fr = lane & 15, fq = lane >> 4;
    const int K = g.K, nt = K / BK;
    int ts_lo = 0, ts_hi = 0, nts = 0; const unsigned long long rt_entry = STAMP ? (unsigned long long)wall_clock64() : 0ull;
#define PG8_STAMP() do { if (STAMP && wid == 0 && nts < 64) { const unsigned long long _c = (unsigned long long)clock64(); \
        ts_lo = (lane == nts) ? (int)(unsigned)_c : ts_lo; ts_hi = (lane == nts) ? (int)(unsigned)(_c >> 32) : ts_hi; ++nts; } } while (0)
    PG8_STAMP();
    unsigned voffA[2], voffB[2];
#pragma unroll
    for (int i = 0; i < 2; ++i) { int R, C; stage_rc(tid * 16 + i * 8192, R, C); const int Rb = Epi::PERM ? ((R & ~31) + perm32(R & 31)) : R;
        voffA[i] = (unsigned)(R * K + C) * 2u; voffB[i] = (unsigned)(Rb * K + C) * 2u; }
    const size_t kstep = (size_t)(BK * 2);
    const size_t hstep = (size_t)HALF * K * 2;
    const size_t tstep = 2 * hstep;
    const unsigned ldsw = (unsigned)wid * 1024u;
    const int aoff = lds_byte(wr * 64 + fr, fq * 8), boff = lds_byte(wc * 32 + fr, fq * 8);
#define PG8_SA(b, h) (((b) * 2 + (h)) * HTB)
#define PG8_SB(b, h) ((4 + (b) * 2 + (h)) * HTB)
#define PG8_STAGE(bufoff, gbase, voff) do { _Pragma("unroll") for (int _i = 0; _i < 2; ++_i) \
        __builtin_amdgcn_global_load_lds((const unsigned*)((const char*)(gbase) + (voff)[_i]), (PG8_LAS unsigned*)(lds + (bufoff) + ldsw + _i * 8192), 16, 0, 0); } while (0)
#define PG8_LDA(dst, b, h) do { _Pragma("unroll") for (int m = 0; m < 4; ++m) _Pragma("unroll") for (int k = 0; k < 2; ++k) dst[m][k] = *(const PG8_LAS bf16x8*)(lds + PG8_SA(b, h) + aoff + m * 2048 + k * 1024); } while (0)
#define PG8_LDB(dst, b, h) do { _Pragma("unroll") for (int n = 0; n < 2; ++n) _Pragma("unroll") for (int k = 0; k < 2; ++k) dst[n][k] = *(const PG8_LAS bf16x8*)(lds + PG8_SB(b, h) + boff + n * 2048 + k * 1024); } while (0)
#define PG8_MMA(ai, bj, At, Bt) do { __builtin_amdgcn_s_setprio(1); _Pragma("unroll") for (int m = 0; m < 4; ++m) _Pragma("unroll") for (int n = 0; n < 2; ++n) _Pragma("unroll") for (int k = 0; k < 2; ++k) \
        acc[ai][bj][m][n] = __builtin_amdgcn_mfma_f32_16x16x32_bf16(Bt[n][k], At[m][k], acc[ai][bj][m][n], 0, 0, 0); __builtin_amdgcn_s_setprio(0); } while (0)
#define PG8_WAIT_V(n) asm volatile("s_waitcnt vmcnt(" #n ")" ::: "memory")
#define PG8_WAIT_L(n) asm volatile("s_waitcnt lgkmcnt(" #n ")" ::: "memory")
#define PG8_BAR __builtin_amdgcn_s_barrier()
#define PG8_SCHED __builtin_amdgcn_sched_barrier(0)
    Unit cur, nxt; int ui = 0;
    if (!S.next(0, cur)) return;
    f32x4 acc[2][2][4][2];
#pragma unroll
    for (int a = 0; a < 2; ++a)
#pragma unroll
        for (int b = 0; b < 2; ++b)
#pragma unroll
            for (int m = 0; m < 4; ++m)
#pragma unroll
                for (int n = 0; n < 2; ++n) acc[a][b][m][n] = (f32x4){0.f, 0.f, 0.f, 0.f};
    bf16x8 At[4][2], B0[2][2], B1[2][2];
    const char* cA = (const char*)g.A + (size_t)cur.pm * tstep; const char* cB = (const char*)g.Bt + (size_t)cur.pn * tstep;
    S.a_ready(cur);
    PG8_STAGE(PG8_SB(0, 0), cB, voffB); PG8_STAGE(PG8_SA(0, 0), cA, voffA); PG8_STAGE(PG8_SB(0, 1), cB + hstep, voffB); PG8_STAGE(PG8_SA(0, 1), cA + hstep, voffA);
    if (wr == 1) PG8_BAR;
    PG8_WAIT_V(4); PG8_BAR;
    PG8_STAGE(PG8_SB(1, 0), cB + kstep, voffB); PG8_STAGE(PG8_SA(1, 0), cA + kstep, voffA); PG8_STAGE(PG8_SB(1, 1), cB + hstep + kstep, voffB);
    PG8_WAIT_V(6); PG8_BAR;
    PG8_STAMP();
    for (;;) {
        const bool has_next = S.next(ui + 1, nxt);
        const char* nA = has_next ? (const char*)g.A + (size_t)nxt.pm * tstep : cA; const char* nB = has_next ? (const char*)g.Bt + (size_t)nxt.pn * tstep : cB;
        for (int t = 0; t < nt; t += 2) {
            const bool last = (t == nt - 2);
            const char* a1 = cA + (size_t)(t + 1) * kstep;
            const char* a2 = last ? nA : cA + (size_t)(t + 2) * kstep; const char* b2 = last ? nB : cB + (size_t)(t + 2) * kstep;
            const char* a3 = a2 + kstep; const char* b3 = b2 + kstep;
            if (last && has_next) S.a_ready(nxt);
            PG8_LDB(B0, 0, 0); PG8_SCHED; PG8_LDA(At, 0, 0); PG8_STAGE(PG8_SA(1, 1), a1 + hstep, voffA);
            PG8_WAIT_L(8); PG8_BAR; PG8_WAIT_L(0); PG8_MMA(0, 0, At, B0); PG8_BAR; PG8_SCHED;
            PG8_LDB(B1, 0, 1); PG8_STAGE(PG8_SB(0, 0), b2, voffB);
            PG8_BAR; PG8_WAIT_L(0); PG8_MMA(0, 1, At, B1); PG8_BAR;
            PG8_LDA(At, 0, 1); PG8_STAGE(PG8_SA(0, 0), a2, voffA);
            PG8_BAR; PG8_WAIT_L(0); PG8_MMA(1, 0, At, B0); PG8_BAR; PG8_SCHED;
            PG8_STAGE(PG8_SB(0, 1), b2 + hstep, voffB);
            PG8_WAIT_V(6); PG8_BAR; PG8_MMA(1, 1, At, B1); PG8_BAR;
            PG8_LDB(B0, 1, 0); PG8_SCHED; PG8_LDA(At, 1, 0); PG8_STAGE(PG8_SA(0, 1), a2 + hstep, voffA);
            PG8_WAIT_L(8); PG8_BAR; PG8_WAIT_L(0); PG8_MMA(0, 0, At, B0); PG8_BAR; PG8_SCHED;
            PG8_LDB(B1, 1, 1); PG8_STAGE(PG8_SB(1, 0), b3, voffB);
            PG8_BAR; PG8_WAIT_L(0); PG8_MMA(0, 1, At, B1); PG8_BAR;
            PG8_LDA(At, 1, 1); PG8_STAGE(PG8_SA(1, 0), a3, voffA);
            PG8_BAR; PG8_WAIT_L(0); PG8_MMA(1, 0, At, B0); PG8_BAR; PG8_SCHED;
            PG8_STAGE(PG8_SB(1, 1), b3 + hstep, voffB);
            PG8_WAIT_V(6); PG8_BAR; PG8_MMA(1, 1, At, B1); PG8_BAR;
        }
        PG8_STAMP();
        if constexpr (!Epi::AFTER_DRAIN) {
            if constexpr (Epi::REALIGN) { if (wr == 0) PG8_BAR; }
            E(acc, cur, wr, wc, fr, fq); S.done(cur);
            if constexpr (Epi::REALIGN) { if (wr == 1) PG8_BAR; }
        }
        PG8_STAMP();
        if (!has_next) break;
#pragma unroll
        for (int a = 0; a < 2; ++a)
#pragma unroll
            for (int b = 0; b < 2; ++b)
#pragma unroll
                for (int m = 0; m < 4; ++m)
#pragma unroll
                    for (int n = 0; n < 2; ++n) acc[a][b][m][n] = (f32x4){0.f, 0.f, 0.f, 0.f};
        cur = nxt; cA = nA; cB = nB; ++ui;
    }
    PG8_WAIT_V(0);
    if (wr == 0) PG8_BAR;
    PG8_BAR;
    if constexpr (Epi::AFTER_DRAIN) { E.fused(acc, cur, wr, wc, fr, fq, lds, wid, lane); S.done(cur); }
    PG8_STAMP();
    if (STAMP && wid == 0) { stamps[lane] = lane < nts ? (((unsigned long long)(unsigned)ts_hi << 32) | (unsigned)ts_lo) : 0ull;
        if (lane == 62) stamps[62] = rt_entry; if (lane == 63) stamps[63] = (unsigned long long)wall_clock64(); }
#undef PG8_STAMP
#undef PG8_SA
#undef PG8_SB
#undef PG8_STAGE
#undef PG8_LDA
#undef PG8_LDB
#undef PG8_MMA
#undef PG8_WAIT_V
#undef PG8_WAIT_L
#undef PG8_BAR
#undef PG8_SCHED
}
}
#define LAS __attribute__((address_space(3)))
#define XB_TMO      128
#define XB_XCNT(j)  (256  + 64 * (j))
#define XB_XSUB(j)  (1280 + 64 * (j))
#define XB_XGEN(j)  (2304 + 64 * (j))
#define XB_TOP      3328
#define XB_TOPGEN   3392
#define XCD_BAR_WORDS 3456
#define XB_SPIN_CAP (1u << 18)

__device__ __forceinline__ unsigned xb_ld(unsigned* p)              { return __hip_atomic_load(p, __ATOMIC_RELAXED, __HIP_MEMORY_SCOPE_AGENT); }
__device__ __forceinline__ unsigned xb_add(unsigned* p, unsigned v) { return __hip_atomic_fetch_add(p, v, __ATOMIC_RELAXED, __HIP_MEMORY_SCOPE_AGENT); }
__device__ __forceinline__ unsigned xb_xcc_id() { return (unsigned)__builtin_amdgcn_s_getreg((3 << 11) | 20) & 0xFu; }
#define XB_SPIN(cond, bar) do { unsigned _sp = 0; while (cond) { __builtin_amdgcn_s_sleep(1); \
    if ((++_sp & 255u) == 0u) { if (xb_ld(&(bar)[XB_TMO])) break; if (_sp > XB_SPIN_CAP) { atomicAdd(&(bar)[XB_TMO], 1u); break; } } } } while (0)

struct XcdBarrier {
    unsigned* bar; unsigned x;
    volatile LAS unsigned* st;
};

__device__ __forceinline__ XcdBarrier xcd_barrier_post(unsigned* bar, volatile LAS unsigned* st) {
    XcdBarrier b; b.bar = bar; b.x = xb_xcc_id(); b.st = st;
    if (threadIdx.x == 0) (void)xb_add(&bar[XB_XCNT(b.x)], 1u);
    return b;
}
__device__ __forceinline__ void xcd_barrier_complete(unsigned* bar, unsigned x, unsigned& nloc, unsigned& nx) {
    const unsigned G = gridDim.x * gridDim.y * gridDim.z;
    unsigned sum, cnt, mine, sp = 0u;
    for (;;) {
        sum = 0u; cnt = 0u; mine = 0u;
#pragma unroll
        for (unsigned j = 0; j < 16; ++j) { const unsigned c = xb_ld(&bar[XB_XCNT(j)]); sum += c; cnt += (c > 0u) ? 1u : 0u; mine = (j == x) ? c : mine; }
        if (sum == G) break;
        __builtin_amdgcn_s_sleep(1);
        if ((++sp & 255u) == 0u) { if (xb_ld(&bar[XB_TMO])) break; if (sp > XB_SPIN_CAP) { atomicAdd(&bar[XB_TMO], 1u); break; } }
    }
    nloc = mine > 0u ? mine : 1u; nx = cnt > 0u ? cnt : 1u;
}

__device__ __forceinline__ void xcd_barrier(const XcdBarrier& b) {
    asm volatile("s_waitcnt vmcnt(0)" ::: "memory");
    __syncthreads();
    if (threadIdx.x == 0) {
        unsigned* bar = b.bar;
        __builtin_amdgcn_s_waitcnt(0);
        unsigned nloc = b.st[0], nx = b.st[1];
        if (nloc == 0u) { xcd_barrier_complete(bar, b.x, nloc, nx); b.st[0] = nloc; b.st[1] = nx; }
        const unsigned old = xb_add(&bar[XB_XSUB(b.x)], 1u);
        const unsigned gen = old / nloc;
        if (old + 1u == (gen + 1u) * nloc) {
            __builtin_amdgcn_fence(__ATOMIC_RELEASE, "agent");
            asm volatile("s_waitcnt vmcnt(0)" ::: "memory");
            const unsigned og = xb_add(&bar[XB_TOP], 1u);
            const unsigned tg = og / nx;
            if (og + 1u == (tg + 1u) * nx) xb_add(&bar[XB_TOPGEN], 1u);
            else XB_SPIN(xb_ld(&bar[XB_TOPGEN]) == tg, bar);
            __builtin_amdgcn_fence(__ATOMIC_ACQUIRE, "agent");
            xb_add(&bar[XB_XGEN(b.x)], 1u);
            asm volatile("s_waitcnt vmcnt(0)" ::: "memory");
        } else {
            XB_SPIN(xb_ld(&bar[XB_XGEN(b.x)]) == gen, bar);
            __builtin_amdgcn_fence(__ATOMIC_ACQUIRE, "agent");
            asm volatile("s_waitcnt vmcnt(0)" ::: "memory");
        }
    }
    __syncthreads();
}


#define DI __device__ __forceinline__

using pg8::bf16_t; using pg8::bf16x8; using pg8::f32x4; using pg8::f32x2; using pg8::u32x4; using pg8::Unit;
typedef unsigned u32x2 __attribute__((ext_vector_type(2)));
typedef short s16x4 __attribute__((ext_vector_type(4)));
typedef __bf16 bf2_t __attribute__((ext_vector_type(2)));

constexpr int NB = 8, T = 4096, D = 1024, NTOK = NB * T, CTXL = 256, NCTX = NB * CTXL, NP = 3072, NC = 32;
constexpr int NTHREADS = 512;
constexpr int LDS_BYTES = 147456 + 256;
constexpr float EPS = 1e-6f, LOG2E = 1.4426950408889634f;

constexpr size_t al256(size_t x) { return (x + 255) & ~(size_t)255; }
constexpr size_t WS_MOD  = 0;
constexpr size_t WS_ROPE = WS_MOD + al256(9 * 3072 * 4);
constexpr size_t WS_WIN  = WS_ROPE + 8192;
constexpr size_t WS_WOUT = WS_WIN + (size_t)3072 * 1024 * 2;
constexpr size_t WS_WSB  = WS_WOUT + (size_t)1024 * 1024 * 2;
constexpr size_t WS_H    = WS_WSB + (size_t)4 * 128 * 128 * 2;
constexpr size_t WS_Q    = WS_H + (size_t)(NTOK + NCTX) * 1024 * 2;
constexpr size_t WS_K    = WS_Q + (size_t)NTOK * 256 * 2;
constexpr size_t WS_V    = WS_K + (size_t)NTOK * 256 * 2;
constexpr size_t WS_GR   = WS_V + (size_t)NTOK * 512 * 2;
constexpr size_t WS_U    = WS_GR + (size_t)NTOK * 512 * 2;
constexpr size_t WS_VG   = WS_U + (size_t)NTOK * 512 * 2;
constexpr size_t WS_GM   = WS_VG + (size_t)NTOK * 512 * 2;
constexpr size_t WS_KC   = WS_GM + (size_t)NTOK * 512 * 2;
constexpr size_t WS_VC   = WS_KC + (size_t)NCTX * 256 * 2;
constexpr size_t WS_KV   = WS_VC + (size_t)NCTX * 512 * 2;
constexpr size_t WS_KVC  = WS_KV + (size_t)1024 * 2 * 8192 * 4;
constexpr size_t WS_ST   = WS_KVC + (size_t)64 * 2 * 8192 * 4;
constexpr size_t WS_BAR  = WS_ST + (size_t)1024 * 2 * 8192 * 2;
constexpr size_t WS_CNT  = WS_BAR + (size_t)XCD_BAR_WORDS * 4;
constexpr size_t WS_SLOT = WS_CNT + 32768;
constexpr size_t WS_END  = WS_SLOT + (size_t)NTOK * 16 * 4;

struct Args {
    const float* x; const float* c; const float* ctx; const float* c_ctx; const float* w_ada; const float* b_ada; const float* norm_w; const float* w_in;
    const float* dec_f; const float* dec_b; const float* gn_w; const float* ln_w; const float* w_s; const float* b_s; const float* w_out; const float* fnorm_w;
    float* out; unsigned char* ws; int ph_lo, ph_hi;
};

DI unsigned pk2(float lo, float hi) { f32x2 v = {lo, hi}; bf2_t r = __builtin_convertvector(v, bf2_t); return __builtin_bit_cast(unsigned, r); }
DI f32x4 ldnt_f4(const float* p) { return __builtin_nontemporal_load((const f32x4*)p); }
DI u32x4 ldnt_u4(const void* p) { return __builtin_nontemporal_load((const u32x4*)p); }
DI u32x2 ldnt_u2(const void* p) { return __builtin_nontemporal_load((const u32x2*)p); }
DI float bflo(unsigned w) { return __uint_as_float(w << 16); }
DI float bfhi(unsigned w) { return __uint_as_float(w & 0xffff0000u); }
DI float silu_f(float v) { return v * __builtin_amdgcn_rcpf(1.0f + __expf(-v)); }
DI void lds_barrier() { asm volatile("s_waitcnt lgkmcnt(0)" ::: "memory"); __builtin_amdgcn_s_barrier(); asm volatile("" ::: "memory"); }
DI f32x4 mfma16(bf16x8 a, bf16x8 b, f32x4 c) { return __builtin_amdgcn_mfma_f32_16x16x32_bf16(a, b, c, 0, 0, 0); }

DI bf16x8 frag_tr(LAS const unsigned char* base, int S, int k0, int n0, int lane) {
    const int i = lane & 15, g = lane >> 4;
    LAS const unsigned char* p = base + (k0 + 4 * g + (i >> 2)) * S + (n0 + 4 * (i & 3)) * 2;
    const s16x4 lo = __builtin_amdgcn_ds_read_tr16_b64_v4i16((LAS s16x4*)p);
    const s16x4 hi = __builtin_amdgcn_ds_read_tr16_b64_v4i16((LAS s16x4*)(p + 16 * S));
    return __builtin_shufflevector(lo, hi, 0, 1, 2, 3, 4, 5, 6, 7);
}
DI bf16x8 frag_rowP(const bf16_t* rowk0, int g) {
    const u32x2 lo = *(const u32x2*)(rowk0 + 4 * g), hi = *(const u32x2*)(rowk0 + 16 + 4 * g);
    const u32x4 v = {lo.x, lo.y, hi.x, hi.y}; return __builtin_bit_cast(bf16x8, v);
}
DI bf16x8 frag_rowP_lds(LAS const unsigned char* rowk0, int g) {
    const u32x2 lo = *(LAS const u32x2*)(rowk0 + 8 * g), hi = *(LAS const u32x2*)(rowk0 + 32 + 8 * g);
    const u32x4 v = {lo.x, lo.y, hi.x, hi.y}; return __builtin_bit_cast(bf16x8, v);
}
DI bf16x8 scale_frag(bf16x8 f, float s) {
    const u32x4 u = __builtin_bit_cast(u32x4, f); u32x4 r;
#pragma unroll
    for (int q = 0; q < 4; ++q) r[q] = pk2(bflo(u[q]) * s, bfhi(u[q]) * s);
    return __builtin_bit_cast(bf16x8, r);
}

struct EpiIn {
    static constexpr bool PERM = true, AFTER_DRAIN = false, REALIGN = false;
    unsigned char* ws;
    DI void operator()(const f32x4 (&acc)[2][2][4][2], const Unit& u, int wr, int wc, int fr, int fq) const {
        const int pn = u.pn, rbase = u.pm * 256 + wr * 64 + fr, cbase = wc * 32 + 8 * fq;
        if (u.pm >= 128) {
            bf16_t* dst = (bf16_t*)(ws + (pn == 1 ? WS_KC : WS_VC));
            const float scl = pn == 1 ? 0.125f : 1.0f;
#pragma unroll
            for (int ai = 0; ai < 2; ++ai)
#pragma unroll
                for (int m = 0; m < 4; ++m) {
                    const int rc = rbase + ai * 128 + m * 16 - NTOK, b = rc >> 8, t = rc & 255;
#pragma unroll
                    for (int bj = 0; bj < 2; ++bj) {
                        const f32x4 v0 = acc[ai][bj][m][0] * scl, v1 = acc[ai][bj][m][1] * scl;
                        const u32x4 o = {pk2(v0[0], v0[1]), pk2(v0[2], v0[3]), pk2(v1[0], v1[1]), pk2(v1[2], v1[3])};
                        size_t off;
                        if (pn == 1) { const int head = bj * 2 + (wc >> 1), d0 = (wc & 1) * 32 + 8 * fq; off = ((size_t)((b * 4 + head) * 256 + t)) * 64 + d0; }
                        else { const int head = (pn - 2) * 2 + bj; off = ((size_t)(((b * 4 + head) * 8 + (cbase >> 4)) * 256 + t)) * 16 + (cbase & 15); }
                        *(u32x4*)(dst + off) = o;
                    }
                }
            return;
        }
        if (pn <= 1) {
            bf16_t* dst = (bf16_t*)(ws + (pn == 0 ? WS_Q : WS_K));
            const float scl = pn == 0 ? 1.0f : 0.125f;
            const float* rc = (const float*)(ws + WS_ROPE); const float* rs = rc + 1024;
            const int hh = wc & 1, fi0 = 8 * (fq & 1); const bool second = fq >= 2;
#pragma unroll
            for (int ai = 0; ai < 2; ++ai)
#pragma unroll
                for (int m = 0; m < 4; ++m) {
                    const int r = rbase + ai * 128 + m * 16, b = r >> 12, t = r & 4095, pos = hh ? (t & 63) : (t >> 6);
                    const f32x4 c0 = *(const f32x4*)(rc + pos * 16 + fi0), c1 = *(const f32x4*)(rc + pos * 16 + fi0 + 4);
                    const f32x4 s0 = *(const f32x4*)(rs + pos * 16 + fi0), s1 = *(const f32x4*)(rs + pos * 16 + fi0 + 4);
#pragma unroll
                    for (int bj = 0; bj < 2; ++bj) {
                        const f32x4 v0 = acc[ai][bj][m][0], v1 = acc[ai][bj][m][1];
                        float o[8];
#pragma unroll
                        for (int j = 0; j < 4; ++j) {
                            const float xa = v0[j], xb = v1[j], pa = __shfl_xor(xa, 32), pb = __shfl_xor(xb, 32);
                            o[j]     = (second ? (pa * s0[j] + xa * c0[j]) : (xa * c0[j] - pa * s0[j])) * scl;
                            o[4 + j] = (second ? (pb * s1[j] + xb * c1[j]) : (xb * c1[j] - pb * s1[j])) * scl;
                        }
                        const u32x4 ov = {pk2(o[0], o[1]), pk2(o[2], o[3]), pk2(o[4], o[5]), pk2(o[6], o[7])};
                        const int head = bj * 2 + (wc >> 1), d0 = hh * 32 + 8 * fq;
                        *(u32x4*)(dst + ((size_t)((b * 4 + head) * 4096 + t)) * 64 + d0) = ov;
                    }
                }
            return;
        }
        if (pn <= 3) {
            bf16_t* dst = (bf16_t*)(ws + WS_V);
#pragma unroll
            for (int ai = 0; ai < 2; ++ai)
#pragma unroll
                for (int m = 0; m < 4; ++m) {
                    const int r = rbase + ai * 128 + m * 16, b = r >> 12, t = r & 4095;
#pragma unroll
                    for (int bj = 0; bj < 2; ++bj) {
                        const f32x4 v0 = acc[ai][bj][m][0], v1 = acc[ai][bj][m][1];
                        const u32x4 o = {pk2(v0[0], v0[1]), pk2(v0[2], v0[3]), pk2(v1[0], v1[1]), pk2(v1[2], v1[3])};
                        const int head = (pn - 2) * 2 + bj;
                        *(u32x4*)(dst + ((size_t)(((b * 4 + head) * 8 + (cbase >> 4)) * 4096 + t)) * 16 + (cbase & 15)) = o;
                    }
                }
            return;
        }
        if (pn == 6 || pn == 7 || pn >= 10) {
            const int t = pn == 6 ? 0 : (pn == 7 ? 1 : (pn == 10 ? 2 : 3));
            bf16_t* dst = (bf16_t*)(ws + WS_U);
#pragma unroll
            for (int ai = 0; ai < 2; ++ai)
#pragma unroll
                for (int m = 0; m < 4; ++m) {
                    const int r = rbase + ai * 128 + m * 16;
                    const f32x4 u0 = acc[ai][0][m][0], u1 = acc[ai][0][m][1], g0 = acc[ai][1][m][0], g1 = acc[ai][1][m][1];
                    const f32x2 a0 = pg8::gelu_pk((f32x2){u0[0], u0[1]}), a1 = pg8::gelu_pk((f32x2){u0[2], u0[3]}), a2 = pg8::gelu_pk((f32x2){u1[0], u1[1]}), a3 = pg8::gelu_pk((f32x2){u1[2], u1[3]});
                    const u32x4 o = {pk2(a0.x * silu_f(g0[0]), a0.y * silu_f(g0[1])), pk2(a1.x * silu_f(g0[2]), a1.y * silu_f(g0[3])),
                                     pk2(a2.x * silu_f(g1[0]), a2.y * silu_f(g1[1])), pk2(a3.x * silu_f(g1[2]), a3.y * silu_f(g1[3]))};
                    *(u32x4*)(dst + (size_t)r * 512 + 128 * t + cbase) = o;
                }
            return;
        }
        {
            const int region = (pn - 4) >> 1; const bool is_gelu = (region == 1) || (region == 2);
            bf16_t* dst = (bf16_t*)(ws + WS_GR + (size_t)region * ((size_t)NTOK * 512 * 2));
            const int colb = ((pn - 4) & 1) * 256 + cbase;
#pragma unroll
            for (int ai = 0; ai < 2; ++ai)
#pragma unroll
                for (int m = 0; m < 4; ++m) {
                    const int r = rbase + ai * 128 + m * 16;
#pragma unroll
                    for (int bj = 0; bj < 2; ++bj) {
                        const f32x4 v0 = acc[ai][bj][m][0], v1 = acc[ai][bj][m][1];
                        u32x4 o;
                        if (is_gelu) {
                            const f32x2 a = pg8::gelu_pk((f32x2){v0[0], v0[1]}), bq = pg8::gelu_pk((f32x2){v0[2], v0[3]}), cq = pg8::gelu_pk((f32x2){v1[0], v1[1]}), dq = pg8::gelu_pk((f32x2){v1[2], v1[3]});
                            o = (u32x4){pk2(a.x, a.y), pk2(bq.x, bq.y), pk2(cq.x, cq.y), pk2(dq.x, dq.y)};
                        } else {
                            o = (u32x4){pk2(silu_f(v0[0]), silu_f(v0[1])), pk2(silu_f(v0[2]), silu_f(v0[3])), pk2(silu_f(v1[0]), silu_f(v1[1])), pk2(silu_f(v1[2]), silu_f(v1[3]))};
                        }
                        *(u32x4*)(dst + (size_t)r * 512 + colb + bj * 128) = o;
                    }
                }
        }
    }
};
struct EpiOut {
    static constexpr bool PERM = false, AFTER_DRAIN = false, REALIGN = true;
    const float* x; const float* mod; const float* fw; float* out; float* slots; unsigned* cnt;
    DI void operator()(const f32x4 (&acc_)[2][2][4][2], const Unit& u, int wr, int wc, int fr, int fq) const {
        f32x4 (&acc)[2][2][4][2] = const_cast<f32x4 (&)[2][2][4][2]>(acc_);
        const int rbase = u.pm * 256 + wr * 64 + fr, cbase = u.pn * 256 + wc * 32 + 4 * fq;
        const float* gate = mod + (size_t)(rbase >> 12) * 3072 + 2048;
        f32x4 gv[2][2];
#pragma unroll
        for (int bj = 0; bj < 2; ++bj)
#pragma unroll
            for (int n = 0; n < 2; ++n) gv[bj][n] = *(const f32x4*)(gate + cbase + bj * 128 + n * 16);
        f32x4 xv[2][4]; float ss[8];
#pragma unroll
        for (int q = 0; q < 4; ++q) xv[0][q] = ldnt_f4(x + (size_t)rbase * 1024 + cbase + (q >> 1) * 128 + (q & 1) * 16);
#pragma unroll
        for (int k = 0; k < 8; ++k) {
            const int ai = k >> 2, m = k & 3;
            if (k + 1 < 8) {
                const size_t ro = (size_t)(rbase + ((k + 1) >> 2) * 128 + ((k + 1) & 3) * 16) * 1024 + cbase;
#pragma unroll
                for (int q = 0; q < 4; ++q) xv[(k + 1) & 1][q] = ldnt_f4(x + ro + (q >> 1) * 128 + (q & 1) * 16);
            }
            float sk = 0.f;
#pragma unroll
            for (int q = 0; q < 4; ++q) {
                const int bj = q >> 1, n = q & 1;
                const f32x4 v = xv[k & 1][q] + gv[bj][n] * acc[ai][bj][m][n];
                acc[ai][bj][m][n] = v;
                sk += v[0] * v[0] + v[1] * v[1] + v[2] * v[2] + v[3] * v[3];
            }
            ss[k] = sk;
        }
#pragma unroll
        for (int k = 0; k < 8; ++k) { ss[k] += __shfl_xor(ss[k], 16); ss[k] += __shfl_xor(ss[k], 32); }
        if (fq == 0) {
#pragma unroll
            for (int k = 0; k < 8; ++k)
                __hip_atomic_store(slots + (size_t)(rbase + (k >> 2) * 128 + (k & 3) * 16) * 16 + u.pn * 4 + wc, ss[k], __ATOMIC_RELAXED, __HIP_MEMORY_SCOPE_AGENT);
        }
        asm volatile("s_waitcnt vmcnt(0)" ::: "memory");
        if ((threadIdx.x & 63) == 0) {
            __hip_atomic_fetch_add(cnt + u.pm * 64, 1u, __ATOMIC_RELAXED, __HIP_MEMORY_SCOPE_AGENT);
            unsigned spins = 0;
            while (__hip_atomic_load(cnt + u.pm * 64, __ATOMIC_RELAXED, __HIP_MEMORY_SCOPE_AGENT) < 32u) { __builtin_amdgcn_s_sleep(8); if (++spins > (1u << 22)) break; }
        }
        __builtin_amdgcn_fence(__ATOMIC_ACQUIRE, "agent");
        asm volatile("s_waitcnt vmcnt(0)" ::: "memory");
        f32x4 sl[8];
#pragma unroll
        for (int k = 0; k < 8; ++k) sl[k] = *(const f32x4*)(slots + (size_t)(rbase + (k >> 2) * 128 + (k & 3) * 16) * 16 + fq * 4);
        f32x4 fv[2][2];
#pragma unroll
        for (int bj = 0; bj < 2; ++bj)
#pragma unroll
            for (int n = 0; n < 2; ++n) fv[bj][n] = *(const f32x4*)(fw + cbase + bj * 128 + n * 16);
        float rs[8];
#pragma unroll
        for (int k = 0; k < 8; ++k) {
            float t = (sl[k][0] + sl[k][1]) + (sl[k][2] + sl[k][3]);
            t += __shfl_xor(t, 16); t += __shfl_xor(t, 32);
            rs[k] = rsqrtf(t * (1.0f / 1024.0f) + EPS);
        }
#pragma unroll
        for (int k = 0; k < 8; ++k) {
            const int ai = k >> 2, m = k & 3;
            const size_t ro = (size_t)(rbase + ai * 128 + m * 16) * 1024 + cbase;
#pragma unroll
            for (int bj = 0; bj < 2; ++bj)
#pragma unroll
                for (int n = 0; n < 2; ++n) __builtin_nontemporal_store(acc[ai][bj][m][n] * rs[k] * fv[bj][n], (f32x4*)(out + ro + bj * 128 + n * 16));
        }
    }
};
struct SchedIn {
    pg8::StaticOrder so;
    DI bool next(int i, Unit& u) const {
        if (so.G == 256) {
            const int x = so.c & 7, j = so.c >> 3;
            if (j < 3) {
                if (i == 0) { u.pm = 128 + x; u.pn = 1 + j; return true; }
                if (i > 6) return false;
                const int q = 6 * j + (i - 1);
                u.pm = 16 * x + (q >> 2); u.pn = q & 3; return true;
            }
            if (i > 5) return false;
            const int e = (j - 3) + 29 * i;
            if (e < 64) { u.pm = 16 * x + (e >> 2); u.pn = 6 + (e & 3); }
            else if (e < 128) { const int t = e & 3; u.pm = 16 * x + ((e - 64) >> 2); u.pn = t < 2 ? 4 + t : 8 + t; }
            else { const int q = 18 + (e - 128); u.pm = 16 * x + (q >> 2); u.pn = q & 3; }
            return true;
        }
        long L = (long)i * so.G + so.c;
        if (L < so.nwg) return so.next(i, u);
        L -= so.nwg; if (L >= 24) return false;
        u.pm = 128 + (int)(L / 3); u.pn = 1 + (int)(L % 3); return true;
    }
    DI void a_ready(const Unit&) const {}
    DI void done(const Unit&) const {}
};

DI void phase0(const Args& a, LAS unsigned char* lds) {
    const int tid = threadIdx.x;
    float* mod = (float*)(a.ws + WS_MOD);
    LAS float* red = (LAS float*)lds;
    for (int it = blockIdx.x; it < 1233; it += gridDim.x) {
        if (it < 192) {
            const int c0 = it * 16, f = tid & 3, rg = tid >> 2;
            LAS float* scv = red + 36 * 512;
            for (int q = tid; q < 9 * 1024; q += NTHREADS) { const float cv = (q < 8192) ? a.c[q] : a.c_ctx[q - 8192]; scv[q] = cv / (1.0f + expf(-cv)); }
            __syncthreads();
            float acc[9][4];
#pragma unroll
            for (int j = 0; j < 9; ++j)
#pragma unroll
                for (int e = 0; e < 4; ++e) acc[j][e] = 0.f;
            f32x4 wv[8];
#pragma unroll
            for (int i = 0; i < 8; ++i) wv[i] = ldnt_f4(a.w_ada + (size_t)(rg + 128 * i) * 3072 + c0 + f * 4);
#pragma unroll
            for (int i = 0; i < 8; ++i) {
                const int r = rg + 128 * i;
#pragma unroll
                for (int j = 0; j < 9; ++j) {
                    const float sv = scv[j * 1024 + r];
#pragma unroll
                    for (int e = 0; e < 4; ++e) acc[j][e] += sv * wv[i][e];
                }
            }
#pragma unroll
            for (int j = 0; j < 9; ++j)
#pragma unroll
                for (int e = 0; e < 4; ++e) red[(j * 4 + e) * 512 + tid] = acc[j][e];
            __syncthreads();
            if (tid < 144) {
                const int j = tid >> 4, cc = tid & 15, ff = cc >> 2, e = cc & 3;
                float s = 0.f;
                for (int q = 0; q < 128; ++q) s += red[(j * 4 + e) * 512 + q * 4 + ff];
                mod[j * 3072 + c0 + cc] = s + a.b_ada[c0 + cc];
            }
            __syncthreads();
        } else if (it < 1216) {
            const bool is_in = it < 960; const int tt = is_in ? it - 192 : it - 960;
            const int nN = is_in ? 48 : 16, NN = is_in ? 3072 : 1024;
            const int k0 = (tt / nN) * 64, n0 = (tt % nN) * 64;
            int ns = n0;
            if (is_in && ((n0 >= 1536 && n0 < 2048) || n0 >= 2560)) {
                const int base = n0 >= 2560 ? 2560 : 1536, t = (n0 >= 2560 ? 2 : 0) + (n0 - base) / 256, w = (n0 - base) % 256;
                ns = (w < 128 ? 1536 : 2560 - 128) + 128 * t + w;
            }
            const float* src = is_in ? a.w_in : a.w_out;
            bf16_t* dst = (bf16_t*)(a.ws + (is_in ? WS_WIN : WS_WOUT));
            const int kr = tid >> 4, n4 = tid & 15;
#pragma unroll
            for (int p = 0; p < 2; ++p) {
                const int k = kr + 32 * p;
                const f32x4 v = ldnt_f4(src + (size_t)(k0 + k) * NN + ns + n4 * 4);
#pragma unroll
                for (int e = 0; e < 4; ++e) red[k * 65 + n4 * 4 + e] = v[e];
            }
            __syncthreads();
            const int n = tid >> 3, k8 = tid & 7;
            float v[8];
#pragma unroll
            for (int j = 0; j < 8; ++j) v[j] = red[(k8 * 8 + j) * 65 + n];
            const u32x4 o = {pk2(v[0], v[1]), pk2(v[2], v[3]), pk2(v[4], v[5]), pk2(v[6], v[7])};
            *(u32x4*)(dst + (size_t)(n0 + n) * 1024 + k0 + k8 * 8) = o;
            __syncthreads();
        } else if (it < 1232) {
            const size_t base = (size_t)(it - 1216) * 4096 + tid * 8;
            const f32x4 v0 = *(const f32x4*)(a.w_s + base), v1 = *(const f32x4*)(a.w_s + base + 4);
            const u32x4 o = {pk2(v0[0], v0[1]), pk2(v0[2], v0[3]), pk2(v1[0], v1[1]), pk2(v1[2], v1[3])};
            *(u32x4*)((bf16_t*)(a.ws + WS_WSB) + base) = o;
        } else {
            float* rc = (float*)(a.ws + WS_ROPE); float* rs = rc + 1024;
            for (int idx = tid; idx < 1024; idx += NTHREADS) {
                const int pos = idx >> 4, fi = idx & 15;
                const float inv = powf(10000.0f, -(float)fi / 16.0f), ang = (float)pos * inv;
                rc[idx] = cosf(ang); rs[idx] = sinf(ang);
            }
        }
    }
}

template <int R> DI void norm_rows(const Args& a, const float* mod, bf16_t* H, const int (&rows)[R], int lane) {
    f32x4 v[R][4]; const float* mrow[R];
#pragma unroll
    for (int k = 0; k < R; ++k) {
        const int r = rows[k]; const float* src; int j;
        if (r < NTOK) { src = a.x + (size_t)r * 1024; j = r >> 12; } else { src = a.ctx + (size_t)(r - NTOK) * 1024; j = 8; }
        mrow[k] = mod + j * 3072;
#pragma unroll
        for (int q = 0; q < 4; ++q) v[k][q] = ldnt_f4(src + q * 256 + lane * 4);
    }
#pragma unroll
    for (int k = 0; k < R; ++k) {
        float ss = 0.f;
#pragma unroll
        for (int q = 0; q < 4; ++q) ss += v[k][q][0] * v[k][q][0] + v[k][q][1] * v[k][q][1] + v[k][q][2] * v[k][q][2] + v[k][q][3] * v[k][q][3];
#pragma unroll
        for (int off = 32; off >= 1; off >>= 1) ss += __shfl_xor(ss, off);
        const float rstd = rsqrtf(ss * (1.0f / 1024.0f) + EPS);
#pragma unroll
        for (int q = 0; q < 4; ++q) {
            const int cidx = q * 256 + lane * 4;
            const f32x4 nw = *(const f32x4*)(a.norm_w + cidx), sc = *(const f32x4*)(mrow[k] + 1024 + cidx), sh = *(const f32x4*)(mrow[k] + cidx);
            f32x4 hv;
#pragma unroll
            for (int e = 0; e < 4; ++e) hv[e] = (v[k][q][e] * rstd * nw[e]) * (1.0f + sc[e]) + sh[e];
            const u32x2 o = {pk2(hv[0], hv[1]), pk2(hv[2], hv[3])};
            *(u32x2*)(H + (size_t)rows[k] * 1024 + cidx) = o;
        }
    }
}
DI void norm_row(const Args& a, const float* mod, bf16_t* H, int r, int lane) { const int rows[1] = {r}; norm_rows<1>(a, mod, H, rows, lane); }
DI void phase1(const Args& a) {
    const int tid = threadIdx.x, wave = tid >> 6, lane = tid & 63, blk = blockIdx.x, G = gridDim.x;
    const float* mod = (const float*)(a.ws + WS_MOD);
    bf16_t* H = (bf16_t*)(a.ws + WS_H);
    constexpr int NCH = (NTOK + NCTX) / 8;
    int ch = blk;
    for (; ch + 3 * G < NCH; ch += 4 * G) { const int rows[4] = {ch * 8 + wave, (ch + G) * 8 + wave, (ch + 2 * G) * 8 + wave, (ch + 3 * G) * 8 + wave}; norm_rows<4>(a, mod, H, rows, lane); }
    for (; ch < NCH; ch += G) norm_row(a, mod, H, ch * 8 + wave, lane);
}

constexpr int VS = 288, KS = 144, KS2 = 160;
DI void gmlp_unit(const Args& a, LAS unsigned char* lds, int b, int c) {
    const int tid = threadIdx.x, lane = tid & 63, w = tid >> 6, i = lane & 15, g = lane >> 4;
    const int r0 = b * 4096 + c * 128;
    const bf16_t* VG = (const bf16_t*)(a.ws + WS_VG); const bf16_t* U = (const bf16_t*)(a.ws + WS_U);
    const bf16_t* WSB = (const bf16_t*)(a.ws + WS_WSB); bf16_t* Y = (bf16_t*)(a.ws + WS_H);
    constexpr int GSZ = 128 * VS;
    {
        const int row = tid >> 2, q = tid & 3;
        const bf16_t* src = VG + (size_t)(r0 + row) * 512 + q * 8;
        float s = 0.f, s2 = 0.f;
#pragma unroll 8
        for (int p = 0; p < 16; ++p) {
            const u32x4 pc = *(const u32x4*)(src + p * 32);
#pragma unroll
            for (int e = 0; e < 4; ++e) { const float lo = bflo(pc[e]), hi = bfhi(pc[e]); s += lo + hi; s2 += lo * lo + hi * hi; }
        }
        s += __shfl_xor(s, 1); s += __shfl_xor(s, 2); s2 += __shfl_xor(s2, 1); s2 += __shfl_xor(s2, 2);
        const float mean = s * (1.0f / 512.0f);
        const float var = fmaxf(s2 * (1.0f / 512.0f) - mean * mean, 0.f);
        const float rstd = rsqrtf(var + EPS);
        const float* lw = a.ln_w + q * 8;
#pragma unroll 4
        for (int p = 0; p < 16; ++p) {
            const u32x4 pc = *(const u32x4*)(src + p * 32);
            const f32x4 w0 = *(const f32x4*)(lw + p * 32), w1 = *(const f32x4*)(lw + p * 32 + 4);
            u32x4 o;
            o[0] = pk2((bflo(pc[0]) - mean) * rstd * w0[0], (bfhi(pc[0]) - mean) * rstd * w0[1]);
            o[1] = pk2((bflo(pc[1]) - mean) * rstd * w0[2], (bfhi(pc[1]) - mean) * rstd * w0[3]);
            o[2] = pk2((bflo(pc[2]) - mean) * rstd * w1[0], (bfhi(pc[2]) - mean) * rstd * w1[1]);
            o[3] = pk2((bflo(pc[3]) - mean) * rstd * w1[2], (bfhi(pc[3]) - mean) * rstd * w1[3]);
            *(LAS u32x4*)(lds + (p >> 2) * GSZ + row * VS + ((p & 3) * 4 + q) * 16) = o;
        }
    }
    __syncthreads();
    const int n = 16 * w + i, r = r0 + n;
#pragma unroll 1
    for (int gq = 0; gq < 4; ++gq) {
        f32x4 acc[8];
#pragma unroll
        for (int et = 0; et < 8; ++et) acc[et] = (f32x4){0.f, 0.f, 0.f, 0.f};
        const bf16_t* wrow = WSB + (size_t)(gq * 128 + n) * 128;
        bf16x8 bw[4];
#pragma unroll
        for (int s = 0; s < 4; ++s) bw[s] = frag_rowP(wrow + 32 * s, g);
#pragma unroll
        for (int s = 0; s < 4; ++s) {
#pragma unroll
            for (int et = 0; et < 8; ++et) acc[et] = mfma16(frag_tr(lds + gq * GSZ, VS, 32 * s, 16 * et, lane), bw[s], acc[et]);
        }
        const float bias = a.b_s[gq * 128 + n];
#pragma unroll
        for (int et = 0; et < 8; et += 2) {
            const int colw = gq * 128 + 16 * (et + (g & 1)) + 8 * (g >> 1);
            const u32x4 uw = *(const u32x4*)(U + (size_t)r * 512 + colw);
            const u32x2 ux = __builtin_amdgcn_permlane16_swap(uw[0], uw[2], false, false), uy = __builtin_amdgcn_permlane16_swap(uw[1], uw[3], false, false);
            const u32x2 ua = {ux[0], uy[0]}, ub = {ux[1], uy[1]};
            const u32x2 oa = {pk2(bflo(ua.x) * (acc[et][0] + bias), bfhi(ua.x) * (acc[et][1] + bias)), pk2(bflo(ua.y) * (acc[et][2] + bias), bfhi(ua.y) * (acc[et][3] + bias))};
            const u32x2 ob = {pk2(bflo(ub.x) * (acc[et + 1][0] + bias), bfhi(ub.x) * (acc[et + 1][1] + bias)), pk2(bflo(ub.y) * (acc[et + 1][2] + bias), bfhi(ub.y) * (acc[et + 1][3] + bias))};
            const u32x2 wx = __builtin_amdgcn_permlane16_swap(oa.x, ob.x, false, false), wy = __builtin_amdgcn_permlane16_swap(oa.y, ob.y, false, false);
            const u32x4 ow = {wx[0], wy[0], wx[1], wy[1]};
            __builtin_nontemporal_store(ow, (u32x4*)(Y + (size_t)r * 1024 + 512 + colw));
        }
    }
    __syncthreads();
}
struct ChStage { u32x4 kf[2], kb[2], v; };
DI void chain_load(const Args& a, int bh, int es, int it, ChStage& st) {
    const int tid = threadIdx.x;
    const bf16_t *Kf, *Kb, *Vf, *Vb;
    if (it < 2) {
        const size_t of = (size_t)bh * 256 + it * 128, ob = (size_t)bh * 256 + (1 - it) * 128;
        Kf = (const bf16_t*)(a.ws + WS_KC) + of * 64; Kb = (const bf16_t*)(a.ws + WS_KC) + ob * 64;
        Vf = (const bf16_t*)(a.ws + WS_VC) + (((size_t)bh * 8 + es) * 256 + it * 128) * 16; Vb = (const bf16_t*)(a.ws + WS_VC) + (((size_t)bh * 8 + es) * 256 + (1 - it) * 128) * 16;
    } else {
        const size_t of = (size_t)bh * 4096 + (it - 2) * 128, ob = (size_t)bh * 4096 + (33 - it) * 128;
        Kf = (const bf16_t*)(a.ws + WS_K) + of * 64; Kb = (const bf16_t*)(a.ws + WS_K) + ob * 64;
        Vf = (const bf16_t*)(a.ws + WS_V) + (((size_t)bh * 8 + es) * 4096 + (it - 2) * 128) * 16; Vb = (const bf16_t*)(a.ws + WS_V) + (((size_t)bh * 8 + es) * 4096 + (33 - it) * 128) * 16;
    }
#pragma unroll
    for (int q = 0; q < 2; ++q) { const int p = tid + 512 * q; st.kf[q] = *(const u32x4*)(Kf + (p >> 3) * 64 + (p & 7) * 8); st.kb[q] = *(const u32x4*)(Kb + (p >> 3) * 64 + (p & 7) * 8); }
    const int t = tid & 255; const bf16_t* Vx = (tid < 256) ? Vf : Vb;
    st.v = *(const u32x4*)(Vx + t * 8);
}
DI void chain_item(const Args& a, LAS unsigned char* lds, int item) {
    const int tid = threadIdx.x, lane = tid & 63, w = tid >> 6, i = lane & 15, g = lane >> 4;
    const int bh = item >> 3, es = item & 7, h = bh & 3, dirw = w >> 2, dt = w & 3;
    const float l2f = -expf(a.dec_f[h]) * LOG2E, l2b = -expf(a.dec_b[h]) * LOG2E;
    const float G = exp2f(128.0f * (dirw ? l2b : l2f));
    constexpr int BUFSZ = 2 * 128 * KS2 + 2 * 128 * 32;
    float tf[2], tb[2];
#pragma unroll
    for (int q = 0; q < 2; ++q) { const int m = (tid >> 3) + 64 * q; tf[q] = exp2f((float)(127 - m) * l2f); tb[q] = exp2f((float)m * l2b); }
    bf16_t* ST = (bf16_t*)(a.ws + WS_ST);
    f32x4 S = {0.f, 0.f, 0.f, 0.f};
    ChStage st0, st1, st2, st3;
    chain_load(a, bh, es, 0, st0); chain_load(a, bh, es, 1, st1); chain_load(a, bh, es, 2, st2);
#define CH_STEP(IT, CUR, NXT, STORE) do { const int it = (IT); { \
        LAS unsigned char* buf = lds + (it & 1) * BUFSZ; \
        LAS unsigned char* KFs = buf; LAS unsigned char* KBs = buf + 128 * KS2; LAS unsigned char* VFs = buf + 2 * 128 * KS2; LAS unsigned char* VBs = VFs + 128 * 32; \
        _Pragma("unroll") for (int q = 0; q < 2; ++q) { \
            const int p = tid + 512 * q, m = p >> 3, d8 = p & 7; \
            u32x4 of, ob; \
            _Pragma("unroll") for (int e = 0; e < 4; ++e) { of[e] = pk2(bflo(CUR.kf[q][e]) * tf[q], bfhi(CUR.kf[q][e]) * tf[q]); ob[e] = pk2(bflo(CUR.kb[q][e]) * tb[q], bfhi(CUR.kb[q][e]) * tb[q]); } \
            *(LAS u32x4*)(KFs + m * KS2 + d8 * 16) = of; *(LAS u32x4*)(KBs + m * KS2 + d8 * 16) = ob; \
        } \
        { const int t = tid & 255; *(LAS u32x4*)((tid < 256 ? VFs : VBs) + (t >> 1) * 32 + (t & 1) * 16) = CUR.v; } \
        lds_barrier(); \
        chain_load(a, bh, es, (it + 3 < 34) ? it + 3 : 33, NXT);                  \
        LAS const unsigned char* Kx = dirw ? KBs : KFs; LAS const unsigned char* Vx = dirw ? VBs : VFs; \
        f32x4 kv = {0.f, 0.f, 0.f, 0.f}; \
        _Pragma("unroll") for (int s = 0; s < 4; ++s) kv = mfma16(frag_tr(Vx, 32, 32 * s, 0, lane), frag_tr(Kx, KS2, 32 * s, 16 * dt, lane), kv); \
        if (STORE) {                                                              \
            const int c = dirw ? 33 - it : it - 2; \
            const u32x2 o = {pk2(S[0], S[1]), pk2(S[2], S[3])}; \
            *(u32x2*)(ST + (((size_t)(bh * 32 + c) * 2 + dirw) * 64 + 16 * dt + i) * 128 + es * 16 + 4 * g) = o; \
        } \
        S = S * G + kv; } } while (0)
    CH_STEP(0, st0, st3, false); CH_STEP(1, st1, st0, false);
#pragma unroll 1
    for (int it4 = 2; it4 < 34; it4 += 4) {
        CH_STEP(it4, st2, st1, true); CH_STEP(it4 + 1, st3, st2, true); CH_STEP(it4 + 2, st0, st3, true); CH_STEP(it4 + 3, st1, st0, true);
    }
#undef CH_STEP
    __syncthreads();
}
DI void phase3(const Args& a, LAS unsigned char* lds) {
    for (int it = blockIdx.x; it < 256; it += gridDim.x) gmlp_unit(a, lds, it >> 5, it & 31);
    for (int it = blockIdx.x; it < 256; it += gridDim.x) { const int j = it >> 3; chain_item(a, lds, (((it & 7) * 4 + (j >> 3)) << 3) + (j & 7)); }
}

DI void phase4(const Args& a) {
    const float* KV = (const float*)(a.ws + WS_KV); const float* KVC = (const float*)(a.ws + WS_KVC);
    bf16_t* ST = (bf16_t*)(a.ws + WS_ST);
    for (int idx = blockIdx.x * NTHREADS + threadIdx.x; idx < 64 * 2048; idx += gridDim.x * NTHREADS) {
        const int chain = idx >> 11, pos = idx & 2047, bh = chain >> 1, dir = chain & 1, h = bh & 3;
        const float lg = -expf(dir ? a.dec_b[h] : a.dec_f[h]), G = expf(128.0f * lg);
        const f32x4 k0 = *(const f32x4*)(KVC + ((size_t)(bh * 2 + 0) * 2 + dir) * 8192 + pos * 4);
        const f32x4 k1 = *(const f32x4*)(KVC + ((size_t)(bh * 2 + 1) * 2 + dir) * 8192 + pos * 4);
        f32x4 S = dir ? (k1 * G + k0) : (k0 * G + k1);
#pragma unroll 8
        for (int step = 0; step < NC; ++step) {
            const int c = dir ? (NC - 1 - step) : step;
            const size_t off = ((size_t)(bh * 32 + c) * 2 + dir) * 8192 + pos * 4;
            const f32x4 kvv = *(const f32x4*)(KV + off);
            const u32x2 o = {pk2(S[0], S[1]), pk2(S[2], S[3])};
            *(u32x2*)(ST + off) = o;
            S = S * G + kvv;
        }
    }
}

struct RetStage { u32x4 k[2], v[4], sf[2], sb[2]; bf16x8 q[2]; };
DI void ret_load(const Args& a, int unit, RetStage& st) {
    const int tid = threadIdx.x, lane = tid & 63, w = tid >> 6, i = lane & 15, g = lane >> 4;
    const int bh = unit >> 5, c = unit & 31;
    const bf16_t* Qp = (const bf16_t*)(a.ws + WS_Q) + ((size_t)bh * 4096 + c * 128) * 64;
    const bf16_t* Kp = (const bf16_t*)(a.ws + WS_K) + ((size_t)bh * 4096 + c * 128) * 64;
    const bf16_t* Vp = (const bf16_t*)(a.ws + WS_V) + ((size_t)bh * 8 * 4096 + c * 128) * 16;
    const bf16_t* SFp = (const bf16_t*)(a.ws + WS_ST) + (size_t)unit * 16384; const bf16_t* SBp = SFp + 8192;
#pragma unroll
    for (int q = 0; q < 2; ++q) { const int p = tid + 512 * q; st.k[q] = *(const u32x4*)(Kp + (p >> 3) * 64 + (p & 7) * 8); }
#pragma unroll
    for (int q = 0; q < 4; ++q) { const int p = tid + 512 * q; st.v[q] = *(const u32x4*)(Vp + (size_t)(p >> 8) * (4096 * 16) + (p & 255) * 8); }
#pragma unroll
    for (int q = 0; q < 2; ++q) { const int p = tid + 512 * q; st.sf[q] = *(const u32x4*)(SFp + (p >> 4) * 128 + (p & 15) * 8); st.sb[q] = *(const u32x4*)(SBp + (p >> 4) * 128 + (p & 15) * 8); }
#pragma unroll
    for (int s = 0; s < 2; ++s) st.q[s] = frag_rowP(Qp + (16 * w + i) * 64 + 32 * s, g);
}
DI void ret_unit(const Args& a, LAS unsigned char* lds, int unit, RetStage& st, int next_unit) {
    const int tid = threadIdx.x, lane = tid & 63, w = tid >> 6, i = lane & 15, g = lane >> 4;
    const int bh = unit >> 5, c = unit & 31, b = bh >> 2, h = bh & 3;
    const bf16_t* GR = (const bf16_t*)(a.ws + WS_GR); bf16_t* Y = (bf16_t*)(a.ws + WS_H);
    LAS unsigned char* Kt = lds; LAS unsigned char* Vt = lds + 128 * KS; LAS unsigned char* SF = Vt + 128 * VS; LAS unsigned char* SB = SF + 64 * VS;
#pragma unroll
    for (int q = 0; q < 2; ++q) { const int p = tid + 512 * q; *(LAS u32x4*)(Kt + (p >> 3) * KS + (p & 7) * 16) = st.k[q]; }
#pragma unroll
    for (int q = 0; q < 4; ++q) { const int p = tid + 512 * q; *(LAS u32x4*)(Vt + ((p & 255) >> 1) * VS + (p >> 8) * 32 + (p & 1) * 16) = st.v[q]; }
#pragma unroll
    for (int q = 0; q < 2; ++q) { const int p = tid + 512 * q; *(LAS u32x4*)(SF + (p >> 4) * VS + (p & 15) * 16) = st.sf[q]; *(LAS u32x4*)(SB + (p >> 4) * VS + (p & 15) * 16) = st.sb[q]; }
    bf16x8 Qf[2];
#pragma unroll
    for (int s = 0; s < 2; ++s) Qf[s] = st.q[s];
    lds_barrier();
    if (next_unit >= 0) ret_load(a, next_unit, st);
    const float l2f = -expf(a.dec_f[h]) * LOG2E, l2b = -expf(a.dec_b[h]) * LOG2E;
    const int n = 16 * w + i;

    f32x4 accS[8];
#pragma unroll
    for (int mt = 0; mt < 8; ++mt) {
        accS[mt] = (f32x4){0.f, 0.f, 0.f, 0.f};
#pragma unroll
        for (int s = 0; s < 2; ++s) accS[mt] = mfma16(frag_rowP_lds(Kt + (16 * mt + i) * KS + 64 * s, g), Qf[s], accS[mt]);
    }
#pragma unroll
    for (int mt = 0; mt < 8; ++mt)
#pragma unroll
        for (int reg = 0; reg < 4; ++reg) {
            const int diff = n - (16 * mt + 4 * g + reg);
            const float ex = __builtin_amdgcn_exp2f(diff > 0 ? (float)diff * l2f : (float)(-diff) * l2b);
            accS[mt][reg] *= (diff == 0 ? 2.0f : ex);
        }
    const float fsf = __builtin_amdgcn_exp2f((float)(n + 1) * l2f), fsb = __builtin_amdgcn_exp2f((float)(128 - n) * l2b);
    f32x4 accO[8];
#pragma unroll
    for (int et = 0; et < 8; ++et) accO[et] = (f32x4){0.f, 0.f, 0.f, 0.f};
#pragma unroll
    for (int s = 0; s < 4; ++s) {
        const u32x4 pu = {pk2(accS[2 * s][0], accS[2 * s][1]), pk2(accS[2 * s][2], accS[2 * s][3]), pk2(accS[2 * s + 1][0], accS[2 * s + 1][1]), pk2(accS[2 * s + 1][2], accS[2 * s + 1][3])};
        const bf16x8 Pf = __builtin_bit_cast(bf16x8, pu);
#pragma unroll
        for (int et = 0; et < 8; ++et) accO[et] = mfma16(frag_tr(Vt, VS, 32 * s, 16 * et, lane), Pf, accO[et]);
        __builtin_amdgcn_sched_barrier(0);
    }
#pragma unroll
    for (int s = 0; s < 2; ++s) {
        const bf16x8 qsf = scale_frag(Qf[s], fsf), qsb = scale_frag(Qf[s], fsb);
#pragma unroll
        for (int et = 0; et < 8; ++et) {
            accO[et] = mfma16(frag_tr(SF, VS, 32 * s, 16 * et, lane), qsf, accO[et]);
            accO[et] = mfma16(frag_tr(SB, VS, 32 * s, 16 * et, lane), qsb, accO[et]);
        }
        __builtin_amdgcn_sched_barrier(0);
    }
    float sm = 0.f;
#pragma unroll
    for (int et = 0; et < 8; ++et) sm += accO[et][0] + accO[et][1] + accO[et][2] + accO[et][3];
    sm += __shfl_xor(sm, 16); sm += __shfl_xor(sm, 32);
    const float mean = sm * (1.0f / 128.0f);
    float v2 = 0.f;
#pragma unroll
    for (int et = 0; et < 8; ++et)
#pragma unroll
        for (int e = 0; e < 4; ++e) { const float d0 = accO[et][e] - mean; v2 += d0 * d0; }
    v2 += __shfl_xor(v2, 16); v2 += __shfl_xor(v2, 32);
    const float rstd = rsqrtf(v2 * (1.0f / 128.0f) + EPS);
    const int r = b * 4096 + c * 128 + n;
#pragma unroll
    for (int et = 0; et < 8; et += 2) {
        const int colw = h * 128 + 16 * (et + (g & 1)) + 8 * (g >> 1);
        const u32x4 gww = *(const u32x4*)(GR + (size_t)r * 512 + colw);
        const u32x2 gx = __builtin_amdgcn_permlane16_swap(gww[0], gww[2], false, false), gy = __builtin_amdgcn_permlane16_swap(gww[1], gww[3], false, false);
        const u32x2 ga = {gx[0], gy[0]}, gb = {gx[1], gy[1]};
        const f32x4 wa = *(const f32x4*)(a.gn_w + h * 128 + 16 * et + 4 * g), wb = *(const f32x4*)(a.gn_w + h * 128 + 16 * (et + 1) + 4 * g);
        const u32x2 oa = {pk2((accO[et][0] - mean) * rstd * wa[0] * bflo(ga.x), (accO[et][1] - mean) * rstd * wa[1] * bfhi(ga.x)),
                          pk2((accO[et][2] - mean) * rstd * wa[2] * bflo(ga.y), (accO[et][3] - mean) * rstd * wa[3] * bfhi(ga.y))};
        const u32x2 ob = {pk2((accO[et + 1][0] - mean) * rstd * wb[0] * bflo(gb.x), (accO[et + 1][1] - mean) * rstd * wb[1] * bfhi(gb.x)),
                          pk2((accO[et + 1][2] - mean) * rstd * wb[2] * bflo(gb.y), (accO[et + 1][3] - mean) * rstd * wb[3] * bfhi(gb.y))};
        const u32x2 wx = __builtin_amdgcn_permlane16_swap(oa.x, ob.x, false, false), wy = __builtin_amdgcn_permlane16_swap(oa.y, ob.y, false, false);
        const u32x4 ow = {wx[0], wy[0], wx[1], wy[1]};
        *(u32x4*)(Y + (size_t)r * 1024 + colw) = ow;
    }
    lds_barrier();
}

DI void phase7(const Args& a) {
    const int tid = threadIdx.x, wave = tid >> 6, lane = tid & 63;
    for (int r = blockIdx.x * 8 + wave; r < NTOK; r += gridDim.x * 8) {
        float* row = a.out + (size_t)r * 1024;
        f32x4 v[4]; float ss = 0.f;
#pragma unroll
        for (int q = 0; q < 4; ++q) { v[q] = *(const f32x4*)(row + q * 256 + lane * 4); ss += v[q][0] * v[q][0] + v[q][1] * v[q][1] + v[q][2] * v[q][2] + v[q][3] * v[q][3]; }
#pragma unroll
        for (int off = 32; off >= 1; off >>= 1) ss += __shfl_xor(ss, off);
        const float rstd = rsqrtf(ss * (1.0f / 1024.0f) + EPS);
#pragma unroll
        for (int q = 0; q < 4; ++q) {
            const f32x4 fw = *(const f32x4*)(a.fnorm_w + q * 256 + lane * 4);
            *(f32x4*)(row + q * 256 + lane * 4) = v[q] * rstd * fw;
        }
    }
}

__global__ __launch_bounds__(512, 2) void fwd_megakernel(Args a) {
    extern __shared__ __attribute__((aligned(16))) unsigned char shm[];
    LAS unsigned char* lds = (LAS unsigned char*)shm;
    cg::grid_group grid = cg::this_grid();
    volatile LAS unsigned* st = (volatile LAS unsigned*)(lds + LDS_BYTES - 16);
    if (threadIdx.x == 0) { st[0] = 0u; st[1] = 0u; }
    __syncthreads();
    const XcdBarrier xb = xcd_barrier_post((unsigned*)(a.ws + WS_BAR), st);
    if (a.ph_hi > 7) grid.sync();
#ifndef PHMASK
#define PHMASK 255
#endif
#ifndef REPMASK
#define REPMASK 0
#endif
#ifndef EXTRA_SYNCS
#define EXTRA_SYNCS 0
#endif
#define GSYNC() xcd_barrier(xb)
    for (int xs = 0; xs < EXTRA_SYNCS; ++xs) GSYNC();
#define PHASE(P, ...) do { if (((PHMASK >> (P)) & 1) && a.ph_lo <= (P) && (P) < a.ph_hi) { if ((REPMASK >> (P)) & 1) { __VA_ARGS__; GSYNC(); } __VA_ARGS__; if ((P) + 1 < a.ph_hi) GSYNC(); } } while (0)
    PHASE(0, phase0(a, lds));
    PHASE(1, phase1(a));
    PHASE(2, {
        pg8::Gemm gm{(const bf16_t*)(a.ws + WS_H), (const bf16_t*)(a.ws + WS_WIN), NTOK, NP, D};
        SchedIn S; S.so.init(NTOK, NP, (int)gridDim.x, (int)blockIdx.x);
        EpiIn E{a.ws};
        pg8::gemm_phase<EpiIn, SchedIn, false>(lds, gm, S, E, nullptr);
    });
    PHASE(3, phase3(a, lds));
    PHASE(5, { int it = blockIdx.x; if (it < 1024) { RetStage st; ret_load(a, it, st); for (;;) { const int nx = it + (int)gridDim.x; ret_unit(a, lds, it, st, nx < 1024 ? nx : -1); if (nx >= 1024) break; it = nx; } } });
    PHASE(6, {
        pg8::Gemm gm{(const bf16_t*)(a.ws + WS_H), (const bf16_t*)(a.ws + WS_WOUT), NTOK, D, D};
        pg8::StaticOrder S; S.init(NTOK, D, (int)gridDim.x, (int)blockIdx.x);
        EpiOut E{a.x, (const float*)(a.ws + WS_MOD), a.fnorm_w, a.out, (float*)(a.ws + WS_SLOT), (unsigned*)(a.ws + WS_CNT)};
        pg8::gemm_phase<EpiOut, pg8::StaticOrder, false>(lds, gm, S, E, nullptr);
    });
#undef PHASE
}

extern "C" void kernel_launch(void* const* d_in, const int* in_sizes, int n_in, void* d_out, int out_size, void* d_ws, size_t ws_size, hipStream_t stream) {
    static int grid = 0;
    if (grid == 0) {
        if (n_in != 16 || out_size != NTOK * D || ws_size < WS_END) { fprintf(stderr, "kernel_launch: unexpected shapes (n_in %d out %d ws %zu need %zu)\n", n_in, out_size, ws_size, (size_t)WS_END); grid = -1; return; }
        int dev = 0, cus = 0, per_cu = 0;
        (void)hipGetDevice(&dev); (void)hipDeviceGetAttribute(&cus, hipDeviceAttributeMultiprocessorCount, dev);
        if (hipFuncSetAttribute((const void*)fwd_megakernel, hipFuncAttributeMaxDynamicSharedMemorySize, LDS_BYTES) != hipSuccess) { fprintf(stderr, "kernel_launch: hipFuncSetAttribute failed\n"); grid = -1; return; }
        if (hipOccupancyMaxActiveBlocksPerMultiprocessor(&per_cu, (const void*)fwd_megakernel, NTHREADS, LDS_BYTES) != hipSuccess || per_cu < 1) { fprintf(stderr, "kernel_launch: occupancy query gives %d\n", per_cu); per_cu = 1; }
        (void)hipGetLastError();
        grid = cus;
    }
    if (grid < 0) return;
    Args a{};
    a.x = (const float*)d_in[0]; a.c = (const float*)d_in[1]; a.ctx = (const float*)d_in[2]; a.c_ctx = (const float*)d_in[3]; a.w_ada = (const float*)d_in[4]; a.b_ada = (const float*)d_in[5];
    a.norm_w = (const float*)d_in[6]; a.w_in = (const float*)d_in[7]; a.dec_f = (const float*)d_in[8]; a.dec_b = (const float*)d_in[9]; a.gn_w = (const float*)d_in[10]; a.ln_w = (const float*)d_in[11];
    a.w_s = (const float*)d_in[12]; a.b_s = (const float*)d_in[13]; a.w_out = (const float*)d_in[14]; a.fnorm_w = (const float*)d_in[15];
    a.out = (float*)d_out; a.ws = (unsigned char*)d_ws;
    (void)hipMemsetAsync((unsigned char*)d_ws + WS_BAR, 0, (size_t)XCD_BAR_WORDS * 4 + 32768, stream);
#if N_LAUNCHES == 1
    a.ph_lo = 0; a.ph_hi = 7;
    void* args[] = {&a};
    hipError_t e = hipLaunchCooperativeKernel((const void*)fwd_megakernel, dim3(grid), dim3(NTHREADS), args, LDS_BYTES, stream);
    if (e != hipSuccess) fprintf(stderr, "cooperative launch failed: %s (grid %d)\n", hipGetErrorString(e), grid);
#else
    for (int p = 0; p < 7; ++p) {
        a.ph_lo = p; a.ph_hi = p + 1;
        hipLaunchKernelGGL(fwd_megakernel, dim3(grid), dim3(NTHREADS), LDS_BYTES, stream, a);
    }
#endif
}
```

```cpp
#include <hip/hip_runtime.h>
#include <hip/hip_cooperative_groups.h>
#include <cstdio>
namespace cg = cooperative_groups;
#ifndef N_LAUNCHES
#define N_LAUNCHES 1
#endif
namespace pg8 {
#define PG8_LAS __attribute__((address_space(3)))
typedef unsigned short bf16_t;
typedef short bf16x8 __attribute__((ext_vector_type(8)));
typedef float f32x4 __attribute__((ext_vector_type(4)));
typedef unsigned u32x4 __attribute__((ext_vector_type(4)));
constexpr int BM = 256, BK = 64, HALF = 128, HTB = HALF * BK * 2  , STAGE_BYTES = 8 * HTB, NXCD = 8, WGM = 8;

__host__ __device__ __forceinline__ int lds_byte(int r, int c) { const int st = (r >> 4) * 2 + (c >> 5), rr = r & 15, cc = c & 31, ob = rr * 64 + cc * 2; return st * 1024 + (ob ^ (((ob >> 9) & 1) << 5)); }
__host__ __device__ __forceinline__ void stage_rc(int b, int& R, int& C) { const int st = b / 1024, sb = b % 1024, swz = sb ^ (((sb >> 9) & 1) << 5); R = (st >> 1) * 16 + swz / 64; C = (st & 1) * 32 + (swz % 64) / 2; }
__host__ __device__ __forceinline__ int perm32(int rho) { const int n = rho >> 4, i = rho & 15; return 8 * (i >> 2) + 4 * n + (i & 3); }

struct Unit { int pm, pn; };
struct Gemm { const bf16_t* A; const bf16_t* Bt; int M, N, K; };

struct StaticOrder {
    int nM, nN, nwg, G, c;
    __host__ __device__ void init(int M, int N, int G_, int c_) { nM = M / BM; nN = N / BM; nwg = nM * nN; G = G_; c = c_; }
    __host__ __device__ bool next(int i, Unit& u) const {
        const long L = (long)i * G + c; if (L >= nwg) return false;
        int wgid = (int)L; { const int q = nwg / NXCD, r = nwg % NXCD, xcd = wgid % NXCD, off = wgid / NXCD; wgid = (xcd < r ? xcd * (q + 1) : r * (q + 1) + (xcd - r) * q) + off; }
        const int nig = WGM * nN, gid = wgid / nig, fm = gid * WGM, gsz = (nM - fm) < WGM ? (nM - fm) : WGM;
        u.pm = fm + ((wgid % nig) % gsz); u.pn = (wgid % nig) / gsz; return true;
    }
    __device__ __forceinline__ void a_ready(const Unit&) const {}
    __device__ __forceinline__ void done(const Unit&) const {}
};
struct CountedOrder : StaticOrder {
    const unsigned* ready; unsigned need; unsigned* tmo;
    __device__ __forceinline__ void a_ready(const Unit& u) const {
        if (threadIdx.x < 64) {
            const unsigned long long t0 = __builtin_amdgcn_s_memrealtime(); unsigned polls = 0;
            while ((unsigned)__builtin_amdgcn_readfirstlane(__hip_atomic_load(ready + 64 * u.pm, __ATOMIC_RELAXED, __HIP_MEMORY_SCOPE_AGENT)) < need) {
                if ((++polls & 255u) == 0u && __builtin_amdgcn_readfirstlane(__hip_atomic_load(tmo, __ATOMIC_RELAXED, __HIP_MEMORY_SCOPE_AGENT)) != 0u) break;
                if (__builtin_amdgcn_s_memrealtime() - t0 > 2000000ull) {
                    if (threadIdx.x == 0) { unsigned expect = 0u; __hip_atomic_compare_exchange_strong(tmo + 1, &expect, 0x600u | (unsigned)(u.pm & 0xff), __ATOMIC_RELAXED, __ATOMIC_RELAXED, __HIP_MEMORY_SCOPE_AGENT); __hip_atomic_store(tmo, 1u, __ATOMIC_RELAXED, __HIP_MEMORY_SCOPE_AGENT); }
                    break; }
                __builtin_amdgcn_s_sleep(2); }
            __builtin_amdgcn_fence(__ATOMIC_ACQUIRE, "agent");
            asm volatile("s_waitcnt vmcnt(0)" ::: "memory");
        }
#if !defined(BROKEN_HOOK_NO_BARRIER)
        asm volatile("" ::: "memory"); __builtin_amdgcn_s_barrier(); asm volatile("" ::: "memory");
#endif
    }
};

__device__ __forceinline__ unsigned cvt_pk_bf16(float lo, float hi) { unsigned r; asm volatile("v_cvt_pk_bf16_f32 %0, %1, %2" : "=v"(r) : "v"(lo), "v"(hi)); return r; }
typedef float f32x2 __attribute__((ext_vector_type(2)));
__device__ __forceinline__ f32x2 gelu_pk(f32x2 v) {
    const f32x2 av = __builtin_elementwise_abs(v), d = av * 0.2316418882f + 1.0f;
    f32x2 t; t.x = __builtin_amdgcn_rcpf(d.x); t.y = __builtin_amdgcn_rcpf(d.y);
    f32x2 q = t * 0.5307027145f + (-0.7265760135f); q = q * t + 0.7107068705f; q = q * t + (-0.142248368f); q = q * t + 0.127414796f; q = q * t;
    const f32x2 s = (v * v) * (-0.72134752044f);
    f32x2 e; e.x = __builtin_amdgcn_exp2f(s.x); e.y = __builtin_amdgcn_exp2f(s.y);
    const f32x2 m = v * (q * e), r = v - m;
    f32x2 o; o.x = v.x < 0.f ? m.x : r.x; o.y = v.y < 0.f ? m.y : r.y; return o;
}
template <class Epi, class Sched, bool STAMP = false>
__device__ __forceinline__ void gemm_phase(PG8_LAS unsigned char* lds, const Gemm g, const Sched& S, const Epi& E, unsigned long long* stamps) {
    const int tid = threadIdx.x, wid = __builtin_amdgcn_readfirstlane(tid >> 6), lane = tid & 63, wr = wid >> 2, wc = wid & 3, fr = lane & 15, fq = lane >> 4;
    const int K = g.K, nt = K / BK;
    int ts_lo = 0, ts_hi = 0, nts = 0; const unsigned long long rt_entry = STAMP ? (unsigned long long)wall_clock64() : 0ull;
#define PG8_STAMP() do { if (STAMP && wid == 0 && nts < 64) { const unsigned long long _c = (unsigned long long)clock64(); \
        ts_lo = (lane == nts) ? (int)(unsigned)_c : ts_lo; ts_hi = (lane == nts) ? (int)(unsigned)(_c >> 32) : ts_hi; ++nts; } } while (0)
    PG8_STAMP();
    unsigned voffA[2], voffB[2];
#pragma unroll
    for (int i = 0; i < 2; ++i) { int R, C; stage_rc(tid * 16 + i * 8192, R, C); const int Rb = Epi::PERM ? ((R & ~31) + perm32(R & 31)) : R;
        voffA[i] = (unsigned)(R * K + C) * 2u; voffB[i] = (unsigned)(Rb * K + C) * 2u; }
    const size_t kstep = (size_t)(BK * 2);
    const size_t hstep = (size_t)HALF * K * 2;
    const size_t tstep = 2 * hstep;
    const unsigned ldsw = (unsigned)wid * 1024u;
    const int aoff = lds_byte(wr * 64 + fr, fq * 8), boff = lds_byte(wc * 32 + fr, fq * 8);
#define PG8_SA(b, h) (((b) * 2 + (h)) * HTB)
#define PG8_SB(b, h) ((4 + (b) * 2 + (h)) * HTB)
#define PG8_STAGE(bufoff, gbase, voff) do { _Pragma("unroll") for (int _i = 0; _i < 2; ++_i) \
        __builtin_amdgcn_global_load_lds((const unsigned*)((const char*)(gbase) + (voff)[_i]), (PG8_LAS unsigned*)(lds + (bufoff) + ldsw + _i * 8192), 16, 0, 0); } while (0)
#define PG8_LDA(dst, b, h) do { _Pragma("unroll") for (int m = 0; m < 4; ++m) _Pragma("unroll") for (int k = 0; k < 2; ++k) dst[m][k] = *(const PG8_LAS bf16x8*)(lds + PG8_SA(b, h) + aoff + m * 2048 + k * 1024); } while (0)
#define PG8_LDB(dst, b, h) do { _Pragma("unroll") for (int n = 0; n < 2; ++n) _Pragma("unroll") for (int k = 0; k < 2; ++k) dst[n][k] = *(const PG8_LAS bf16x8*)(lds + PG8_SB(b, h) + boff + n * 2048 + k * 1024); } while (0)
#define PG8_MMA(ai, bj, At, Bt) do { __builtin_amdgcn_s_setprio(1); _Pragma("unroll") for (int m = 0; m < 4; ++m) _Pragma("unroll") for (int n = 0; n < 2; ++n) _Pragma("unroll") for (int k = 0; k < 2; ++k) \
        acc[ai][bj][m][n] = __builtin_amdgcn_mfma_f32_16x16x32_bf16(Bt[n][k], At[m][k], acc[ai][bj][m][n], 0, 0, 0); __builtin_amdgcn_s_setprio(0); } while (0)
#define PG8_WAIT_V(n) asm volatile("s_waitcnt vmcnt(" #n ")" ::: "memory")
#define PG8_WAIT_L(n) asm volatile("s_waitcnt lgkmcnt(" #n ")" ::: "memory")
#define PG8_BAR __builtin_amdgcn_s_barrier()
#define PG8_SCHED __builtin_amdgcn_sched_barrier(0)
    Unit cur, nxt; int ui = 0;
    if (!S.next(0, cur)) return;
    f32x4 acc[2][2][4][2];
#pragma unroll
    for (int a = 0; a < 2; ++a)
#pragma unroll
        for (int b = 0; b < 2; ++b)
#pragma unroll
            for (int m = 0; m < 4; ++m)
#pragma unroll
                for (int n = 0; n < 2; ++n) acc[a][b][m][n] = (f32x4){0.f, 0.f, 0.f, 0.f};
    bf16x8 At[4][2], B0[2][2], B1[2][2];
    const char* cA = (const char*)g.A + (size_t)cur.pm * tstep; const char* cB = (const char*)g.Bt + (size_t)cur.pn * tstep;
    S.a_ready(cur);
    PG8_STAGE(PG8_SB(0, 0), cB, voffB); PG8_STAGE(PG8_SA(0, 0), cA, voffA); PG8_STAGE(PG8_SB(0, 1), cB + hstep, voffB); PG8_STAGE(PG8_SA(0, 1), cA + hstep, voffA);
    if (wr == 1) PG8_BAR;
    PG8_WAIT_V(4); PG8_BAR;
    PG8_STAGE(PG8_SB(1, 0), cB + kstep, voffB); PG8_STAGE(PG8_SA(1, 0), cA + kstep, voffA); PG8_STAGE(PG8_SB(1, 1), cB + hstep + kstep, voffB);
    PG8_WAIT_V(6); PG8_BAR;
    PG8_STAMP();
    for (;;) {
        const bool has_next = S.next(ui + 1, nxt);
        const char* nA = has_next ? (const char*)g.A + (size_t)nxt.pm * tstep : cA; const char* nB = has_next ? (const char*)g.Bt + (size_t)nxt.pn * tstep : cB;
        for (int t = 0; t < nt; t += 2) {
            const bool last = (t == nt - 2);
            const char* a1 = cA + (size_t)(t + 1) * kstep;
            const char* a2 = last ? nA : cA + (size_t)(t + 2) * kstep; const char* b2 = last ? nB : cB + (size_t)(t + 2) * kstep;
            const char* a3 = a2 + kstep; const char* b3 = b2 + kstep;
            if (last && has_next) S.a_ready(nxt);
            PG8_LDB(B0, 0, 0); PG8_SCHED; PG8_LDA(At, 0, 0); PG8_STAGE(PG8_SA(1, 1), a1 + hstep, voffA);
            PG8_WAIT_L(8); PG8_BAR; PG8_WAIT_L(0); PG8_MMA(0, 0, At, B0); PG8_BAR; PG8_SCHED;
            PG8_LDB(B1, 0, 1); PG8_STAGE(PG8_SB(0, 0), b2, voffB);
            PG8_BAR; PG8_WAIT_L(0); PG8_MMA(0, 1, At, B1); PG8_BAR;
            PG8_LDA(At, 0, 1); PG8_STAGE(PG8_SA(0, 0), a2, voffA);
            PG8_BAR; PG8_WAIT_L(0); PG8_MMA(1, 0, At, B0); PG8_BAR; PG8_SCHED;
            PG8_STAGE(PG8_SB(0, 1), b2 + hstep, voffB);
            PG8_WAIT_V(6); PG8_BAR; PG8_MMA(1, 1, At, B1); PG8_BAR;
            PG8_LDB(B0, 1, 0); PG8_SCHED; PG8_LDA(At, 1, 0); PG8_STAGE(PG8_SA(0, 1), a2 + hstep, voffA);
            PG8_WAIT_L(8); PG8_BAR; PG8_WAIT_L(0); PG8_MMA(0, 0, At, B0); PG8_BAR; PG8_SCHED;
            PG8_LDB(B1, 1, 1); PG8_STAGE(PG8_SB(1, 0), b3, voffB);
            PG8_BAR; PG8_WAIT_L(0); PG8_MMA(0, 1, At, B1); PG8_BAR;
            PG8_LDA(At, 1, 1); PG8_STAGE(PG8_SA(1, 0), a3, voffA);
            PG8_BAR; PG8_WAIT_L(0); PG8_MMA(1, 0, At, B0); PG8_BAR; PG8_SCHED;
            PG8_STAGE(PG8_SB(1, 1), b3 + hstep, voffB);
            PG8_WAIT_V(6); PG8_BAR; PG8_MMA(1, 1, At, B1); PG8_BAR;
        }
        PG8_STAMP();
        if constexpr (!Epi::AFTER_DRAIN) {
            if constexpr (Epi::REALIGN) { if (wr == 0) PG8_BAR; }
            E(acc, cur, wr, wc, fr, fq); S.done(cur);
            if constexpr (Epi::REALIGN) { if (wr == 1) PG8_BAR; }
        }
        PG8_STAMP();
        if (!has_next) break;
#pragma unroll
        for (int a = 0; a < 2; ++a)
#pragma unroll
            for (int b = 0; b < 2; ++b)
#pragma unroll
                for (int m = 0; m < 4; ++m)
#pragma unroll
                    for (int n = 0; n < 2; ++n) acc[a][b][m][n] = (f32x4){0.f, 0.f, 0.f, 0.f};
        cur = nxt; cA = nA; cB = nB; ++ui;
    }
    PG8_WAIT_V(0);
    if (wr == 0) PG8_BAR;
    PG8_BAR;
    if constexpr (Epi::AFTER_DRAIN) { E.fused(acc, cur, wr, wc, fr, fq, lds, wid, lane); S.done(cur); }
    PG8_STAMP();
    if (STAMP && wid == 0) { stamps[lane] = lane < nts ? (((unsigned long long)(unsigned)ts_hi << 32) | (unsigned)ts_lo) : 0ull;
        if (lane == 62) stamps[62] = rt_entry; if (lane == 63) stamps[63] = (unsigned long long)wall_clock64(); }
#undef PG8_STAMP
#undef PG8_SA
#undef PG8_SB
#undef PG8_STAGE
#undef PG8_LDA
#undef PG8_LDB
#undef PG8_MMA
#undef PG8_WAIT_V
#undef PG8_WAIT_L
#undef PG8_BAR
#undef PG8_SCHED
}
}
#define LAS __attribute__((address_space(3)))
#define XB_TMO      128
#define XB_XCNT(j)  (256  + 64 * (j))
#define XB_XSUB(j)  (1280 + 64 * (j))
#define XB_XGEN(j)  (2304 + 64 * (j))
#define XB_TOP      3328
#define XB_TOPGEN   3392
#define XCD_BAR_WORDS 3456
#define XB_SPIN_CAP (1u << 18)

__device__ __forceinline__ unsigned xb_ld(unsigned* p)              { return __hip_atomic_load(p, __ATOMIC_RELAXED, __HIP_MEMORY_SCOPE_AGENT); }
__device__ __forceinline__ unsigned xb_add(unsigned* p, unsigned v) { return __hip_atomic_fetch_add(p, v, __ATOMIC_RELAXED, __HIP_MEMORY_SCOPE_AGENT); }
__device__ __forceinline__ unsigned xb_xcc_id() { return (unsigned)__builtin_amdgcn_s_getreg((3 << 11) | 20) & 0xFu; }
#define XB_SPIN(cond, bar) do { unsigned _sp = 0; while (cond) { __builtin_amdgcn_s_sleep(1); \
    if ((++_sp & 255u) == 0u) { if (xb_ld(&(bar)[XB_TMO])) break; if (_sp > XB_SPIN_CAP) { atomicAdd(&(bar)[XB_TMO], 1u); break; } } } } while (0)

struct XcdBarrier {
    unsigned* bar; unsigned x;
    volatile LAS unsigned* st;
};

__device__ __forceinline__ XcdBarrier xcd_barrier_post(unsigned* bar, volatile LAS unsigned* st) {
    XcdBarrier b; b.bar = bar; b.x = xb_xcc_id(); b.st = st;
    if (threadIdx.x == 0) (void)xb_add(&bar[XB_XCNT(b.x)], 1u);
    return b;
}
__device__ __forceinline__ void xcd_barrier_complete(unsigned* bar, unsigned x, unsigned& nloc, unsigned& nx) {
    const unsigned G = gridDim.x * gridDim.y * gridDim.z;
    unsigned sum, cnt, mine, sp = 0u;
    for (;;) {
        sum = 0u; cnt = 0u; mine = 0u;
#pragma unroll
        for (unsigned j = 0; j < 16; ++j) { const unsigned c = xb_ld(&bar[XB_XCNT(j)]); sum += c; cnt += (c > 0u) ? 1u : 0u; mine = (j == x) ? c : mine; }
        if (sum == G) break;
        __builtin_amdgcn_s_sleep(1);
        if ((++sp & 255u) == 0u) { if (xb_ld(&bar[XB_TMO])) break; if (sp > XB_SPIN_CAP) { atomicAdd(&bar[XB_TMO], 1u); break; } }
    }
    nloc = mine > 0u ? mine : 1u; nx = cnt > 0u ? cnt : 1u;
}

__device__ __forceinline__ void xcd_barrier(const XcdBarrier& b) {
    asm volatile("s_waitcnt vmcnt(0)" ::: "memory");
    __syncthreads();
    if (threadIdx.x == 0) {
        unsigned* bar = b.bar;
        __builtin_amdgcn_s_waitcnt(0);
        unsigned nloc = b.st[0], nx = b.st[1];
        if (nloc == 0u) { xcd_barrier_complete(bar, b.x, nloc, nx); b.st[0] = nloc; b.st[1] = nx; }
        const unsigned old = xb_add(&bar[XB_XSUB(b.x)], 1u);
        const unsigned gen = old / nloc;
        if (old + 1u == (gen + 1u) * nloc) {
            __builtin_amdgcn_fence(__ATOMIC_RELEASE, "agent");
            asm volatile("s_waitcnt vmcnt(0)" ::: "memory");
            const unsigned og = xb_add(&bar[XB_TOP], 1u);
            const unsigned tg = og / nx;
            if (og + 1u == (tg + 1u) * nx) xb_add(&bar[XB_TOPGEN], 1u);
            else XB_SPIN(xb_ld(&bar[XB_TOPGEN]) == tg, bar);
            __builtin_amdgcn_fence(__ATOMIC_ACQUIRE, "agent");
            xb_add(&bar[XB_XGEN(b.x)], 1u);
            asm volatile("s_waitcnt vmcnt(0)" ::: "memory");
        } else {
            XB_SPIN(xb_ld(&bar[XB_XGEN(b.x)]) == gen, bar);
            __builtin_amdgcn_fence(__ATOMIC_ACQUIRE, "agent");
            asm volatile("s_waitcnt vmcnt(0)" ::: "memory");
        }
    }
    __syncthreads();
}


#define DI __device__ __forceinline__

using pg8::bf16_t; using pg8::bf16x8; using pg8::f32x4; using pg8::f32x2; using pg8::u32x4; using pg8::Unit;
typedef unsigned u32x2 __attribute__((ext_vector_type(2)));
typedef short s16x4 __attribute__((ext_vector_type(4)));
typedef __bf16 bf2_t __attribute__((ext_vector_type(2)));

constexpr int NB = 8, T = 4096, D = 1024, NTOK = NB * T, CTXL = 256, NCTX = NB * CTXL, NP = 3072, NC = 32;
constexpr int NTHREADS = 512;
constexpr int LDS_BYTES = 147456 + 256;
constexpr float EPS = 1e-6f, LOG2E = 1.4426950408889634f;

constexpr size_t al256(size_t x) { return (x + 255) & ~(size_t)255; }
constexpr size_t WS_MOD  = 0;
constexpr size_t WS_ROPE = WS_MOD + al256(9 * 3072 * 4);
constexpr size_t WS_WIN  = WS_ROPE + 8192;
constexpr size_t WS_WOUT = WS_WIN + (size_t)3072 * 1024 * 2;
constexpr size_t WS_WSB  = WS_WOUT + (size_t)1024 * 1024 * 2;
constexpr size_t WS_H    = WS_WSB + (size_t)4 * 128 * 128 * 2;
constexpr size_t WS_Q    = WS_H + (size_t)(NTOK + NCTX) * 1024 * 2;
constexpr size_t WS_K    = WS_Q + (size_t)NTOK * 256 * 2;
constexpr size_t WS_V    = WS_K + (size_t)NTOK * 256 * 2;
constexpr size_t WS_GR   = WS_V + (size_t)NTOK * 512 * 2;
constexpr size_t WS_U    = WS_GR + (size_t)NTOK * 512 * 2;
constexpr size_t WS_VG   = WS_U + (size_t)NTOK * 512 * 2;
constexpr size_t WS_GM   = WS_VG + (size_t)NTOK * 512 * 2;
constexpr size_t WS_KC   = WS_GM + (size_t)NTOK * 512 * 2;
constexpr size_t WS_VC   = WS_KC + (size_t)NCTX * 256 * 2;
constexpr size_t WS_KV   = WS_VC + (size_t)NCTX * 512 * 2;
constexpr size_t WS_KVC  = WS_KV + (size_t)1024 * 2 * 8192 * 4;
constexpr size_t WS_ST   = WS_KVC + (size_t)64 * 2 * 8192 * 4;
constexpr size_t WS_BAR  = WS_ST + (size_t)1024 * 2 * 8192 * 2;
constexpr size_t WS_CNT  = WS_BAR + (size_t)XCD_BAR_WORDS * 4;
constexpr size_t WS_SLOT = WS_CNT + 32768;
constexpr size_t WS_END  = WS_SLOT + (size_t)NTOK * 16 * 4;

struct Args {
    const float* x; const float* c; const float* ctx; const float* c_ctx; const float* w_ada; const float* b_ada; const float* norm_w; const float* w_in;
    const float* dec_f; const float* dec_b; const float* gn_w; const float* ln_w; const float* w_s; const float* b_s; const float* w_out; const float* fnorm_w;
    float* out; unsigned char* ws; int ph_lo, ph_hi;
};

DI unsigned pk2(float lo, float hi) { f32x2 v = {lo, hi}; bf2_t r = __builtin_convertvector(v, bf2_t); return __builtin_bit_cast(unsigned, r); }
DI f32x4 ldnt_f4(const float* p) { return __builtin_nontemporal_load((const f32x4*)p); }
DI u32x4 ldnt_u4(const void* p) { return __builtin_nontemporal_load((const u32x4*)p); }
DI u32x2 ldnt_u2(const void* p) { return __builtin_nontemporal_load((const u32x2*)p); }
DI float bflo(unsigned w) { return __uint_as_float(w << 16); }
DI float bfhi(unsigned w) { return __uint_as_float(w & 0xffff0000u); }
DI float silu_f(float v) { return v * __builtin_amdgcn_rcpf(1.0f + __expf(-v)); }
DI void lds_barrier() { asm volatile("s_waitcnt lgkmcnt(0)" ::: "memory"); __builtin_amdgcn_s_barrier(); asm volatile("" ::: "memory"); }
DI f32x4 mfma16(bf16x8 a, bf16x8 b, f32x4 c) { return __builtin_amdgcn_mfma_f32_16x16x32_bf16(a, b, c, 0, 0, 0); }

DI bf16x8 frag_tr(LAS const unsigned char* base, int S, int k0, int n0, int lane) {
    const int i = lane & 15, g = lane >> 4;
    LAS const unsigned char* p = base + (k0 + 4 * g + (i >> 2)) * S + (n0 + 4 * (i & 3)) * 2;
    const s16x4 lo = __builtin_amdgcn_ds_read_tr16_b64_v4i16((LAS s16x4*)p);
    const s16x4 hi = __builtin_amdgcn_ds_read_tr16_b64_v4i16((LAS s16x4*)(p + 16 * S));
    return __builtin_shufflevector(lo, hi, 0, 1, 2, 3, 4, 5, 6, 7);
}
DI bf16x8 frag_rowP(const bf16_t* rowk0, int g) {
    const u32x2 lo = *(const u32x2*)(rowk0 + 4 * g), hi = *(const u32x2*)(rowk0 + 16 + 4 * g);
    const u32x4 v = {lo.x, lo.y, hi.x, hi.y}; return __builtin_bit_cast(bf16x8, v);
}
DI bf16x8 frag_rowP_lds(LAS const unsigned char* rowk0, int g) {
    const u32x2 lo = *(LAS const u32x2*)(rowk0 + 8 * g), hi = *(LAS const u32x2*)(rowk0 + 32 + 8 * g);
    const u32x4 v = {lo.x, lo.y, hi.x, hi.y}; return __builtin_bit_cast(bf16x8, v);
}
DI bf16x8 scale_frag(bf16x8 f, float s) {
    const u32x4 u = __builtin_bit_cast(u32x4, f); u32x4 r;
#pragma unroll
    for (int q = 0; q < 4; ++q) r[q] = pk2(bflo(u[q]) * s, bfhi(u[q]) * s);
    return __builtin_bit_cast(bf16x8, r);
}

struct EpiIn {
    static constexpr bool PERM = true, AFTER_DRAIN = false, REALIGN = false;
    unsigned char* ws;
    DI void operator()(const f32x4 (&acc)[2][2][4][2], const Unit& u, int wr, int wc, int fr, int fq) const {
        const int pn = u.pn, rbase = u.pm * 256 + wr * 64 + fr, cbase = wc * 32 + 8 * fq;
        if (u.pm >= 128) {
            bf16_t* dst = (bf16_t*)(ws + (pn == 1 ? WS_KC : WS_VC));
            const float scl = pn == 1 ? 0.125f : 1.0f;
#pragma unroll
            for (int ai = 0; ai < 2; ++ai)
#pragma unroll
                for (int m = 0; m < 4; ++m) {
                    const int rc = rbase + ai * 128 + m * 16 - NTOK, b = rc >> 8, t = rc & 255;
#pragma unroll
                    for (int bj = 0; bj < 2; ++bj) {
                        const f32x4 v0 = acc[ai][bj][m][0] * scl, v1 = acc[ai][bj][m][1] * scl;
                        const u32x4 o = {pk2(v0[0], v0[1]), pk2(v0[2], v0[3]), pk2(v1[0], v1[1]), pk2(v1[2], v1[3])};
                        size_t off;
                        if (pn == 1) { const int head = bj * 2 + (wc >> 1), d0 = (wc & 1) * 32 + 8 * fq; off = ((size_t)((b * 4 + head) * 256 + t)) * 64 + d0; }
                        else { const int head = (pn - 2) * 2 + bj; off = ((size_t)(((b * 4 + head) * 8 + (cbase >> 4)) * 256 + t)) * 16 + (cbase & 15); }
                        *(u32x4*)(dst + off) = o;
                    }
                }
            return;
        }
        if (pn <= 1) {
            bf16_t* dst = (bf16_t*)(ws + (pn == 0 ? WS_Q : WS_K));
            const float scl = pn == 0 ? 1.0f : 0.125f;
            const float* rc = (const float*)(ws + WS_ROPE); const float* rs = rc + 1024;
            const int hh = wc & 1, fi0 = 8 * (fq & 1); const bool second = fq >= 2;
#pragma unroll
            for (int ai = 0; ai < 2; ++ai)
#pragma unroll
                for (int m = 0; m < 4; ++m) {
                    const int r = rbase + ai * 128 + m * 16, b = r >> 12, t = r & 4095, pos = hh ? (t & 63) : (t >> 6);
                    const f32x4 c0 = *(const f32x4*)(rc + pos * 16 + fi0), c1 = *(const f32x4*)(rc + pos * 16 + fi0 + 4);
                    const f32x4 s0 = *(const f32x4*)(rs + pos * 16 + fi0), s1 = *(const f32x4*)(rs + pos * 16 + fi0 + 4);
#pragma unroll
                    for (int bj = 0; bj < 2; ++bj) {
                        const f32x4 v0 = acc[ai][bj][m][0], v1 = acc[ai][bj][m][1];
                        float o[8];
#pragma unroll
                        for (int j = 0; j < 4; ++j) {
                            const float xa = v0[j], xb = v1[j], pa = __shfl_xor(xa, 32), pb = __shfl_xor(xb, 32);
                            o[j]     = (second ? (pa * s0[j] + xa * c0[j]) : (xa * c0[j] - pa * s0[j])) * scl;
                            o[4 + j] = (second ? (pb * s1[j] + xb * c1[j]) : (xb * c1[j] - pb * s1[j])) * scl;
                        }
                        const u32x4 ov = {pk2(o[0], o[1]), pk2(o[2], o[3]), pk2(o[4], o[5]), pk2(o[6], o[7])};
                        const int head = bj * 2 + (wc >> 1), d0 = hh * 32 + 8 * fq;
                        *(u32x4*)(dst + ((size_t)((b * 4 + head) * 4096 + t)) * 64 + d0) = ov;
                    }
                }
            return;
        }
        if (pn <= 3) {
            bf16_t* dst = (bf16_t*)(ws + WS_V);
#pragma unroll
            for (int ai = 0; ai < 2; ++ai)
#pragma unroll
                for (int m = 0; m < 4; ++m) {
                    const int r = rbase + ai * 128 + m * 16, b = r >> 12, t = r & 4095;
#pragma unroll
                    for (int bj = 0; bj < 2; ++bj) {
                        const f32x4 v0 = acc[ai][bj][m][0], v1 = acc[ai][bj][m][1];
                        const u32x4 o = {pk2(v0[0], v0[1]), pk2(v0[2], v0[3]), pk2(v1[0], v1[1]), pk2(v1[2], v1[3])};
                        const int head = (pn - 2) * 2 + bj;
                        *(u32x4*)(dst + ((size_t)(((b * 4 + head) * 8 + (cbase >> 4)) * 4096 + t)) * 16 + (cbase & 15)) = o;
                    }
                }
            return;
        }
        if (pn == 6 || pn == 7 || pn >= 10) {
            const int t = pn == 6 ? 0 : (pn == 7 ? 1 : (pn == 10 ? 2 : 3));
            bf16_t* dst = (bf16_t*)(ws + WS_U);
#pragma unroll
            for (int ai = 0; ai < 2; ++ai)
#pragma unroll
                for (int m = 0; m < 4; ++m) {
                    const int r = rbase + ai * 128 + m * 16;
                    const f32x4 u0 = acc[ai][0][m][0], u1 = acc[ai][0][m][1], g0 = acc[ai][1][m][0], g1 = acc[ai][1][m][1];
                    const f32x2 a0 = pg8::gelu_pk((f32x2){u0[0], u0[1]}), a1 = pg8::gelu_pk((f32x2){u0[2], u0[3]}), a2 = pg8::gelu_pk((f32x2){u1[0], u1[1]}), a3 = pg8::gelu_pk((f32x2){u1[2], u1[3]});
                    const u32x4 o = {pk2(a0.x * silu_f(g0[0]), a0.y * silu_f(g0[1])), pk2(a1.x * silu_f(g0[2]), a1.y * silu_f(g0[3])),
                                     pk2(a2.x * silu_f(g1[0]), a2.y * silu_f(g1[1])), pk2(a3.x * silu_f(g1[2]), a3.y * silu_f(g1[3]))};
                    *(u32x4*)(dst + (size_t)r * 512 + 128 * t + cbase) = o;
                }
            return;
        }
        {
            const int region = (pn - 4) >> 1; const bool is_gelu = (region == 1) || (region == 2);
            bf16_t* dst = (bf16_t*)(ws + WS_GR + (size_t)region * ((size_t)NTOK * 512 * 2));
            const int colb = ((pn - 4) & 1) * 256 + cbase;
#pragma unroll
            for (int ai = 0; ai < 2; ++ai)
#pragma unroll
                for (int m = 0; m < 4; ++m) {
                    const int r = rbase + ai * 128 + m * 16;
#pragma unroll
                    for (int bj = 0; bj < 2; ++bj) {
                        const f32x4 v0 = acc[ai][bj][m][0], v1 = acc[ai][bj][m][1];
                        u32x4 o;
                        if (is_gelu) {
                            const f32x2 a = pg8::gelu_pk((f32x2){v0[0], v0[1]}), bq = pg8::gelu_pk((f32x2){v0[2], v0[3]}), cq = pg8::gelu_pk((f32x2){v1[0], v1[1]}), dq = pg8::gelu_pk((f32x2){v1[2], v1[3]});
                            o = (u32x4){pk2(a.x, a.y), pk2(bq.x, bq.y), pk2(cq.x, cq.y), pk2(dq.x, dq.y)};
                        } else {
                            o = (u32x4){pk2(silu_f(v0[0]), silu_f(v0[1])), pk2(silu_f(v0[2]), silu_f(v0[3])), pk2(silu_f(v1[0]), silu_f(v1[1])), pk2(silu_f(v1[2]), silu_f(v1[3]))};
                        }
                        *(u32x4*)(dst + (size_t)r * 512 + colb + bj * 128) = o;
                    }
                }
        }
    }
};
struct EpiOut {
    static constexpr bool PERM = false, AFTER_DRAIN = false, REALIGN = true;
    const float* x; const float* mod; const float* fw; float* out; float* slots; unsigned* cnt;
    DI void operator()(const f32x4 (&acc_)[2][2][4][2], const Unit& u, int wr, int wc, int fr, int fq) const {
        f32x4 (&acc)[2][2][4][2] = const_cast<f32x4 (&)[2][2][4][2]>(acc_);
        const int rbase = u.pm * 256 + wr * 64 + fr, cbase = u.pn * 256 + wc * 32 + 4 * fq;
        const float* gate = mod + (size_t)(rbase >> 12) * 3072 + 2048;
        f32x4 gv[2][2];
#pragma unroll
        for (int bj = 0; bj < 2; ++bj)
#pragma unroll
            for (int n = 0; n < 2; ++n) gv[bj][n] = *(const f32x4*)(gate + cbase + bj * 128 + n * 16);
        f32x4 xv[2][4]; float ss[8];
#pragma unroll
        for (int q = 0; q < 4; ++q) xv[0][q] = ldnt_f4(x + (size_t)rbase * 1024 + cbase + (q >> 1) * 128 + (q & 1) * 16);
#pragma unroll
        for (int k = 0; k < 8; ++k) {
            const int ai = k >> 2, m = k & 3;
            if (k + 1 < 8) {
                const size_t ro = (size_t)(rbase + ((k + 1) >> 2) * 128 + ((k + 1) & 3) * 16) * 1024 + cbase;
#pragma unroll
                for (int q = 0; q < 4; ++q) xv[(k + 1) & 1][q] = ldnt_f4(x + ro + (q >> 1) * 128 + (q & 1) * 16);
            }
            float sk = 0.f;
#pragma unroll
            for (int q = 0; q < 4; ++q) {
                const int bj = q >> 1, n = q & 1;
                const f32x4 v = xv[k & 1][q] + gv[bj][n] * acc[ai][bj][m][n];
                acc[ai][bj][m][n] = v;
                sk += v[0] * v[0] + v[1] * v[1] + v[2] * v[2] + v[3] * v[3];
            }
            ss[k] = sk;
        }
#pragma unroll
        for (int k = 0; k < 8; ++k) { ss[k] += __shfl_xor(ss[k], 16); ss[k] += __shfl_xor(ss[k], 32); }
        if (fq == 0) {
#pragma unroll
            for (int k = 0; k < 8; ++k)
                __hip_atomic_store(slots + (size_t)(rbase + (k >> 2) * 128 + (k & 3) * 16) * 16 + u.pn * 4 + wc, ss[k], __ATOMIC_RELAXED, __HIP_MEMORY_SCOPE_AGENT);
        }
        asm volatile("s_waitcnt vmcnt(0)" ::: "memory");
        if ((threadIdx.x & 63) == 0) {
            __hip_atomic_fetch_add(cnt + u.pm * 64, 1u, __ATOMIC_RELAXED, __HIP_MEMORY_SCOPE_AGENT);
            unsigned spins = 0;
            while (__hip_atomic_load(cnt + u.pm * 64, __ATOMIC_RELAXED, __HIP_MEMORY_SCOPE_AGENT) < 32u) { __builtin_amdgcn_s_sleep(8); if (++spins > (1u << 22)) break; }
        }
        __builtin_amdgcn_fence(__ATOMIC_ACQUIRE, "agent");
        asm volatile("s_waitcnt vmcnt(0)" ::: "memory");
        f32x4 sl[8];
#pragma unroll
        for (int k = 0; k < 8; ++k) sl[k] = *(const f32x4*)(slots + (size_t)(rbase + (k >> 2) * 128 + (k & 3) * 16) * 16 + fq * 4);
        f32x4 fv[2][2];
#pragma unroll
        for (int bj = 0; bj < 2; ++bj)
#pragma unroll
            for (int n = 0; n < 2; ++n) fv[bj][n] = *(const f32x4*)(fw + cbase + bj * 128 + n * 16);
        float rs[8];
#pragma unroll
        for (int k = 0; k < 8; ++k) {
            float t = (sl[k][0] + sl[k][1]) + (sl[k][2] + sl[k][3]);
            t += __shfl_xor(t, 16); t += __shfl_xor(t, 32);
            rs[k] = rsqrtf(t * (1.0f / 1024.0f) + EPS);
        }
#pragma unroll
        for (int k = 0; k < 8; ++k) {
            const int ai = k >> 2, m = k & 3;
            const size_t ro = (size_t)(rbase + ai * 128 + m * 16) * 1024 + cbase;
#pragma unroll
            for (int bj = 0; bj < 2; ++bj)
#pragma unroll
                for (int n = 0; n < 2; ++n) __builtin_nontemporal_store(acc[ai][bj][m][n] * rs[k] * fv[bj][n], (f32x4*)(out + ro + bj * 128 + n * 16));
        }
    }
};
struct SchedIn {
    pg8::StaticOrder so;
    DI bool next(int i, Unit& u) const {
        if (so.G == 256) {
            const int x = so.c & 7, j = so.c >> 3;
            if (j < 3) {
                if (i == 0) { u.pm = 128 + x; u.pn = 1 + j; return true; }
                if (i > 6) return false;
                const int q = 6 * j + (i - 1);
                u.pm = 16 * x + (q >> 2); u.pn = q & 3; return true;
            }
            if (i > 5) return false;
            const int e = (j - 3) + 29 * i;
            if (e < 64) { u.pm = 16 * x + (e >> 2); u.pn = 6 + (e & 3); }
            else if (e < 128) { const int t = e & 3; u.pm = 16 * x + ((e - 64) >> 2); u.pn = t < 2 ? 4 + t : 8 + t; }
            else { const int q = 18 + (e - 128); u.pm = 16 * x + (q >> 2); u.pn = q & 3; }
            return true;
        }
        long L = (long)i * so.G + so.c;
        if (L < so.nwg) return so.next(i, u);
        L -= so.nwg; if (L >= 24) return false;
        u.pm = 128 + (int)(L / 3); u.pn = 1 + (int)(L % 3); return true;
    }
    DI void a_ready(const Unit&) const {}
    DI void done(const Unit&) const {}
};

DI void phase0(const Args& a, LAS unsigned char* lds) {
    const int tid = threadIdx.x;
    float* mod = (float*)(a.ws + WS_MOD);
    LAS float* red = (LAS float*)lds;
    for (int it = blockIdx.x; it < 1233; it += gridDim.x) {
        if (it < 192) {
            const int c0 = it * 16, f = tid & 3, rg = tid >> 2;
            LAS float* scv = red + 36 * 512;
            for (int q = tid; q < 9 * 1024; q += NTHREADS) { const float cv = (q < 8192) ? a.c[q] : a.c_ctx[q - 8192]; scv[q] = cv / (1.0f + expf(-cv)); }
            __syncthreads();
            float acc[9][4];
#pragma unroll
            for (int j = 0; j < 9; ++j)
#pragma unroll
                for (int e = 0; e < 4; ++e) acc[j][e] = 0.f;
            f32x4 wv[8];
#pragma unroll
            for (int i = 0; i < 8; ++i) wv[i] = ldnt_f4(a.w_ada + (size_t)(rg + 128 * i) * 3072 + c0 + f * 4);
#pragma unroll
            for (int i = 0; i < 8; ++i) {
                const int r = rg + 128 * i;
#pragma unroll
                for (int j = 0; j < 9; ++j) {
                    const float sv = scv[j * 1024 + r];
#pragma unroll
                    for (int e = 0; e < 4; ++e) acc[j][e] += sv * wv[i][e];
                }
            }
#pragma unroll
            for (int j = 0; j < 9; ++j)
#pragma unroll
                for (int e = 0; e < 4; ++e) red[(j * 4 + e) * 512 + tid] = acc[j][e];
            __syncthreads();
            if (tid < 144) {
                const int j = tid >> 4, cc = tid & 15, ff = cc >> 2, e = cc & 3;
                float s = 0.f;
                for (int q = 0; q < 128; ++q) s += red[(j * 4 + e) * 512 + q * 4 + ff];
                mod[j * 3072 + c0 + cc] = s + a.b_ada[c0 + cc];
            }
            __syncthreads();
        } else if (it < 1216) {
            const bool is_in = it < 960; const int tt = is_in ? it - 192 : it - 960;
            const int nN = is_in ? 48 : 16, NN = is_in ? 3072 : 1024;
            const int k0 = (tt / nN) * 64, n0 = (tt % nN) * 64;
            int ns = n0;
            if (is_in && ((n0 >= 1536 && n0 < 2048) || n0 >= 2560)) {
                const int base = n0 >= 2560 ? 2560 : 1536, t = (n0 >= 2560 ? 2 : 0) + (n0 - base) / 256, w = (n0 - base) % 256;
                ns = (w < 128 ? 1536 : 2560 - 128) + 128 * t + w;
            }
            const float* src = is_in ? a.w_in : a.w_out;
            bf16_t* dst = (bf16_t*)(a.ws + (is_in ? WS_WIN : WS_WOUT));
            const int kr = tid >> 4, n4 = tid & 15;
#pragma unroll
            for (int p = 0; p < 2; ++p) {
                const int k = kr + 32 * p;
                const f32x4 v = ldnt_f4(src + (size_t)(k0 + k) * NN + ns + n4 * 4);
#pragma unroll
                for (int e = 0; e < 4; ++e) red[k * 65 + n4 * 4 + e] = v[e];
            }
            __syncthreads();
            const int n = tid >> 3, k8 = tid & 7;
            float v[8];
#pragma unroll
            for (int j = 0; j < 8; ++j) v[j] = red[(k8 * 8 + j) * 65 + n];
            const u32x4 o = {pk2(v[0], v[1]), pk2(v[2], v[3]), pk2(v[4], v[5]), pk2(v[6], v[7])};
            *(u32x4*)(dst + (size_t)(n0 + n) * 1024 + k0 + k8 * 8) = o;
            __syncthreads();
        } else if (it < 1232) {
            const size_t base = (size_t)(it - 1216) * 4096 + tid * 8;
            const f32x4 v0 = *(const f32x4*)(a.w_s + base), v1 = *(const f32x4*)(a.w_s + base + 4);
            const u32x4 o = {pk2(v0[0], v0[1]), pk2(v0[2], v0[3]), pk2(v1[0], v1[1]), pk2(v1[2], v1[3])};
            *(u32x4*)((bf16_t*)(a.ws + WS_WSB) + base) = o;
        } else {
            float* rc = (float*)(a.ws + WS_ROPE); float* rs = rc + 1024;
            for (int idx = tid; idx < 1024; idx += NTHREADS) {
                const int pos = idx >> 4, fi = idx & 15;
                const float inv = powf(10000.0f, -(float)fi / 16.0f), ang = (float)pos * inv;
                rc[idx] = cosf(ang); rs[idx] = sinf(ang);
            }
        }
    }
}

template <int R> DI void norm_rows(const Args& a, const float* mod, bf16_t* H, const int (&rows)[R], int lane) {
    f32x4 v[R][4]; const float* mrow[R];
#pragma unroll
    for (int k = 0; k < R; ++k) {
        const int r = rows[k]; const float* src; int j;
        if (r < NTOK) { src = a.x + (size_t)r * 1024; j = r >> 12; } else { src = a.ctx + (size_t)(r - NTOK) * 1024; j = 8; }
        mrow[k] = mod + j * 3072;
#pragma unroll
        for (int q = 0; q < 4; ++q) v[k][q] = ldnt_f4(src + q * 256 + lane * 4);
    }
#pragma unroll
    for (int k = 0; k < R; ++k) {
        float ss = 0.f;
#pragma unroll
        for (int q = 0; q < 4; ++q) ss += v[k][q][0] * v[k][q][0] + v[k][q][1] * v[k][q][1] + v[k][q][2] * v[k][q][2] + v[k][q][3] * v[k][q][3];
#pragma unroll
        for (int off = 32; off >= 1; off >>= 1) ss += __shfl_xor(ss, off);
        const float rstd = rsqrtf(ss * (1.0f / 1024.0f) + EPS);
#pragma unroll
        for (int q = 0; q < 4; ++q) {
            const int cidx = q * 256 + lane * 4;
            const f32x4 nw = *(const f32x4*)(a.norm_w + cidx), sc = *(const f32x4*)(mrow[k] + 1024 + cidx), sh = *(const f32x4*)(mrow[k] + cidx);
            f32x4 hv;
#pragma unroll
            for (int e = 0; e < 4; ++e) hv[e] = (v[k][q][e] * rstd * nw[e]) * (1.0f + sc[e]) + sh[e];
            const u32x2 o = {pk2(hv[0], hv[1]), pk2(hv[2], hv[3])};
            *(u32x2*)(H + (size_t)rows[k] * 1024 + cidx) = o;
        }
    }
}
DI void norm_row(const Args& a, const float* mod, bf16_t* H, int r, int lane) { const int rows[1] = {r}; norm_rows<1>(a, mod, H, rows, lane); }
DI void phase1(const Args& a) {
    const int tid = threadIdx.x, wave = tid >> 6, lane = tid & 63, blk = blockIdx.x, G = gridDim.x;
    const float* mod = (const float*)(a.ws + WS_MOD);
    bf16_t* H = (bf16_t*)(a.ws + WS_H);
    constexpr int NCH = (NTOK + NCTX) / 8;
    int ch = blk;
    for (; ch + 3 * G < NCH; ch += 4 * G) { const int rows[4] = {ch * 8 + wave, (ch + G) * 8 + wave, (ch + 2 * G) * 8 + wave, (ch + 3 * G) * 8 + wave}; norm_rows<4>(a, mod, H, rows, lane); }
    for (; ch < NCH; ch += G) norm_row(a, mod, H, ch * 8 + wave, lane);
}

constexpr int VS = 288, KS = 144, KS2 = 160;
DI void gmlp_unit(const Args& a, LAS unsigned char* lds, int b, int c) {
    const int tid = threadIdx.x, lane = tid & 63, w = tid >> 6, i = lane & 15, g = lane >> 4;
    const int r0 = b * 4096 + c * 128;
    const bf16_t* VG = (const bf16_t*)(a.ws + WS_VG); const bf16_t* U = (const bf16_t*)(a.ws + WS_U);
    const bf16_t* WSB = (const bf16_t*)(a.ws + WS_WSB); bf16_t* Y = (bf16_t*)(a.ws + WS_H);
    constexpr int GSZ = 128 * VS;
    {
        const int row = tid >> 2, q = tid & 3;
        const bf16_t* src = VG + (size_t)(r0 + row) * 512 + q * 8;
        float s = 0.f, s2 = 0.f;
#pragma unroll 8
        for (int p = 0; p < 16; ++p) {
            const u32x4 pc = *(const u32x4*)(src + p * 32);
#pragma unroll
            for (int e = 0; e < 4; ++e) { const float lo = bflo(pc[e]), hi = bfhi(pc[e]); s += lo + hi; s2 += lo * lo + hi * hi; }
        }
        s += __shfl_xor(s, 1); s += __shfl_xor(s, 2); s2 += __shfl_xor(s2, 1); s2 += __shfl_xor(s2, 2);
        const float mean = s * (1.0f / 512.0f);
        const float var = fmaxf(s2 * (1.0f / 512.0f) - mean * mean, 0.f);
        const float rstd = rsqrtf(var + EPS);
        const float* lw = a.ln_w + q * 8;
#pragma unroll 4
        for (int p = 0; p < 16; ++p) {
            const u32x4 pc = *(const u32x4*)(src + p * 32);
            const f32x4 w0 = *(const f32x4*)(lw + p * 32), w1 = *(const f32x4*)(lw + p * 32 + 4);
            u32x4 o;
            o[0] = pk2((bflo(pc[0]) - mean) * rstd * w0[0], (bfhi(pc[0]) - mean) * rstd * w0[1]);
            o[1] = pk2((bflo(pc[1]) - mean) * rstd * w0[2], (bfhi(pc[1]) - mean) * rstd * w0[3]);
            o[2] = pk2((bflo(pc[2]) - mean) * rstd * w1[0], (bfhi(pc[2]) - mean) * rstd * w1[1]);
            o[3] = pk2((bflo(pc[3]) - mean) * rstd * w1[2], (bfhi(pc[3]) - mean) * rstd * w1[3]);
            *(LAS u32x4*)(lds + (p >> 2) * GSZ + row * VS + ((p & 3) * 4 + q) * 16) = o;
        }
    }
    __syncthreads();
    const int n = 16 * w + i, r = r0 + n;
#pragma unroll 1
    for (int gq = 0; gq < 4; ++gq) {
        f32x4 acc[8];
#pragma unroll
        for (int et = 0; et < 8; ++et) acc[et] = (f32x4){0.f, 0.f, 0.f, 0.f};
        const bf16_t* wrow = WSB + (size_t)(gq * 128 + n) * 128;
        bf16x8 bw[4];
#pragma unroll
        for (int s = 0; s < 4; ++s) bw[s] = frag_rowP(wrow + 32 * s, g);
#pragma unroll
        for (int s = 0; s < 4; ++s) {
#pragma unroll
            for (int et = 0; et < 8; ++et) acc[et] = mfma16(frag_tr(lds + gq * GSZ, VS, 32 * s, 16 * et, lane), bw[s], acc[et]);
        }
        const float bias = a.b_s[gq * 128 + n];
#pragma unroll
        for (int et = 0; et < 8; et += 2) {
            const int colw = gq * 128 + 16 * (et + (g & 1)) + 8 * (g >> 1);
            const u32x4 uw = *(const u32x4*)(U + (size_t)r * 512 + colw);
            const u32x2 ux = __builtin_amdgcn_permlane16_swap(uw[0], uw[2], false, false), uy = __builtin_amdgcn_permlane16_swap(uw[1], uw[3], false, false);
            const u32x2 ua = {ux[0], uy[0]}, ub = {ux[1], uy[1]};
            const u32x2 oa = {pk2(bflo(ua.x) * (acc[et][0] + bias), bfhi(ua.x) * (acc[et][1] + bias)), pk2(bflo(ua.y) * (acc[et][2] + bias), bfhi(ua.y) * (acc[et][3] + bias))};
            const u32x2 ob = {pk2(bflo(ub.x) * (acc[et + 1][0] + bias), bfhi(ub.x) * (acc[et + 1][1] + bias)), pk2(bflo(ub.y) * (acc[et + 1][2] + bias), bfhi(ub.y) * (acc[et + 1][3] + bias))};
            const u32x2 wx = __builtin_amdgcn_permlane16_swap(oa.x, ob.x, false, false), wy = __builtin_amdgcn_permlane16_swap(oa.y, ob.y, false, false);
            const u32x4 ow = {wx[0], wy[0], wx[1], wy[1]};
            __builtin_nontemporal_store(ow, (u32x4*)(Y + (size_t)r * 1024 + 512 + colw));
        }
    }
    __syncthreads();
}
struct ChStage { u32x4 kf[2], kb[2], v; };
DI void chain_load(const Args& a, int bh, int es, int it, ChStage& st) {
    const int tid = threadIdx.x;
    const bf16_t *Kf, *Kb, *Vf, *Vb;
    if (it < 2) {
        const size_t of = (size_t)bh * 256 + it * 128, ob = (size_t)bh * 256 + (1 - it) * 128;
        Kf = (const bf16_t*)(a.ws + WS_KC) + of * 64; Kb = (const bf16_t*)(a.ws + WS_KC) + ob * 64;
        Vf = (const bf16_t*)(a.ws + WS_VC) + (((size_t)bh * 8 + es) * 256 + it * 128) * 16; Vb = (const bf16_t*)(a.ws + WS_VC) + (((size_t)bh * 8 + es) * 256 + (1 - it) * 128) * 16;
    } else {
        const size_t of = (size_t)bh * 4096 + (it - 2) * 128, ob = (size_t)bh * 4096 + (33 - it) * 128;
        Kf = (const bf16_t*)(a.ws + WS_K) + of * 64; Kb = (const bf16_t*)(a.ws + WS_K) + ob * 64;
        Vf = (const bf16_t*)(a.ws + WS_V) + (((size_t)bh * 8 + es) * 4096 + (it - 2) * 128) * 16; Vb = (const bf16_t*)(a.ws + WS_V) + (((size_t)bh * 8 + es) * 4096 + (33 - it) * 128) * 16;
    }
#pragma unroll
    for (int q = 0; q < 2; ++q) { const int p = tid + 512 * q; st.kf[q] = *(const u32x4*)(Kf + (p >> 3) * 64 + (p & 7) * 8); st.kb[q] = *(const u32x4*)(Kb + (p >> 3) * 64 + (p & 7) * 8); }
    const int t = tid & 255; const bf16_t* Vx = (tid < 256) ? Vf : Vb;
    st.v = *(const u32x4*)(Vx + t * 8);
}
DI void chain_item(const Args& a, LAS unsigned char* lds, int item) {
    const int tid = threadIdx.x, lane = tid & 63, w = tid >> 6, i = lane & 15, g = lane >> 4;
    const int bh = item >> 3, es = item & 7, h = bh & 3, dirw = w >> 2, dt = w & 3;
    const float l2f = -expf(a.dec_f[h]) * LOG2E, l2b = -expf(a.dec_b[h]) * LOG2E;
    const float G = exp2f(128.0f * (dirw ? l2b : l2f));
    constexpr int BUFSZ = 2 * 128 * KS2 + 2 * 128 * 32;
    const float tv = (tid < 256) ? exp2f((float)(127 - ((tid & 255) >> 1)) * l2f) : exp2f((float)((tid & 255) >> 1) * l2b);
    bf16_t* ST = (bf16_t*)(a.ws + WS_ST);
    f32x4 S = {0.f, 0.f, 0.f, 0.f};
    ChStage st0, st1, st2, st3;
    chain_load(a, bh, es, 0, st0); chain_load(a, bh, es, 1, st1); chain_load(a, bh, es, 2, st2);
#define CH_STEP(IT, CUR, NXT, STORE) do { const int it = (IT); { \
        LAS unsigned char* buf = lds + (it & 1) * BUFSZ; \
        LAS unsigned char* KFs = buf; LAS unsigned char* KBs = buf + 128 * KS2; LAS unsigned char* VFs = buf + 2 * 128 * KS2; LAS unsigned char* VBs = VFs + 128 * 32; \
        _Pragma("unroll") for (int q = 0; q < 2; ++q) { \
            const int p = tid + 512 * q, m = p >> 3, d8 = p & 7; \
            *(LAS u32x4*)(KFs + m * KS2 + d8 * 16) = CUR.kf[q]; *(LAS u32x4*)(KBs + m * KS2 + d8 * 16) = CUR.kb[q]; \
        } \
        { const int t = tid & 255; u32x4 sv; _Pragma("unroll") for (int e = 0; e < 4; ++e) sv[e] = pk2(bflo(CUR.v[e]) * tv, bfhi(CUR.v[e]) * tv); \
          *(LAS u32x4*)((tid < 256 ? VFs : VBs) + (t >> 1) * 32 + (t & 1) * 16) = sv; } \
        lds_barrier(); \
        chain_load(a, bh, es, (it + 3 < 34) ? it + 3 : 33, NXT);                  \
        LAS const unsigned char* Kx = dirw ? KBs : KFs; LAS const unsigned char* Vx = dirw ? VBs : VFs; \
        f32x4 kv = {0.f, 0.f, 0.f, 0.f}; \
        _Pragma("unroll") for (int s = 0; s < 4; ++s) kv = mfma16(frag_tr(Vx, 32, 32 * s, 0, lane), frag_tr(Kx, KS2, 32 * s, 16 * dt, lane), kv); \
        if (STORE) {                                                              \
            const int c = dirw ? 33 - it : it - 2; \
            const u32x2 o = {pk2(S[0], S[1]), pk2(S[2], S[3])}; \
            *(u32x2*)(ST + (((size_t)(bh * 32 + c) * 2 + dirw) * 64 + 16 * dt + i) * 128 + es * 16 + 4 * g) = o; \
        } \
        S = S * G + kv; } } while (0)
    CH_STEP(0, st0, st3, false); CH_STEP(1, st1, st0, false);
#pragma unroll 1
    for (int it4 = 2; it4 < 34; it4 += 4) {
        CH_STEP(it4, st2, st1, true); CH_STEP(it4 + 1, st3, st2, true); CH_STEP(it4 + 2, st0, st3, true); CH_STEP(it4 + 3, st1, st0, true);
    }
#undef CH_STEP
    __syncthreads();
}
DI void phase3(const Args& a, LAS unsigned char* lds) {
    for (int it = blockIdx.x; it < 256; it += gridDim.x) gmlp_unit(a, lds, it >> 5, it & 31);
    for (int it = blockIdx.x; it < 256; it += gridDim.x) { const int j = it >> 3; chain_item(a, lds, (((it & 7) * 4 + (j >> 3)) << 3) + (j & 7)); }
}

DI void phase4(const Args& a) {
    const float* KV = (const float*)(a.ws + WS_KV); const float* KVC = (const float*)(a.ws + WS_KVC);
    bf16_t* ST = (bf16_t*)(a.ws + WS_ST);
    for (int idx = blockIdx.x * NTHREADS + threadIdx.x; idx < 64 * 2048; idx += gridDim.x * NTHREADS) {
        const int chain = idx >> 11, pos = idx & 2047, bh = chain >> 1, dir = chain & 1, h = bh & 3;
        const float lg = -expf(dir ? a.dec_b[h] : a.dec_f[h]), G = expf(128.0f * lg);
        const f32x4 k0 = *(const f32x4*)(KVC + ((size_t)(bh * 2 + 0) * 2 + dir) * 8192 + pos * 4);
        const f32x4 k1 = *(const f32x4*)(KVC + ((size_t)(bh * 2 + 1) * 2 + dir) * 8192 + pos * 4);
        f32x4 S = dir ? (k1 * G + k0) : (k0 * G + k1);
#pragma unroll 8
        for (int step = 0; step < NC; ++step) {
            const int c = dir ? (NC - 1 - step) : step;
            const size_t off = ((size_t)(bh * 32 + c) * 2 + dir) * 8192 + pos * 4;
            const f32x4 kvv = *(const f32x4*)(KV + off);
            const u32x2 o = {pk2(S[0], S[1]), pk2(S[2], S[3])};
            *(u32x2*)(ST + off) = o;
            S = S * G + kvv;
        }
    }
}

struct RetStage { u32x4 k[2], v[4], sf[2], sb[2]; bf16x8 q[2]; };
DI void ret_load(const Args& a, int unit, RetStage& st) {
    const int tid = threadIdx.x, lane = tid & 63, w = tid >> 6, i = lane & 15, g = lane >> 4;
    const int bh = unit >> 5, c = unit & 31;
    const bf16_t* Qp = (const bf16_t*)(a.ws + WS_Q) + ((size_t)bh * 4096 + c * 128) * 64;
    const bf16_t* Kp = (const bf16_t*)(a.ws + WS_K) + ((size_t)bh * 4096 + c * 128) * 64;
    const bf16_t* Vp = (const bf16_t*)(a.ws + WS_V) + ((size_t)bh * 8 * 4096 + c * 128) * 16;
    const bf16_t* SFp = (const bf16_t*)(a.ws + WS_ST) + (size_t)unit * 16384; const bf16_t* SBp = SFp + 8192;
#pragma unroll
    for (int q = 0; q < 2; ++q) { const int p = tid + 512 * q; st.k[q] = *(const u32x4*)(Kp + (p >> 3) * 64 + (p & 7) * 8); }
#pragma unroll
    for (int q = 0; q < 4; ++q) { const int p = tid + 512 * q; st.v[q] = *(const u32x4*)(Vp + (size_t)(p >> 8) * (4096 * 16) + (p & 255) * 8); }
#pragma unroll
    for (int q = 0; q < 2; ++q) { const int p = tid + 512 * q; st.sf[q] = *(const u32x4*)(SFp + (p >> 4) * 128 + (p & 15) * 8); st.sb[q] = *(const u32x4*)(SBp + (p >> 4) * 128 + (p & 15) * 8); }
#pragma unroll
    for (int s = 0; s < 2; ++s) st.q[s] = frag_rowP(Qp + (16 * w + i) * 64 + 32 * s, g);
}
DI void ret_unit(const Args& a, LAS unsigned char* lds, int unit, RetStage& st, int next_unit) {
    const int tid = threadIdx.x, lane = tid & 63, w = tid >> 6, i = lane & 15, g = lane >> 4;
    const int bh = unit >> 5, c = unit & 31, b = bh >> 2, h = bh & 3;
    const bf16_t* GR = (const bf16_t*)(a.ws + WS_GR); bf16_t* Y = (bf16_t*)(a.ws + WS_H);
    LAS unsigned char* Kt = lds; LAS unsigned char* Vt = lds + 128 * KS; LAS unsigned char* SF = Vt + 128 * VS; LAS unsigned char* SB = SF + 64 * VS;
#pragma unroll
    for (int q = 0; q < 2; ++q) { const int p = tid + 512 * q; *(LAS u32x4*)(Kt + (p >> 3) * KS + (p & 7) * 16) = st.k[q]; }
#pragma unroll
    for (int q = 0; q < 4; ++q) { const int p = tid + 512 * q; *(LAS u32x4*)(Vt + ((p & 255) >> 1) * VS + (p >> 8) * 32 + (p & 1) * 16) = st.v[q]; }
#pragma unroll
    for (int q = 0; q < 2; ++q) { const int p = tid + 512 * q; *(LAS u32x4*)(SF + (p >> 4) * VS + (p & 15) * 16) = st.sf[q]; *(LAS u32x4*)(SB + (p >> 4) * VS + (p & 15) * 16) = st.sb[q]; }
    bf16x8 Qf[2];
#pragma unroll
    for (int s = 0; s < 2; ++s) Qf[s] = st.q[s];
    lds_barrier();
    if (next_unit >= 0) ret_load(a, next_unit, st);
    const float l2f = -expf(a.dec_f[h]) * LOG2E, l2b = -expf(a.dec_b[h]) * LOG2E;
    const int n = 16 * w + i;

    f32x4 accS[8];
#pragma unroll
    for (int mt = 0; mt < 8; ++mt) {
        accS[mt] = (f32x4){0.f, 0.f, 0.f, 0.f};
#pragma unroll
        for (int s = 0; s < 2; ++s) accS[mt] = mfma16(frag_rowP_lds(Kt + (16 * mt + i) * KS + 64 * s, g), Qf[s], accS[mt]);
    }
#pragma unroll
    for (int mt = 0; mt < 8; ++mt)
#pragma unroll
        for (int reg = 0; reg < 4; ++reg) {
            const int diff = n - (16 * mt + 4 * g + reg);
            const float ex = __builtin_amdgcn_exp2f(diff > 0 ? (float)diff * l2f : (float)(-diff) * l2b);
            accS[mt][reg] *= (diff == 0 ? 2.0f : ex);
        }
    const float fsf = __builtin_amdgcn_exp2f((float)(n + 1) * l2f), fsb = __builtin_amdgcn_exp2f((float)(128 - n) * l2b);
    f32x4 accO[8];
#pragma unroll
    for (int et = 0; et < 8; ++et) accO[et] = (f32x4){0.f, 0.f, 0.f, 0.f};
#pragma unroll
    for (int s = 0; s < 4; ++s) {
        const u32x4 pu = {pk2(accS[2 * s][0], accS[2 * s][1]), pk2(accS[2 * s][2], accS[2 * s][3]), pk2(accS[2 * s + 1][0], accS[2 * s + 1][1]), pk2(accS[2 * s + 1][2], accS[2 * s + 1][3])};
        const bf16x8 Pf = __builtin_bit_cast(bf16x8, pu);
#pragma unroll
        for (int et = 0; et < 8; ++et) accO[et] = mfma16(frag_tr(Vt, VS, 32 * s, 16 * et, lane), Pf, accO[et]);
        __builtin_amdgcn_sched_barrier(0);
    }
#pragma unroll
    for (int s = 0; s < 2; ++s) {
        const bf16x8 qsf = scale_frag(Qf[s], fsf), qsb = scale_frag(Qf[s], fsb);
#pragma unroll
        for (int et = 0; et < 8; ++et) {
            accO[et] = mfma16(frag_tr(SF, VS, 32 * s, 16 * et, lane), qsf, accO[et]);
            accO[et] = mfma16(frag_tr(SB, VS, 32 * s, 16 * et, lane), qsb, accO[et]);
        }
        __builtin_amdgcn_sched_barrier(0);
    }
    float sm = 0.f;
#pragma unroll
    for (int et = 0; et < 8; ++et) sm += accO[et][0] + accO[et][1] + accO[et][2] + accO[et][3];
    sm += __shfl_xor(sm, 16); sm += __shfl_xor(sm, 32);
    const float mean = sm * (1.0f / 128.0f);
    float v2 = 0.f;
#pragma unroll
    for (int et = 0; et < 8; ++et)
#pragma unroll
        for (int e = 0; e < 4; ++e) { const float d0 = accO[et][e] - mean; v2 += d0 * d0; }
    v2 += __shfl_xor(v2, 16); v2 += __shfl_xor(v2, 32);
    const float rstd = rsqrtf(v2 * (1.0f / 128.0f) + EPS);
    const int r = b * 4096 + c * 128 + n;
#pragma unroll
    for (int et = 0; et < 8; et += 2) {
        const int colw = h * 128 + 16 * (et + (g & 1)) + 8 * (g >> 1);
        const u32x4 gww = *(const u32x4*)(GR + (size_t)r * 512 + colw);
        const u32x2 gx = __builtin_amdgcn_permlane16_swap(gww[0], gww[2], false, false), gy = __builtin_amdgcn_permlane16_swap(gww[1], gww[3], false, false);
        const u32x2 ga = {gx[0], gy[0]}, gb = {gx[1], gy[1]};
        const f32x4 wa = *(const f32x4*)(a.gn_w + h * 128 + 16 * et + 4 * g), wb = *(const f32x4*)(a.gn_w + h * 128 + 16 * (et + 1) + 4 * g);
        const u32x2 oa = {pk2((accO[et][0] - mean) * rstd * wa[0] * bflo(ga.x), (accO[et][1] - mean) * rstd * wa[1] * bfhi(ga.x)),
                          pk2((accO[et][2] - mean) * rstd * wa[2] * bflo(ga.y), (accO[et][3] - mean) * rstd * wa[3] * bfhi(ga.y))};
        const u32x2 ob = {pk2((accO[et + 1][0] - mean) * rstd * wb[0] * bflo(gb.x), (accO[et + 1][1] - mean) * rstd * wb[1] * bfhi(gb.x)),
                          pk2((accO[et + 1][2] - mean) * rstd * wb[2] * bflo(gb.y), (accO[et + 1][3] - mean) * rstd * wb[3] * bfhi(gb.y))};
        const u32x2 wx = __builtin_amdgcn_permlane16_swap(oa.x, ob.x, false, false), wy = __builtin_amdgcn_permlane16_swap(oa.y, ob.y, false, false);
        const u32x4 ow = {wx[0], wy[0], wx[1], wy[1]};
        *(u32x4*)(Y + (size_t)r * 1024 + colw) = ow;
    }
    lds_barrier();
}

DI void phase7(const Args& a) {
    const int tid = threadIdx.x, wave = tid >> 6, lane = tid & 63;
    for (int r = blockIdx.x * 8 + wave; r < NTOK; r += gridDim.x * 8) {
        float* row = a.out + (size_t)r * 1024;
        f32x4 v[4]; float ss = 0.f;
#pragma unroll
        for (int q = 0; q < 4; ++q) { v[q] = *(const f32x4*)(row + q * 256 + lane * 4); ss += v[q][0] * v[q][0] + v[q][1] * v[q][1] + v[q][2] * v[q][2] + v[q][3] * v[q][3]; }
#pragma unroll
        for (int off = 32; off >= 1; off >>= 1) ss += __shfl_xor(ss, off);
        const float rstd = rsqrtf(ss * (1.0f / 1024.0f) + EPS);
#pragma unroll
        for (int q = 0; q < 4; ++q) {
            const f32x4 fw = *(const f32x4*)(a.fnorm_w + q * 256 + lane * 4);
            *(f32x4*)(row + q * 256 + lane * 4) = v[q] * rstd * fw;
        }
    }
}

__global__ __launch_bounds__(512, 2) void fwd_megakernel(Args a) {
    extern __shared__ __attribute__((aligned(16))) unsigned char shm[];
    LAS unsigned char* lds = (LAS unsigned char*)shm;
    cg::grid_group grid = cg::this_grid();
    volatile LAS unsigned* st = (volatile LAS unsigned*)(lds + LDS_BYTES - 16);
    if (threadIdx.x == 0) { st[0] = 0u; st[1] = 0u; }
    __syncthreads();
    const XcdBarrier xb = xcd_barrier_post((unsigned*)(a.ws + WS_BAR), st);
    if (a.ph_hi > 7) grid.sync();
#ifndef PHMASK
#define PHMASK 255
#endif
#ifndef REPMASK
#define REPMASK 0
#endif
#ifndef EXTRA_SYNCS
#define EXTRA_SYNCS 0
#endif
#define GSYNC() xcd_barrier(xb)
    for (int xs = 0; xs < EXTRA_SYNCS; ++xs) GSYNC();
#define PHASE(P, ...) do { if (((PHMASK >> (P)) & 1) && a.ph_lo <= (P) && (P) < a.ph_hi) { if ((REPMASK >> (P)) & 1) { __VA_ARGS__; GSYNC(); } __VA_ARGS__; if ((P) + 1 < a.ph_hi) GSYNC(); } } while (0)
    PHASE(0, phase0(a, lds));
    PHASE(1, phase1(a));
    PHASE(2, {
        pg8::Gemm gm{(const bf16_t*)(a.ws + WS_H), (const bf16_t*)(a.ws + WS_WIN), NTOK, NP, D};
        SchedIn S; S.so.init(NTOK, NP, (int)gridDim.x, (int)blockIdx.x);
        EpiIn E{a.ws};
        pg8::gemm_phase<EpiIn, SchedIn, false>(lds, gm, S, E, nullptr);
    });
    PHASE(3, phase3(a, lds));
    PHASE(5, { int it = blockIdx.x; if (it < 1024) { RetStage st; ret_load(a, it, st); for (;;) { const int nx = it + (int)gridDim.x; ret_unit(a, lds, it, st, nx < 1024 ? nx : -1); if (nx >= 1024) break; it = nx; } } });
    PHASE(6, {
        pg8::Gemm gm{(const bf16_t*)(a.ws + WS_H), (const bf16_t*)(a.ws + WS_WOUT), NTOK, D, D};
        pg8::StaticOrder S; S.init(NTOK, D, (int)gridDim.x, (int)blockIdx.x);
        EpiOut E{a.x, (const float*)(a.ws + WS_MOD), a.fnorm_w, a.out, (float*)(a.ws + WS_SLOT), (unsigned*)(a.ws + WS_CNT)};
        pg8::gemm_phase<EpiOut, pg8::StaticOrder, false>(lds, gm, S, E, nullptr);
    });
#undef PHASE
}

extern "C" void kernel_launch(void* const* d_in, const int* in_sizes, int n_in, void* d_out, int out_size, void* d_ws, size_t ws_size, hipStream_t stream) {
    static int grid = 0;
    if (grid == 0) {
        if (n_in != 16 || out_size != NTOK * D || ws_size < WS_END) { fprintf(stderr, "kernel_launch: unexpected shapes (n_in %d out %d ws %zu need %zu)\n", n_in, out_size, ws_size, (size_t)WS_END); grid = -1; return; }
        int dev = 0, cus = 0, per_cu = 0;
        (void)hipGetDevice(&dev); (void)hipDeviceGetAttribute(&cus, hipDeviceAttributeMultiprocessorCount, dev);
        if (hipFuncSetAttribute((const void*)fwd_megakernel, hipFuncAttributeMaxDynamicSharedMemorySize, LDS_BYTES) != hipSuccess) { fprintf(stderr, "kernel_launch: hipFuncSetAttribute failed\n"); grid = -1; return; }
        if (hipOccupancyMaxActiveBlocksPerMultiprocessor(&per_cu, (const void*)fwd_megakernel, NTHREADS, LDS_BYTES) != hipSuccess || per_cu < 1) { fprintf(stderr, "kernel_launch: occupancy query gives %d\n", per_cu); per_cu = 1; }
        (void)hipGetLastError();
        grid = cus;
    }
    if (grid < 0) return;
    Args a{};
    a.x = (const float*)d_in[0]; a.c = (const float*)d_in[1]; a.ctx = (const float*)d_in[2]; a.c_ctx = (const float*)d_in[3]; a.w_ada = (const float*)d_in[4]; a.b_ada = (const float*)d_in[5];
    a.norm_w = (const float*)d_in[6]; a.w_in = (const float*)d_in[7]; a.dec_f = (const float*)d_in[8]; a.dec_b = (const float*)d_in[9]; a.gn_w = (const float*)d_in[10]; a.ln_w = (const float*)d_in[11];
    a.w_s = (const float*)d_in[12]; a.b_s = (const float*)d_in[13]; a.w_out = (const float*)d_in[14]; a.fnorm_w = (const float*)d_in[15];
    a.out = (float*)d_out; a.ws = (unsigned char*)d_ws;
    (void)hipMemsetAsync((unsigned char*)d_ws + WS_BAR, 0, (size_t)XCD_BAR_WORDS * 4 + 32768, stream);
#if N_LAUNCHES == 1
    a.ph_lo = 0; a.ph_hi = 7;
    void* args[] = {&a};
    hipError_t e = hipLaunchCooperativeKernel((const void*)fwd_megakernel, dim3(grid), dim3(NTHREADS), args, LDS_BYTES, stream);
    if (e != hipSuccess) fprintf(stderr, "cooperative launch failed: %s (grid %d)\n", hipGetErrorString(e), grid);
#else
    for (int p = 0; p < 7; ++p) {
        a.ph_lo = p; a.ph_hi = p + 1;
        hipLaunchKernelGGL(fwd_megakernel, dim3(grid), dim3(NTHREADS), LDS_BYTES, stream, a);
    }
#endif
}
```

```cpp
#include <hip/hip_runtime.h>
#include <hip/hip_cooperative_groups.h>
#include <cstdio>
namespace cg = cooperative_groups;
#ifndef N_LAUNCHES
#define N_LAUNCHES 1
#endif
namespace pg8 {
#define PG8_LAS __attribute__((address_space(3)))
typedef unsigned short bf16_t;
typedef short bf16x8 __attribute__((ext_vector_type(8)));
typedef float f32x4 __attribute__((ext_vector_type(4)));
typedef unsigned u32x4 __attribute__((ext_vector_type(4)));
constexpr int BM = 256, BK = 64, HALF = 128, HTB = HALF * BK * 2  , STAGE_BYTES = 8 * HTB, NXCD = 8, WGM = 8;

__host__ __device__ __forceinline__ int lds_byte(int r, int c) { const int st = (r >> 4) * 2 + (c >> 5), rr = r & 15, cc = c & 31, ob = rr * 64 + cc * 2; return st * 1024 + (ob ^ (((ob >> 9) & 1) << 5)); }
__host__ __device__ __forceinline__ void stage_rc(int b, int& R, int& C) { const int st = b / 1024, sb = b % 1024, swz = sb ^ (((sb >> 9) & 1) << 5); R = (st >> 1) * 16 + swz / 64; C = (st & 1) * 32 + (swz % 64) / 2; }
__host__ __device__ __forceinline__ int perm32(int rho) { const int n = rho >> 4, i = rho & 15; return 8 * (i >> 2) + 4 * n + (i & 3); }

struct Unit { int pm, pn; };
struct Gemm { const bf16_t* A; const bf16_t* Bt; int M, N, K; };

struct StaticOrder {
    int nM, nN, nwg, G, c;
    __host__ __device__ void init(int M, int N, int G_, int c_) { nM = M / BM; nN = N / BM; nwg = nM * nN; G = G_; c = c_; }
    __host__ __device__ bool next(int i, Unit& u) const {
        const long L = (long)i * G + c; if (L >= nwg) return false;
        int wgid = (int)L; { const int q = nwg / NXCD, r = nwg % NXCD, xcd = wgid % NXCD, off = wgid / NXCD; wgid = (xcd < r ? xcd * (q + 1) : r * (q + 1) + (xcd - r) * q) + off; }
        const int nig = WGM * nN, gid = wgid / nig, fm = gid * WGM, gsz = (nM - fm) < WGM ? (nM - fm) : WGM;
        u.pm = fm + ((wgid % nig) % gsz); u.pn = (wgid % nig) / gsz; return true;
    }
    __device__ __forceinline__ void a_ready(const Unit&) const {}
    __device__ __forceinline__ void done(const Unit&) const {}
};
struct CountedOrder : StaticOrder {
    const unsigned* ready; unsigned need; unsigned* tmo;
    __device__ __forceinline__ void a_ready(const Unit& u) const {
        if (threadIdx.x < 64) {
            const unsigned long long t0 = __builtin_amdgcn_s_memrealtime(); unsigned polls = 0;
            while ((unsigned)__builtin_amdgcn_readfirstlane(__hip_atomic_load(ready + 64 * u.pm, __ATOMIC_RELAXED, __HIP_MEMORY_SCOPE_AGENT)) < need) {
                if ((++polls & 255u) == 0u && __builtin_amdgcn_readfirstlane(__hip_atomic_load(tmo, __ATOMIC_RELAXED, __HIP_MEMORY_SCOPE_AGENT)) != 0u) break;
                if (__builtin_amdgcn_s_memrealtime() - t0 > 2000000ull) {
                    if (threadIdx.x == 0) { unsigned expect = 0u; __hip_atomic_compare_exchange_strong(tmo + 1, &expect, 0x600u | (unsigned)(u.pm & 0xff), __ATOMIC_RELAXED, __ATOMIC_RELAXED, __HIP_MEMORY_SCOPE_AGENT); __hip_atomic_store(tmo, 1u, __ATOMIC_RELAXED, __HIP_MEMORY_SCOPE_AGENT); }
                    break; }
                __builtin_amdgcn_s_sleep(2); }
            __builtin_amdgcn_fence(__ATOMIC_ACQUIRE, "agent");
            asm volatile("s_waitcnt vmcnt(0)" ::: "memory");
        }
#if !defined(BROKEN_HOOK_NO_BARRIER)
        asm volatile("" ::: "memory"); __builtin_amdgcn_s_barrier(); asm volatile("" ::: "memory");
#endif
    }
};

__device__ __forceinline__ unsigned cvt_pk_bf16(float lo, float hi) { unsigned r; asm volatile("v_cvt_pk_bf16_f32 %0, %1, %2" : "=v"(r) : "v"(lo), "v"(hi)); return r; }
typedef float f32x2 __attribute__((ext_vector_type(2)));
__device__ __forceinline__ f32x2 gelu_pk(f32x2 v) {
    const f32x2 av = __builtin_elementwise_abs(v), d = av * 0.2316418882f + 1.0f;
    f32x2 t; t.x = __builtin_amdgcn_rcpf(d.x); t.y = __builtin_amdgcn_rcpf(d.y);
    f32x2 q = t * 0.5307027145f + (-0.7265760135f); q = q * t + 0.7107068705f; q = q * t + (-0.142248368f); q = q * t + 0.127414796f; q = q * t;
    const f32x2 s = (v * v) * (-0.72134752044f);
    f32x2 e; e.x = __builtin_amdgcn_exp2f(s.x); e.y = __builtin_amdgcn_exp2f(s.y);
    const f32x2 m = v * (q * e), r = v - m;
    f32x2 o; o.x = v.x < 0.f ? m.x : r.x; o.y = v.y < 0.f ? m.y : r.y; return o;
}
template <class Epi, class Sched, bool STAMP = false>
__device__ __forceinline__ void gemm_phase(PG8_LAS unsigned char* lds, const Gemm g, const Sched& S, const Epi& E, unsigned long long* stamps) {
    const int tid = threadIdx.x, wid = __builtin_amdgcn_readfirstlane(tid >> 6), lane = tid & 63, wr = wid >> 2, wc = wid & 3, fr = lane & 15, fq = lane >> 4;
    const int K = g.K, nt = K / BK;
    int ts_lo = 0, ts_hi = 0, nts = 0; const unsigned long long rt_entry = STAMP ? (unsigned long long)wall_clock64() : 0ull;
#define PG8_STAMP() do { if (STAMP && wid == 0 && nts < 64) { const unsigned long long _c = (unsigned long long)clock64(); \
        ts_lo = (lane == nts) ? (int)(unsigned)_c : ts_lo; ts_hi = (lane == nts) ? (int)(unsigned)(_c >> 32) : ts_hi; ++nts; } } while (0)
    PG8_STAMP();
    unsigned voffA[2], voffB[2];
#pragma unroll
    for (int i = 0; i < 2; ++i) { int R, C; stage_rc(tid * 16 + i * 8192, R, C); const int Rb = Epi::PERM ? ((R & ~31) + perm32(R & 31)) : R;
        voffA[i] = (unsigned)(R * K + C) * 2u; voffB[i] = (unsigned)(Rb * K + C) * 2u; }
    const size_t kstep = (size_t)(BK * 2);
    const size_t hstep = (size_t)HALF * K * 2;
    const size_t tstep = 2 * hstep;
    const unsigned ldsw = (unsigned)wid * 1024u;
    const int aoff = lds_byte(wr * 64 + fr, fq * 8), boff = lds_byte(wc * 32 + fr, fq * 8);
#define PG8_SA(b, h) (((b) * 2 + (h)) * HTB)
#define PG8_SB(b, h) ((4 + (b) * 2 + (h)) * HTB)
#define PG8_STAGE(bufoff, gbase, voff) do { _Pragma("unroll") for (int _i = 0; _i < 2; ++_i) \
        __builtin_amdgcn_global_load_lds((const unsigned*)((const char*)(gbase) + (voff)[_i]), (PG8_LAS unsigned*)(lds + (bufoff) + ldsw + _i * 8192), 16, 0, 0); } while (0)
#define PG8_LDA(dst, b, h) do { _Pragma("unroll") for (int m = 0; m < 4; ++m) _Pragma("unroll") for (int k = 0; k < 2; ++k) dst[m][k] = *(const PG8_LAS bf16x8*)(lds + PG8_SA(b, h) + aoff + m * 2048 + k * 1024); } while (0)
#define PG8_LDB(dst, b, h) do { _Pragma("unroll") for (int n = 0; n < 2; ++n) _Pragma("unroll") for (int k = 0; k < 2; ++k) dst[n][k] = *(const PG8_LAS bf16x8*)(lds + PG8_SB(b, h) + boff + n * 2048 + k * 1024); } while (0)
#define PG8_MMA(ai, bj, At, Bt) do { __builtin_amdgcn_s_setprio(1); _Pragma("unroll") for (int m = 0; m < 4; ++m) _Pragma("unroll") for (int n = 0; n < 2; ++n) _Pragma("unroll") for (int k = 0; k < 2; ++k) \
        acc[ai][bj][m][n] = __builtin_amdgcn_mfma_f32_16x16x32_bf16(Bt[n][k], At[m][k], acc[ai][bj][m][n], 0, 0, 0); __builtin_amdgcn_s_setprio(0); } while (0)
#define PG8_WAIT_V(n) asm volatile("s_waitcnt vmcnt(" #n ")" ::: "memory")
#define PG8_WAIT_L(n) asm volatile("s_waitcnt lgkmcnt(" #n ")" ::: "memory")
#define PG8_BAR __builtin_amdgcn_s_barrier()
#define PG8_SCHED __builtin_amdgcn_sched_barrier(0)
    Unit cur, nxt; int ui = 0;
    if (!S.next(0, cur)) return;
    f32x4 acc[2][2][4][2];
#pragma unroll
    for (int a = 0; a < 2; ++a)
#pragma unroll
        for (int b = 0; b < 2; ++b)
#pragma unroll
            for (int m = 0; m < 4; ++m)
#pragma unroll
                for (int n = 0; n < 2; ++n) acc[a][b][m][n] = (f32x4){0.f, 0.f, 0.f, 0.f};
    bf16x8 At[4][2], B0[2][2], B1[2][2];
    const char* cA = (const char*)g.A + (size_t)cur.pm * tstep; const char* cB = (const char*)g.Bt + (size_t)cur.pn * tstep;
    S.a_ready(cur);
    PG8_STAGE(PG8_SB(0, 0), cB, voffB); PG8_STAGE(PG8_SA(0, 0), cA, voffA); PG8_STAGE(PG8_SB(0, 1), cB + hstep, voffB); PG8_STAGE(PG8_SA(0, 1), cA + hstep, voffA);
    if (wr == 1) PG8_BAR;
    PG8_WAIT_V(4); PG8_BAR;
    PG8_STAGE(PG8_SB(1, 0), cB + kstep, voffB); PG8_STAGE(PG8_SA(1, 0), cA + kstep, voffA); PG8_STAGE(PG8_SB(1, 1), cB + hstep + kstep, voffB);
    PG8_WAIT_V(6); PG8_BAR;
    PG8_STAMP();
    for (;;) {
        const bool has_next = S.next(ui + 1, nxt);
        const char* nA = has_next ? (const char*)g.A + (size_t)nxt.pm * tstep : cA; const char* nB = has_next ? (const char*)g.Bt + (size_t)nxt.pn * tstep : cB;
        for (int t = 0; t < nt; t += 2) {
            const bool last = (t == nt - 2);
            const char* a1 = cA + (size_t)(t + 1) * kstep;
            const char* a2 = last ? nA : cA + (size_t)(t + 2) * kstep; const char* b2 = last ? nB : cB + (size_t)(t + 2) * kstep;
            const char* a3 = a2 + kstep; const char* b3 = b2 + kstep;
            if (last && has_next) S.a_ready(nxt);
            PG8_LDB(B0, 0, 0); PG8_SCHED; PG8_LDA(At, 0, 0); PG8_STAGE(PG8_SA(1, 1), a1 + hstep, voffA);
            PG8_WAIT_L(8); PG8_BAR; PG8_WAIT_L(0); PG8_MMA(0, 0, At, B0); PG8_BAR; PG8_SCHED;
            PG8_LDB(B1, 0, 1); PG8_STAGE(PG8_SB(0, 0), b2, voffB);
            PG8_BAR; PG8_WAIT_L(0); PG8_MMA(0, 1, At, B1); PG8_BAR;
            PG8_LDA(At, 0, 1); PG8_STAGE(PG8_SA(0, 0), a2, voffA);
            PG8_BAR; PG8_WAIT_L(0); PG8_MMA(1, 0, At, B0); PG8_BAR; PG8_SCHED;
            PG8_STAGE(PG8_SB(0, 1), b2 + hstep, voffB);
            PG8_WAIT_V(6); PG8_BAR; PG8_MMA(1, 1, At, B1); PG8_BAR;
            PG8_LDB(B0, 1, 0); PG8_SCHED; PG8_LDA(At, 1, 0); PG8_STAGE(PG8_SA(0, 1), a2 + hstep, voffA);
            PG8_WAIT_L(8); PG8_BAR; PG8_WAIT_L(0); PG8_MMA(0, 0, At, B0); PG8_BAR; PG8_SCHED;
            PG8_LDB(B1, 1, 1); PG8_STAGE(PG8_SB(1, 0), b3, voffB);
            PG8_BAR; PG8_WAIT_L(0); PG8_MMA(0, 1, At, B1); PG8_BAR;
            PG8_LDA(At, 1, 1); PG8_STAGE(PG8_SA(1, 0), a3, voffA);
            PG8_BAR; PG8_WAIT_L(0); PG8_MMA(1, 0, At, B0); PG8_BAR; PG8_SCHED;
            PG8_STAGE(PG8_SB(1, 1), b3 + hstep, voffB);
            PG8_WAIT_V(6); PG8_BAR; PG8_MMA(1, 1, At, B1); PG8_BAR;
        }
        PG8_STAMP();
        if constexpr (!Epi::AFTER_DRAIN) {
            if constexpr (Epi::REALIGN) { if (wr == 0) PG8_BAR; }
            E(acc, cur, wr, wc, fr, fq); S.done(cur);
            if constexpr (Epi::REALIGN) { if (wr == 1) PG8_BAR; }
        }
        PG8_STAMP();
        if (!has_next) break;
#pragma unroll
        for (int a = 0; a < 2; ++a)
#pragma unroll
            for (int b = 0; b < 2; ++b)
#pragma unroll
                for (int m = 0; m < 4; ++m)
#pragma unroll
                    for (int n = 0; n < 2; ++n) acc[a][b][m][n] = (f32x4){0.f, 0.f, 0.f, 0.f};
        cur = nxt; cA = nA; cB = nB; ++ui;
    }
    PG8_WAIT_V(0);
    if (wr == 0) PG8_BAR;
    PG8_BAR;
    if constexpr (Epi::AFTER_DRAIN) { E.fused(acc, cur, wr, wc, fr, fq, lds, wid, lane); S.done(cur); }
    PG8_STAMP();
    if (STAMP && wid == 0) { stamps[lane] = lane < nts ? (((unsigned long long)(unsigned)ts_hi << 32) | (unsigned)ts_lo) : 0ull;
        if (lane == 62) stamps[62] = rt_entry; if (lane == 63) stamps[63] = (unsigned long long)wall_clock64(); }
#undef PG8_STAMP
#undef PG8_SA
#undef PG8_SB
#undef PG8_STAGE
#undef PG8_LDA
#undef PG8_LDB
#undef PG8_MMA
#undef PG8_WAIT_V
#undef PG8_WAIT_L
#undef PG8_BAR
#undef PG8_SCHED
}
}
#define LAS __attribute__((address_space(3)))
#define XB_TMO      128
#define XB_XCNT(j)  (256  + 64 * (j))
#define XB_XSUB(j)  (1280 + 64 * (j))
#define XB_XGEN(j)  (2304 + 64 * (j))
#define XB_TOP      3328
#define XB_TOPGEN   3392
#define XCD_BAR_WORDS 3456
#define XB_SPIN_CAP (1u << 18)

__device__ __forceinline__ unsigned xb_ld(unsigned* p)              { return __hip_atomic_load(p, __ATOMIC_RELAXED, __HIP_MEMORY_SCOPE_AGENT); }
__device__ __forceinline__ unsigned xb_add(unsigned* p, unsigned v) { return __hip_atomic_fetch_add(p, v, __ATOMIC_RELAXED, __HIP_MEMORY_SCOPE_AGENT); }
__device__ __forceinline__ unsigned xb_xcc_id() { return (unsigned)__builtin_amdgcn_s_getreg((3 << 11) | 20) & 0xFu; }
#define XB_SPIN(cond, bar) do { unsigned _sp = 0; while (cond) { __builtin_amdgcn_s_sleep(1); \
    if ((++_sp & 255u) == 0u) { if (xb_ld(&(bar)[XB_TMO])) break; if (_sp > XB_SPIN_CAP) { atomicAdd(&(bar)[XB_TMO], 1u); break; } } } } while (0)

struct XcdBarrier {
    unsigned* bar; unsigned x;
    volatile LAS unsigned* st;
};

__device__ __forceinline__ XcdBarrier xcd_barrier_post(unsigned* bar, volatile LAS unsigned* st) {
    XcdBarrier b; b.bar = bar; b.x = xb_xcc_id(); b.st = st;
    if (threadIdx.x == 0) (void)xb_add(&bar[XB_XCNT(b.x)], 1u);
    return b;
}
__device__ __forceinline__ void xcd_barrier_complete(unsigned* bar, unsigned x, unsigned& nloc, unsigned& nx) {
    const unsigned G = gridDim.x * gridDim.y * gridDim.z;
    unsigned sum, cnt, mine, sp = 0u;
    for (;;) {
        sum = 0u; cnt = 0u; mine = 0u;
#pragma unroll
        for (unsigned j = 0; j < 16; ++j) { const unsigned c = xb_ld(&bar[XB_XCNT(j)]); sum += c; cnt += (c > 0u) ? 1u : 0u; mine = (j == x) ? c : mine; }
        if (sum == G) break;
        __builtin_amdgcn_s_sleep(1);
        if ((++sp & 255u) == 0u) { if (xb_ld(&bar[XB_TMO])) break; if (sp > XB_SPIN_CAP) { atomicAdd(&bar[XB_TMO], 1u); break; } }
    }
    nloc = mine > 0u ? mine : 1u; nx = cnt > 0u ? cnt : 1u;
}

__device__ __forceinline__ void xcd_barrier(const XcdBarrier& b) {
    asm volatile("s_waitcnt vmcnt(0)" ::: "memory");
    __syncthreads();
    if (threadIdx.x == 0) {
        unsigned* bar = b.bar;
        __builtin_amdgcn_s_waitcnt(0);
        unsigned nloc = b.st[0], nx = b.st[1];
        if (nloc == 0u) { xcd_barrier_complete(bar, b.x, nloc, nx); b.st[0] = nloc; b.st[1] = nx; }
        const unsigned old = xb_add(&bar[XB_XSUB(b.x)], 1u);
        const unsigned gen = old / nloc;
        if (old + 1u == (gen + 1u) * nloc) {
            __builtin_amdgcn_fence(__ATOMIC_RELEASE, "agent");
            asm volatile("s_waitcnt vmcnt(0)" ::: "memory");
            const unsigned og = xb_add(&bar[XB_TOP], 1u);
            const unsigned tg = og / nx;
            if (og + 1u == (tg + 1u) * nx) xb_add(&bar[XB_TOPGEN], 1u);
            else XB_SPIN(xb_ld(&bar[XB_TOPGEN]) == tg, bar);
            __builtin_amdgcn_fence(__ATOMIC_ACQUIRE, "agent");
            xb_add(&bar[XB_XGEN(b.x)], 1u);
            asm volatile("s_waitcnt vmcnt(0)" ::: "memory");
        } else {
            XB_SPIN(xb_ld(&bar[XB_XGEN(b.x)]) == gen, bar);
            __builtin_amdgcn_fence(__ATOMIC_ACQUIRE, "agent");
            asm volatile("s_waitcnt vmcnt(0)" ::: "memory");
        }
    }
    __syncthreads();
}


#define DI __device__ __forceinline__

using pg8::bf16_t; using pg8::bf16x8; using pg8::f32x4; using pg8::f32x2; using pg8::u32x4; using pg8::Unit;
typedef unsigned u32x2 __attribute__((ext_vector_type(2)));
typedef short s16x4 __attribute__((ext_vector_type(4)));
typedef __bf16 bf2_t __attribute__((ext_vector_type(2)));

constexpr int NB = 8, T = 4096, D = 1024, NTOK = NB * T, CTXL = 256, NCTX = NB * CTXL, NP = 3072, NC = 32;
constexpr int NTHREADS = 512;
constexpr int LDS_BYTES = 147456 + 256;
constexpr float EPS = 1e-6f, LOG2E = 1.4426950408889634f;

constexpr size_t al256(size_t x) { return (x + 255) & ~(size_t)255; }
constexpr size_t WS_MOD  = 0;
constexpr size_t WS_ROPE = WS_MOD + al256(9 * 3072 * 4);
constexpr size_t WS_WIN  = WS_ROPE + 8192;
constexpr size_t WS_WOUT = WS_WIN + (size_t)3072 * 1024 * 2;
constexpr size_t WS_WSB  = WS_WOUT + (size_t)1024 * 1024 * 2;
constexpr size_t WS_H    = WS_WSB + (size_t)4 * 128 * 128 * 2;
constexpr size_t WS_Q    = WS_H + (size_t)(NTOK + NCTX) * 1024 * 2;
constexpr size_t WS_K    = WS_Q + (size_t)NTOK * 256 * 2;
constexpr size_t WS_V    = WS_K + (size_t)NTOK * 256 * 2;
constexpr size_t WS_GR   = WS_V + (size_t)NTOK * 512 * 2;
constexpr size_t WS_U    = WS_GR + (size_t)NTOK * 512 * 2;
constexpr size_t WS_VG   = WS_U + (size_t)NTOK * 512 * 2;
constexpr size_t WS_GM   = WS_VG + (size_t)NTOK * 512 * 2;
constexpr size_t WS_KC   = WS_GM + (size_t)NTOK * 512 * 2;
constexpr size_t WS_VC   = WS_KC + (size_t)NCTX * 256 * 2;
constexpr size_t WS_KV   = WS_VC + (size_t)NCTX * 512 * 2;
constexpr size_t WS_KVC  = WS_KV + (size_t)1024 * 2 * 8192 * 4;
constexpr size_t WS_ST   = WS_KVC + (size_t)64 * 2 * 8192 * 4;
constexpr size_t WS_BAR  = WS_ST + (size_t)1024 * 2 * 8192 * 2;
constexpr size_t WS_CNT  = WS_BAR + (size_t)XCD_BAR_WORDS * 4;
constexpr size_t WS_SLOT = WS_CNT + 32768;
constexpr size_t WS_END  = WS_SLOT + (size_t)NTOK * 16 * 4;

struct Args {
    const float* x; const float* c; const float* ctx; const float* c_ctx; const float* w_ada; const float* b_ada; const float* norm_w; const float* w_in;
    const float* dec_f; const float* dec_b; const float* gn_w; const float* ln_w; const float* w_s; const float* b_s; const float* w_out; const float* fnorm_w;
    float* out; unsigned char* ws; int ph_lo, ph_hi;
};

DI unsigned pk2(float lo, float hi) { f32x2 v = {lo, hi}; bf2_t r = __builtin_convertvector(v, bf2_t); return __builtin_bit_cast(unsigned, r); }
DI f32x4 ldnt_f4(const float* p) { return __builtin_nontemporal_load((const f32x4*)p); }
DI u32x4 ldnt_u4(const void* p) { return __builtin_nontemporal_load((const u32x4*)p); }
DI u32x2 ldnt_u2(const void* p) { return __builtin_nontemporal_load((const u32x2*)p); }
DI float bflo(unsigned w) { return __uint_as_float(w << 16); }
DI float bfhi(unsigned w) { return __uint_as_float(w & 0xffff0000u); }
DI float silu_f(float v) { return v * __builtin_amdgcn_rcpf(1.0f + __expf(-v)); }
DI void lds_barrier() { asm volatile("s_waitcnt lgkmcnt(0)" ::: "memory"); __builtin_amdgcn_s_barrier(); asm volatile("" ::: "memory"); }
DI f32x4 mfma16(bf16x8 a, bf16x8 b, f32x4 c) { return __builtin_amdgcn_mfma_f32_16x16x32_bf16(a, b, c, 0, 0, 0); }

DI bf16x8 frag_tr(LAS const unsigned char* base, int S, int k0, int n0, int lane) {
    const int i = lane & 15, g = lane >> 4;
    LAS const unsigned char* p = base + (k0 + 4 * g + (i >> 2)) * S + (n0 + 4 * (i & 3)) * 2;
    const s16x4 lo = __builtin_amdgcn_ds_read_tr16_b64_v4i16((LAS s16x4*)p);
    const s16x4 hi = __builtin_amdgcn_ds_read_tr16_b64_v4i16((LAS s16x4*)(p + 16 * S));
    return __builtin_shufflevector(lo, hi, 0, 1, 2, 3, 4, 5, 6, 7);
}
DI bf16x8 frag_rowP(const bf16_t* rowk0, int g) {
    const u32x2 lo = *(const u32x2*)(rowk0 + 4 * g), hi = *(const u32x2*)(rowk0 + 16 + 4 * g);
    const u32x4 v = {lo.x, lo.y, hi.x, hi.y}; return __builtin_bit_cast(bf16x8, v);
}
DI bf16x8 frag_rowP_lds(LAS const unsigned char* rowk0, int g) {
    const u32x2 lo = *(LAS const u32x2*)(rowk0 + 8 * g), hi = *(LAS const u32x2*)(rowk0 + 32 + 8 * g);
    const u32x4 v = {lo.x, lo.y, hi.x, hi.y}; return __builtin_bit_cast(bf16x8, v);
}
DI bf16x8 scale_frag(bf16x8 f, float s) {
    const u32x4 u = __builtin_bit_cast(u32x4, f); u32x4 r;
#pragma unroll
    for (int q = 0; q < 4; ++q) r[q] = pk2(bflo(u[q]) * s, bfhi(u[q]) * s);
    return __builtin_bit_cast(bf16x8, r);
}

struct EpiIn {
    static constexpr bool PERM = true, AFTER_DRAIN = false, REALIGN = false;
    unsigned char* ws;
    DI void operator()(const f32x4 (&acc)[2][2][4][2], const Unit& u, int wr, int wc, int fr, int fq) const {
        const int pn = u.pn, rbase = u.pm * 256 + wr * 64 + fr, cbase = wc * 32 + 8 * fq;
        if (u.pm >= 128) {
            bf16_t* dst = (bf16_t*)(ws + (pn == 1 ? WS_KC : WS_VC));
            const float scl = pn == 1 ? 0.125f : 1.0f;
#pragma unroll
            for (int ai = 0; ai < 2; ++ai)
#pragma unroll
                for (int m = 0; m < 4; ++m) {
                    const int rc = rbase + ai * 128 + m * 16 - NTOK, b = rc >> 8, t = rc & 255;
#pragma unroll
                    for (int bj = 0; bj < 2; ++bj) {
                        const f32x4 v0 = acc[ai][bj][m][0] * scl, v1 = acc[ai][bj][m][1] * scl;
                        const u32x4 o = {pk2(v0[0], v0[1]), pk2(v0[2], v0[3]), pk2(v1[0], v1[1]), pk2(v1[2], v1[3])};
                        size_t off;
                        if (pn == 1) { const int head = bj * 2 + (wc >> 1), d0 = (wc & 1) * 32 + 8 * fq; off = ((size_t)((b * 4 + head) * 256 + t)) * 64 + d0; }
                        else { const int head = (pn - 2) * 2 + bj; off = ((size_t)(((b * 4 + head) * 8 + (cbase >> 4)) * 256 + t)) * 16 + (cbase & 15); }
                        *(u32x4*)(dst + off) = o;
                    }
                }
            return;
        }
        if (pn <= 1) {
            bf16_t* dst = (bf16_t*)(ws + (pn == 0 ? WS_Q : WS_K));
            const float scl = pn == 0 ? 1.0f : 0.125f;
            const float* rc = (const float*)(ws + WS_ROPE); const float* rs = rc + 1024;
            const int hh = wc & 1, fi0 = 8 * (fq & 1); const bool second = fq >= 2;
#pragma unroll
            for (int ai = 0; ai < 2; ++ai)
#pragma unroll
                for (int m = 0; m < 4; ++m) {
                    const int r = rbase + ai * 128 + m * 16, b = r >> 12, t = r & 4095, pos = hh ? (t & 63) : (t >> 6);
                    const f32x4 c0 = *(const f32x4*)(rc + pos * 16 + fi0), c1 = *(const f32x4*)(rc + pos * 16 + fi0 + 4);
                    const f32x4 s0 = *(const f32x4*)(rs + pos * 16 + fi0), s1 = *(const f32x4*)(rs + pos * 16 + fi0 + 4);
#pragma unroll
                    for (int bj = 0; bj < 2; ++bj) {
                        const f32x4 v0 = acc[ai][bj][m][0], v1 = acc[ai][bj][m][1];
                        float o[8];
#pragma unroll
                        for (int j = 0; j < 4; ++j) {
                            const float xa = v0[j], xb = v1[j], pa = __shfl_xor(xa, 32), pb = __shfl_xor(xb, 32);
                            o[j]     = (second ? (pa * s0[j] + xa * c0[j]) : (xa * c0[j] - pa * s0[j])) * scl;
                            o[4 + j] = (second ? (pb * s1[j] + xb * c1[j]) : (xb * c1[j] - pb * s1[j])) * scl;
                        }
                        const u32x4 ov = {pk2(o[0], o[1]), pk2(o[2], o[3]), pk2(o[4], o[5]), pk2(o[6], o[7])};
                        const int head = bj * 2 + (wc >> 1), d0 = hh * 32 + 8 * fq;
                        *(u32x4*)(dst + ((size_t)((b * 4 + head) * 4096 + t)) * 64 + d0) = ov;
                    }
                }
            return;
        }
        if (pn <= 3) {
            bf16_t* dst = (bf16_t*)(ws + WS_V);
#pragma unroll
            for (int ai = 0; ai < 2; ++ai)
#pragma unroll
                for (int m = 0; m < 4; ++m) {
                    const int r = rbase + ai * 128 + m * 16, b = r >> 12, t = r & 4095;
#pragma unroll
                    for (int bj = 0; bj < 2; ++bj) {
                        const f32x4 v0 = acc[ai][bj][m][0], v1 = acc[ai][bj][m][1];
                        const u32x4 o = {pk2(v0[0], v0[1]), pk2(v0[2], v0[3]), pk2(v1[0], v1[1]), pk2(v1[2], v1[3])};
                        const int head = (pn - 2) * 2 + bj;
                        *(u32x4*)(dst + ((size_t)(((b * 4 + head) * 8 + (cbase >> 4)) * 4096 + t)) * 16 + (cbase & 15)) = o;
                    }
                }
            return;
        }
        if (pn == 6 || pn == 7 || pn >= 10) {
            const int t = pn == 6 ? 0 : (pn == 7 ? 1 : (pn == 10 ? 2 : 3));
            bf16_t* dst = (bf16_t*)(ws + WS_U);
#pragma unroll
            for (int ai = 0; ai < 2; ++ai)
#pragma unroll
                for (int m = 0; m < 4; ++m) {
                    const int r = rbase + ai * 128 + m * 16;
                    const f32x4 u0 = acc[ai][0][m][0], u1 = acc[ai][0][m][1], g0 = acc[ai][1][m][0], g1 = acc[ai][1][m][1];
                    const f32x2 a0 = pg8::gelu_pk((f32x2){u0[0], u0[1]}), a1 = pg8::gelu_pk((f32x2){u0[2], u0[3]}), a2 = pg8::gelu_pk((f32x2){u1[0], u1[1]}), a3 = pg8::gelu_pk((f32x2){u1[2], u1[3]});
                    const u32x4 o = {pk2(a0.x * silu_f(g0[0]), a0.y * silu_f(g0[1])), pk2(a1.x * silu_f(g0[2]), a1.y * silu_f(g0[3])),
                                     pk2(a2.x * silu_f(g1[0]), a2.y * silu_f(g1[1])), pk2(a3.x * silu_f(g1[2]), a3.y * silu_f(g1[3]))};
                    *(u32x4*)(dst + (size_t)r * 512 + 128 * t + cbase) = o;
                }
            return;
        }
        {
            const int region = (pn - 4) >> 1; const bool is_gelu = (region == 1) || (region == 2);
            bf16_t* dst = (bf16_t*)(ws + WS_GR + (size_t)region * ((size_t)NTOK * 512 * 2));
            const int colb = ((pn - 4) & 1) * 256 + cbase;
#pragma unroll
            for (int ai = 0; ai < 2; ++ai)
#pragma unroll
                for (int m = 0; m < 4; ++m) {
                    const int r = rbase + ai * 128 + m * 16;
#pragma unroll
                    for (int bj = 0; bj < 2; ++bj) {
                        const f32x4 v0 = acc[ai][bj][m][0], v1 = acc[ai][bj][m][1];
                        u32x4 o;
                        if (is_gelu) {
                            const f32x2 a = pg8::gelu_pk((f32x2){v0[0], v0[1]}), bq = pg8::gelu_pk((f32x2){v0[2], v0[3]}), cq = pg8::gelu_pk((f32x2){v1[0], v1[1]}), dq = pg8::gelu_pk((f32x2){v1[2], v1[3]});
                            o = (u32x4){pk2(a.x, a.y), pk2(bq.x, bq.y), pk2(cq.x, cq.y), pk2(dq.x, dq.y)};
                        } else {
                            o = (u32x4){pk2(silu_f(v0[0]), silu_f(v0[1])), pk2(silu_f(v0[2]), silu_f(v0[3])), pk2(silu_f(v1[0]), silu_f(v1[1])), pk2(silu_f(v1[2]), silu_f(v1[3]))};
                        }
                        *(u32x4*)(dst + (size_t)r * 512 + colb + bj * 128) = o;
                    }
                }
        }
    }
};
struct EpiOut {
    static constexpr bool PERM = false, AFTER_DRAIN = false, REALIGN = true;
    const float* x; const float* mod; const float* fw; float* out; float* slots; unsigned* cnt;
    DI void operator()(const f32x4 (&acc_)[2][2][4][2], const Unit& u, int wr, int wc, int fr, int fq) const {
        f32x4 (&acc)[2][2][4][2] = const_cast<f32x4 (&)[2][2][4][2]>(acc_);
        const int rbase = u.pm * 256 + wr * 64 + fr, cbase = u.pn * 256 + wc * 32 + 4 * fq;
        const float* gate = mod + (size_t)(rbase >> 12) * 3072 + 2048;
        f32x4 gv[2][2];
#pragma unroll
        for (int bj = 0; bj < 2; ++bj)
#pragma unroll
            for (int n = 0; n < 2; ++n) gv[bj][n] = *(const f32x4*)(gate + cbase + bj * 128 + n * 16);
        f32x4 xv[2][4]; float ss[8];
#pragma unroll
        for (int q = 0; q < 4; ++q) xv[0][q] = ldnt_f4(x + (size_t)rbase * 1024 + cbase + (q >> 1) * 128 + (q & 1) * 16);
#pragma unroll
        for (int k = 0; k < 8; ++k) {
            const int ai = k >> 2, m = k & 3;
            if (k + 1 < 8) {
                const size_t ro = (size_t)(rbase + ((k + 1) >> 2) * 128 + ((k + 1) & 3) * 16) * 1024 + cbase;
#pragma unroll
                for (int q = 0; q < 4; ++q) xv[(k + 1) & 1][q] = ldnt_f4(x + ro + (q >> 1) * 128 + (q & 1) * 16);
            }
            float sk = 0.f;
#pragma unroll
            for (int q = 0; q < 4; ++q) {
                const int bj = q >> 1, n = q & 1;
                const f32x4 v = xv[k & 1][q] + gv[bj][n] * acc[ai][bj][m][n];
                acc[ai][bj][m][n] = v;
                sk += v[0] * v[0] + v[1] * v[1] + v[2] * v[2] + v[3] * v[3];
            }
            ss[k] = sk;
        }
#pragma unroll
        for (int k = 0; k < 8; ++k) { ss[k] += __shfl_xor(ss[k], 16); ss[k] += __shfl_xor(ss[k], 32); }
        if (fq == 0) {
#pragma unroll
            for (int k = 0; k < 8; ++k)
                __hip_atomic_store(slots + (size_t)(rbase + (k >> 2) * 128 + (k & 3) * 16) * 16 + u.pn * 4 + wc, ss[k], __ATOMIC_RELAXED, __HIP_MEMORY_SCOPE_AGENT);
        }
        asm volatile("s_waitcnt vmcnt(0)" ::: "memory");
        if ((threadIdx.x & 63) == 0) {
            __hip_atomic_fetch_add(cnt + u.pm * 64, 1u, __ATOMIC_RELAXED, __HIP_MEMORY_SCOPE_AGENT);
            unsigned spins = 0;
            while (__hip_atomic_load(cnt + u.pm * 64, __ATOMIC_RELAXED, __HIP_MEMORY_SCOPE_AGENT) < 32u) { __builtin_amdgcn_s_sleep(8); if (++spins > (1u << 22)) break; }
        }
        __builtin_amdgcn_fence(__ATOMIC_ACQUIRE, "agent");
        asm volatile("s_waitcnt vmcnt(0)" ::: "memory");
        f32x4 sl[8];
#pragma unroll
        for (int k = 0; k < 8; ++k) sl[k] = *(const f32x4*)(slots + (size_t)(rbase + (k >> 2) * 128 + (k & 3) * 16) * 16 + fq * 4);
        f32x4 fv[2][2];
#pragma unroll
        for (int bj = 0; bj < 2; ++bj)
#pragma unroll
            for (int n = 0; n < 2; ++n) fv[bj][n] = *(const f32x4*)(fw + cbase + bj * 128 + n * 16);
        float rs[8];
#pragma unroll
        for (int k = 0; k < 8; ++k) {
            float t = (sl[k][0] + sl[k][1]) + (sl[k][2] + sl[k][3]);
            t += __shfl_xor(t, 16); t += __shfl_xor(t, 32);
            rs[k] = rsqrtf(t * (1.0f / 1024.0f) + EPS);
        }
#pragma unroll
        for (int k = 0; k < 8; ++k) {
            const int ai = k >> 2, m = k & 3;
            const size_t ro = (size_t)(rbase + ai * 128 + m * 16) * 1024 + cbase;
#pragma unroll
            for (int bj = 0; bj < 2; ++bj)
#pragma unroll
                for (int n = 0; n < 2; ++n) __builtin_nontemporal_store(acc[ai][bj][m][n] * rs[k] * fv[bj][n], (f32x4*)(out + ro + bj * 128 + n * 16));
        }
    }
};
struct SchedIn {
    pg8::StaticOrder so;
    DI bool next(int i, Unit& u) const {
        if (so.G == 256) {
            const int x = so.c & 7, j = so.c >> 3;
            if (j < 3) {
                if (i == 0) { u.pm = 128 + x; u.pn = 1 + j; return true; }
                if (i > 6) return false;
                const int q = 6 * j + (i - 1);
                u.pm = 16 * x + (q >> 2); u.pn = q & 3; return true;
            }
            if (i > 5) return false;
            const int e = (j - 3) + 29 * i;
            if (e < 64) { u.pm = 16 * x + (e >> 2); u.pn = 6 + (e & 3); }
            else if (e < 128) { const int t = e & 3; u.pm = 16 * x + ((e - 64) >> 2); u.pn = t < 2 ? 10 + t : 2 + t; }
            else { const int q = 18 + (e - 128); u.pm = 16 * x + (q >> 2); u.pn = q & 3; }
            return true;
        }
        long L = (long)i * so.G + so.c;
        if (L < so.nwg) return so.next(i, u);
        L -= so.nwg; if (L >= 24) return false;
        u.pm = 128 + (int)(L / 3); u.pn = 1 + (int)(L % 3); return true;
    }
    DI void a_ready(const Unit&) const {}
    DI void done(const Unit&) const {}
};

DI void phase0(const Args& a, LAS unsigned char* lds) {
    const int tid = threadIdx.x;
    float* mod = (float*)(a.ws + WS_MOD);
    LAS float* red = (LAS float*)lds;
    for (int it = blockIdx.x; it < 1233; it += gridDim.x) {
        if (it < 192) {
            const int c0 = it * 16, f = tid & 3, rg = tid >> 2;
            LAS float* scv = red + 36 * 512;
            for (int q = tid; q < 9 * 1024; q += NTHREADS) { const float cv = (q < 8192) ? a.c[q] : a.c_ctx[q - 8192]; scv[q] = cv / (1.0f + expf(-cv)); }
            __syncthreads();
            float acc[9][4];
#pragma unroll
            for (int j = 0; j < 9; ++j)
#pragma unroll
                for (int e = 0; e < 4; ++e) acc[j][e] = 0.f;
            f32x4 wv[8];
#pragma unroll
            for (int i = 0; i < 8; ++i) wv[i] = ldnt_f4(a.w_ada + (size_t)(rg + 128 * i) * 3072 + c0 + f * 4);
#pragma unroll
            for (int i = 0; i < 8; ++i) {
                const int r = rg + 128 * i;
#pragma unroll
                for (int j = 0; j < 9; ++j) {
                    const float sv = scv[j * 1024 + r];
#pragma unroll
                    for (int e = 0; e < 4; ++e) acc[j][e] += sv * wv[i][e];
                }
            }
#pragma unroll
            for (int j = 0; j < 9; ++j)
#pragma unroll
                for (int e = 0; e < 4; ++e) red[(j * 4 + e) * 512 + tid] = acc[j][e];
            __syncthreads();
            if (tid < 144) {
                const int j = tid >> 4, cc = tid & 15, ff = cc >> 2, e = cc & 3;
                float s = 0.f;
                for (int q = 0; q < 128; ++q) s += red[(j * 4 + e) * 512 + q * 4 + ff];
                mod[j * 3072 + c0 + cc] = s + a.b_ada[c0 + cc];
            }
            __syncthreads();
        } else if (it < 1216) {
            const bool is_in = it < 960; const int tt = is_in ? it - 192 : it - 960;
            const int nN = is_in ? 48 : 16, NN = is_in ? 3072 : 1024;
            const int k0 = (tt / nN) * 64, n0 = (tt % nN) * 64;
            int ns = n0;
            if (is_in && ((n0 >= 1536 && n0 < 2048) || n0 >= 2560)) {
                const int base = n0 >= 2560 ? 2560 : 1536, t = (n0 >= 2560 ? 2 : 0) + (n0 - base) / 256, w = (n0 - base) % 256;
                ns = (w < 128 ? 1536 : 2560 - 128) + 128 * t + w;
            }
            const float* src = is_in ? a.w_in : a.w_out;
            bf16_t* dst = (bf16_t*)(a.ws + (is_in ? WS_WIN : WS_WOUT));
            const int kr = tid >> 4, n4 = tid & 15;
#pragma unroll
            for (int p = 0; p < 2; ++p) {
                const int k = kr + 32 * p;
                const f32x4 v = ldnt_f4(src + (size_t)(k0 + k) * NN + ns + n4 * 4);
#pragma unroll
                for (int e = 0; e < 4; ++e) red[k * 65 + n4 * 4 + e] = v[e];
            }
            __syncthreads();
            const int n = tid >> 3, k8 = tid & 7;
            float v[8];
#pragma unroll
            for (int j = 0; j < 8; ++j) v[j] = red[(k8 * 8 + j) * 65 + n];
            const u32x4 o = {pk2(v[0], v[1]), pk2(v[2], v[3]), pk2(v[4], v[5]), pk2(v[6], v[7])};
            *(u32x4*)(dst + (size_t)(n0 + n) * 1024 + k0 + k8 * 8) = o;
            __syncthreads();
        } else if (it < 1232) {
            const size_t base = (size_t)(it - 1216) * 4096 + tid * 8;
            const f32x4 v0 = *(const f32x4*)(a.w_s + base), v1 = *(const f32x4*)(a.w_s + base + 4);
            const u32x4 o = {pk2(v0[0], v0[1]), pk2(v0[2], v0[3]), pk2(v1[0], v1[1]), pk2(v1[2], v1[3])};
            *(u32x4*)((bf16_t*)(a.ws + WS_WSB) + base) = o;
        } else {
            float* rc = (float*)(a.ws + WS_ROPE); float* rs = rc + 1024;
            for (int idx = tid; idx < 1024; idx += NTHREADS) {
                const int pos = idx >> 4, fi = idx & 15;
                const float inv = powf(10000.0f, -(float)fi / 16.0f), ang = (float)pos * inv;
                rc[idx] = cosf(ang); rs[idx] = sinf(ang);
            }
        }
    }
}

template <int R> DI void norm_rows(const Args& a, const float* mod, bf16_t* H, const int (&rows)[R], int lane) {
    f32x4 v[R][4]; const float* mrow[R];
#pragma unroll
    for (int k = 0; k < R; ++k) {
        const int r = rows[k]; const float* src; int j;
        if (r < NTOK) { src = a.x + (size_t)r * 1024; j = r >> 12; } else { src = a.ctx + (size_t)(r - NTOK) * 1024; j = 8; }
        mrow[k] = mod + j * 3072;
#pragma unroll
        for (int q = 0; q < 4; ++q) v[k][q] = ldnt_f4(src + q * 256 + lane * 4);
    }
#pragma unroll
    for (int k = 0; k < R; ++k) {
        float ss = 0.f;
#pragma unroll
        for (int q = 0; q < 4; ++q) ss += v[k][q][0] * v[k][q][0] + v[k][q][1] * v[k][q][1] + v[k][q][2] * v[k][q][2] + v[k][q][3] * v[k][q][3];
#pragma unroll
        for (int off = 32; off >= 1; off >>= 1) ss += __shfl_xor(ss, off);
        const float rstd = rsqrtf(ss * (1.0f / 1024.0f) + EPS);
#pragma unroll
        for (int q = 0; q < 4; ++q) {
            const int cidx = q * 256 + lane * 4;
            const f32x4 nw = *(const f32x4*)(a.norm_w + cidx), sc = *(const f32x4*)(mrow[k] + 1024 + cidx), sh = *(const f32x4*)(mrow[k] + cidx);
            f32x4 hv;
#pragma unroll
            for (int e = 0; e < 4; ++e) hv[e] = (v[k][q][e] * rstd * nw[e]) * (1.0f + sc[e]) + sh[e];
            const u32x2 o = {pk2(hv[0], hv[1]), pk2(hv[2], hv[3])};
            *(u32x2*)(H + (size_t)rows[k] * 1024 + cidx) = o;
        }
    }
}
DI void norm_row(const Args& a, const float* mod, bf16_t* H, int r, int lane) { const int rows[1] = {r}; norm_rows<1>(a, mod, H, rows, lane); }
DI void phase1(const Args& a) {
    const int tid = threadIdx.x, wave = tid >> 6, lane = tid & 63, blk = blockIdx.x, G = gridDim.x;
    const float* mod = (const float*)(a.ws + WS_MOD);
    bf16_t* H = (bf16_t*)(a.ws + WS_H);
    constexpr int NCH = (NTOK + NCTX) / 8;
    int ch = blk;
    for (; ch + 3 * G < NCH; ch += 4 * G) { const int rows[4] = {ch * 8 + wave, (ch + G) * 8 + wave, (ch + 2 * G) * 8 + wave, (ch + 3 * G) * 8 + wave}; norm_rows<4>(a, mod, H, rows, lane); }
    for (; ch < NCH; ch += G) norm_row(a, mod, H, ch * 8 + wave, lane);
}

constexpr int VS = 288, KS = 144, KS2 = 160;
DI void gmlp_unit(const Args& a, LAS unsigned char* lds, int b, int c) {
    const int tid = threadIdx.x, lane = tid & 63, w = tid >> 6, i = lane & 15, g = lane >> 4;
    const int r0 = b * 4096 + c * 128;
    const bf16_t* VG = (const bf16_t*)(a.ws + WS_VG); const bf16_t* U = (const bf16_t*)(a.ws + WS_U);
    const bf16_t* WSB = (const bf16_t*)(a.ws + WS_WSB); bf16_t* Y = (bf16_t*)(a.ws + WS_H);
    constexpr int GSZ = 128 * VS;
    {
        const int row = tid >> 2, q = tid & 3;
        const bf16_t* src = VG + (size_t)(r0 + row) * 512 + q * 8;
        float s = 0.f, s2 = 0.f;
#pragma unroll 8
        for (int p = 0; p < 16; ++p) {
            const u32x4 pc = *(const u32x4*)(src + p * 32);
#pragma unroll
            for (int e = 0; e < 4; ++e) { const float lo = bflo(pc[e]), hi = bfhi(pc[e]); s += lo + hi; s2 += lo * lo + hi * hi; }
        }
        s += __shfl_xor(s, 1); s += __shfl_xor(s, 2); s2 += __shfl_xor(s2, 1); s2 += __shfl_xor(s2, 2);
        const float mean = s * (1.0f / 512.0f);
        const float var = fmaxf(s2 * (1.0f / 512.0f) - mean * mean, 0.f);
        const float rstd = rsqrtf(var + EPS);
        const float* lw = a.ln_w + q * 8;
#pragma unroll 4
        for (int p = 0; p < 16; ++p) {
            const u32x4 pc = *(const u32x4*)(src + p * 32);
            const f32x4 w0 = *(const f32x4*)(lw + p * 32), w1 = *(const f32x4*)(lw + p * 32 + 4);
            u32x4 o;
            o[0] = pk2((bflo(pc[0]) - mean) * rstd * w0[0], (bfhi(pc[0]) - mean) * rstd * w0[1]);
            o[1] = pk2((bflo(pc[1]) - mean) * rstd * w0[2], (bfhi(pc[1]) - mean) * rstd * w0[3]);
            o[2] = pk2((bflo(pc[2]) - mean) * rstd * w1[0], (bfhi(pc[2]) - mean) * rstd * w1[1]);
            o[3] = pk2((bflo(pc[3]) - mean) * rstd * w1[2], (bfhi(pc[3]) - mean) * rstd * w1[3]);
            *(LAS u32x4*)(lds + (p >> 2) * GSZ + row * VS + ((p & 3) * 4 + q) * 16) = o;
        }
    }
    __syncthreads();
    const int n = 16 * w + i, r = r0 + n;
#pragma unroll 1
    for (int gq = 0; gq < 4; ++gq) {
        f32x4 acc[8];
#pragma unroll
        for (int et = 0; et < 8; ++et) acc[et] = (f32x4){0.f, 0.f, 0.f, 0.f};
        const bf16_t* wrow = WSB + (size_t)(gq * 128 + n) * 128;
        bf16x8 bw[4];
#pragma unroll
        for (int s = 0; s < 4; ++s) bw[s] = frag_rowP(wrow + 32 * s, g);
#pragma unroll
        for (int s = 0; s < 4; ++s) {
#pragma unroll
            for (int et = 0; et < 8; ++et) acc[et] = mfma16(frag_tr(lds + gq * GSZ, VS, 32 * s, 16 * et, lane), bw[s], acc[et]);
        }
        const float bias = a.b_s[gq * 128 + n];
#pragma unroll
        for (int et = 0; et < 8; et += 2) {
            const int colw = gq * 128 + 16 * (et + (g & 1)) + 8 * (g >> 1);
            const u32x4 uw = *(const u32x4*)(U + (size_t)r * 512 + colw);
            const u32x2 ux = __builtin_amdgcn_permlane16_swap(uw[0], uw[2], false, false), uy = __builtin_amdgcn_permlane16_swap(uw[1], uw[3], false, false);
            const u32x2 ua = {ux[0], uy[0]}, ub = {ux[1], uy[1]};
            const u32x2 oa = {pk2(bflo(ua.x) * (acc[et][0] + bias), bfhi(ua.x) * (acc[et][1] + bias)), pk2(bflo(ua.y) * (acc[et][2] + bias), bfhi(ua.y) * (acc[et][3] + bias))};
            const u32x2 ob = {pk2(bflo(ub.x) * (acc[et + 1][0] + bias), bfhi(ub.x) * (acc[et + 1][1] + bias)), pk2(bflo(ub.y) * (acc[et + 1][2] + bias), bfhi(ub.y) * (acc[et + 1][3] + bias))};
            const u32x2 wx = __builtin_amdgcn_permlane16_swap(oa.x, ob.x, false, false), wy = __builtin_amdgcn_permlane16_swap(oa.y, ob.y, false, false);
            const u32x4 ow = {wx[0], wy[0], wx[1], wy[1]};
            __builtin_nontemporal_store(ow, (u32x4*)(Y + (size_t)r * 1024 + 512 + colw));
        }
    }
    __syncthreads();
}
struct ChStage { u32x4 kf[2], kb[2], v; };
DI void chain_load(const Args& a, int bh, int es, int it, ChStage& st) {
    const int tid = threadIdx.x;
    const bf16_t *Kf, *Kb, *Vf, *Vb;
    if (it < 2) {
        const size_t of = (size_t)bh * 256 + it * 128, ob = (size_t)bh * 256 + (1 - it) * 128;
        Kf = (const bf16_t*)(a.ws + WS_KC) + of * 64; Kb = (const bf16_t*)(a.ws + WS_KC) + ob * 64;
        Vf = (const bf16_t*)(a.ws + WS_VC) + (((size_t)bh * 8 + es) * 256 + it * 128) * 16; Vb = (const bf16_t*)(a.ws + WS_VC) + (((size_t)bh * 8 + es) * 256 + (1 - it) * 128) * 16;
    } else {
        const size_t of = (size_t)bh * 4096 + (it - 2) * 128, ob = (size_t)bh * 4096 + (33 - it) * 128;
        Kf = (const bf16_t*)(a.ws + WS_K) + of * 64; Kb = (const bf16_t*)(a.ws + WS_K) + ob * 64;
        Vf = (const bf16_t*)(a.ws + WS_V) + (((size_t)bh * 8 + es) * 4096 + (it - 2) * 128) * 16; Vb = (const bf16_t*)(a.ws + WS_V) + (((size_t)bh * 8 + es) * 4096 + (33 - it) * 128) * 16;
    }
#pragma unroll
    for (int q = 0; q < 2; ++q) { const int p = tid + 512 * q; st.kf[q] = *(const u32x4*)(Kf + (p >> 3) * 64 + (p & 7) * 8); st.kb[q] = *(const u32x4*)(Kb + (p >> 3) * 64 + (p & 7) * 8); }
    const int t = tid & 255; const bf16_t* Vx = (tid < 256) ? Vf : Vb;
    st.v = *(const u32x4*)(Vx + t * 8);
}
DI void chain_item(const Args& a, LAS unsigned char* lds, int item) {
    const int tid = threadIdx.x, lane = tid & 63, w = tid >> 6, i = lane & 15, g = lane >> 4;
    const int bh = item >> 3, es = item & 7, h = bh & 3, dirw = w >> 2, dt = w & 3;
    const float l2f = -expf(a.dec_f[h]) * LOG2E, l2b = -expf(a.dec_b[h]) * LOG2E;
    const float G = exp2f(128.0f * (dirw ? l2b : l2f));
    constexpr int BUFSZ = 2 * 128 * KS2 + 2 * 128 * 32;
    const float tv = (tid < 256) ? exp2f((float)(127 - ((tid & 255) >> 1)) * l2f) : exp2f((float)((tid & 255) >> 1) * l2b);
    bf16_t* ST = (bf16_t*)(a.ws + WS_ST);
    f32x4 S = {0.f, 0.f, 0.f, 0.f};
    ChStage st0, st1, st2, st3;
    chain_load(a, bh, es, 0, st0); chain_load(a, bh, es, 1, st1); chain_load(a, bh, es, 2, st2);
#define CH_STEP(IT, CUR, NXT, STORE) do { const int it = (IT); { \
        LAS unsigned char* buf = lds + (it & 1) * BUFSZ; \
        LAS unsigned char* KFs = buf; LAS unsigned char* KBs = buf + 128 * KS2; LAS unsigned char* VFs = buf + 2 * 128 * KS2; LAS unsigned char* VBs = VFs + 128 * 32; \
        _Pragma("unroll") for (int q = 0; q < 2; ++q) { \
            const int p = tid + 512 * q, m = p >> 3, d8 = p & 7; \
            *(LAS u32x4*)(KFs + m * KS2 + d8 * 16) = CUR.kf[q]; *(LAS u32x4*)(KBs + m * KS2 + d8 * 16) = CUR.kb[q]; \
        } \
        { const int t = tid & 255; u32x4 sv; _Pragma("unroll") for (int e = 0; e < 4; ++e) sv[e] = pk2(bflo(CUR.v[e]) * tv, bfhi(CUR.v[e]) * tv); \
          *(LAS u32x4*)((tid < 256 ? VFs : VBs) + (t >> 1) * 32 + (t & 1) * 16) = sv; } \
        lds_barrier(); \
        chain_load(a, bh, es, (it + 3 < 34) ? it + 3 : 33, NXT);                  \
        LAS const unsigned char* Kx = dirw ? KBs : KFs; LAS const unsigned char* Vx = dirw ? VBs : VFs; \
        f32x4 kv = {0.f, 0.f, 0.f, 0.f}; \
        _Pragma("unroll") for (int s = 0; s < 4; ++s) kv = mfma16(frag_tr(Vx, 32, 32 * s, 0, lane), frag_tr(Kx, KS2, 32 * s, 16 * dt, lane), kv); \
        if (STORE) {                                                              \
            const int c = dirw ? 33 - it : it - 2; \
            const u32x2 o = {pk2(S[0], S[1]), pk2(S[2], S[3])}; \
            *(u32x2*)(ST + (((size_t)(bh * 32 + c) * 2 + dirw) * 64 + 16 * dt + i) * 128 + es * 16 + 4 * g) = o; \
        } \
        S = S * G + kv; } } while (0)
    CH_STEP(0, st0, st3, false); CH_STEP(1, st1, st0, false);
#pragma unroll 1
    for (int it4 = 2; it4 < 34; it4 += 4) {
        CH_STEP(it4, st2, st1, true); CH_STEP(it4 + 1, st3, st2, true); CH_STEP(it4 + 2, st0, st3, true); CH_STEP(it4 + 3, st1, st0, true);
    }
#undef CH_STEP
    __syncthreads();
}
DI void phase3(const Args& a, LAS unsigned char* lds) {
    for (int it = blockIdx.x; it < 256; it += gridDim.x) gmlp_unit(a, lds, it >> 5, it & 31);
    for (int it = blockIdx.x; it < 256; it += gridDim.x) { const int j = it >> 3; chain_item(a, lds, (((it & 7) * 4 + (j >> 3)) << 3) + (j & 7)); }
}

DI void phase4(const Args& a) {
    const float* KV = (const float*)(a.ws + WS_KV); const float* KVC = (const float*)(a.ws + WS_KVC);
    bf16_t* ST = (bf16_t*)(a.ws + WS_ST);
    for (int idx = blockIdx.x * NTHREADS + threadIdx.x; idx < 64 * 2048; idx += gridDim.x * NTHREADS) {
        const int chain = idx >> 11, pos = idx & 2047, bh = chain >> 1, dir = chain & 1, h = bh & 3;
        const float lg = -expf(dir ? a.dec_b[h] : a.dec_f[h]), G = expf(128.0f * lg);
        const f32x4 k0 = *(const f32x4*)(KVC + ((size_t)(bh * 2 + 0) * 2 + dir) * 8192 + pos * 4);
        const f32x4 k1 = *(const f32x4*)(KVC + ((size_t)(bh * 2 + 1) * 2 + dir) * 8192 + pos * 4);
        f32x4 S = dir ? (k1 * G + k0) : (k0 * G + k1);
#pragma unroll 8
        for (int step = 0; step < NC; ++step) {
            const int c = dir ? (NC - 1 - step) : step;
            const size_t off = ((size_t)(bh * 32 + c) * 2 + dir) * 8192 + pos * 4;
            const f32x4 kvv = *(const f32x4*)(KV + off);
            const u32x2 o = {pk2(S[0], S[1]), pk2(S[2], S[3])};
            *(u32x2*)(ST + off) = o;
            S = S * G + kvv;
        }
    }
}

struct RetStage { u32x4 k[2], v[4], sf[2], sb[2]; bf16x8 q[2]; };
DI void ret_load(const Args& a, int unit, RetStage& st) {
    const int tid = threadIdx.x, lane = tid & 63, w = tid >> 6, i = lane & 15, g = lane >> 4;
    const int bh = unit >> 5, c = unit & 31;
    const bf16_t* Qp = (const bf16_t*)(a.ws + WS_Q) + ((size_t)bh * 4096 + c * 128) * 64;
    const bf16_t* Kp = (const bf16_t*)(a.ws + WS_K) + ((size_t)bh * 4096 + c * 128) * 64;
    const bf16_t* Vp = (const bf16_t*)(a.ws + WS_V) + ((size_t)bh * 8 * 4096 + c * 128) * 16;
    const bf16_t* SFp = (const bf16_t*)(a.ws + WS_ST) + (size_t)unit * 16384; const bf16_t* SBp = SFp + 8192;
#pragma unroll
    for (int q = 0; q < 2; ++q) { const int p = tid + 512 * q; st.k[q] = *(const u32x4*)(Kp + (p >> 3) * 64 + (p & 7) * 8); }
#pragma unroll
    for (int q = 0; q < 4; ++q) { const int p = tid + 512 * q; st.v[q] = *(const u32x4*)(Vp + (size_t)(p >> 8) * (4096 * 16) + (p & 255) * 8); }
#pragma unroll
    for (int q = 0; q < 2; ++q) { const int p = tid + 512 * q; st.sf[q] = *(const u32x4*)(SFp + (p >> 4) * 128 + (p & 15) * 8); st.sb[q] = *(const u32x4*)(SBp + (p >> 4) * 128 + (p & 15) * 8); }
#pragma unroll
    for (int s = 0; s < 2; ++s) st.q[s] = frag_rowP(Qp + (16 * w + i) * 64 + 32 * s, g);
}
DI void ret_unit(const Args& a, LAS unsigned char* lds, int unit, RetStage& st, int next_unit) {
    const int tid = threadIdx.x, lane = tid & 63, w = tid >> 6, i = lane & 15, g = lane >> 4;
    const int bh = unit >> 5, c = unit & 31, b = bh >> 2, h = bh & 3;
    const bf16_t* GR = (const bf16_t*)(a.ws + WS_GR); bf16_t* Y = (bf16_t*)(a.ws + WS_H);
    LAS unsigned char* Kt = lds; LAS unsigned char* Vt = lds + 128 * KS; LAS unsigned char* SF = Vt + 128 * VS; LAS unsigned char* SB = SF + 64 * VS;
#pragma unroll
    for (int q = 0; q < 2; ++q) { const int p = tid + 512 * q; *(LAS u32x4*)(Kt + (p >> 3) * KS + (p & 7) * 16) = st.k[q]; }
#pragma unroll
    for (int q = 0; q < 4; ++q) { const int p = tid + 512 * q; *(LAS u32x4*)(Vt + ((p & 255) >> 1) * VS + (p >> 8) * 32 + (p & 1) * 16) = st.v[q]; }
#pragma unroll
    for (int q = 0; q < 2; ++q) { const int p = tid + 512 * q; *(LAS u32x4*)(SF + (p >> 4) * VS + (p & 15) * 16) = st.sf[q]; *(LAS u32x4*)(SB + (p >> 4) * VS + (p & 15) * 16) = st.sb[q]; }
    bf16x8 Qf[2];
#pragma unroll
    for (int s = 0; s < 2; ++s) Qf[s] = st.q[s];
    lds_barrier();
    if (next_unit >= 0) ret_load(a, next_unit, st);
    const float l2f = -expf(a.dec_f[h]) * LOG2E, l2b = -expf(a.dec_b[h]) * LOG2E;
    const int n = 16 * w + i;

    f32x4 accS[8];
#pragma unroll
    for (int mt = 0; mt < 8; ++mt) {
        accS[mt] = (f32x4){0.f, 0.f, 0.f, 0.f};
#pragma unroll
        for (int s = 0; s < 2; ++s) accS[mt] = mfma16(frag_rowP_lds(Kt + (16 * mt + i) * KS + 64 * s, g), Qf[s], accS[mt]);
    }
#pragma unroll
    for (int mt = 0; mt < 8; ++mt)
#pragma unroll
        for (int reg = 0; reg < 4; ++reg) {
            const int diff = n - (16 * mt + 4 * g + reg);
            const float ex = __builtin_amdgcn_exp2f(diff > 0 ? (float)diff * l2f : (float)(-diff) * l2b);
            accS[mt][reg] *= (diff == 0 ? 2.0f : ex);
        }
    const float fsf = __builtin_amdgcn_exp2f((float)(n + 1) * l2f), fsb = __builtin_amdgcn_exp2f((float)(128 - n) * l2b);
    f32x4 accO[8];
#pragma unroll
    for (int et = 0; et < 8; ++et) accO[et] = (f32x4){0.f, 0.f, 0.f, 0.f};
#pragma unroll
    for (int s = 0; s < 4; ++s) {
        const u32x4 pu = {pk2(accS[2 * s][0], accS[2 * s][1]), pk2(accS[2 * s][2], accS[2 * s][3]), pk2(accS[2 * s + 1][0], accS[2 * s + 1][1]), pk2(accS[2 * s + 1][2], accS[2 * s + 1][3])};
        const bf16x8 Pf = __builtin_bit_cast(bf16x8, pu);
#pragma unroll
        for (int et = 0; et < 8; ++et) accO[et] = mfma16(frag_tr(Vt, VS, 32 * s, 16 * et, lane), Pf, accO[et]);
        __builtin_amdgcn_sched_barrier(0);
    }
#pragma unroll
    for (int s = 0; s < 2; ++s) {
        const bf16x8 qsf = scale_frag(Qf[s], fsf), qsb = scale_frag(Qf[s], fsb);
#pragma unroll
        for (int et = 0; et < 8; ++et) {
            accO[et] = mfma16(frag_tr(SF, VS, 32 * s, 16 * et, lane), qsf, accO[et]);
            accO[et] = mfma16(frag_tr(SB, VS, 32 * s, 16 * et, lane), qsb, accO[et]);
        }
        __builtin_amdgcn_sched_barrier(0);
    }
    float sm = 0.f;
#pragma unroll
    for (int et = 0; et < 8; ++et) sm += accO[et][0] + accO[et][1] + accO[et][2] + accO[et][3];
    sm += __shfl_xor(sm, 16); sm += __shfl_xor(sm, 32);
    const float mean = sm * (1.0f / 128.0f);
    float v2 = 0.f;
#pragma unroll
    for (int et = 0; et < 8; ++et)
#pragma unroll
        for (int e = 0; e < 4; ++e) { const float d0 = accO[et][e] - mean; v2 += d0 * d0; }
    v2 += __shfl_xor(v2, 16); v2 += __shfl_xor(v2, 32);
    const float rstd = rsqrtf(v2 * (1.0f / 128.0f) + EPS);
    const int r = b * 4096 + c * 128 + n;
#pragma unroll
    for (int et = 0; et < 8; et += 2) {
        const int colw = h * 128 + 16 * (et + (g & 1)) + 8 * (g >> 1);
        const u32x4 gww = *(const u32x4*)(GR + (size_t)r * 512 + colw);
        const u32x2 gx = __builtin_amdgcn_permlane16_swap(gww[0], gww[2], false, false), gy = __builtin_amdgcn_permlane16_swap(gww[1], gww[3], false, false);
        const u32x2 ga = {gx[0], gy[0]}, gb = {gx[1], gy[1]};
        const f32x4 wa = *(const f32x4*)(a.gn_w + h * 128 + 16 * et + 4 * g), wb = *(const f32x4*)(a.gn_w + h * 128 + 16 * (et + 1) + 4 * g);
        const u32x2 oa = {pk2((accO[et][0] - mean) * rstd * wa[0] * bflo(ga.x), (accO[et][1] - mean) * rstd * wa[1] * bfhi(ga.x)),
                          pk2((accO[et][2] - mean) * rstd * wa[2] * bflo(ga.y), (accO[et][3] - mean) * rstd * wa[3] * bfhi(ga.y))};
        const u32x2 ob = {pk2((accO[et + 1][0] - mean) * rstd * wb[0] * bflo(gb.x), (accO[et + 1][1] - mean) * rstd * wb[1] * bfhi(gb.x)),
                          pk2((accO[et + 1][2] - mean) * rstd * wb[2] * bflo(gb.y), (accO[et + 1][3] - mean) * rstd * wb[3] * bfhi(gb.y))};
        const u32x2 wx = __builtin_amdgcn_permlane16_swap(oa.x, ob.x, false, false), wy = __builtin_amdgcn_permlane16_swap(oa.y, ob.y, false, false);
        const u32x4 ow = {wx[0], wy[0], wx[1], wy[1]};
        *(u32x4*)(Y + (size_t)r * 1024 + colw) = ow;
    }
    lds_barrier();
}

DI void phase7(const Args& a) {
    const int tid = threadIdx.x, wave = tid >> 6, lane = tid & 63;
    for (int r = blockIdx.x * 8 + wave; r < NTOK; r += gridDim.x * 8) {
        float* row = a.out + (size_t)r * 1024;
        f32x4 v[4]; float ss = 0.f;
#pragma unroll
        for (int q = 0; q < 4; ++q) { v[q] = *(const f32x4*)(row + q * 256 + lane * 4); ss += v[q][0] * v[q][0] + v[q][1] * v[q][1] + v[q][2] * v[q][2] + v[q][3] * v[q][3]; }
#pragma unroll
        for (int off = 32; off >= 1; off >>= 1) ss += __shfl_xor(ss, off);
        const float rstd = rsqrtf(ss * (1.0f / 1024.0f) + EPS);
#pragma unroll
        for (int q = 0; q < 4; ++q) {
            const f32x4 fw = *(const f32x4*)(a.fnorm_w + q * 256 + lane * 4);
            *(f32x4*)(row + q * 256 + lane * 4) = v[q] * rstd * fw;
        }
    }
}

__global__ __launch_bounds__(512, 2) void fwd_megakernel(Args a) {
    extern __shared__ __attribute__((aligned(16))) unsigned char shm[];
    LAS unsigned char* lds = (LAS unsigned char*)shm;
    cg::grid_group grid = cg::this_grid();
    volatile LAS unsigned* st = (volatile LAS unsigned*)(lds + LDS_BYTES - 16);
    if (threadIdx.x == 0) { st[0] = 0u; st[1] = 0u; }
    __syncthreads();
    const XcdBarrier xb = xcd_barrier_post((unsigned*)(a.ws + WS_BAR), st);
    if (a.ph_hi > 7) grid.sync();
#ifndef PHMASK
#define PHMASK 255
#endif
#ifndef REPMASK
#define REPMASK 0
#endif
#ifndef EXTRA_SYNCS
#define EXTRA_SYNCS 0
#endif
#define GSYNC() xcd_barrier(xb)
    for (int xs = 0; xs < EXTRA_SYNCS; ++xs) GSYNC();
#define PHASE(P, ...) do { if (((PHMASK >> (P)) & 1) && a.ph_lo <= (P) && (P) < a.ph_hi) { if ((REPMASK >> (P)) & 1) { __VA_ARGS__; GSYNC(); } __VA_ARGS__; if ((P) + 1 < a.ph_hi) GSYNC(); } } while (0)
    PHASE(0, phase0(a, lds));
    PHASE(1, phase1(a));
    PHASE(2, {
        pg8::Gemm gm{(const bf16_t*)(a.ws + WS_H), (const bf16_t*)(a.ws + WS_WIN), NTOK, NP, D};
        SchedIn S; S.so.init(NTOK, NP, (int)gridDim.x, (int)blockIdx.x);
        EpiIn E{a.ws};
        pg8::gemm_phase<EpiIn, SchedIn, false>(lds, gm, S, E, nullptr);
    });
    PHASE(3, phase3(a, lds));
    PHASE(5, { int it = blockIdx.x; if (it < 1024) { RetStage st; ret_load(a, it, st); for (;;) { const int nx = it + (int)gridDim.x; ret_unit(a, lds, it, st, nx < 1024 ? nx : -1); if (nx >= 1024) break; it = nx; } } });
    PHASE(6, {
        pg8::Gemm gm{(const bf16_t*)(a.ws + WS_H), (const bf16_t*)(a.ws + WS_WOUT), NTOK, D, D};
        pg8::StaticOrder S; S.init(NTOK, D, (int)gridDim.x, (int)blockIdx.x);
        EpiOut E{a.x, (const float*)(a.ws + WS_MOD), a.fnorm_w, a.out, (float*)(a.ws + WS_SLOT), (unsigned*)(a.ws + WS_CNT)};
        pg8::gemm_phase<EpiOut, pg8::StaticOrder, false>(lds, gm, S, E, nullptr);
    });
#undef PHASE
}

extern "C" void kernel_launch(void* const* d_in, const int* in_sizes, int n_in, void* d_out, int out_size, void* d_ws, size_t ws_size, hipStream_t stream) {
    static int grid = 0;
    if (grid == 0) {
        if (n_in != 16 || out_size != NTOK * D || ws_size < WS_END) { fprintf(stderr, "kernel_launch: unexpected shapes (n_in %d out %d ws %zu need %zu)\n", n_in, out_size, ws_size, (size_t)WS_END); grid = -1; return; }
        int dev = 0, cus = 0, per_cu = 0;
        (void)hipGetDevice(&dev); (void)hipDeviceGetAttribute(&cus, hipDeviceAttributeMultiprocessorCount, dev);
        if (hipFuncSetAttribute((const void*)fwd_megakernel, hipFuncAttributeMaxDynamicSharedMemorySize, LDS_BYTES) != hipSuccess) { fprintf(stderr, "kernel_launch: hipFuncSetAttribute failed\n"); grid = -1; return; }
        if (hipOccupancyMaxActiveBlocksPerMultiprocessor(&per_cu, (const void*)fwd_megakernel, NTHREADS, LDS_BYTES) != hipSuccess || per_cu < 1) { fprintf(stderr, "kernel_launch: occupancy query gives %d\n", per_cu); per_cu = 1; }
        (void)hipGetLastError();
        grid = cus;
    }
    if (grid < 0) return;
    Args a{};
    a.x = (const float*)d_in[0]; a.c = (const float*)d_in[1]; a.ctx = (const float*)d_in[2]; a.c_ctx = (const float*)d_in[3]; a.w_ada = (const float*)d_in[4]; a.b_ada = (const float*)d_in[5];
    a.norm_w = (const float*)d_in[6]; a.w_in = (const float*)d_in[7]; a.dec_f = (const float*)d_in[8]; a.dec_b = (const float*)d_in[9]; a.gn_w = (const float*)d_in[10]; a.ln_w = (const float*)d_in[11];
    a.w_s = (const float*)d_in[12]; a.b_s = (const float*)d_in[13]; a.w_out = (const float*)d_in[14]; a.fnorm_w = (const float*)d_in[15];
    a.out = (float*)d_out; a.ws = (unsigned char*)d_ws;
    (void)hipMemsetAsync((unsigned char*)d_ws + WS_BAR, 0, (size_t)XCD_BAR_WORDS * 4 + 32768, stream);
#if N_LAUNCHES == 1
    a.ph_lo = 0; a.ph_hi = 7;
    void* args[] = {&a};
    hipError_t e = hipLaunchCooperativeKernel((const void*)fwd_megakernel, dim3(grid), dim3(NTHREADS), args, LDS_BYTES, stream);
    if (e != hipSuccess) fprintf(stderr, "cooperative launch failed: %s (grid %d)\n", hipGetErrorString(e), grid);
#else
    for (int p = 0; p < 7; ++p) {
        a.ph_lo = p; a.ph_hi = p + 1;
        hipLaunchKernelGGL(fwd_megakernel, dim3(grid), dim3(NTHREADS), LDS_BYTES, stream, a);
    }
#endif
}
```

```cpp
#include <hip/hip_runtime.h>
#include <hip/hip_cooperative_groups.h>
#include <cstdio>
namespace cg = cooperative_groups;
#ifndef N_LAUNCHES
#define N_LAUNCHES 1
#endif
namespace pg8 {
#define PG8_LAS __attribute__((address_space(3)))
typedef unsigned short bf16_t;
typedef short bf16x8 __attribute__((ext_vector_type(8)));
typedef float f32x4 __attribute__((ext_vector_type(4)));
typedef unsigned u32x4 __attribute__((ext_vector_type(4)));
constexpr int BM = 256, BK = 64, HALF = 128, HTB = HALF * BK * 2  , STAGE_BYTES = 8 * HTB, NXCD = 8, WGM = 8;

__host__ __device__ __forceinline__ int lds_byte(int r, int c) { const int st = (r >> 4) * 2 + (c >> 5), rr = r & 15, cc = c & 31, ob = rr * 64 + cc * 2; return st * 1024 + (ob ^ (((ob >> 9) & 1) << 5)); }
__host__ __device__ __forceinline__ void stage_rc(int b, int& R, int& C) { const int st = b / 1024, sb = b % 1024, swz = sb ^ (((sb >> 9) & 1) << 5); R = (st >> 1) * 16 + swz / 64; C = (st & 1) * 32 + (swz % 64) / 2; }
__host__ __device__ __forceinline__ int perm32(int rho) { const int n = rho >> 4, i = rho & 15; return 8 * (i >> 2) + 4 * n + (i & 3); }

struct Unit { int pm, pn; };
struct Gemm { const bf16_t* A; const bf16_t* Bt; int M, N, K; };

struct StaticOrder {
    int nM, nN, nwg, G, c;
    __host__ __device__ void init(int M, int N, int G_, int c_) { nM = M / BM; nN = N / BM; nwg = nM * nN; G = G_; c = c_; }
    __host__ __device__ bool next(int i, Unit& u) const {
        const long L = (long)i * G + c; if (L >= nwg) return false;
        int wgid = (int)L; { const int q = nwg / NXCD, r = nwg % NXCD, xcd = wgid % NXCD, off = wgid / NXCD; wgid = (xcd < r ? xcd * (q + 1) : r * (q + 1) + (xcd - r) * q) + off; }
        const int nig = WGM * nN, gid = wgid / nig, fm = gid * WGM, gsz = (nM - fm) < WGM ? (nM - fm) : WGM;
        u.pm = fm + ((wgid % nig) % gsz); u.pn = (wgid % nig) / gsz; return true;
    }
    __device__ __forceinline__ void a_ready(const Unit&) const {}
    __device__ __forceinline__ void done(const Unit&) const {}
};
struct CountedOrder : StaticOrder {
    const unsigned* ready; unsigned need; unsigned* tmo;
    __device__ __forceinline__ void a_ready(const Unit& u) const {
        if (threadIdx.x < 64) {
            const unsigned long long t0 = __builtin_amdgcn_s_memrealtime(); unsigned polls = 0;
            while ((unsigned)__builtin_amdgcn_readfirstlane(__hip_atomic_load(ready + 64 * u.pm, __ATOMIC_RELAXED, __HIP_MEMORY_SCOPE_AGENT)) < need) {
                if ((++polls & 255u) == 0u && __builtin_amdgcn_readfirstlane(__hip_atomic_load(tmo, __ATOMIC_RELAXED, __HIP_MEMORY_SCOPE_AGENT)) != 0u) break;
                if (__builtin_amdgcn_s_memrealtime() - t0 > 2000000ull) {
                    if (threadIdx.x == 0) { unsigned expect = 0u; __hip_atomic_compare_exchange_strong(tmo + 1, &expect, 0x600u | (unsigned)(u.pm & 0xff), __ATOMIC_RELAXED, __ATOMIC_RELAXED, __HIP_MEMORY_SCOPE_AGENT); __hip_atomic_store(tmo, 1u, __ATOMIC_RELAXED, __HIP_MEMORY_SCOPE_AGENT); }
                    break; }
                __builtin_amdgcn_s_sleep(2); }
            __builtin_amdgcn_fence(__ATOMIC_ACQUIRE, "agent");
            asm volatile("s_waitcnt vmcnt(0)" ::: "memory");
        }
#if !defined(BROKEN_HOOK_NO_BARRIER)
        asm volatile("" ::: "memory"); __builtin_amdgcn_s_barrier(); asm volatile("" ::: "memory");
#endif
    }
};

__device__ __forceinline__ unsigned cvt_pk_bf16(float lo, float hi) { unsigned r; asm volatile("v_cvt_pk_bf16_f32 %0, %1, %2" : "=v"(r) : "v"(lo), "v"(hi)); return r; }
typedef float f32x2 __attribute__((ext_vector_type(2)));
__device__ __forceinline__ f32x2 gelu_pk(f32x2 v) {
    const f32x2 av = __builtin_elementwise_abs(v), d = av * 0.2316418882f + 1.0f;
    f32x2 t; t.x = __builtin_amdgcn_rcpf(d.x); t.y = __builtin_amdgcn_rcpf(d.y);
    f32x2 q = t * 0.5307027145f + (-0.7265760135f); q = q * t + 0.7107068705f; q = q * t + (-0.142248368f); q = q * t + 0.127414796f; q = q * t;
    const f32x2 s = (v * v) * (-0.72134752044f);
    f32x2 e; e.x = __builtin_amdgcn_exp2f(s.x); e.y = __builtin_amdgcn_exp2f(s.y);
    const f32x2 m = v * (q * e), r = v - m;
    f32x2 o; o.x = v.x < 0.f ? m.x : r.x; o.y = v.y < 0.f ? m.y : r.y; return o;
}
template <class Epi, class Sched, bool STAMP = false>
__device__ __forceinline__ void gemm_phase(PG8_LAS unsigned char* lds, const Gemm g, const Sched& S, const Epi& E, unsigned long long* stamps) {
    const int tid = threadIdx.x, wid = __builtin_amdgcn_readfirstlane(tid >> 6), lane = tid & 63, wr = wid >> 2, wc = wid & 3, fr = lane & 15, fq = lane >> 4;
    const int K = g.K, nt = K / BK;
    int ts_lo = 0, ts_hi = 0, nts = 0; const unsigned long long rt_entry = STAMP ? (unsigned long long)wall_clock64() : 0ull;
#define PG8_STAMP() do { if (STAMP && wid == 0 && nts < 64) { const unsigned long long _c = (unsigned long long)clock64(); \
        ts_lo = (lane == nts) ? (int)(unsigned)_c : ts_lo; ts_hi = (lane == nts) ? (int)(unsigned)(_c >> 32) : ts_hi; ++nts; } } while (0)
    PG8_STAMP();
    unsigned voffA[2], voffB[2];
#pragma unroll
    for (int i = 0; i < 2; ++i) { int R, C; stage_rc(tid * 16 + i * 8192, R, C); const int Rb = Epi::PERM ? ((R & ~31) + perm32(R & 31)) : R;
        voffA[i] = (unsigned)(R * K + C) * 2u; voffB[i] = (unsigned)(Rb * K + C) * 2u; }
    const size_t kstep = (size_t)(BK * 2);
    const size_t hstep = (size_t)HALF * K * 2;
    const size_t tstep = 2 * hstep;
    const unsigned ldsw = (unsigned)wid * 1024u;
    const int aoff = lds_byte(wr * 64 + fr, fq * 8), boff = lds_byte(wc * 32 + fr, fq * 8);
#define PG8_SA(b, h) (((b) * 2 + (h)) * HTB)
#define PG8_SB(b, h) ((4 + (b) * 2 + (h)) * HTB)
#define PG8_STAGE(bufoff, gbase, voff) do { _Pragma("unroll") for (int _i = 0; _i < 2; ++_i) \
        __builtin_amdgcn_global_load_lds((const unsigned*)((const char*)(gbase) + (voff)[_i]), (PG8_LAS unsigned*)(lds + (bufoff) + ldsw + _i * 8192), 16, 0, 0); } while (0)
#define PG8_LDA(dst, b, h) do { _Pragma("unroll") for (int m = 0; m < 4; ++m) _Pragma("unroll") for (int k = 0; k < 2; ++k) dst[m][k] = *(const PG8_LAS bf16x8*)(lds + PG8_SA(b, h) + aoff + m * 2048 + k * 1024); } while (0)
#define PG8_LDB(dst, b, h) do { _Pragma("unroll") for (int n = 0; n < 2; ++n) _Pragma("unroll") for (int k = 0; k < 2; ++k) dst[n][k] = *(const PG8_LAS bf16x8*)(lds + PG8_SB(b, h) + boff + n * 2048 + k * 1024); } while (0)
#define PG8_MMA(ai, bj, At, Bt) do { __builtin_amdgcn_s_setprio(1); _Pragma("unroll") for (int m = 0; m < 4; ++m) _Pragma("unroll") for (int n = 0; n < 2; ++n) _Pragma("unroll") for (int k = 0; k < 2; ++k) \
        acc[ai][bj][m][n] = __builtin_amdgcn_mfma_f32_16x16x32_bf16(Bt[n][k], At[m][k], acc[ai][bj][m][n], 0, 0, 0); __builtin_amdgcn_s_setprio(0); } while (0)
#define PG8_WAIT_V(n) asm volatile("s_waitcnt vmcnt(" #n ")" ::: "memory")
#define PG8_WAIT_L(n) asm volatile("s_waitcnt lgkmcnt(" #n ")" ::: "memory")
#define PG8_BAR __builtin_amdgcn_s_barrier()
#define PG8_SCHED __builtin_amdgcn_sched_barrier(0)
    Unit cur, nxt; int ui = 0;
    if (!S.next(0, cur)) return;
    f32x4 acc[2][2][4][2];
#pragma unroll
    for (int a = 0; a < 2; ++a)
#pragma unroll
        for (int b = 0; b < 2; ++b)
#pragma unroll
            for (int m = 0; m < 4; ++m)
#pragma unroll
                for (int n = 0; n < 2; ++n) acc[a][b][m][n] = (f32x4){0.f, 0.f, 0.f, 0.f};
    bf16x8 At[4][2], B0[2][2], B1[2][2];
    const char* cA = (const char*)g.A + (size_t)cur.pm * tstep; const char* cB = (const char*)g.Bt + (size_t)cur.pn * tstep;
    S.a_ready(cur);
    PG8_STAGE(PG8_SB(0, 0), cB, voffB); PG8_STAGE(PG8_SA(0, 0), cA, voffA); PG8_STAGE(PG8_SB(0, 1), cB + hstep, voffB); PG8_STAGE(PG8_SA(0, 1), cA + hstep, voffA);
    if (wr == 1) PG8_BAR;
    PG8_WAIT_V(4); PG8_BAR;
    PG8_STAGE(PG8_SB(1, 0), cB + kstep, voffB); PG8_STAGE(PG8_SA(1, 0), cA + kstep, voffA); PG8_STAGE(PG8_SB(1, 1), cB + hstep + kstep, voffB);
    PG8_WAIT_V(6); PG8_BAR;
    PG8_STAMP();
    for (;;) {
        const bool has_next = S.next(ui + 1, nxt);
        const char* nA = has_next ? (const char*)g.A + (size_t)nxt.pm * tstep : cA; const char* nB = has_next ? (const char*)g.Bt + (size_t)nxt.pn * tstep : cB;
        for (int t = 0; t < nt; t += 2) {
            const bool last = (t == nt - 2);
            const char* a1 = cA + (size_t)(t + 1) * kstep;
            const char* a2 = last ? nA : cA + (size_t)(t + 2) * kstep; const char* b2 = last ? nB : cB + (size_t)(t + 2) * kstep;
            const char* a3 = a2 + kstep; const char* b3 = b2 + kstep;
            if (last && has_next) S.a_ready(nxt);
            PG8_LDB(B0, 0, 0); PG8_SCHED; PG8_LDA(At, 0, 0); PG8_STAGE(PG8_SA(1, 1), a1 + hstep, voffA);
            PG8_WAIT_L(8); PG8_BAR; PG8_WAIT_L(0); PG8_MMA(0, 0, At, B0); PG8_BAR; PG8_SCHED;
            PG8_LDB(B1, 0, 1); PG8_STAGE(PG8_SB(0, 0), b2, voffB);
            PG8_BAR; PG8_WAIT_L(0); PG8_MMA(0, 1, At, B1); PG8_BAR;
            PG8_LDA(At, 0, 1); PG8_STAGE(PG8_SA(0, 0), a2, voffA);
            PG8_BAR; PG8_WAIT_L(0); PG8_MMA(1, 0, At, B0); PG8_BAR; PG8_SCHED;
            PG8_STAGE(PG8_SB(0, 1), b2 + hstep, voffB);
            PG8_WAIT_V(6); PG8_BAR; PG8_MMA(1, 1, At, B1); PG8_BAR;
            PG8_LDB(B0, 1, 0); PG8_SCHED; PG8_LDA(At, 1, 0); PG8_STAGE(PG8_SA(0, 1), a2 + hstep, voffA);
            PG8_WAIT_L(8); PG8_BAR; PG8_WAIT_L(0); PG8_MMA(0, 0, At, B0); PG8_BAR; PG8_SCHED;
            PG8_LDB(B1, 1, 1); PG8_STAGE(PG8_SB(1, 0), b3, voffB);
            PG8_BAR; PG8_WAIT_L(0); PG8_MMA(0, 1, At, B1); PG8_BAR;
            PG8_LDA(At, 1, 1); PG8_STAGE(PG8_SA(1, 0), a3, voffA);
            PG8_BAR; PG8_WAIT_L(0); PG8_MMA(1, 0, At, B0); PG8_BAR; PG8_SCHED;
            PG8_STAGE(PG8_SB(1, 1), b3 + hstep, voffB);
            PG8_WAIT_V(6); PG8_BAR; PG8_MMA(1, 1, At, B1); PG8_BAR;
        }
        PG8_STAMP();
        if constexpr (!Epi::AFTER_DRAIN) {
            if constexpr (Epi::REALIGN) { if (wr == 0) PG8_BAR; }
            E(acc, cur, wr, wc, fr, fq); S.done(cur);
            if constexpr (Epi::REALIGN) { if (wr == 1) PG8_BAR; }
        }
        PG8_STAMP();
        if (!has_next) break;
#pragma unroll
        for (int a = 0; a < 2; ++a)
#pragma unroll
            for (int b = 0; b < 2; ++b)
#pragma unroll
                for (int m = 0; m < 4; ++m)
#pragma unroll
                    for (int n = 0; n < 2; ++n) acc[a][b][m][n] = (f32x4){0.f, 0.f, 0.f, 0.f};
        cur = nxt; cA = nA; cB = nB; ++ui;
    }
    PG8_WAIT_V(0);
    if (wr == 0) PG8_BAR;
    PG8_BAR;
    if constexpr (Epi::AFTER_DRAIN) { E.fused(acc, cur, wr, wc, fr, fq, lds, wid, lane); S.done(cur); }
    PG8_STAMP();
    if (STAMP && wid == 0) { stamps[lane] = lane < nts ? (((unsigned long long)(unsigned)ts_hi << 32) | (unsigned)ts_lo) : 0ull;
        if (lane == 62) stamps[62] = rt_entry; if (lane == 63) stamps[63] = (unsigned long long)wall_clock64(); }
#undef PG8_STAMP
#undef PG8_SA
#undef PG8_SB
#undef PG8_STAGE
#undef PG8_LDA
#undef PG8_LDB
#undef PG8_MMA
#undef PG8_WAIT_V
#undef PG8_WAIT_L
#undef PG8_BAR
#undef PG8_SCHED
}
}
#define LAS __attribute__((address_space(3)))
#define XB_TMO      128
#define XB_XCNT(j)  (256  + 64 * (j))
#define XB_XSUB(j)  (1280 + 64 * (j))
#define XB_XGEN(j)  (2304 + 64 * (j))
#define XB_TOP      3328
#define XB_TOPGEN   3392
#define XCD_BAR_WORDS 3456
#define XB_SPIN_CAP (1u << 18)

__device__ __forceinline__ unsigned xb_ld(unsigned* p)              { return __hip_atomic_load(p, __ATOMIC_RELAXED, __HIP_MEMORY_SCOPE_AGENT); }
__device__ __forceinline__ unsigned xb_add(unsigned* p, unsigned v) { return __hip_atomic_fetch_add(p, v, __ATOMIC_RELAXED, __HIP_MEMORY_SCOPE_AGENT); }
__device__ __forceinline__ unsigned xb_xcc_id() { return (unsigned)__builtin_amdgcn_s_getreg((3 << 11) | 20) & 0xFu; }
#define XB_SPIN(cond, bar) do { unsigned _sp = 0; while (cond) { __builtin_amdgcn_s_sleep(1); \
    if ((++_sp & 255u) == 0u) { if (xb_ld(&(bar)[XB_TMO])) break; if (_sp > XB_SPIN_CAP) { atomicAdd(&(bar)[XB_TMO], 1u); break; } } } } while (0)

struct XcdBarrier {
    unsigned* bar; unsigned x;
    volatile LAS unsigned* st;
};

__device__ __forceinline__ XcdBarrier xcd_barrier_post(unsigned* bar, volatile LAS unsigned* st) {
    XcdBarrier b; b.bar = bar; b.x = xb_xcc_id(); b.st = st;
    if (threadIdx.x == 0) (void)xb_add(&bar[XB_XCNT(b.x)], 1u);
    return b;
}
__device__ __forceinline__ void xcd_barrier_complete(unsigned* bar, unsigned x, unsigned& nloc, unsigned& nx) {
    const unsigned G = gridDim.x * gridDim.y * gridDim.z;
    unsigned sum, cnt, mine, sp = 0u;
    for (;;) {
        sum = 0u; cnt = 0u; mine = 0u;
#pragma unroll
        for (unsigned j = 0; j < 16; ++j) { const unsigned c = xb_ld(&bar[XB_XCNT(j)]); sum += c; cnt += (c > 0u) ? 1u : 0u; mine = (j == x) ? c : mine; }
        if (sum == G) break;
        __builtin_amdgcn_s_sleep(1);
        if ((++sp & 255u) == 0u) { if (xb_ld(&bar[XB_TMO])) break; if (sp > XB_SPIN_CAP) { atomicAdd(&bar[XB_TMO], 1u); break; } }
    }
    nloc = mine > 0u ? mine : 1u; nx = cnt > 0u ? cnt : 1u;
}

__device__ __forceinline__ void xcd_barrier(const XcdBarrier& b) {
    asm volatile("s_waitcnt vmcnt(0)" ::: "memory");
    __syncthreads();
    if (threadIdx.x == 0) {
        unsigned* bar = b.bar;
        __builtin_amdgcn_s_waitcnt(0);
        unsigned nloc = b.st[0], nx = b.st[1];
        if (nloc == 0u) { xcd_barrier_complete(bar, b.x, nloc, nx); b.st[0] = nloc; b.st[1] = nx; }
        const unsigned old = xb_add(&bar[XB_XSUB(b.x)], 1u);
        const unsigned gen = old / nloc;
        if (old + 1u == (gen + 1u) * nloc) {
            __builtin_amdgcn_fence(__ATOMIC_RELEASE, "agent");
            asm volatile("s_waitcnt vmcnt(0)" ::: "memory");
            const unsigned og = xb_add(&bar[XB_TOP], 1u);
            const unsigned tg = og / nx;
            if (og + 1u == (tg + 1u) * nx) xb_add(&bar[XB_TOPGEN], 1u);
            else XB_SPIN(xb_ld(&bar[XB_TOPGEN]) == tg, bar);
            __builtin_amdgcn_fence(__ATOMIC_ACQUIRE, "agent");
            xb_add(&bar[XB_XGEN(b.x)], 1u);
            asm volatile("s_waitcnt vmcnt(0)" ::: "memory");
        } else {
            XB_SPIN(xb_ld(&bar[XB_XGEN(b.x)]) == gen, bar);
            __builtin_amdgcn_fence(__ATOMIC_ACQUIRE, "agent");
            asm volatile("s_waitcnt vmcnt(0)" ::: "memory");
        }
    }
    __syncthreads();
}


#define DI __device__ __forceinline__

using pg8::bf16_t; using pg8::bf16x8; using pg8::f32x4; using pg8::f32x2; using pg8::u32x4; using pg8::Unit;
typedef unsigned u32x2 __attribute__((ext_vector_type(2)));
typedef short s16x4 __attribute__((ext_vector_type(4)));
typedef __bf16 bf2_t __attribute__((ext_vector_type(2)));

constexpr int NB = 8, T = 4096, D = 1024, NTOK = NB * T, CTXL = 256, NCTX = NB * CTXL, NP = 3072, NC = 32;
constexpr int NTHREADS = 512;
constexpr int LDS_BYTES = 147456 + 256;
constexpr float EPS = 1e-6f, LOG2E = 1.4426950408889634f;

constexpr size_t al256(size_t x) { return (x + 255) & ~(size_t)255; }
constexpr size_t WS_MOD  = 0;
constexpr size_t WS_ROPE = WS_MOD + al256(9 * 3072 * 4);
constexpr size_t WS_WIN  = WS_ROPE + 8192;
constexpr size_t WS_WOUT = WS_WIN + (size_t)3072 * 1024 * 2;
constexpr size_t WS_WSB  = WS_WOUT + (size_t)1024 * 1024 * 2;
constexpr size_t WS_H    = WS_WSB + (size_t)4 * 128 * 128 * 2;
constexpr size_t WS_Q    = WS_H + (size_t)(NTOK + NCTX) * 1024 * 2;
constexpr size_t WS_K    = WS_Q + (size_t)NTOK * 256 * 2;
constexpr size_t WS_V    = WS_K + (size_t)NTOK * 256 * 2;
constexpr size_t WS_GR   = WS_V + (size_t)NTOK * 512 * 2;
constexpr size_t WS_U    = WS_GR + (size_t)NTOK * 512 * 2;
constexpr size_t WS_VG   = WS_U + (size_t)NTOK * 512 * 2;
constexpr size_t WS_GM   = WS_VG + (size_t)NTOK * 512 * 2;
constexpr size_t WS_KC   = WS_GM + (size_t)NTOK * 512 * 2;
constexpr size_t WS_VC   = WS_KC + (size_t)NCTX * 256 * 2;
constexpr size_t WS_KV   = WS_VC + (size_t)NCTX * 512 * 2;
constexpr size_t WS_KVC  = WS_KV + (size_t)1024 * 2 * 8192 * 4;
constexpr size_t WS_ST   = WS_KVC + (size_t)64 * 2 * 8192 * 4;
constexpr size_t WS_BAR  = WS_ST + (size_t)1024 * 2 * 8192 * 2;
constexpr size_t WS_CNT  = WS_BAR + (size_t)XCD_BAR_WORDS * 4;
constexpr size_t WS_SLOT = WS_CNT + 32768;
constexpr size_t WS_END  = WS_SLOT + (size_t)NTOK * 16 * 4;

struct Args {
    const float* x; const float* c; const float* ctx; const float* c_ctx; const float* w_ada; const float* b_ada; const float* norm_w; const float* w_in;
    const float* dec_f; const float* dec_b; const float* gn_w; const float* ln_w; const float* w_s; const float* b_s; const float* w_out; const float* fnorm_w;
    float* out; unsigned char* ws; int ph_lo, ph_hi;
};

DI unsigned pk2(float lo, float hi) { f32x2 v = {lo, hi}; bf2_t r = __builtin_convertvector(v, bf2_t); return __builtin_bit_cast(unsigned, r); }
DI f32x4 ldnt_f4(const float* p) { return __builtin_nontemporal_load((const f32x4*)p); }
DI u32x4 ldnt_u4(const void* p) { return __builtin_nontemporal_load((const u32x4*)p); }
DI u32x2 ldnt_u2(const void* p) { return __builtin_nontemporal_load((const u32x2*)p); }
DI float bflo(unsigned w) { return __uint_as_float(w << 16); }
DI float bfhi(unsigned w) { return __uint_as_float(w & 0xffff0000u); }
DI float silu_f(float v) { return v * __builtin_amdgcn_rcpf(1.0f + __expf(-v)); }
DI void lds_barrier() { asm volatile("s_waitcnt lgkmcnt(0)" ::: "memory"); __builtin_amdgcn_s_barrier(); asm volatile("" ::: "memory"); }
DI f32x4 mfma16(bf16x8 a, bf16x8 b, f32x4 c) { return __builtin_amdgcn_mfma_f32_16x16x32_bf16(a, b, c, 0, 0, 0); }

DI bf16x8 frag_tr(LAS const unsigned char* base, int S, int k0, int n0, int lane) {
    const int i = lane & 15, g = lane >> 4;
    LAS const unsigned char* p = base + (k0 + 4 * g + (i >> 2)) * S + (n0 + 4 * (i & 3)) * 2;
    const s16x4 lo = __builtin_amdgcn_ds_read_tr16_b64_v4i16((LAS s16x4*)p);
    const s16x4 hi = __builtin_amdgcn_ds_read_tr16_b64_v4i16((LAS s16x4*)(p + 16 * S));
    return __builtin_shufflevector(lo, hi, 0, 1, 2, 3, 4, 5, 6, 7);
}
DI bf16x8 frag_rowP(const bf16_t* rowk0, int g) {
    const u32x2 lo = *(const u32x2*)(rowk0 + 4 * g), hi = *(const u32x2*)(rowk0 + 16 + 4 * g);
    const u32x4 v = {lo.x, lo.y, hi.x, hi.y}; return __builtin_bit_cast(bf16x8, v);
}
DI bf16x8 frag_rowP_lds(LAS const unsigned char* rowk0, int g) {
    const u32x2 lo = *(LAS const u32x2*)(rowk0 + 8 * g), hi = *(LAS const u32x2*)(rowk0 + 32 + 8 * g);
    const u32x4 v = {lo.x, lo.y, hi.x, hi.y}; return __builtin_bit_cast(bf16x8, v);
}
DI bf16x8 scale_frag(bf16x8 f, float s) {
    const u32x4 u = __builtin_bit_cast(u32x4, f); u32x4 r;
#pragma unroll
    for (int q = 0; q < 4; ++q) r[q] = pk2(bflo(u[q]) * s, bfhi(u[q]) * s);
    return __builtin_bit_cast(bf16x8, r);
}

struct EpiIn {
    static constexpr bool PERM = true, AFTER_DRAIN = false, REALIGN = false;
    unsigned char* ws;
    DI void operator()(const f32x4 (&acc)[2][2][4][2], const Unit& u, int wr, int wc, int fr, int fq) const {
        const int pn = u.pn, rbase = u.pm * 256 + wr * 64 + fr, cbase = wc * 32 + 8 * fq;
        if (u.pm >= 128) {
            bf16_t* dst = (bf16_t*)(ws + (pn == 1 ? WS_KC : WS_VC));
            const float scl = pn == 1 ? 0.125f : 1.0f;
#pragma unroll
            for (int ai = 0; ai < 2; ++ai)
#pragma unroll
                for (int m = 0; m < 4; ++m) {
                    const int rc = rbase + ai * 128 + m * 16 - NTOK, b = rc >> 8, t = rc & 255;
#pragma unroll
                    for (int bj = 0; bj < 2; ++bj) {
                        const f32x4 v0 = acc[ai][bj][m][0] * scl, v1 = acc[ai][bj][m][1] * scl;
                        const u32x4 o = {pk2(v0[0], v0[1]), pk2(v0[2], v0[3]), pk2(v1[0], v1[1]), pk2(v1[2], v1[3])};
                        size_t off;
                        if (pn == 1) { const int head = bj * 2 + (wc >> 1), d0 = (wc & 1) * 32 + 8 * fq; off = ((size_t)((b * 4 + head) * 256 + t)) * 64 + d0; }
                        else { const int head = (pn - 2) * 2 + bj; off = ((size_t)(((b * 4 + head) * 8 + (cbase >> 4)) * 256 + t)) * 16 + (cbase & 15); }
                        *(u32x4*)(dst + off) = o;
                    }
                }
            return;
        }
        if (pn <= 1) {
            bf16_t* dst = (bf16_t*)(ws + (pn == 0 ? WS_Q : WS_K));
            const float scl = pn == 0 ? 1.0f : 0.125f;
            const float* rc = (const float*)(ws + WS_ROPE); const float* rs = rc + 1024;
            const int hh = wc & 1, fi0 = 8 * (fq & 1); const bool second = fq >= 2;
#pragma unroll
            for (int ai = 0; ai < 2; ++ai)
#pragma unroll
                for (int m = 0; m < 4; ++m) {
                    const int r = rbase + ai * 128 + m * 16, b = r >> 12, t = r & 4095, pos = hh ? (t & 63) : (t >> 6);
                    const f32x4 c0 = *(const f32x4*)(rc + pos * 16 + fi0), c1 = *(const f32x4*)(rc + pos * 16 + fi0 + 4);
                    const f32x4 s0 = *(const f32x4*)(rs + pos * 16 + fi0), s1 = *(const f32x4*)(rs + pos * 16 + fi0 + 4);
#pragma unroll
                    for (int bj = 0; bj < 2; ++bj) {
                        const f32x4 v0 = acc[ai][bj][m][0], v1 = acc[ai][bj][m][1];
                        float o[8];
#pragma unroll
                        for (int j = 0; j < 4; ++j) {
                            const float xa = v0[j], xb = v1[j], pa = __shfl_xor(xa, 32), pb = __shfl_xor(xb, 32);
                            o[j]     = (second ? (pa * s0[j] + xa * c0[j]) : (xa * c0[j] - pa * s0[j])) * scl;
                            o[4 + j] = (second ? (pb * s1[j] + xb * c1[j]) : (xb * c1[j] - pb * s1[j])) * scl;
                        }
                        const u32x4 ov = {pk2(o[0], o[1]), pk2(o[2], o[3]), pk2(o[4], o[5]), pk2(o[6], o[7])};
                        const int head = bj * 2 + (wc >> 1), d0 = hh * 32 + 8 * fq;
                        *(u32x4*)(dst + ((size_t)((b * 4 + head) * 4096 + t)) * 64 + d0) = ov;
                    }
                }
            return;
        }
        if (pn <= 3) {
            bf16_t* dst = (bf16_t*)(ws + WS_V);
#pragma unroll
            for (int ai = 0; ai < 2; ++ai)
#pragma unroll
                for (int m = 0; m < 4; ++m) {
                    const int r = rbase + ai * 128 + m * 16, b = r >> 12, t = r & 4095;
#pragma unroll
                    for (int bj = 0; bj < 2; ++bj) {
                        const f32x4 v0 = acc[ai][bj][m][0], v1 = acc[ai][bj][m][1];
                        const u32x4 o = {pk2(v0[0], v0[1]), pk2(v0[2], v0[3]), pk2(v1[0], v1[1]), pk2(v1[2], v1[3])};
                        const int head = (pn - 2) * 2 + bj;
                        *(u32x4*)(dst + ((size_t)(((b * 4 + head) * 8 + (cbase >> 4)) * 4096 + t)) * 16 + (cbase & 15)) = o;
                    }
                }
            return;
        }
        if (pn == 6 || pn == 7 || pn >= 10) {
            const int t = pn == 6 ? 0 : (pn == 7 ? 1 : (pn == 10 ? 2 : 3));
            bf16_t* dst = (bf16_t*)(ws + WS_U);
#pragma unroll
            for (int ai = 0; ai < 2; ++ai)
#pragma unroll
                for (int m = 0; m < 4; ++m) {
                    const int r = rbase + ai * 128 + m * 16;
                    const f32x4 u0 = acc[ai][0][m][0], u1 = acc[ai][0][m][1], g0 = acc[ai][1][m][0], g1 = acc[ai][1][m][1];
                    const f32x2 a0 = pg8::gelu_pk((f32x2){u0[0], u0[1]}), a1 = pg8::gelu_pk((f32x2){u0[2], u0[3]}), a2 = pg8::gelu_pk((f32x2){u1[0], u1[1]}), a3 = pg8::gelu_pk((f32x2){u1[2], u1[3]});
                    const u32x4 o = {pk2(a0.x * silu_f(g0[0]), a0.y * silu_f(g0[1])), pk2(a1.x * silu_f(g0[2]), a1.y * silu_f(g0[3])),
                                     pk2(a2.x * silu_f(g1[0]), a2.y * silu_f(g1[1])), pk2(a3.x * silu_f(g1[2]), a3.y * silu_f(g1[3]))};
                    *(u32x4*)(dst + (size_t)r * 512 + 128 * t + cbase) = o;
                }
            return;
        }
        {
            const int region = (pn - 4) >> 1; const bool is_gelu = (region == 1) || (region == 2);
            bf16_t* dst = (bf16_t*)(ws + WS_GR + (size_t)region * ((size_t)NTOK * 512 * 2));
            const int colb = ((pn - 4) & 1) * 256 + cbase;
#pragma unroll
            for (int ai = 0; ai < 2; ++ai)
#pragma unroll
                for (int m = 0; m < 4; ++m) {
                    const int r = rbase + ai * 128 + m * 16;
#pragma unroll
                    for (int bj = 0; bj < 2; ++bj) {
                        const f32x4 v0 = acc[ai][bj][m][0], v1 = acc[ai][bj][m][1];
                        u32x4 o;
                        if (is_gelu) {
                            const f32x2 a = pg8::gelu_pk((f32x2){v0[0], v0[1]}), bq = pg8::gelu_pk((f32x2){v0[2], v0[3]}), cq = pg8::gelu_pk((f32x2){v1[0], v1[1]}), dq = pg8::gelu_pk((f32x2){v1[2], v1[3]});
                            o = (u32x4){pk2(a.x, a.y), pk2(bq.x, bq.y), pk2(cq.x, cq.y), pk2(dq.x, dq.y)};
                        } else {
                            o = (u32x4){pk2(silu_f(v0[0]), silu_f(v0[1])), pk2(silu_f(v0[2]), silu_f(v0[3])), pk2(silu_f(v1[0]), silu_f(v1[1])), pk2(silu_f(v1[2]), silu_f(v1[3]))};
                        }
                        *(u32x4*)(dst + (size_t)r * 512 + colb + bj * 128) = o;
                    }
                }
        }
    }
};
struct EpiOut {
    static constexpr bool PERM = false, AFTER_DRAIN = false, REALIGN = true;
    const float* x; const float* mod; const float* fw; float* out; float* slots; unsigned* cnt;
    DI void operator()(const f32x4 (&acc_)[2][2][4][2], const Unit& u, int wr, int wc, int fr, int fq) const {
        f32x4 (&acc)[2][2][4][2] = const_cast<f32x4 (&)[2][2][4][2]>(acc_);
        const int rbase = u.pm * 256 + wr * 64 + fr, cbase = u.pn * 256 + wc * 32 + 4 * fq;
        const float* gate = mod + (size_t)(rbase >> 12) * 3072 + 2048;
        f32x4 gv[2][2];
#pragma unroll
        for (int bj = 0; bj < 2; ++bj)
#pragma unroll
            for (int n = 0; n < 2; ++n) gv[bj][n] = *(const f32x4*)(gate + cbase + bj * 128 + n * 16);
        f32x4 xv[2][4]; float ss[8];
#pragma unroll
        for (int q = 0; q < 4; ++q) xv[0][q] = ldnt_f4(x + (size_t)rbase * 1024 + cbase + (q >> 1) * 128 + (q & 1) * 16);
#pragma unroll
        for (int k = 0; k < 8; ++k) {
            const int ai = k >> 2, m = k & 3;
            if (k + 1 < 8) {
                const size_t ro = (size_t)(rbase + ((k + 1) >> 2) * 128 + ((k + 1) & 3) * 16) * 1024 + cbase;
#pragma unroll
                for (int q = 0; q < 4; ++q) xv[(k + 1) & 1][q] = ldnt_f4(x + ro + (q >> 1) * 128 + (q & 1) * 16);
            }
            float sk = 0.f;
#pragma unroll
            for (int q = 0; q < 4; ++q) {
                const int bj = q >> 1, n = q & 1;
                const f32x4 v = xv[k & 1][q] + gv[bj][n] * acc[ai][bj][m][n];
                acc[ai][bj][m][n] = v;
                sk += v[0] * v[0] + v[1] * v[1] + v[2] * v[2] + v[3] * v[3];
            }
            ss[k] = sk;
        }
#pragma unroll
        for (int k = 0; k < 8; ++k) { ss[k] += __shfl_xor(ss[k], 16); ss[k] += __shfl_xor(ss[k], 32); }
        if (fq == 0) {
#pragma unroll
            for (int k = 0; k < 8; ++k)
                __hip_atomic_store(slots + (size_t)(rbase + (k >> 2) * 128 + (k & 3) * 16) * 16 + u.pn * 4 + wc, ss[k], __ATOMIC_RELAXED, __HIP_MEMORY_SCOPE_AGENT);
        }
        asm volatile("s_waitcnt vmcnt(0)" ::: "memory");
        __builtin_amdgcn_s_barrier();
        if (threadIdx.x == 0) {
            __hip_atomic_fetch_add(cnt + u.pm * 64, 1u, __ATOMIC_RELAXED, __HIP_MEMORY_SCOPE_AGENT);
            unsigned spins = 0;
            while (__hip_atomic_load(cnt + u.pm * 64, __ATOMIC_RELAXED, __HIP_MEMORY_SCOPE_AGENT) < 4u) { __builtin_amdgcn_s_sleep(4); if (++spins > (1u << 23)) break; }
        }
        __builtin_amdgcn_s_barrier();
        __builtin_amdgcn_fence(__ATOMIC_ACQUIRE, "agent");
        asm volatile("s_waitcnt vmcnt(0)" ::: "memory");
        f32x4 sl[8];
#pragma unroll
        for (int k = 0; k < 8; ++k) sl[k] = *(const f32x4*)(slots + (size_t)(rbase + (k >> 2) * 128 + (k & 3) * 16) * 16 + fq * 4);
        f32x4 fv[2][2];
#pragma unroll
        for (int bj = 0; bj < 2; ++bj)
#pragma unroll
            for (int n = 0; n < 2; ++n) fv[bj][n] = *(const f32x4*)(fw + cbase + bj * 128 + n * 16);
        float rs[8];
#pragma unroll
        for (int k = 0; k < 8; ++k) {
            float t = (sl[k][0] + sl[k][1]) + (sl[k][2] + sl[k][3]);
            t += __shfl_xor(t, 16); t += __shfl_xor(t, 32);
            rs[k] = rsqrtf(t * (1.0f / 1024.0f) + EPS);
        }
#pragma unroll
        for (int k = 0; k < 8; ++k) {
            const int ai = k >> 2, m = k & 3;
            const size_t ro = (size_t)(rbase + ai * 128 + m * 16) * 1024 + cbase;
#pragma unroll
            for (int bj = 0; bj < 2; ++bj)
#pragma unroll
                for (int n = 0; n < 2; ++n) __builtin_nontemporal_store(acc[ai][bj][m][n] * rs[k] * fv[bj][n], (f32x4*)(out + ro + bj * 128 + n * 16));
        }
    }
};
struct SchedIn {
    pg8::StaticOrder so;
    DI bool next(int i, Unit& u) const {
        if (so.G == 256) {
            const int x = so.c & 7, j = so.c >> 3;
            if (j < 3) {
                if (i == 0) { u.pm = 128 + x; u.pn = 1 + j; return true; }
                if (i > 6) return false;
                const int q = 6 * j + (i - 1);
                u.pm = 16 * x + (q >> 2); u.pn = q & 3; return true;
            }
            if (i > 5) return false;
            const int e = (j - 3) + 29 * i;
            if (e < 64) { u.pm = 16 * x + (e >> 2); u.pn = 6 + (e & 3); }
            else if (e < 128) { const int t = e & 3; u.pm = 16 * x + ((e - 64) >> 2); u.pn = t < 2 ? 10 + t : 2 + t; }
            else { const int q = 18 + (e - 128); u.pm = 16 * x + (q >> 2); u.pn = q & 3; }
            return true;
        }
        long L = (long)i * so.G + so.c;
        if (L < so.nwg) return so.next(i, u);
        L -= so.nwg; if (L >= 24) return false;
        u.pm = 128 + (int)(L / 3); u.pn = 1 + (int)(L % 3); return true;
    }
    DI void a_ready(const Unit&) const {}
    DI void done(const Unit&) const {}
};

DI void phase0(const Args& a, LAS unsigned char* lds) {
    const int tid = threadIdx.x;
    float* mod = (float*)(a.ws + WS_MOD);
    LAS float* red = (LAS float*)lds;
    for (int it = blockIdx.x; it < 1233; it += gridDim.x) {
        if (it < 192) {
            const int c0 = it * 16, f = tid & 3, rg = tid >> 2;
            LAS float* scv = red + 36 * 512;
            for (int q = tid; q < 9 * 1024; q += NTHREADS) { const float cv = (q < 8192) ? a.c[q] : a.c_ctx[q - 8192]; scv[q] = cv / (1.0f + expf(-cv)); }
            __syncthreads();
            float acc[9][4];
#pragma unroll
            for (int j = 0; j < 9; ++j)
#pragma unroll
                for (int e = 0; e < 4; ++e) acc[j][e] = 0.f;
            f32x4 wv[8];
#pragma unroll
            for (int i = 0; i < 8; ++i) wv[i] = ldnt_f4(a.w_ada + (size_t)(rg + 128 * i) * 3072 + c0 + f * 4);
#pragma unroll
            for (int i = 0; i < 8; ++i) {
                const int r = rg + 128 * i;
#pragma unroll
                for (int j = 0; j < 9; ++j) {
                    const float sv = scv[j * 1024 + r];
#pragma unroll
                    for (int e = 0; e < 4; ++e) acc[j][e] += sv * wv[i][e];
                }
            }
#pragma unroll
            for (int j = 0; j < 9; ++j)
#pragma unroll
                for (int e = 0; e < 4; ++e) red[(j * 4 + e) * 512 + tid] = acc[j][e];
            __syncthreads();
            if (tid < 144) {
                const int j = tid >> 4, cc = tid & 15, ff = cc >> 2, e = cc & 3;
                float s = 0.f;
                for (int q = 0; q < 128; ++q) s += red[(j * 4 + e) * 512 + q * 4 + ff];
                mod[j * 3072 + c0 + cc] = s + a.b_ada[c0 + cc];
            }
            __syncthreads();
        } else if (it < 1216) {
            const bool is_in = it < 960; const int tt = is_in ? it - 192 : it - 960;
            const int nN = is_in ? 48 : 16, NN = is_in ? 3072 : 1024;
            const int k0 = (tt / nN) * 64, n0 = (tt % nN) * 64;
            int ns = n0;
            if (is_in && ((n0 >= 1536 && n0 < 2048) || n0 >= 2560)) {
                const int base = n0 >= 2560 ? 2560 : 1536, t = (n0 >= 2560 ? 2 : 0) + (n0 - base) / 256, w = (n0 - base) % 256;
                ns = (w < 128 ? 1536 : 2560 - 128) + 128 * t + w;
            }
            const float* src = is_in ? a.w_in : a.w_out;
            bf16_t* dst = (bf16_t*)(a.ws + (is_in ? WS_WIN : WS_WOUT));
            const int kr = tid >> 4, n4 = tid & 15;
#pragma unroll
            for (int p = 0; p < 2; ++p) {
                const int k = kr + 32 * p;
                const f32x4 v = ldnt_f4(src + (size_t)(k0 + k) * NN + ns + n4 * 4);
#pragma unroll
                for (int e = 0; e < 4; ++e) red[k * 65 + n4 * 4 + e] = v[e];
            }
            __syncthreads();
            const int n = tid >> 3, k8 = tid & 7;
            float v[8];
#pragma unroll
            for (int j = 0; j < 8; ++j) v[j] = red[(k8 * 8 + j) * 65 + n];
            const u32x4 o = {pk2(v[0], v[1]), pk2(v[2], v[3]), pk2(v[4], v[5]), pk2(v[6], v[7])};
            *(u32x4*)(dst + (size_t)(n0 + n) * 1024 + k0 + k8 * 8) = o;
            __syncthreads();
        } else if (it < 1232) {
            const size_t base = (size_t)(it - 1216) * 4096 + tid * 8;
            const f32x4 v0 = *(const f32x4*)(a.w_s + base), v1 = *(const f32x4*)(a.w_s + base + 4);
            const u32x4 o = {pk2(v0[0], v0[1]), pk2(v0[2], v0[3]), pk2(v1[0], v1[1]), pk2(v1[2], v1[3])};
            *(u32x4*)((bf16_t*)(a.ws + WS_WSB) + base) = o;
        } else {
            float* rc = (float*)(a.ws + WS_ROPE); float* rs = rc + 1024;
            for (int idx = tid; idx < 1024; idx += NTHREADS) {
                const int pos = idx >> 4, fi = idx & 15;
                const float inv = powf(10000.0f, -(float)fi / 16.0f), ang = (float)pos * inv;
                rc[idx] = cosf(ang); rs[idx] = sinf(ang);
            }
        }
    }
}

template <int R> DI void norm_rows(const Args& a, const float* mod, bf16_t* H, const int (&rows)[R], int lane) {
    f32x4 v[R][4]; const float* mrow[R];
#pragma unroll
    for (int k = 0; k < R; ++k) {
        const int r = rows[k]; const float* src; int j;
        if (r < NTOK) { src = a.x + (size_t)r * 1024; j = r >> 12; } else { src = a.ctx + (size_t)(r - NTOK) * 1024; j = 8; }
        mrow[k] = mod + j * 3072;
#pragma unroll
        for (int q = 0; q < 4; ++q) v[k][q] = ldnt_f4(src + q * 256 + lane * 4);
    }
#pragma unroll
    for (int k = 0; k < R; ++k) {
        float ss = 0.f;
#pragma unroll
        for (int q = 0; q < 4; ++q) ss += v[k][q][0] * v[k][q][0] + v[k][q][1] * v[k][q][1] + v[k][q][2] * v[k][q][2] + v[k][q][3] * v[k][q][3];
#pragma unroll
        for (int off = 32; off >= 1; off >>= 1) ss += __shfl_xor(ss, off);
        const float rstd = rsqrtf(ss * (1.0f / 1024.0f) + EPS);
#pragma unroll
        for (int q = 0; q < 4; ++q) {
            const int cidx = q * 256 + lane * 4;
            const f32x4 nw = *(const f32x4*)(a.norm_w + cidx), sc = *(const f32x4*)(mrow[k] + 1024 + cidx), sh = *(const f32x4*)(mrow[k] + cidx);
            f32x4 hv;
#pragma unroll
            for (int e = 0; e < 4; ++e) hv[e] = (v[k][q][e] * rstd * nw[e]) * (1.0f + sc[e]) + sh[e];
            const u32x2 o = {pk2(hv[0], hv[1]), pk2(hv[2], hv[3])};
            *(u32x2*)(H + (size_t)rows[k] * 1024 + cidx) = o;
        }
    }
}
DI void norm_row(const Args& a, const float* mod, bf16_t* H, int r, int lane) { const int rows[1] = {r}; norm_rows<1>(a, mod, H, rows, lane); }
DI void phase1(const Args& a) {
    const int tid = threadIdx.x, wave = tid >> 6, lane = tid & 63, blk = blockIdx.x, G = gridDim.x;
    const float* mod = (const float*)(a.ws + WS_MOD);
    bf16_t* H = (bf16_t*)(a.ws + WS_H);
    constexpr int NCH = (NTOK + NCTX) / 8;
    int ch = blk;
    for (; ch + 3 * G < NCH; ch += 4 * G) { const int rows[4] = {ch * 8 + wave, (ch + G) * 8 + wave, (ch + 2 * G) * 8 + wave, (ch + 3 * G) * 8 + wave}; norm_rows<4>(a, mod, H, rows, lane); }
    for (; ch < NCH; ch += G) norm_row(a, mod, H, ch * 8 + wave, lane);
}

constexpr int VS = 288, KS = 144, KS2 = 160;
DI void gmlp_unit(const Args& a, LAS unsigned char* lds, int b, int c) {
    const int tid = threadIdx.x, lane = tid & 63, w = tid >> 6, i = lane & 15, g = lane >> 4;
    const int r0 = b * 4096 + c * 128;
    const bf16_t* VG = (const bf16_t*)(a.ws + WS_VG); const bf16_t* U = (const bf16_t*)(a.ws + WS_U);
    const bf16_t* WSB = (const bf16_t*)(a.ws + WS_WSB); bf16_t* Y = (bf16_t*)(a.ws + WS_H);
    constexpr int GSZ = 128 * VS;
    {
        const int row = tid >> 2, q = tid & 3;
        const bf16_t* src = VG + (size_t)(r0 + row) * 512 + q * 8;
        float s = 0.f, s2 = 0.f;
#pragma unroll 8
        for (int p = 0; p < 16; ++p) {
            const u32x4 pc = *(const u32x4*)(src + p * 32);
#pragma unroll
            for (int e = 0; e < 4; ++e) { const float lo = bflo(pc[e]), hi = bfhi(pc[e]); s += lo + hi; s2 += lo * lo + hi * hi; }
        }
        s += __shfl_xor(s, 1); s += __shfl_xor(s, 2); s2 += __shfl_xor(s2, 1); s2 += __shfl_xor(s2, 2);
        const float mean = s * (1.0f / 512.0f);
        const float var = fmaxf(s2 * (1.0f / 512.0f) - mean * mean, 0.f);
        const float rstd = rsqrtf(var + EPS);
        const float* lw = a.ln_w + q * 8;
#pragma unroll 4
        for (int p = 0; p < 16; ++p) {
            const u32x4 pc = *(const u32x4*)(src + p * 32);
            const f32x4 w0 = *(const f32x4*)(lw + p * 32), w1 = *(const f32x4*)(lw + p * 32 + 4);
            u32x4 o;
            o[0] = pk2((bflo(pc[0]) - mean) * rstd * w0[0], (bfhi(pc[0]) - mean) * rstd * w0[1]);
            o[1] = pk2((bflo(pc[1]) - mean) * rstd * w0[2], (bfhi(pc[1]) - mean) * rstd * w0[3]);
            o[2] = pk2((bflo(pc[2]) - mean) * rstd * w1[0], (bfhi(pc[2]) - mean) * rstd * w1[1]);
            o[3] = pk2((bflo(pc[3]) - mean) * rstd * w1[2], (bfhi(pc[3]) - mean) * rstd * w1[3]);
            *(LAS u32x4*)(lds + (p >> 2) * GSZ + row * VS + ((p & 3) * 4 + q) * 16) = o;
        }
    }
    __syncthreads();
    const int n = 16 * w + i, r = r0 + n;
#pragma unroll 1
    for (int gq = 0; gq < 4; ++gq) {
        f32x4 acc[8];
#pragma unroll
        for (int et = 0; et < 8; ++et) acc[et] = (f32x4){0.f, 0.f, 0.f, 0.f};
        const bf16_t* wrow = WSB + (size_t)(gq * 128 + n) * 128;
        bf16x8 bw[4];
#pragma unroll
        for (int s = 0; s < 4; ++s) bw[s] = frag_rowP(wrow + 32 * s, g);
#pragma unroll
        for (int s = 0; s < 4; ++s) {
#pragma unroll
            for (int et = 0; et < 8; ++et) acc[et] = mfma16(frag_tr(lds + gq * GSZ, VS, 32 * s, 16 * et, lane), bw[s], acc[et]);
        }
        const float bias = a.b_s[gq * 128 + n];
#pragma unroll
        for (int et = 0; et < 8; et += 2) {
            const int colw = gq * 128 + 16 * (et + (g & 1)) + 8 * (g >> 1);
            const u32x4 uw = *(const u32x4*)(U + (size_t)r * 512 + colw);
            const u32x2 ux = __builtin_amdgcn_permlane16_swap(uw[0], uw[2], false, false), uy = __builtin_amdgcn_permlane16_swap(uw[1], uw[3], false, false);
            const u32x2 ua = {ux[0], uy[0]}, ub = {ux[1], uy[1]};
            const u32x2 oa = {pk2(bflo(ua.x) * (acc[et][0] + bias), bfhi(ua.x) * (acc[et][1] + bias)), pk2(bflo(ua.y) * (acc[et][2] + bias), bfhi(ua.y) * (acc[et][3] + bias))};
            const u32x2 ob = {pk2(bflo(ub.x) * (acc[et + 1][0] + bias), bfhi(ub.x) * (acc[et + 1][1] + bias)), pk2(bflo(ub.y) * (acc[et + 1][2] + bias), bfhi(ub.y) * (acc[et + 1][3] + bias))};
            const u32x2 wx = __builtin_amdgcn_permlane16_swap(oa.x, ob.x, false, false), wy = __builtin_amdgcn_permlane16_swap(oa.y, ob.y, false, false);
            const u32x4 ow = {wx[0], wy[0], wx[1], wy[1]};
            __builtin_nontemporal_store(ow, (u32x4*)(Y + (size_t)r * 1024 + 512 + colw));
        }
    }
    __syncthreads();
}
struct ChStage { u32x4 kf[2], kb[2], v; };
DI void chain_load(const Args& a, int bh, int es, int it, ChStage& st) {
    const int tid = threadIdx.x;
    const bf16_t *Kf, *Kb, *Vf, *Vb;
    if (it < 2) {
        const size_t of = (size_t)bh * 256 + it * 128, ob = (size_t)bh * 256 + (1 - it) * 128;
        Kf = (const bf16_t*)(a.ws + WS_KC) + of * 64; Kb = (const bf16_t*)(a.ws + WS_KC) + ob * 64;
        Vf = (const bf16_t*)(a.ws + WS_VC) + (((size_t)bh * 8 + es) * 256 + it * 128) * 16; Vb = (const bf16_t*)(a.ws + WS_VC) + (((size_t)bh * 8 + es) * 256 + (1 - it) * 128) * 16;
    } else {
        const size_t of = (size_t)bh * 4096 + (it - 2) * 128, ob = (size_t)bh * 4096 + (33 - it) * 128;
        Kf = (const bf16_t*)(a.ws + WS_K) + of * 64; Kb = (const bf16_t*)(a.ws + WS_K) + ob * 64;
        Vf = (const bf16_t*)(a.ws + WS_V) + (((size_t)bh * 8 + es) * 4096 + (it - 2) * 128) * 16; Vb = (const bf16_t*)(a.ws + WS_V) + (((size_t)bh * 8 + es) * 4096 + (33 - it) * 128) * 16;
    }
#pragma unroll
    for (int q = 0; q < 2; ++q) { const int p = tid + 512 * q; st.kf[q] = *(const u32x4*)(Kf + (p >> 3) * 64 + (p & 7) * 8); st.kb[q] = *(const u32x4*)(Kb + (p >> 3) * 64 + (p & 7) * 8); }
    const int t = tid & 255; const bf16_t* Vx = (tid < 256) ? Vf : Vb;
    st.v = *(const u32x4*)(Vx + t * 8);
}
DI void chain_item(const Args& a, LAS unsigned char* lds, int item) {
    const int tid = threadIdx.x, lane = tid & 63, w = tid >> 6, i = lane & 15, g = lane >> 4;
    const int bh = item >> 3, es = item & 7, h = bh & 3, dirw = w >> 2, dt = w & 3;
    const float l2f = -expf(a.dec_f[h]) * LOG2E, l2b = -expf(a.dec_b[h]) * LOG2E;
    const float G = exp2f(128.0f * (dirw ? l2b : l2f));
    constexpr int BUFSZ = 2 * 128 * KS2 + 2 * 128 * 32;
    const float tv = (tid < 256) ? exp2f((float)(127 - ((tid & 255) >> 1)) * l2f) : exp2f((float)((tid & 255) >> 1) * l2b);
    bf16_t* ST = (bf16_t*)(a.ws + WS_ST);
    f32x4 S = {0.f, 0.f, 0.f, 0.f};
    ChStage st0, st1, st2, st3;
    chain_load(a, bh, es, 0, st0); chain_load(a, bh, es, 1, st1); chain_load(a, bh, es, 2, st2);
#define CH_STEP(IT, CUR, NXT, STORE) do { const int it = (IT); { \
        LAS unsigned char* buf = lds + (it & 1) * BUFSZ; \
        LAS unsigned char* KFs = buf; LAS unsigned char* KBs = buf + 128 * KS2; LAS unsigned char* VFs = buf + 2 * 128 * KS2; LAS unsigned char* VBs = VFs + 128 * 32; \
        _Pragma("unroll") for (int q = 0; q < 2; ++q) { \
            const int p = tid + 512 * q, m = p >> 3, d8 = p & 7; \
            *(LAS u32x4*)(KFs + m * KS2 + d8 * 16) = CUR.kf[q]; *(LAS u32x4*)(KBs + m * KS2 + d8 * 16) = CUR.kb[q]; \
        } \
        { const int t = tid & 255; u32x4 sv; _Pragma("unroll") for (int e = 0; e < 4; ++e) sv[e] = pk2(bflo(CUR.v[e]) * tv, bfhi(CUR.v[e]) * tv); \
          *(LAS u32x4*)((tid < 256 ? VFs : VBs) + (t >> 1) * 32 + (t & 1) * 16) = sv; } \
        lds_barrier(); \
        chain_load(a, bh, es, (it + 3 < 34) ? it + 3 : 33, NXT);                  \
        LAS const unsigned char* Kx = dirw ? KBs : KFs; LAS const unsigned char* Vx = dirw ? VBs : VFs; \
        f32x4 kv = {0.f, 0.f, 0.f, 0.f}; \
        _Pragma("unroll") for (int s = 0; s < 4; ++s) kv = mfma16(frag_tr(Vx, 32, 32 * s, 0, lane), frag_tr(Kx, KS2, 32 * s, 16 * dt, lane), kv); \
        if (STORE) {                                                              \
            const int c = dirw ? 33 - it : it - 2; \
            const u32x2 o = {pk2(S[0], S[1]), pk2(S[2], S[3])}; \
            *(u32x2*)(ST + (((size_t)(bh * 32 + c) * 2 + dirw) * 64 + 16 * dt + i) * 128 + es * 16 + 4 * g) = o; \
        } \
        S = S * G + kv; } } while (0)
    CH_STEP(0, st0, st3, false); CH_STEP(1, st1, st0, false);
#pragma unroll 1
    for (int it4 = 2; it4 < 34; it4 += 4) {
        CH_STEP(it4, st2, st1, true); CH_STEP(it4 + 1, st3, st2, true); CH_STEP(it4 + 2, st0, st3, true); CH_STEP(it4 + 3, st1, st0, true);
    }
#undef CH_STEP
    __syncthreads();
}
DI void phase3(const Args& a, LAS unsigned char* lds) {
    for (int it = blockIdx.x; it < 256; it += gridDim.x) gmlp_unit(a, lds, it >> 5, it & 31);
    for (int it = blockIdx.x; it < 256; it += gridDim.x) { const int j = it >> 3; chain_item(a, lds, (((it & 7) * 4 + (j >> 3)) << 3) + (j & 7)); }
}

DI void phase4(const Args& a) {
    const float* KV = (const float*)(a.ws + WS_KV); const float* KVC = (const float*)(a.ws + WS_KVC);
    bf16_t* ST = (bf16_t*)(a.ws + WS_ST);
    for (int idx = blockIdx.x * NTHREADS + threadIdx.x; idx < 64 * 2048; idx += gridDim.x * NTHREADS) {
        const int chain = idx >> 11, pos = idx & 2047, bh = chain >> 1, dir = chain & 1, h = bh & 3;
        const float lg = -expf(dir ? a.dec_b[h] : a.dec_f[h]), G = expf(128.0f * lg);
        const f32x4 k0 = *(const f32x4*)(KVC + ((size_t)(bh * 2 + 0) * 2 + dir) * 8192 + pos * 4);
        const f32x4 k1 = *(const f32x4*)(KVC + ((size_t)(bh * 2 + 1) * 2 + dir) * 8192 + pos * 4);
        f32x4 S = dir ? (k1 * G + k0) : (k0 * G + k1);
#pragma unroll 8
        for (int step = 0; step < NC; ++step) {
            const int c = dir ? (NC - 1 - step) : step;
            const size_t off = ((size_t)(bh * 32 + c) * 2 + dir) * 8192 + pos * 4;
            const f32x4 kvv = *(const f32x4*)(KV + off);
            const u32x2 o = {pk2(S[0], S[1]), pk2(S[2], S[3])};
            *(u32x2*)(ST + off) = o;
            S = S * G + kvv;
        }
    }
}

struct RetStage { u32x4 k[2], v[4], sf[2], sb[2]; bf16x8 q[2]; };
DI void ret_load(const Args& a, int unit, RetStage& st) {
    const int tid = threadIdx.x, lane = tid & 63, w = tid >> 6, i = lane & 15, g = lane >> 4;
    const int bh = unit >> 5, c = unit & 31;
    const bf16_t* Qp = (const bf16_t*)(a.ws + WS_Q) + ((size_t)bh * 4096 + c * 128) * 64;
    const bf16_t* Kp = (const bf16_t*)(a.ws + WS_K) + ((size_t)bh * 4096 + c * 128) * 64;
    const bf16_t* Vp = (const bf16_t*)(a.ws + WS_V) + ((size_t)bh * 8 * 4096 + c * 128) * 16;
    const bf16_t* SFp = (const bf16_t*)(a.ws + WS_ST) + (size_t)unit * 16384; const bf16_t* SBp = SFp + 8192;
#pragma unroll
    for (int q = 0; q < 2; ++q) { const int p = tid + 512 * q; st.k[q] = *(const u32x4*)(Kp + (p >> 3) * 64 + (p & 7) * 8); }
#pragma unroll
    for (int q = 0; q < 4; ++q) { const int p = tid + 512 * q; st.v[q] = *(const u32x4*)(Vp + (size_t)(p >> 8) * (4096 * 16) + (p & 255) * 8); }
#pragma unroll
    for (int q = 0; q < 2; ++q) { const int p = tid + 512 * q; st.sf[q] = *(const u32x4*)(SFp + (p >> 4) * 128 + (p & 15) * 8); st.sb[q] = *(const u32x4*)(SBp + (p >> 4) * 128 + (p & 15) * 8); }
#pragma unroll
    for (int s = 0; s < 2; ++s) st.q[s] = frag_rowP(Qp + (16 * w + i) * 64 + 32 * s, g);
}
DI void ret_unit(const Args& a, LAS unsigned char* lds, int unit, RetStage& st, int next_unit) {
    const int tid = threadIdx.x, lane = tid & 63, w = tid >> 6, i = lane & 15, g = lane >> 4;
    const int bh = unit >> 5, c = unit & 31, b = bh >> 2, h = bh & 3;
    const bf16_t* GR = (const bf16_t*)(a.ws + WS_GR); bf16_t* Y = (bf16_t*)(a.ws + WS_H);
    LAS unsigned char* Kt = lds; LAS unsigned char* Vt = lds + 128 * KS; LAS unsigned char* SF = Vt + 128 * VS; LAS unsigned char* SB = SF + 64 * VS;
#pragma unroll
    for (int q = 0; q < 2; ++q) { const int p = tid + 512 * q; *(LAS u32x4*)(Kt + (p >> 3) * KS + (p & 7) * 16) = st.k[q]; }
#pragma unroll
    for (int q = 0; q < 4; ++q) { const int p = tid + 512 * q; *(LAS u32x4*)(Vt + ((p & 255) >> 1) * VS + (p >> 8) * 32 + (p & 1) * 16) = st.v[q]; }
#pragma unroll
    for (int q = 0; q < 2; ++q) { const int p = tid + 512 * q; *(LAS u32x4*)(SF + (p >> 4) * VS + (p & 15) * 16) = st.sf[q]; *(LAS u32x4*)(SB + (p >> 4) * VS + (p & 15) * 16) = st.sb[q]; }
    bf16x8 Qf[2];
#pragma unroll
    for (int s = 0; s < 2; ++s) Qf[s] = st.q[s];
    lds_barrier();
    if (next_unit >= 0) ret_load(a, next_unit, st);
    const float l2f = -expf(a.dec_f[h]) * LOG2E, l2b = -expf(a.dec_b[h]) * LOG2E;
    const int n = 16 * w + i;

    f32x4 accS[8];
#pragma unroll
    for (int mt = 0; mt < 8; ++mt) {
        accS[mt] = (f32x4){0.f, 0.f, 0.f, 0.f};
#pragma unroll
        for (int s = 0; s < 2; ++s) accS[mt] = mfma16(frag_rowP_lds(Kt + (16 * mt + i) * KS + 64 * s, g), Qf[s], accS[mt]);
    }
#pragma unroll
    for (int mt = 0; mt < 8; ++mt)
#pragma unroll
        for (int reg = 0; reg < 4; ++reg) {
            const int diff = n - (16 * mt + 4 * g + reg);
            const float ex = __builtin_amdgcn_exp2f(diff > 0 ? (float)diff * l2f : (float)(-diff) * l2b);
            accS[mt][reg] *= (diff == 0 ? 2.0f : ex);
        }
    const float fsf = __builtin_amdgcn_exp2f((float)(n + 1) * l2f), fsb = __builtin_amdgcn_exp2f((float)(128 - n) * l2b);
    f32x4 accO[8];
#pragma unroll
    for (int et = 0; et < 8; ++et) accO[et] = (f32x4){0.f, 0.f, 0.f, 0.f};
#pragma unroll
    for (int s = 0; s < 4; ++s) {
        const u32x4 pu = {pk2(accS[2 * s][0], accS[2 * s][1]), pk2(accS[2 * s][2], accS[2 * s][3]), pk2(accS[2 * s + 1][0], accS[2 * s + 1][1]), pk2(accS[2 * s + 1][2], accS[2 * s + 1][3])};
        const bf16x8 Pf = __builtin_bit_cast(bf16x8, pu);
#pragma unroll
        for (int et = 0; et < 8; ++et) accO[et] = mfma16(frag_tr(Vt, VS, 32 * s, 16 * et, lane), Pf, accO[et]);
        __builtin_amdgcn_sched_barrier(0);
    }
#pragma unroll
    for (int s = 0; s < 2; ++s) {
        const bf16x8 qsf = scale_frag(Qf[s], fsf), qsb = scale_frag(Qf[s], fsb);
#pragma unroll
        for (int et = 0; et < 8; ++et) {
            accO[et] = mfma16(frag_tr(SF, VS, 32 * s, 16 * et, lane), qsf, accO[et]);
            accO[et] = mfma16(frag_tr(SB, VS, 32 * s, 16 * et, lane), qsb, accO[et]);
        }
        __builtin_amdgcn_sched_barrier(0);
    }
    float sm = 0.f;
#pragma unroll
    for (int et = 0; et < 8; ++et) sm += accO[et][0] + accO[et][1] + accO[et][2] + accO[et][3];
    sm += __shfl_xor(sm, 16); sm += __shfl_xor(sm, 32);
    const float mean = sm * (1.0f / 128.0f);
    float v2 = 0.f;
#pragma unroll
    for (int et = 0; et < 8; ++et)
#pragma unroll
        for (int e = 0; e < 4; ++e) { const float d0 = accO[et][e] - mean; v2 += d0 * d0; }
    v2 += __shfl_xor(v2, 16); v2 += __shfl_xor(v2, 32);
    const float rstd = rsqrtf(v2 * (1.0f / 128.0f) + EPS);
    const int r = b * 4096 + c * 128 + n;
#pragma unroll
    for (int et = 0; et < 8; et += 2) {
        const int colw = h * 128 + 16 * (et + (g & 1)) + 8 * (g >> 1);
        const u32x4 gww = *(const u32x4*)(GR + (size_t)r * 512 + colw);
        const u32x2 gx = __builtin_amdgcn_permlane16_swap(gww[0], gww[2], false, false), gy = __builtin_amdgcn_permlane16_swap(gww[1], gww[3], false, false);
        const u32x2 ga = {gx[0], gy[0]}, gb = {gx[1], gy[1]};
        const f32x4 wa = *(const f32x4*)(a.gn_w + h * 128 + 16 * et + 4 * g), wb = *(const f32x4*)(a.gn_w + h * 128 + 16 * (et + 1) + 4 * g);
        const u32x2 oa = {pk2((accO[et][0] - mean) * rstd * wa[0] * bflo(ga.x), (accO[et][1] - mean) * rstd * wa[1] * bfhi(ga.x)),
                          pk2((accO[et][2] - mean) * rstd * wa[2] * bflo(ga.y), (accO[et][3] - mean) * rstd * wa[3] * bfhi(ga.y))};
        const u32x2 ob = {pk2((accO[et + 1][0] - mean) * rstd * wb[0] * bflo(gb.x), (accO[et + 1][1] - mean) * rstd * wb[1] * bfhi(gb.x)),
                          pk2((accO[et + 1][2] - mean) * rstd * wb[2] * bflo(gb.y), (accO[et + 1][3] - mean) * rstd * wb[3] * bfhi(gb.y))};
        const u32x2 wx = __builtin_amdgcn_permlane16_swap(oa.x, ob.x, false, false), wy = __builtin_amdgcn_permlane16_swap(oa.y, ob.y, false, false);
        const u32x4 ow = {wx[0], wy[0], wx[1], wy[1]};
        *(u32x4*)(Y + (size_t)r * 1024 + colw) = ow;
    }
    lds_barrier();
}

DI void phase7(const Args& a) {
    const int tid = threadIdx.x, wave = tid >> 6, lane = tid & 63;
    for (int r = blockIdx.x * 8 + wave; r < NTOK; r += gridDim.x * 8) {
        float* row = a.out + (size_t)r * 1024;
        f32x4 v[4]; float ss = 0.f;
#pragma unroll
        for (int q = 0; q < 4; ++q) { v[q] = *(const f32x4*)(row + q * 256 + lane * 4); ss += v[q][0] * v[q][0] + v[q][1] * v[q][1] + v[q][2] * v[q][2] + v[q][3] * v[q][3]; }
#pragma unroll
        for (int off = 32; off >= 1; off >>= 1) ss += __shfl_xor(ss, off);
        const float rstd = rsqrtf(ss * (1.0f / 1024.0f) + EPS);
#pragma unroll
        for (int q = 0; q < 4; ++q) {
            const f32x4 fw = *(const f32x4*)(a.fnorm_w + q * 256 + lane * 4);
            *(f32x4*)(row + q * 256 + lane * 4) = v[q] * rstd * fw;
        }
    }
}

__global__ __launch_bounds__(512, 2) void fwd_megakernel(Args a) {
    extern __shared__ __attribute__((aligned(16))) unsigned char shm[];
    LAS unsigned char* lds = (LAS unsigned char*)shm;
    cg::grid_group grid = cg::this_grid();
    volatile LAS unsigned* st = (volatile LAS unsigned*)(lds + LDS_BYTES - 16);
    if (threadIdx.x == 0) { st[0] = 0u; st[1] = 0u; }
    __syncthreads();
    const XcdBarrier xb = xcd_barrier_post((unsigned*)(a.ws + WS_BAR), st);
    if (a.ph_hi > 7) grid.sync();
#ifndef PHMASK
#define PHMASK 255
#endif
#ifndef REPMASK
#define REPMASK 0
#endif
#ifndef EXTRA_SYNCS
#define EXTRA_SYNCS 0
#endif
#define GSYNC() xcd_barrier(xb)
    for (int xs = 0; xs < EXTRA_SYNCS; ++xs) GSYNC();
#define PHASE(P, ...) do { if (((PHMASK >> (P)) & 1) && a.ph_lo <= (P) && (P) < a.ph_hi) { if ((REPMASK >> (P)) & 1) { __VA_ARGS__; GSYNC(); } __VA_ARGS__; if ((P) + 1 < a.ph_hi) GSYNC(); } } while (0)
    PHASE(0, phase0(a, lds));
    PHASE(1, phase1(a));
    PHASE(2, {
        pg8::Gemm gm{(const bf16_t*)(a.ws + WS_H), (const bf16_t*)(a.ws + WS_WIN), NTOK, NP, D};
        SchedIn S; S.so.init(NTOK, NP, (int)gridDim.x, (int)blockIdx.x);
        EpiIn E{a.ws};
        pg8::gemm_phase<EpiIn, SchedIn, false>(lds, gm, S, E, nullptr);
    });
    PHASE(3, phase3(a, lds));
    PHASE(5, { int it = blockIdx.x; if (it < 1024) { RetStage st; ret_load(a, it, st); for (;;) { const int nx = it + (int)gridDim.x; ret_unit(a, lds, it, st, nx < 1024 ? nx : -1); if (nx >= 1024) break; it = nx; } } });
    PHASE(6, {
        pg8::Gemm gm{(const bf16_t*)(a.ws + WS_H), (const bf16_t*)(a.ws + WS_WOUT), NTOK, D, D};
        pg8::StaticOrder S; S.init(NTOK, D, (int)gridDim.x, (int)blockIdx.x);
        EpiOut E{a.x, (const float*)(a.ws + WS_MOD), a.fnorm_w, a.out, (float*)(a.ws + WS_SLOT), (unsigned*)(a.ws + WS_CNT)};
        pg8::gemm_phase<EpiOut, pg8::StaticOrder, false>(lds, gm, S, E, nullptr);
    });
#undef PHASE
}

extern "C" void kernel_launch(void* const* d_in, const int* in_sizes, int n_in, void* d_out, int out_size, void* d_ws, size_t ws_size, hipStream_t stream) {
    static int grid = 0;
    if (grid == 0) {
        if (n_in != 16 || out_size != NTOK * D || ws_size < WS_END) { fprintf(stderr, "kernel_launch: unexpected shapes (n_in %d out %d ws %zu need %zu)\n", n_in, out_size, ws_size, (size_t)WS_END); grid = -1; return; }
        int dev = 0, cus = 0, per_cu = 0;
        (void)hipGetDevice(&dev); (void)hipDeviceGetAttribute(&cus, hipDeviceAttributeMultiprocessorCount, dev);
        if (hipFuncSetAttribute((const void*)fwd_megakernel, hipFuncAttributeMaxDynamicSharedMemorySize, LDS_BYTES) != hipSuccess) { fprintf(stderr, "kernel_launch: hipFuncSetAttribute failed\n"); grid = -1; return; }
        if (hipOccupancyMaxActiveBlocksPerMultiprocessor(&per_cu, (const void*)fwd_megakernel, NTHREADS, LDS_BYTES) != hipSuccess || per_cu < 1) { fprintf(stderr, "kernel_launch: occupancy query gives %d\n", per_cu); per_cu = 1; }
        (void)hipGetLastError();
        grid = cus;
    }
    if (grid < 0) return;
    Args a{};
    a.x = (const float*)d_in[0]; a.c = (const float*)d_in[1]; a.ctx = (const float*)d_in[2]; a.c_ctx = (const float*)d_in[3]; a.w_ada = (const float*)d_in[4]; a.b_ada = (const float*)d_in[5];
    a.norm_w = (const float*)d_in[6]; a.w_in = (const float*)d_in[7]; a.dec_f = (const float*)d_in[8]; a.dec_b = (const float*)d_in[9]; a.gn_w = (const float*)d_in[10]; a.ln_w = (const float*)d_in[11];
    a.w_s = (const float*)d_in[12]; a.b_s = (const float*)d_in[13]; a.w_out = (const float*)d_in[14]; a.fnorm_w = (const float*)d_in[15];
    a.out = (float*)d_out; a.ws = (unsigned char*)d_ws;
    (void)hipMemsetAsync((unsigned char*)d_ws + WS_BAR, 0, (size_t)XCD_BAR_WORDS * 4 + 32768, stream);
#if N_LAUNCHES == 1
    a.ph_lo = 0; a.ph_hi = 7;
    void* args[] = {&a};
    hipError_t e = hipLaunchCooperativeKernel((const void*)fwd_megakernel, dim3(grid), dim3(NTHREADS), args, LDS_BYTES, stream);
    if (e != hipSuccess) fprintf(stderr, "cooperative launch failed: %s (grid %d)\n", hipGetErrorString(e), grid);
#else
    for (int p = 0; p < 7; ++p) {
        a.ph_lo = p; a.ph_hi = p + 1;
        hipLaunchKernelGGL(fwd_megakernel, dim3(grid), dim3(NTHREADS), LDS_BYTES, stream, a);
    }
#endif
}
```

```cpp
#include <hip/hip_runtime.h>
#include <hip/hip_cooperative_groups.h>
#include <cstdio>
namespace cg = cooperative_groups;
#ifndef N_LAUNCHES
#define N_LAUNCHES 1
#endif
namespace pg8 {
#define PG8_LAS __attribute__((address_space(3)))
typedef unsigned short bf16_t;
typedef short bf16x8 __attribute__((ext_vector_type(8)));
typedef float f32x4 __attribute__((ext_vector_type(4)));
typedef unsigned u32x4 __attribute__((ext_vector_type(4)));
constexpr int BM = 256, BK = 64, HALF = 128, HTB = HALF * BK * 2  , STAGE_BYTES = 8 * HTB, NXCD = 8, WGM = 8;

__host__ __device__ __forceinline__ int lds_byte(int r, int c) { const int st = (r >> 4) * 2 + (c >> 5), rr = r & 15, cc = c & 31, ob = rr * 64 + cc * 2; return st * 1024 + (ob ^ (((ob >> 9) & 1) << 5)); }
__host__ __device__ __forceinline__ void stage_rc(int b, int& R, int& C) { const int st = b / 1024, sb = b % 1024, swz = sb ^ (((sb >> 9) & 1) << 5); R = (st >> 1) * 16 + swz / 64; C = (st & 1) * 32 + (swz % 64) / 2; }
__host__ __device__ __forceinline__ int perm32(int rho) { const int n = rho >> 4, i = rho & 15; return 8 * (i >> 2) + 4 * n + (i & 3); }

struct Unit { int pm, pn; };
struct Gemm { const bf16_t* A; const bf16_t* Bt; int M, N, K; };

struct StaticOrder {
    int nM, nN, nwg, G, c;
    __host__ __device__ void init(int M, int N, int G_, int c_) { nM = M / BM; nN = N / BM; nwg = nM * nN; G = G_; c = c_; }
    __host__ __device__ bool next(int i, Unit& u) const {
        const long L = (long)i * G + c; if (L >= nwg) return false;
        int wgid = (int)L; { const int q = nwg / NXCD, r = nwg % NXCD, xcd = wgid % NXCD, off = wgid / NXCD; wgid = (xcd < r ? xcd * (q + 1) : r * (q + 1) + (xcd - r) * q) + off; }
        const int nig = WGM * nN, gid = wgid / nig, fm = gid * WGM, gsz = (nM - fm) < WGM ? (nM - fm) : WGM;
        u.pm = fm + ((wgid % nig) % gsz); u.pn = (wgid % nig) / gsz; return true;
    }
    __device__ __forceinline__ void a_ready(const Unit&) const {}
    __device__ __forceinline__ void done(const Unit&) const {}
};
struct CountedOrder : StaticOrder {
    const unsigned* ready; unsigned need; unsigned* tmo;
    __device__ __forceinline__ void a_ready(const Unit& u) const {
        if (threadIdx.x < 64) {
            const unsigned long long t0 = __builtin_amdgcn_s_memrealtime(); unsigned polls = 0;
            while ((unsigned)__builtin_amdgcn_readfirstlane(__hip_atomic_load(ready + 64 * u.pm, __ATOMIC_RELAXED, __HIP_MEMORY_SCOPE_AGENT)) < need) {
                if ((++polls & 255u) == 0u && __builtin_amdgcn_readfirstlane(__hip_atomic_load(tmo, __ATOMIC_RELAXED, __HIP_MEMORY_SCOPE_AGENT)) != 0u) break;
                if (__builtin_amdgcn_s_memrealtime() - t0 > 2000000ull) {
                    if (threadIdx.x == 0) { unsigned expect = 0u; __hip_atomic_compare_exchange_strong(tmo + 1, &expect, 0x600u | (unsigned)(u.pm & 0xff), __ATOMIC_RELAXED, __ATOMIC_RELAXED, __HIP_MEMORY_SCOPE_AGENT); __hip_atomic_store(tmo, 1u, __ATOMIC_RELAXED, __HIP_MEMORY_SCOPE_AGENT); }
                    break; }
                __builtin_amdgcn_s_sleep(2); }
            __builtin_amdgcn_fence(__ATOMIC_ACQUIRE, "agent");
            asm volatile("s_waitcnt vmcnt(0)" ::: "memory");
        }
#if !defined(BROKEN_HOOK_NO_BARRIER)
        asm volatile("" ::: "memory"); __builtin_amdgcn_s_barrier(); asm volatile("" ::: "memory");
#endif
    }
};

__device__ __forceinline__ unsigned cvt_pk_bf16(float lo, float hi) { unsigned r; asm volatile("v_cvt_pk_bf16_f32 %0, %1, %2" : "=v"(r) : "v"(lo), "v"(hi)); return r; }
typedef float f32x2 __attribute__((ext_vector_type(2)));
__device__ __forceinline__ f32x2 gelu_pk(f32x2 v) {
    const f32x2 av = __builtin_elementwise_abs(v), d = av * 0.2316418882f + 1.0f;
    f32x2 t; t.x = __builtin_amdgcn_rcpf(d.x); t.y = __builtin_amdgcn_rcpf(d.y);
    f32x2 q = t * 0.5307027145f + (-0.7265760135f); q = q * t + 0.7107068705f; q = q * t + (-0.142248368f); q = q * t + 0.127414796f; q = q * t;
    const f32x2 s = (v * v) * (-0.72134752044f);
    f32x2 e; e.x = __builtin_amdgcn_exp2f(s.x); e.y = __builtin_amdgcn_exp2f(s.y);
    const f32x2 m = v * (q * e), r = v - m;
    f32x2 o; o.x = v.x < 0.f ? m.x : r.x; o.y = v.y < 0.f ? m.y : r.y; return o;
}
template <class Epi, class Sched, bool STAMP = false>
__device__ __forceinline__ void gemm_phase(PG8_LAS unsigned char* lds, const Gemm g, const Sched& S, const Epi& E, unsigned long long* stamps) {
    const int tid = threadIdx.x, wid = __builtin_amdgcn_readfirstlane(tid >> 6), lane = tid & 63, wr = wid >> 2, wc = wid & 3, fr = lane & 15, fq = lane >> 4;
    const int K = g.K, nt = K / BK;
    int ts_lo = 0, ts_hi = 0, nts = 0; const unsigned long long rt_entry = STAMP ? (unsigned long long)wall_clock64() : 0ull;
#define PG8_STAMP() do { if (STAMP && wid == 0 && nts < 64) { const unsigned long long _c = (unsigned long long)clock64(); \
        ts_lo = (lane == nts) ? (int)(unsigned)_c : ts_lo; ts_hi = (lane == nts) ? (int)(unsigned)(_c >> 32) : ts_hi; ++nts; } } while (0)
    PG8_STAMP();
    unsigned voffA[2], voffB[2];
#pragma unroll
    for (int i = 0; i < 2; ++i) { int R, C; stage_rc(tid * 16 + i * 8192, R, C); const int Rb = Epi::PERM ? ((R & ~31) + perm32(R & 31)) : R;
        voffA[i] = (unsigned)(R * K + C) * 2u; voffB[i] = (unsigned)(Rb * K + C) * 2u; }
    const size_t kstep = (size_t)(BK * 2);
    const size_t hstep = (size_t)HALF * K * 2;
    const size_t tstep = 2 * hstep;
    const unsigned ldsw = (unsigned)wid * 1024u;
    const int aoff = lds_byte(wr * 64 + fr, fq * 8), boff = lds_byte(wc * 32 + fr, fq * 8);
#define PG8_SA(b, h) (((b) * 2 + (h)) * HTB)
#define PG8_SB(b, h) ((4 + (b) * 2 + (h)) * HTB)
#define PG8_STAGE(bufoff, gbase, voff) do { _Pragma("unroll") for (int _i = 0; _i < 2; ++_i) \
        __builtin_amdgcn_global_load_lds((const unsigned*)((const char*)(gbase) + (voff)[_i]), (PG8_LAS unsigned*)(lds + (bufoff) + ldsw + _i * 8192), 16, 0, 0); } while (0)
#define PG8_LDA(dst, b, h) do { _Pragma("unroll") for (int m = 0; m < 4; ++m) _Pragma("unroll") for (int k = 0; k < 2; ++k) dst[m][k] = *(const PG8_LAS bf16x8*)(lds + PG8_SA(b, h) + aoff + m * 2048 + k * 1024); } while (0)
#define PG8_LDB(dst, b, h) do { _Pragma("unroll") for (int n = 0; n < 2; ++n) _Pragma("unroll") for (int k = 0; k < 2; ++k) dst[n][k] = *(const PG8_LAS bf16x8*)(lds + PG8_SB(b, h) + boff + n * 2048 + k * 1024); } while (0)
#define PG8_MMA(ai, bj, At, Bt) do { __builtin_amdgcn_s_setprio(1); _Pragma("unroll") for (int m = 0; m < 4; ++m) _Pragma("unroll") for (int n = 0; n < 2; ++n) _Pragma("unroll") for (int k = 0; k < 2; ++k) \
        acc[ai][bj][m][n] = __builtin_amdgcn_mfma_f32_16x16x32_bf16(Bt[n][k], At[m][k], acc[ai][bj][m][n], 0, 0, 0); __builtin_amdgcn_s_setprio(0); } while (0)
#define PG8_WAIT_V(n) asm volatile("s_waitcnt vmcnt(" #n ")" ::: "memory")
#define PG8_WAIT_L(n) asm volatile("s_waitcnt lgkmcnt(" #n ")" ::: "memory")
#define PG8_BAR __builtin_amdgcn_s_barrier()
#define PG8_SCHED __builtin_amdgcn_sched_barrier(0)
    Unit cur, nxt; int ui = 0;
    if (!S.next(0, cur)) return;
    f32x4 acc[2][2][4][2];
#pragma unroll
    for (int a = 0; a < 2; ++a)
#pragma unroll
        for (int b = 0; b < 2; ++b)
#pragma unroll
            for (int m = 0; m < 4; ++m)
#pragma unroll
                for (int n = 0; n < 2; ++n) acc[a][b][m][n] = (f32x4){0.f, 0.f, 0.f, 0.f};
    bf16x8 At[4][2], B0[2][2], B1[2][2];
    const char* cA = (const char*)g.A + (size_t)cur.pm * tstep; const char* cB = (const char*)g.Bt + (size_t)cur.pn * tstep;
    S.a_ready(cur);
    PG8_STAGE(PG8_SB(0, 0), cB, voffB); PG8_STAGE(PG8_SA(0, 0), cA, voffA); PG8_STAGE(PG8_SB(0, 1), cB + hstep, voffB); PG8_STAGE(PG8_SA(0, 1), cA + hstep, voffA);
    if (wr == 1) PG8_BAR;
    PG8_WAIT_V(4); PG8_BAR;
    PG8_STAGE(PG8_SB(1, 0), cB + kstep, voffB); PG8_STAGE(PG8_SA(1, 0), cA + kstep, voffA); PG8_STAGE(PG8_SB(1, 1), cB + hstep + kstep, voffB);
    PG8_WAIT_V(6); PG8_BAR;
    PG8_STAMP();
    for (;;) {
        const bool has_next = S.next(ui + 1, nxt);
        const char* nA = has_next ? (const char*)g.A + (size_t)nxt.pm * tstep : cA; const char* nB = has_next ? (const char*)g.Bt + (size_t)nxt.pn * tstep : cB;
        for (int t = 0; t < nt; t += 2) {
            const bool last = (t == nt - 2);
            const char* a1 = cA + (size_t)(t + 1) * kstep;
            const char* a2 = last ? nA : cA + (size_t)(t + 2) * kstep; const char* b2 = last ? nB : cB + (size_t)(t + 2) * kstep;
            const char* a3 = a2 + kstep; const char* b3 = b2 + kstep;
            if (last && has_next) S.a_ready(nxt);
            PG8_LDB(B0, 0, 0); PG8_SCHED; PG8_LDA(At, 0, 0); PG8_STAGE(PG8_SA(1, 1), a1 + hstep, voffA);
            PG8_WAIT_L(8); PG8_BAR; PG8_WAIT_L(0); PG8_MMA(0, 0, At, B0); PG8_BAR; PG8_SCHED;
            PG8_LDB(B1, 0, 1); PG8_STAGE(PG8_SB(0, 0), b2, voffB);
            PG8_BAR; PG8_WAIT_L(0); PG8_MMA(0, 1, At, B1); PG8_BAR;
            PG8_LDA(At, 0, 1); PG8_STAGE(PG8_SA(0, 0), a2, voffA);
            PG8_BAR; PG8_WAIT_L(0); PG8_MMA(1, 0, At, B0); PG8_BAR; PG8_SCHED;
            PG8_STAGE(PG8_SB(0, 1), b2 + hstep, voffB);
            PG8_WAIT_V(6); PG8_BAR; PG8_MMA(1, 1, At, B1); PG8_BAR;
            PG8_LDB(B0, 1, 0); PG8_SCHED; PG8_LDA(At, 1, 0); PG8_STAGE(PG8_SA(0, 1), a2 + hstep, voffA);
            PG8_WAIT_L(8); PG8_BAR; PG8_WAIT_L(0); PG8_MMA(0, 0, At, B0); PG8_BAR; PG8_SCHED;
            PG8_LDB(B1, 1, 1); PG8_STAGE(PG8_SB(1, 0), b3, voffB);
            PG8_BAR; PG8_WAIT_L(0); PG8_MMA(0, 1, At, B1); PG8_BAR;
            PG8_LDA(At, 1, 1); PG8_STAGE(PG8_SA(1, 0), a3, voffA);
            PG8_BAR; PG8_WAIT_L(0); PG8_MMA(1, 0, At, B0); PG8_BAR; PG8_SCHED;
            PG8_STAGE(PG8_SB(1, 1), b3 + hstep, voffB);
            PG8_WAIT_V(6); PG8_BAR; PG8_MMA(1, 1, At, B1); PG8_BAR;
        }
        PG8_STAMP();
        if constexpr (!Epi::AFTER_DRAIN) {
            if constexpr (Epi::REALIGN) { if (wr == 0) PG8_BAR; }
            E(acc, cur, wr, wc, fr, fq); S.done(cur);
            if constexpr (Epi::REALIGN) { if (wr == 1) PG8_BAR; }
        }
        PG8_STAMP();
        if (!has_next) break;
#pragma unroll
        for (int a = 0; a < 2; ++a)
#pragma unroll
            for (int b = 0; b < 2; ++b)
#pragma unroll
                for (int m = 0; m < 4; ++m)
#pragma unroll
                    for (int n = 0; n < 2; ++n) acc[a][b][m][n] = (f32x4){0.f, 0.f, 0.f, 0.f};
        cur = nxt; cA = nA; cB = nB; ++ui;
    }
    PG8_WAIT_V(0);
    if (wr == 0) PG8_BAR;
    PG8_BAR;
    if constexpr (Epi::AFTER_DRAIN) { E.fused(acc, cur, wr, wc, fr, fq, lds, wid, lane); S.done(cur); }
    PG8_STAMP();
    if (STAMP && wid == 0) { stamps[lane] = lane < nts ? (((unsigned long long)(unsigned)ts_hi << 32) | (unsigned)ts_lo) : 0ull;
        if (lane == 62) stamps[62] = rt_entry; if (lane == 63) stamps[63] = (unsigned long long)wall_clock64(); }
#undef PG8_STAMP
#undef PG8_SA
#undef PG8_SB
#undef PG8_STAGE
#undef PG8_LDA
#undef PG8_LDB
#undef PG8_MMA
#undef PG8_WAIT_V
#undef PG8_WAIT_L
#undef PG8_BAR
#undef PG8_SCHED
}
}
#define LAS __attribute__((address_space(3)))
#define XB_TMO      128
#define XB_XCNT(j)  (256  + 64 * (j))
#define XB_XSUB(j)  (1280 + 64 * (j))
#define XB_XGEN(j)  (2304 + 64 * (j))
#define XB_TOP      3328
#define XB_TOPGEN   3392
#define XCD_BAR_WORDS 3456
#define XB_SPIN_CAP (1u << 18)

__device__ __forceinline__ unsigned xb_ld(unsigned* p)              { return __hip_atomic_load(p, __ATOMIC_RELAXED, __HIP_MEMORY_SCOPE_AGENT); }
__device__ __forceinline__ unsigned xb_add(unsigned* p, unsigned v) { return __hip_atomic_fetch_add(p, v, __ATOMIC_RELAXED, __HIP_MEMORY_SCOPE_AGENT); }
__device__ __forceinline__ unsigned xb_xcc_id() { return (unsigned)__builtin_amdgcn_s_getreg((3 << 11) | 20) & 0xFu; }
#define XB_SPIN(cond, bar) do { unsigned _sp = 0; while (cond) { __builtin_amdgcn_s_sleep(1); \
    if ((++_sp & 255u) == 0u) { if (xb_ld(&(bar)[XB_TMO])) break; if (_sp > XB_SPIN_CAP) { atomicAdd(&(bar)[XB_TMO], 1u); break; } } } } while (0)

struct XcdBarrier {
    unsigned* bar; unsigned x;
    volatile LAS unsigned* st;
};

__device__ __forceinline__ XcdBarrier xcd_barrier_post(unsigned* bar, volatile LAS unsigned* st) {
    XcdBarrier b; b.bar = bar; b.x = xb_xcc_id(); b.st = st;
    if (threadIdx.x == 0) (void)xb_add(&bar[XB_XCNT(b.x)], 1u);
    return b;
}
__device__ __forceinline__ void xcd_barrier_complete(unsigned* bar, unsigned x, unsigned& nloc, unsigned& nx) {
    const unsigned G = gridDim.x * gridDim.y * gridDim.z;
    unsigned sum, cnt, mine, sp = 0u;
    for (;;) {
        sum = 0u; cnt = 0u; mine = 0u;
#pragma unroll
        for (unsigned j = 0; j < 16; ++j) { const unsigned c = xb_ld(&bar[XB_XCNT(j)]); sum += c; cnt += (c > 0u) ? 1u : 0u; mine = (j == x) ? c : mine; }
        if (sum == G) break;
        __builtin_amdgcn_s_sleep(1);
        if ((++sp & 255u) == 0u) { if (xb_ld(&bar[XB_TMO])) break; if (sp > XB_SPIN_CAP) { atomicAdd(&bar[XB_TMO], 1u); break; } }
    }
    nloc = mine > 0u ? mine : 1u; nx = cnt > 0u ? cnt : 1u;
}

__device__ __forceinline__ void xcd_barrier(const XcdBarrier& b) {
    asm volatile("s_waitcnt vmcnt(0)" ::: "memory");
    __syncthreads();
    if (threadIdx.x == 0) {
        unsigned* bar = b.bar;
        __builtin_amdgcn_s_waitcnt(0);
        unsigned nloc = b.st[0], nx = b.st[1];
        if (nloc == 0u) { xcd_barrier_complete(bar, b.x, nloc, nx); b.st[0] = nloc; b.st[1] = nx; }
        const unsigned old = xb_add(&bar[XB_XSUB(b.x)], 1u);
        const unsigned gen = old / nloc;
        if (old + 1u == (gen + 1u) * nloc) {
            __builtin_amdgcn_fence(__ATOMIC_RELEASE, "agent");
            asm volatile("s_waitcnt vmcnt(0)" ::: "memory");
            const unsigned og = xb_add(&bar[XB_TOP], 1u);
            const unsigned tg = og / nx;
            if (og + 1u == (tg + 1u) * nx) xb_add(&bar[XB_TOPGEN], 1u);
            else XB_SPIN(xb_ld(&bar[XB_TOPGEN]) == tg, bar);
            __builtin_amdgcn_fence(__ATOMIC_ACQUIRE, "agent");
            xb_add(&bar[XB_XGEN(b.x)], 1u);
            asm volatile("s_waitcnt vmcnt(0)" ::: "memory");
        } else {
            XB_SPIN(xb_ld(&bar[XB_XGEN(b.x)]) == gen, bar);
            __builtin_amdgcn_fence(__ATOMIC_ACQUIRE, "agent");
            asm volatile("s_waitcnt vmcnt(0)" ::: "memory");
        }
    }
    __syncthreads();
}


#define DI __device__ __forceinline__

using pg8::bf16_t; using pg8::bf16x8; using pg8::f32x4; using pg8::f32x2; using pg8::u32x4; using pg8::Unit;
typedef unsigned u32x2 __attribute__((ext_vector_type(2)));
typedef short s16x4 __attribute__((ext_vector_type(4)));
typedef __bf16 bf2_t __attribute__((ext_vector_type(2)));

constexpr int NB = 8, T = 4096, D = 1024, NTOK = NB * T, CTXL = 256, NCTX = NB * CTXL, NP = 3072, NC = 32;
constexpr int NTHREADS = 512;
constexpr int LDS_BYTES = 147456 + 256;
constexpr float EPS = 1e-6f, LOG2E = 1.4426950408889634f;

constexpr size_t al256(size_t x) { return (x + 255) & ~(size_t)255; }
constexpr size_t WS_MOD  = 0;
constexpr size_t WS_ROPE = WS_MOD + al256(9 * 3072 * 4);
constexpr size_t WS_WIN  = WS_ROPE + 8192;
constexpr size_t WS_WOUT = WS_WIN + (size_t)3072 * 1024 * 2;
constexpr size_t WS_WSB  = WS_WOUT + (size_t)1024 * 1024 * 2;
constexpr size_t WS_H    = WS_WSB + (size_t)4 * 128 * 128 * 2;
constexpr size_t WS_Q    = WS_H + (size_t)(NTOK + NCTX) * 1024 * 2;
constexpr size_t WS_K    = WS_Q + (size_t)NTOK * 256 * 2;
constexpr size_t WS_V    = WS_K + (size_t)NTOK * 256 * 2;
constexpr size_t WS_GR   = WS_V + (size_t)NTOK * 512 * 2;
constexpr size_t WS_U    = WS_GR + (size_t)NTOK * 512 * 2;
constexpr size_t WS_VG   = WS_U + (size_t)NTOK * 512 * 2;
constexpr size_t WS_GM   = WS_VG + (size_t)NTOK * 512 * 2;
constexpr size_t WS_KC   = WS_GM + (size_t)NTOK * 512 * 2;
constexpr size_t WS_VC   = WS_KC + (size_t)NCTX * 256 * 2;
constexpr size_t WS_KV   = WS_VC + (size_t)NCTX * 512 * 2;
constexpr size_t WS_KVC  = WS_KV + (size_t)1024 * 2 * 8192 * 4;
constexpr size_t WS_ST   = WS_KVC + (size_t)64 * 2 * 8192 * 4;
constexpr size_t WS_BAR  = WS_ST + (size_t)1024 * 2 * 8192 * 2;
constexpr size_t WS_CNT  = WS_BAR + (size_t)XCD_BAR_WORDS * 4;
constexpr size_t WS_SLOT = WS_CNT + 32768;
constexpr size_t WS_END  = WS_SLOT + (size_t)NTOK * 16 * 4;

struct Args {
    const float* x; const float* c; const float* ctx; const float* c_ctx; const float* w_ada; const float* b_ada; const float* norm_w; const float* w_in;
    const float* dec_f; const float* dec_b; const float* gn_w; const float* ln_w; const float* w_s; const float* b_s; const float* w_out; const float* fnorm_w;
    float* out; unsigned char* ws; int ph_lo, ph_hi;
};

DI unsigned pk2(float lo, float hi) { f32x2 v = {lo, hi}; bf2_t r = __builtin_convertvector(v, bf2_t); return __builtin_bit_cast(unsigned, r); }
DI f32x4 ldnt_f4(const float* p) { return __builtin_nontemporal_load((const f32x4*)p); }
DI u32x4 ldnt_u4(const void* p) { return __builtin_nontemporal_load((const u32x4*)p); }
DI u32x2 ldnt_u2(const void* p) { return __builtin_nontemporal_load((const u32x2*)p); }
DI float bflo(unsigned w) { return __uint_as_float(w << 16); }
DI float bfhi(unsigned w) { return __uint_as_float(w & 0xffff0000u); }
DI float silu_f(float v) { return v * __builtin_amdgcn_rcpf(1.0f + __expf(-v)); }
DI void lds_barrier() { asm volatile("s_waitcnt lgkmcnt(0)" ::: "memory"); __builtin_amdgcn_s_barrier(); asm volatile("" ::: "memory"); }
DI f32x4 mfma16(bf16x8 a, bf16x8 b, f32x4 c) { return __builtin_amdgcn_mfma_f32_16x16x32_bf16(a, b, c, 0, 0, 0); }

DI bf16x8 frag_tr(LAS const unsigned char* base, int S, int k0, int n0, int lane) {
    const int i = lane & 15, g = lane >> 4;
    LAS const unsigned char* p = base + (k0 + 4 * g + (i >> 2)) * S + (n0 + 4 * (i & 3)) * 2;
    const s16x4 lo = __builtin_amdgcn_ds_read_tr16_b64_v4i16((LAS s16x4*)p);
    const s16x4 hi = __builtin_amdgcn_ds_read_tr16_b64_v4i16((LAS s16x4*)(p + 16 * S));
    return __builtin_shufflevector(lo, hi, 0, 1, 2, 3, 4, 5, 6, 7);
}
DI bf16x8 frag_rowP(const bf16_t* rowk0, int g) {
    const u32x2 lo = *(const u32x2*)(rowk0 + 4 * g), hi = *(const u32x2*)(rowk0 + 16 + 4 * g);
    const u32x4 v = {lo.x, lo.y, hi.x, hi.y}; return __builtin_bit_cast(bf16x8, v);
}
DI bf16x8 frag_rowP_lds(LAS const unsigned char* rowk0, int g) {
    const u32x2 lo = *(LAS const u32x2*)(rowk0 + 8 * g), hi = *(LAS const u32x2*)(rowk0 + 32 + 8 * g);
    const u32x4 v = {lo.x, lo.y, hi.x, hi.y}; return __builtin_bit_cast(bf16x8, v);
}
DI bf16x8 scale_frag(bf16x8 f, float s) {
    const u32x4 u = __builtin_bit_cast(u32x4, f); u32x4 r;
#pragma unroll
    for (int q = 0; q < 4; ++q) r[q] = pk2(bflo(u[q]) * s, bfhi(u[q]) * s);
    return __builtin_bit_cast(bf16x8, r);
}

struct EpiIn {
    static constexpr bool PERM = true, AFTER_DRAIN = false, REALIGN = false;
    unsigned char* ws;
    DI void operator()(const f32x4 (&acc)[2][2][4][2], const Unit& u, int wr, int wc, int fr, int fq) const {
        const int pn = u.pn, rbase = u.pm * 256 + wr * 64 + fr, cbase = wc * 32 + 8 * fq;
        if (u.pm >= 128) {
            bf16_t* dst = (bf16_t*)(ws + (pn == 1 ? WS_KC : WS_VC));
            const float scl = pn == 1 ? 0.125f : 1.0f;
#pragma unroll
            for (int ai = 0; ai < 2; ++ai)
#pragma unroll
                for (int m = 0; m < 4; ++m) {
                    const int rc = rbase + ai * 128 + m * 16 - NTOK, b = rc >> 8, t = rc & 255;
#pragma unroll
                    for (int bj = 0; bj < 2; ++bj) {
                        const f32x4 v0 = acc[ai][bj][m][0] * scl, v1 = acc[ai][bj][m][1] * scl;
                        const u32x4 o = {pk2(v0[0], v0[1]), pk2(v0[2], v0[3]), pk2(v1[0], v1[1]), pk2(v1[2], v1[3])};
                        size_t off;
                        if (pn == 1) { const int head = bj * 2 + (wc >> 1), d0 = (wc & 1) * 32 + 8 * fq; off = ((size_t)((b * 4 + head) * 256 + t)) * 64 + d0; }
                        else { const int head = (pn - 2) * 2 + bj; off = ((size_t)(((b * 4 + head) * 8 + (cbase >> 4)) * 256 + t)) * 16 + (cbase & 15); }
                        *(u32x4*)(dst + off) = o;
                    }
                }
            return;
        }
        if (pn <= 1) {
            bf16_t* dst = (bf16_t*)(ws + (pn == 0 ? WS_Q : WS_K));
            const float scl = pn == 0 ? 1.0f : 0.125f;
            const float* rc = (const float*)(ws + WS_ROPE); const float* rs = rc + 1024;
            const int hh = wc & 1, fi0 = 8 * (fq & 1); const bool second = fq >= 2;
#pragma unroll
            for (int ai = 0; ai < 2; ++ai)
#pragma unroll
                for (int m = 0; m < 4; ++m) {
                    const int r = rbase + ai * 128 + m * 16, b = r >> 12, t = r & 4095, pos = hh ? (t & 63) : (t >> 6);
                    const f32x4 c0 = *(const f32x4*)(rc + pos * 16 + fi0), c1 = *(const f32x4*)(rc + pos * 16 + fi0 + 4);
                    const f32x4 s0 = *(const f32x4*)(rs + pos * 16 + fi0), s1 = *(const f32x4*)(rs + pos * 16 + fi0 + 4);
#pragma unroll
                    for (int bj = 0; bj < 2; ++bj) {
                        const f32x4 v0 = acc[ai][bj][m][0], v1 = acc[ai][bj][m][1];
                        float o[8];
#pragma unroll
                        for (int j = 0; j < 4; ++j) {
                            const float xa = v0[j], xb = v1[j], pa = __shfl_xor(xa, 32), pb = __shfl_xor(xb, 32);
                            o[j]     = (second ? (pa * s0[j] + xa * c0[j]) : (xa * c0[j] - pa * s0[j])) * scl;
                            o[4 + j] = (second ? (pb * s1[j] + xb * c1[j]) : (xb * c1[j] - pb * s1[j])) * scl;
                        }
                        const u32x4 ov = {pk2(o[0], o[1]), pk2(o[2], o[3]), pk2(o[4], o[5]), pk2(o[6], o[7])};
                        const int head = bj * 2 + (wc >> 1), d0 = hh * 32 + 8 * fq;
                        *(u32x4*)(dst + ((size_t)((b * 4 + head) * 4096 + t)) * 64 + d0) = ov;
                    }
                }
            return;
        }
        if (pn <= 3) {
            bf16_t* dst = (bf16_t*)(ws + WS_V);
#pragma unroll
            for (int ai = 0; ai < 2; ++ai)
#pragma unroll
                for (int m = 0; m < 4; ++m) {
                    const int r = rbase + ai * 128 + m * 16, b = r >> 12, t = r & 4095;
#pragma unroll
                    for (int bj = 0; bj < 2; ++bj) {
                        const f32x4 v0 = acc[ai][bj][m][0], v1 = acc[ai][bj][m][1];
                        const u32x4 o = {pk2(v0[0], v0[1]), pk2(v0[2], v0[3]), pk2(v1[0], v1[1]), pk2(v1[2], v1[3])};
                        const int head = (pn - 2) * 2 + bj;
                        *(u32x4*)(dst + ((size_t)(((b * 4 + head) * 8 + (cbase >> 4)) * 4096 + t)) * 16 + (cbase & 15)) = o;
                    }
                }
            return;
        }
        if (pn == 6 || pn == 7 || pn >= 10) {
            const int t = pn == 6 ? 0 : (pn == 7 ? 1 : (pn == 10 ? 2 : 3));
            bf16_t* dst = (bf16_t*)(ws + WS_U);
#pragma unroll
            for (int ai = 0; ai < 2; ++ai)
#pragma unroll
                for (int m = 0; m < 4; ++m) {
                    const int r = rbase + ai * 128 + m * 16;
                    const f32x4 u0 = acc[ai][0][m][0], u1 = acc[ai][0][m][1], g0 = acc[ai][1][m][0], g1 = acc[ai][1][m][1];
                    const f32x2 a0 = pg8::gelu_pk((f32x2){u0[0], u0[1]}), a1 = pg8::gelu_pk((f32x2){u0[2], u0[3]}), a2 = pg8::gelu_pk((f32x2){u1[0], u1[1]}), a3 = pg8::gelu_pk((f32x2){u1[2], u1[3]});
                    const u32x4 o = {pk2(a0.x * silu_f(g0[0]), a0.y * silu_f(g0[1])), pk2(a1.x * silu_f(g0[2]), a1.y * silu_f(g0[3])),
                                     pk2(a2.x * silu_f(g1[0]), a2.y * silu_f(g1[1])), pk2(a3.x * silu_f(g1[2]), a3.y * silu_f(g1[3]))};
                    *(u32x4*)(dst + (size_t)r * 512 + 128 * t + cbase) = o;
                }
            return;
        }
        {
            const int region = (pn - 4) >> 1; const bool is_gelu = (region == 1) || (region == 2);
            bf16_t* dst = (bf16_t*)(ws + WS_GR + (size_t)region * ((size_t)NTOK * 512 * 2));
            const int colb = ((pn - 4) & 1) * 256 + cbase;
#pragma unroll
            for (int ai = 0; ai < 2; ++ai)
#pragma unroll
                for (int m = 0; m < 4; ++m) {
                    const int r = rbase + ai * 128 + m * 16;
#pragma unroll
                    for (int bj = 0; bj < 2; ++bj) {
                        const f32x4 v0 = acc[ai][bj][m][0], v1 = acc[ai][bj][m][1];
                        u32x4 o;
                        if (is_gelu) {
                            const f32x2 a = pg8::gelu_pk((f32x2){v0[0], v0[1]}), bq = pg8::gelu_pk((f32x2){v0[2], v0[3]}), cq = pg8::gelu_pk((f32x2){v1[0], v1[1]}), dq = pg8::gelu_pk((f32x2){v1[2], v1[3]});
                            o = (u32x4){pk2(a.x, a.y), pk2(bq.x, bq.y), pk2(cq.x, cq.y), pk2(dq.x, dq.y)};
                        } else {
                            o = (u32x4){pk2(silu_f(v0[0]), silu_f(v0[1])), pk2(silu_f(v0[2]), silu_f(v0[3])), pk2(silu_f(v1[0]), silu_f(v1[1])), pk2(silu_f(v1[2]), silu_f(v1[3]))};
                        }
                        *(u32x4*)(dst + (size_t)r * 512 + colb + bj * 128) = o;
                    }
                }
        }
    }
};
struct EpiOut {
    static constexpr bool PERM = false, AFTER_DRAIN = false, REALIGN = true;
    const float* x; const float* mod; const float* fw; float* out; float* slots; unsigned* cnt;
    DI void operator()(const f32x4 (&acc_)[2][2][4][2], const Unit& u, int wr, int wc, int fr, int fq) const {
        f32x4 (&acc)[2][2][4][2] = const_cast<f32x4 (&)[2][2][4][2]>(acc_);
        const int rbase = u.pm * 256 + wr * 64 + fr, cbase = u.pn * 256 + wc * 32 + 4 * fq;
        const float* gate = mod + (size_t)(rbase >> 12) * 3072 + 2048;
        f32x4 gv[2][2];
#pragma unroll
        for (int bj = 0; bj < 2; ++bj)
#pragma unroll
            for (int n = 0; n < 2; ++n) gv[bj][n] = *(const f32x4*)(gate + cbase + bj * 128 + n * 16);
        f32x4 xv[2][4]; float ss[8];
#pragma unroll
        for (int q = 0; q < 4; ++q) xv[0][q] = ldnt_f4(x + (size_t)rbase * 1024 + cbase + (q >> 1) * 128 + (q & 1) * 16);
#pragma unroll
        for (int k = 0; k < 8; ++k) {
            const int ai = k >> 2, m = k & 3;
            if (k + 1 < 8) {
                const size_t ro = (size_t)(rbase + ((k + 1) >> 2) * 128 + ((k + 1) & 3) * 16) * 1024 + cbase;
#pragma unroll
                for (int q = 0; q < 4; ++q) xv[(k + 1) & 1][q] = ldnt_f4(x + ro + (q >> 1) * 128 + (q & 1) * 16);
            }
            float sk = 0.f;
#pragma unroll
            for (int q = 0; q < 4; ++q) {
                const int bj = q >> 1, n = q & 1;
                const f32x4 v = xv[k & 1][q] + gv[bj][n] * acc[ai][bj][m][n];
                acc[ai][bj][m][n] = v;
                sk += v[0] * v[0] + v[1] * v[1] + v[2] * v[2] + v[3] * v[3];
            }
            ss[k] = sk;
        }
#pragma unroll
        for (int k = 0; k < 8; ++k) { ss[k] += __shfl_xor(ss[k], 16); ss[k] += __shfl_xor(ss[k], 32); }
        if (fq == 0) {
#pragma unroll
            for (int k = 0; k < 8; ++k)
                __hip_atomic_store(slots + (size_t)(rbase + (k >> 2) * 128 + (k & 3) * 16) * 16 + u.pn * 4 + wc, ss[k], __ATOMIC_RELAXED, __HIP_MEMORY_SCOPE_AGENT);
        }
        asm volatile("s_waitcnt vmcnt(0)" ::: "memory");
        __builtin_amdgcn_s_barrier();
        if (threadIdx.x == 0) {
            __hip_atomic_fetch_add(cnt + u.pm * 64, 1u, __ATOMIC_RELAXED, __HIP_MEMORY_SCOPE_AGENT);
            unsigned spins = 0;
            while (__hip_atomic_load(cnt + u.pm * 64, __ATOMIC_RELAXED, __HIP_MEMORY_SCOPE_AGENT) < 4u) { __builtin_amdgcn_s_sleep(4); if (++spins > (1u << 23)) break; }
            __builtin_amdgcn_fence(__ATOMIC_ACQUIRE, "agent");
            asm volatile("s_waitcnt vmcnt(0)" ::: "memory");
        }
        __builtin_amdgcn_s_barrier();
        asm volatile("" ::: "memory");
        f32x4 sl[8];
#pragma unroll
        for (int k = 0; k < 8; ++k) sl[k] = *(const f32x4*)(slots + (size_t)(rbase + (k >> 2) * 128 + (k & 3) * 16) * 16 + fq * 4);
        f32x4 fv[2][2];
#pragma unroll
        for (int bj = 0; bj < 2; ++bj)
#pragma unroll
            for (int n = 0; n < 2; ++n) fv[bj][n] = *(const f32x4*)(fw + cbase + bj * 128 + n * 16);
        float rs[8];
#pragma unroll
        for (int k = 0; k < 8; ++k) {
            float t = (sl[k][0] + sl[k][1]) + (sl[k][2] + sl[k][3]);
            t += __shfl_xor(t, 16); t += __shfl_xor(t, 32);
            rs[k] = rsqrtf(t * (1.0f / 1024.0f) + EPS);
        }
#pragma unroll
        for (int k = 0; k < 8; ++k) {
            const int ai = k >> 2, m = k & 3;
            const size_t ro = (size_t)(rbase + ai * 128 + m * 16) * 1024 + cbase;
#pragma unroll
            for (int bj = 0; bj < 2; ++bj)
#pragma unroll
                for (int n = 0; n < 2; ++n) __builtin_nontemporal_store(acc[ai][bj][m][n] * rs[k] * fv[bj][n], (f32x4*)(out + ro + bj * 128 + n * 16));
        }
    }
};
struct SchedIn {
    pg8::StaticOrder so;
    DI bool next(int i, Unit& u) const {
        if (so.G == 256) {
            const int x = so.c & 7, j = so.c >> 3;
            if (j < 3) {
                if (i == 0) { u.pm = 128 + x; u.pn = 1 + j; return true; }
                if (i > 6) return false;
                const int q = 6 * j + (i - 1);
                u.pm = 16 * x + (q >> 2); u.pn = q & 3; return true;
            }
            if (i > 5) return false;
            const int e = (j - 3) + 29 * i;
            if (e < 64) { u.pm = 16 * x + (e >> 2); u.pn = 6 + (e & 3); }
            else if (e < 128) { const int t = e & 3; u.pm = 16 * x + ((e - 64) >> 2); u.pn = t < 2 ? 10 + t : 2 + t; }
            else { const int q = 18 + (e - 128); u.pm = 16 * x + (q >> 2); u.pn = q & 3; }
            return true;
        }
        long L = (long)i * so.G + so.c;
        if (L < so.nwg) return so.next(i, u);
        L -= so.nwg; if (L >= 24) return false;
        u.pm = 128 + (int)(L / 3); u.pn = 1 + (int)(L % 3); return true;
    }
    DI void a_ready(const Unit&) const {}
    DI void done(const Unit&) const {}
};

DI void phase0(const Args& a, LAS unsigned char* lds) {
    const int tid = threadIdx.x;
    float* mod = (float*)(a.ws + WS_MOD);
    LAS float* red = (LAS float*)lds;
    for (int it = blockIdx.x; it < 1233; it += gridDim.x) {
        if (it < 192) {
            const int c0 = it * 16, f = tid & 3, rg = tid >> 2;
            LAS float* scv = red + 36 * 512;
            for (int q = tid; q < 9 * 1024; q += NTHREADS) { const float cv = (q < 8192) ? a.c[q] : a.c_ctx[q - 8192]; scv[q] = cv / (1.0f + expf(-cv)); }
            __syncthreads();
            float acc[9][4];
#pragma unroll
            for (int j = 0; j < 9; ++j)
#pragma unroll
                for (int e = 0; e < 4; ++e) acc[j][e] = 0.f;
            f32x4 wv[8];
#pragma unroll
            for (int i = 0; i < 8; ++i) wv[i] = ldnt_f4(a.w_ada + (size_t)(rg + 128 * i) * 3072 + c0 + f * 4);
#pragma unroll
            for (int i = 0; i < 8; ++i) {
                const int r = rg + 128 * i;
#pragma unroll
                for (int j = 0; j < 9; ++j) {
                    const float sv = scv[j * 1024 + r];
#pragma unroll
                    for (int e = 0; e < 4; ++e) acc[j][e] += sv * wv[i][e];
                }
            }
#pragma unroll
            for (int j = 0; j < 9; ++j)
#pragma unroll
                for (int e = 0; e < 4; ++e) red[(j * 4 + e) * 512 + tid] = acc[j][e];
            __syncthreads();
            if (tid < 144) {
                const int j = tid >> 4, cc = tid & 15, ff = cc >> 2, e = cc & 3;
                float s = 0.f;
                for (int q = 0; q < 128; ++q) s += red[(j * 4 + e) * 512 + q * 4 + ff];
                mod[j * 3072 + c0 + cc] = s + a.b_ada[c0 + cc];
            }
            __syncthreads();
        } else if (it < 1216) {
            const bool is_in = it < 960; const int tt = is_in ? it - 192 : it - 960;
            const int nN = is_in ? 48 : 16, NN = is_in ? 3072 : 1024;
            const int k0 = (tt / nN) * 64, n0 = (tt % nN) * 64;
            int ns = n0;
            if (is_in && ((n0 >= 1536 && n0 < 2048) || n0 >= 2560)) {
                const int base = n0 >= 2560 ? 2560 : 1536, t = (n0 >= 2560 ? 2 : 0) + (n0 - base) / 256, w = (n0 - base) % 256;
                ns = (w < 128 ? 1536 : 2560 - 128) + 128 * t + w;
            }
            const float* src = is_in ? a.w_in : a.w_out;
            bf16_t* dst = (bf16_t*)(a.ws + (is_in ? WS_WIN : WS_WOUT));
            const int kr = tid >> 4, n4 = tid & 15;
#pragma unroll
            for (int p = 0; p < 2; ++p) {
                const int k = kr + 32 * p;
                const f32x4 v = ldnt_f4(src + (size_t)(k0 + k) * NN + ns + n4 * 4);
#pragma unroll
                for (int e = 0; e < 4; ++e) red[k * 65 + n4 * 4 + e] = v[e];
            }
            __syncthreads();
            const int n = tid >> 3, k8 = tid & 7;
            float v[8];
#pragma unroll
            for (int j = 0; j < 8; ++j) v[j] = red[(k8 * 8 + j) * 65 + n];
            const u32x4 o = {pk2(v[0], v[1]), pk2(v[2], v[3]), pk2(v[4], v[5]), pk2(v[6], v[7])};
            *(u32x4*)(dst + (size_t)(n0 + n) * 1024 + k0 + k8 * 8) = o;
            __syncthreads();
        } else if (it < 1232) {
            const size_t base = (size_t)(it - 1216) * 4096 + tid * 8;
            const f32x4 v0 = *(const f32x4*)(a.w_s + base), v1 = *(const f32x4*)(a.w_s + base + 4);
            const u32x4 o = {pk2(v0[0], v0[1]), pk2(v0[2], v0[3]), pk2(v1[0], v1[1]), pk2(v1[2], v1[3])};
            *(u32x4*)((bf16_t*)(a.ws + WS_WSB) + base) = o;
        } else {
            float* rc = (float*)(a.ws + WS_ROPE); float* rs = rc + 1024;
            for (int idx = tid; idx < 1024; idx += NTHREADS) {
                const int pos = idx >> 4, fi = idx & 15;
                const float inv = powf(10000.0f, -(float)fi / 16.0f), ang = (float)pos * inv;
                rc[idx] = cosf(ang); rs[idx] = sinf(ang);
            }
        }
    }
}

template <int R> DI void norm_rows(const Args& a, const float* mod, bf16_t* H, const int (&rows)[R], int lane) {
    f32x4 v[R][4]; const float* mrow[R];
#pragma unroll
    for (int k = 0; k < R; ++k) {
        const int r = rows[k]; const float* src; int j;
        if (r < NTOK) { src = a.x + (size_t)r * 1024; j = r >> 12; } else { src = a.ctx + (size_t)(r - NTOK) * 1024; j = 8; }
        mrow[k] = mod + j * 3072;
#pragma unroll
        for (int q = 0; q < 4; ++q) v[k][q] = ldnt_f4(src + q * 256 + lane * 4);
    }
#pragma unroll
    for (int k = 0; k < R; ++k) {
        float ss = 0.f;
#pragma unroll
        for (int q = 0; q < 4; ++q) ss += v[k][q][0] * v[k][q][0] + v[k][q][1] * v[k][q][1] + v[k][q][2] * v[k][q][2] + v[k][q][3] * v[k][q][3];
#pragma unroll
        for (int off = 32; off >= 1; off >>= 1) ss += __shfl_xor(ss, off);
        const float rstd = rsqrtf(ss * (1.0f / 1024.0f) + EPS);
#pragma unroll
        for (int q = 0; q < 4; ++q) {
            const int cidx = q * 256 + lane * 4;
            const f32x4 nw = *(const f32x4*)(a.norm_w + cidx), sc = *(const f32x4*)(mrow[k] + 1024 + cidx), sh = *(const f32x4*)(mrow[k] + cidx);
            f32x4 hv;
#pragma unroll
            for (int e = 0; e < 4; ++e) hv[e] = (v[k][q][e] * rstd * nw[e]) * (1.0f + sc[e]) + sh[e];
            const u32x2 o = {pk2(hv[0], hv[1]), pk2(hv[2], hv[3])};
            *(u32x2*)(H + (size_t)rows[k] * 1024 + cidx) = o;
        }
    }
}
DI void norm_row(const Args& a, const float* mod, bf16_t* H, int r, int lane) { const int rows[1] = {r}; norm_rows<1>(a, mod, H, rows, lane); }
DI void phase1(const Args& a) {
    const int tid = threadIdx.x, wave = tid >> 6, lane = tid & 63, blk = blockIdx.x, G = gridDim.x;
    const float* mod = (const float*)(a.ws + WS_MOD);
    bf16_t* H = (bf16_t*)(a.ws + WS_H);
    constexpr int NCH = (NTOK + NCTX) / 8;
    int ch = blk;
    for (; ch + 3 * G < NCH; ch += 4 * G) { const int rows[4] = {ch * 8 + wave, (ch + G) * 8 + wave, (ch + 2 * G) * 8 + wave, (ch + 3 * G) * 8 + wave}; norm_rows<4>(a, mod, H, rows, lane); }
    for (; ch < NCH; ch += G) norm_row(a, mod, H, ch * 8 + wave, lane);
}

constexpr int VS = 288, KS = 144, KS2 = 160;
DI void gmlp_unit(const Args& a, LAS unsigned char* lds, int b, int c) {
    const int tid = threadIdx.x, lane = tid & 63, w = tid >> 6, i = lane & 15, g = lane >> 4;
    const int r0 = b * 4096 + c * 128;
    const bf16_t* VG = (const bf16_t*)(a.ws + WS_VG); const bf16_t* U = (const bf16_t*)(a.ws + WS_U);
    const bf16_t* WSB = (const bf16_t*)(a.ws + WS_WSB); bf16_t* Y = (bf16_t*)(a.ws + WS_H);
    constexpr int GSZ = 128 * VS;
    {
        const int row = tid >> 2, q = tid & 3;
        const bf16_t* src = VG + (size_t)(r0 + row) * 512 + q * 8;
        float s = 0.f, s2 = 0.f;
#pragma unroll 8
        for (int p = 0; p < 16; ++p) {
            const u32x4 pc = *(const u32x4*)(src + p * 32);
#pragma unroll
            for (int e = 0; e < 4; ++e) { const float lo = bflo(pc[e]), hi = bfhi(pc[e]); s += lo + hi; s2 += lo * lo + hi * hi; }
        }
        s += __shfl_xor(s, 1); s += __shfl_xor(s, 2); s2 += __shfl_xor(s2, 1); s2 += __shfl_xor(s2, 2);
        const float mean = s * (1.0f / 512.0f);
        const float var = fmaxf(s2 * (1.0f / 512.0f) - mean * mean, 0.f);
        const float rstd = rsqrtf(var + EPS);
        const float* lw = a.ln_w + q * 8;
#pragma unroll 4
        for (int p = 0; p < 16; ++p) {
            const u32x4 pc = *(const u32x4*)(src + p * 32);
            const f32x4 w0 = *(const f32x4*)(lw + p * 32), w1 = *(const f32x4*)(lw + p * 32 + 4);
            u32x4 o;
            o[0] = pk2((bflo(pc[0]) - mean) * rstd * w0[0], (bfhi(pc[0]) - mean) * rstd * w0[1]);
            o[1] = pk2((bflo(pc[1]) - mean) * rstd * w0[2], (bfhi(pc[1]) - mean) * rstd * w0[3]);
            o[2] = pk2((bflo(pc[2]) - mean) * rstd * w1[0], (bfhi(pc[2]) - mean) * rstd * w1[1]);
            o[3] = pk2((bflo(pc[3]) - mean) * rstd * w1[2], (bfhi(pc[3]) - mean) * rstd * w1[3]);
            *(LAS u32x4*)(lds + (p >> 2) * GSZ + row * VS + ((p & 3) * 4 + q) * 16) = o;
        }
    }
    __syncthreads();
    const int n = 16 * w + i, r = r0 + n;
#pragma unroll 1
    for (int gq = 0; gq < 4; ++gq) {
        f32x4 acc[8];
#pragma unroll
        for (int et = 0; et < 8; ++et) acc[et] = (f32x4){0.f, 0.f, 0.f, 0.f};
        const bf16_t* wrow = WSB + (size_t)(gq * 128 + n) * 128;
        bf16x8 bw[4];
#pragma unroll
        for (int s = 0; s < 4; ++s) bw[s] = frag_rowP(wrow + 32 * s, g);
#pragma unroll
        for (int s = 0; s < 4; ++s) {
#pragma unroll
            for (int et = 0; et < 8; ++et) acc[et] = mfma16(frag_tr(lds + gq * GSZ, VS, 32 * s, 16 * et, lane), bw[s], acc[et]);
        }
        const float bias = a.b_s[gq * 128 + n];
#pragma unroll
        for (int et = 0; et < 8; et += 2) {
            const int colw = gq * 128 + 16 * (et + (g & 1)) + 8 * (g >> 1);
            const u32x4 uw = *(const u32x4*)(U + (size_t)r * 512 + colw);
            const u32x2 ux = __builtin_amdgcn_permlane16_swap(uw[0], uw[2], false, false), uy = __builtin_amdgcn_permlane16_swap(uw[1], uw[3], false, false);
            const u32x2 ua = {ux[0], uy[0]}, ub = {ux[1], uy[1]};
            const u32x2 oa = {pk2(bflo(ua.x) * (acc[et][0] + bias), bfhi(ua.x) * (acc[et][1] + bias)), pk2(bflo(ua.y) * (acc[et][2] + bias), bfhi(ua.y) * (acc[et][3] + bias))};
            const u32x2 ob = {pk2(bflo(ub.x) * (acc[et + 1][0] + bias), bfhi(ub.x) * (acc[et + 1][1] + bias)), pk2(bflo(ub.y) * (acc[et + 1][2] + bias), bfhi(ub.y) * (acc[et + 1][3] + bias))};
            const u32x2 wx = __builtin_amdgcn_permlane16_swap(oa.x, ob.x, false, false), wy = __builtin_amdgcn_permlane16_swap(oa.y, ob.y, false, false);
            const u32x4 ow = {wx[0], wy[0], wx[1], wy[1]};
            __builtin_nontemporal_store(ow, (u32x4*)(Y + (size_t)r * 1024 + 512 + colw));
        }
    }
    __syncthreads();
}
struct ChStage { u32x4 kf[2], kb[2], v; };
DI void chain_load(const Args& a, int bh, int es, int it, ChStage& st) {
    const int tid = threadIdx.x;
    const bf16_t *Kf, *Kb, *Vf, *Vb;
    if (it < 2) {
        const size_t of = (size_t)bh * 256 + it * 128, ob = (size_t)bh * 256 + (1 - it) * 128;
        Kf = (const bf16_t*)(a.ws + WS_KC) + of * 64; Kb = (const bf16_t*)(a.ws + WS_KC) + ob * 64;
        Vf = (const bf16_t*)(a.ws + WS_VC) + (((size_t)bh * 8 + es) * 256 + it * 128) * 16; Vb = (const bf16_t*)(a.ws + WS_VC) + (((size_t)bh * 8 + es) * 256 + (1 - it) * 128) * 16;
    } else {
        const size_t of = (size_t)bh * 4096 + (it - 2) * 128, ob = (size_t)bh * 4096 + (33 - it) * 128;
        Kf = (const bf16_t*)(a.ws + WS_K) + of * 64; Kb = (const bf16_t*)(a.ws + WS_K) + ob * 64;
        Vf = (const bf16_t*)(a.ws + WS_V) + (((size_t)bh * 8 + es) * 4096 + (it - 2) * 128) * 16; Vb = (const bf16_t*)(a.ws + WS_V) + (((size_t)bh * 8 + es) * 4096 + (33 - it) * 128) * 16;
    }
#pragma unroll
    for (int q = 0; q < 2; ++q) { const int p = tid + 512 * q; st.kf[q] = *(const u32x4*)(Kf + (p >> 3) * 64 + (p & 7) * 8); st.kb[q] = *(const u32x4*)(Kb + (p >> 3) * 64 + (p & 7) * 8); }
    const int t = tid & 255; const bf16_t* Vx = (tid < 256) ? Vf : Vb;
    st.v = *(const u32x4*)(Vx + t * 8);
}
DI void chain_item(const Args& a, LAS unsigned char* lds, int item) {
    const int tid = threadIdx.x, lane = tid & 63, w = tid >> 6, i = lane & 15, g = lane >> 4;
    const int bh = item >> 3, es = item & 7, h = bh & 3, dirw = w >> 2, dt = w & 3;
    const float l2f = -expf(a.dec_f[h]) * LOG2E, l2b = -expf(a.dec_b[h]) * LOG2E;
    const float G = exp2f(128.0f * (dirw ? l2b : l2f));
    constexpr int BUFSZ = 2 * 128 * KS2 + 2 * 128 * 32;
    const float tv = (tid < 256) ? exp2f((float)(127 - ((tid & 255) >> 1)) * l2f) : exp2f((float)((tid & 255) >> 1) * l2b);
    bf16_t* ST = (bf16_t*)(a.ws + WS_ST);
    f32x4 S = {0.f, 0.f, 0.f, 0.f};
    ChStage st0, st1, st2, st3;
    chain_load(a, bh, es, 0, st0); chain_load(a, bh, es, 1, st1); chain_load(a, bh, es, 2, st2);
#define CH_STEP(IT, CUR, NXT, STORE) do { const int it = (IT); { \
        LAS unsigned char* buf = lds + (it & 1) * BUFSZ; \
        LAS unsigned char* KFs = buf; LAS unsigned char* KBs = buf + 128 * KS2; LAS unsigned char* VFs = buf + 2 * 128 * KS2; LAS unsigned char* VBs = VFs + 128 * 32; \
        _Pragma("unroll") for (int q = 0; q < 2; ++q) { \
            const int p = tid + 512 * q, m = p >> 3, d8 = p & 7; \
            *(LAS u32x4*)(KFs + m * KS2 + d8 * 16) = CUR.kf[q]; *(LAS u32x4*)(KBs + m * KS2 + d8 * 16) = CUR.kb[q]; \
        } \
        { const int t = tid & 255; u32x4 sv; _Pragma("unroll") for (int e = 0; e < 4; ++e) sv[e] = pk2(bflo(CUR.v[e]) * tv, bfhi(CUR.v[e]) * tv); \
          *(LAS u32x4*)((tid < 256 ? VFs : VBs) + (t >> 1) * 32 + (t & 1) * 16) = sv; } \
        lds_barrier(); \
        chain_load(a, bh, es, (it + 3 < 34) ? it + 3 : 33, NXT);                  \
        LAS const unsigned char* Kx = dirw ? KBs : KFs; LAS const unsigned char* Vx = dirw ? VBs : VFs; \
        f32x4 kv = {0.f, 0.f, 0.f, 0.f}; \
        _Pragma("unroll") for (int s = 0; s < 4; ++s) kv = mfma16(frag_tr(Vx, 32, 32 * s, 0, lane), frag_tr(Kx, KS2, 32 * s, 16 * dt, lane), kv); \
        if (STORE) {                                                              \
            const int c = dirw ? 33 - it : it - 2; \
            const u32x2 o = {pk2(S[0], S[1]), pk2(S[2], S[3])}; \
            *(u32x2*)(ST + (((size_t)(bh * 32 + c) * 2 + dirw) * 64 + 16 * dt + i) * 128 + es * 16 + 4 * g) = o; \
        } \
        S = S * G + kv; } } while (0)
    CH_STEP(0, st0, st3, false); CH_STEP(1, st1, st0, false);
#pragma unroll 1
    for (int it4 = 2; it4 < 34; it4 += 4) {
        CH_STEP(it4, st2, st1, true); CH_STEP(it4 + 1, st3, st2, true); CH_STEP(it4 + 2, st0, st3, true); CH_STEP(it4 + 3, st1, st0, true);
    }
#undef CH_STEP
    __syncthreads();
}
DI void phase3(const Args& a, LAS unsigned char* lds) {
    for (int it = blockIdx.x; it < 256; it += gridDim.x) gmlp_unit(a, lds, it >> 5, it & 31);
    for (int it = blockIdx.x; it < 256; it += gridDim.x) { const int j = it >> 3; chain_item(a, lds, (((it & 7) * 4 + (j >> 3)) << 3) + (j & 7)); }
}

DI void phase4(const Args& a) {
    const float* KV = (const float*)(a.ws + WS_KV); const float* KVC = (const float*)(a.ws + WS_KVC);
    bf16_t* ST = (bf16_t*)(a.ws + WS_ST);
    for (int idx = blockIdx.x * NTHREADS + threadIdx.x; idx < 64 * 2048; idx += gridDim.x * NTHREADS) {
        const int chain = idx >> 11, pos = idx & 2047, bh = chain >> 1, dir = chain & 1, h = bh & 3;
        const float lg = -expf(dir ? a.dec_b[h] : a.dec_f[h]), G = expf(128.0f * lg);
        const f32x4 k0 = *(const f32x4*)(KVC + ((size_t)(bh * 2 + 0) * 2 + dir) * 8192 + pos * 4);
        const f32x4 k1 = *(const f32x4*)(KVC + ((size_t)(bh * 2 + 1) * 2 + dir) * 8192 + pos * 4);
        f32x4 S = dir ? (k1 * G + k0) : (k0 * G + k1);
#pragma unroll 8
        for (int step = 0; step < NC; ++step) {
            const int c = dir ? (NC - 1 - step) : step;
            const size_t off = ((size_t)(bh * 32 + c) * 2 + dir) * 8192 + pos * 4;
            const f32x4 kvv = *(const f32x4*)(KV + off);
            const u32x2 o = {pk2(S[0], S[1]), pk2(S[2], S[3])};
            *(u32x2*)(ST + off) = o;
            S = S * G + kvv;
        }
    }
}

struct RetStage { u32x4 k[2], v[4], sf[2], sb[2]; bf16x8 q[2]; };
DI void ret_load(const Args& a, int unit, RetStage& st) {
    const int tid = threadIdx.x, lane = tid & 63, w = tid >> 6, i = lane & 15, g = lane >> 4;
    const int bh = unit >> 5, c = unit & 31;
    const bf16_t* Qp = (const bf16_t*)(a.ws + WS_Q) + ((size_t)bh * 4096 + c * 128) * 64;
    const bf16_t* Kp = (const bf16_t*)(a.ws + WS_K) + ((size_t)bh * 4096 + c * 128) * 64;
    const bf16_t* Vp = (const bf16_t*)(a.ws + WS_V) + ((size_t)bh * 8 * 4096 + c * 128) * 16;
    const bf16_t* SFp = (const bf16_t*)(a.ws + WS_ST) + (size_t)unit * 16384; const bf16_t* SBp = SFp + 8192;
#pragma unroll
    for (int q = 0; q < 2; ++q) { const int p = tid + 512 * q; st.k[q] = *(const u32x4*)(Kp + (p >> 3) * 64 + (p & 7) * 8); }
#pragma unroll
    for (int q = 0; q < 4; ++q) { const int p = tid + 512 * q; st.v[q] = *(const u32x4*)(Vp + (size_t)(p >> 8) * (4096 * 16) + (p & 255) * 8); }
#pragma unroll
    for (int q = 0; q < 2; ++q) { const int p = tid + 512 * q; st.sf[q] = *(const u32x4*)(SFp + (p >> 4) * 128 + (p & 15) * 8); st.sb[q] = *(const u32x4*)(SBp + (p >> 4) * 128 + (p & 15) * 8); }
#pragma unroll
    for (int s = 0; s < 2; ++s) st.q[s] = frag_rowP(Qp + (16 * w + i) * 64 + 32 * s, g);
}
DI void ret_unit(const Args& a, LAS unsigned char* lds, int unit, RetStage& st, int next_unit) {
    const int tid = threadIdx.x, lane = tid & 63, w = tid >> 6, i = lane & 15, g = lane >> 4;
    const int bh = unit >> 5, c = unit & 31, b = bh >> 2, h = bh & 3;
    const bf16_t* GR = (const bf16_t*)(a.ws + WS_GR); bf16_t* Y = (bf16_t*)(a.ws + WS_H);
    LAS unsigned char* Kt = lds; LAS unsigned char* Vt = lds + 128 * KS; LAS unsigned char* SF = Vt + 128 * VS; LAS unsigned char* SB = SF + 64 * VS;
#pragma unroll
    for (int q = 0; q < 2; ++q) { const int p = tid + 512 * q; *(LAS u32x4*)(Kt + (p >> 3) * KS + (p & 7) * 16) = st.k[q]; }
#pragma unroll
    for (int q = 0; q < 4; ++q) { const int p = tid + 512 * q; *(LAS u32x4*)(Vt + ((p & 255) >> 1) * VS + (p >> 8) * 32 + (p & 1) * 16) = st.v[q]; }
#pragma unroll
    for (int q = 0; q < 2; ++q) { const int p = tid + 512 * q; *(LAS u32x4*)(SF + (p >> 4) * VS + (p & 15) * 16) = st.sf[q]; *(LAS u32x4*)(SB + (p >> 4) * VS + (p & 15) * 16) = st.sb[q]; }
    bf16x8 Qf[2];
#pragma unroll
    for (int s = 0; s < 2; ++s) Qf[s] = st.q[s];
    lds_barrier();
    if (next_unit >= 0) ret_load(a, next_unit, st);
    const float l2f = -expf(a.dec_f[h]) * LOG2E, l2b = -expf(a.dec_b[h]) * LOG2E;
    const int n = 16 * w + i;

    f32x4 accS[8];
#pragma unroll
    for (int mt = 0; mt < 8; ++mt) {
        accS[mt] = (f32x4){0.f, 0.f, 0.f, 0.f};
#pragma unroll
        for (int s = 0; s < 2; ++s) accS[mt] = mfma16(frag_rowP_lds(Kt + (16 * mt + i) * KS + 64 * s, g), Qf[s], accS[mt]);
    }
#pragma unroll
    for (int mt = 0; mt < 8; ++mt)
#pragma unroll
        for (int reg = 0; reg < 4; ++reg) {
            const int diff = n - (16 * mt + 4 * g + reg);
            const float ex = __builtin_amdgcn_exp2f(diff > 0 ? (float)diff * l2f : (float)(-diff) * l2b);
            accS[mt][reg] *= (diff == 0 ? 2.0f : ex);
        }
    const float fsf = __builtin_amdgcn_exp2f((float)(n + 1) * l2f), fsb = __builtin_amdgcn_exp2f((float)(128 - n) * l2b);
    f32x4 accO[8];
#pragma unroll
    for (int et = 0; et < 8; ++et) accO[et] = (f32x4){0.f, 0.f, 0.f, 0.f};
#pragma unroll
    for (int s = 0; s < 4; ++s) {
        const u32x4 pu = {pk2(accS[2 * s][0], accS[2 * s][1]), pk2(accS[2 * s][2], accS[2 * s][3]), pk2(accS[2 * s + 1][0], accS[2 * s + 1][1]), pk2(accS[2 * s + 1][2], accS[2 * s + 1][3])};
        const bf16x8 Pf = __builtin_bit_cast(bf16x8, pu);
#pragma unroll
        for (int et = 0; et < 8; ++et) accO[et] = mfma16(frag_tr(Vt, VS, 32 * s, 16 * et, lane), Pf, accO[et]);
        __builtin_amdgcn_sched_barrier(0);
    }
#pragma unroll
    for (int s = 0; s < 2; ++s) {
        const bf16x8 qsf = scale_frag(Qf[s], fsf), qsb = scale_frag(Qf[s], fsb);
#pragma unroll
        for (int et = 0; et < 8; ++et) {
            accO[et] = mfma16(frag_tr(SF, VS, 32 * s, 16 * et, lane), qsf, accO[et]);
            accO[et] = mfma16(frag_tr(SB, VS, 32 * s, 16 * et, lane), qsb, accO[et]);
        }
        __builtin_amdgcn_sched_barrier(0);
    }
    float sm = 0.f;
#pragma unroll
    for (int et = 0; et < 8; ++et) sm += accO[et][0] + accO[et][1] + accO[et][2] + accO[et][3];
    sm += __shfl_xor(sm, 16); sm += __shfl_xor(sm, 32);
    const float mean = sm * (1.0f / 128.0f);
    float v2 = 0.f;
#pragma unroll
    for (int et = 0; et < 8; ++et)
#pragma unroll
        for (int e = 0; e < 4; ++e) { const float d0 = accO[et][e] - mean; v2 += d0 * d0; }
    v2 += __shfl_xor(v2, 16); v2 += __shfl_xor(v2, 32);
    const float rstd = rsqrtf(v2 * (1.0f / 128.0f) + EPS);
    const int r = b * 4096 + c * 128 + n;
#pragma unroll
    for (int et = 0; et < 8; et += 2) {
        const int colw = h * 128 + 16 * (et + (g & 1)) + 8 * (g >> 1);
        const u32x4 gww = *(const u32x4*)(GR + (size_t)r * 512 + colw);
        const u32x2 gx = __builtin_amdgcn_permlane16_swap(gww[0], gww[2], false, false), gy = __builtin_amdgcn_permlane16_swap(gww[1], gww[3], false, false);
        const u32x2 ga = {gx[0], gy[0]}, gb = {gx[1], gy[1]};
        const f32x4 wa = *(const f32x4*)(a.gn_w + h * 128 + 16 * et + 4 * g), wb = *(const f32x4*)(a.gn_w + h * 128 + 16 * (et + 1) + 4 * g);
        const u32x2 oa = {pk2((accO[et][0] - mean) * rstd * wa[0] * bflo(ga.x), (accO[et][1] - mean) * rstd * wa[1] * bfhi(ga.x)),
                          pk2((accO[et][2] - mean) * rstd * wa[2] * bflo(ga.y), (accO[et][3] - mean) * rstd * wa[3] * bfhi(ga.y))};
        const u32x2 ob = {pk2((accO[et + 1][0] - mean) * rstd * wb[0] * bflo(gb.x), (accO[et + 1][1] - mean) * rstd * wb[1] * bfhi(gb.x)),
                          pk2((accO[et + 1][2] - mean) * rstd * wb[2] * bflo(gb.y), (accO[et + 1][3] - mean) * rstd * wb[3] * bfhi(gb.y))};
        const u32x2 wx = __builtin_amdgcn_permlane16_swap(oa.x, ob.x, false, false), wy = __builtin_amdgcn_permlane16_swap(oa.y, ob.y, false, false);
        const u32x4 ow = {wx[0], wy[0], wx[1], wy[1]};
        *(u32x4*)(Y + (size_t)r * 1024 + colw) = ow;
    }
    lds_barrier();
}

DI void phase7(const Args& a) {
    const int tid = threadIdx.x, wave = tid >> 6, lane = tid & 63;
    for (int r = blockIdx.x * 8 + wave; r < NTOK; r += gridDim.x * 8) {
        float* row = a.out + (size_t)r * 1024;
        f32x4 v[4]; float ss = 0.f;
#pragma unroll
        for (int q = 0; q < 4; ++q) { v[q] = *(const f32x4*)(row + q * 256 + lane * 4); ss += v[q][0] * v[q][0] + v[q][1] * v[q][1] + v[q][2] * v[q][2] + v[q][3] * v[q][3]; }
#pragma unroll
        for (int off = 32; off >= 1; off >>= 1) ss += __shfl_xor(ss, off);
        const float rstd = rsqrtf(ss * (1.0f / 1024.0f) + EPS);
#pragma unroll
        for (int q = 0; q < 4; ++q) {
            const f32x4 fw = *(const f32x4*)(a.fnorm_w + q * 256 + lane * 4);
            *(f32x4*)(row + q * 256 + lane * 4) = v[q] * rstd * fw;
        }
    }
}

__global__ __launch_bounds__(512, 2) void fwd_megakernel(Args a) {
    extern __shared__ __attribute__((aligned(16))) unsigned char shm[];
    LAS unsigned char* lds = (LAS unsigned char*)shm;
    cg::grid_group grid = cg::this_grid();
    volatile LAS unsigned* st = (volatile LAS unsigned*)(lds + LDS_BYTES - 16);
    if (threadIdx.x == 0) { st[0] = 0u; st[1] = 0u; }
    __syncthreads();
    const XcdBarrier xb = xcd_barrier_post((unsigned*)(a.ws + WS_BAR), st);
    if (a.ph_hi > 7) grid.sync();
#ifndef PHMASK
#define PHMASK 255
#endif
#ifndef REPMASK
#define REPMASK 0
#endif
#ifndef EXTRA_SYNCS
#define EXTRA_SYNCS 0
#endif
#define GSYNC() xcd_barrier(xb)
    for (int xs = 0; xs < EXTRA_SYNCS; ++xs) GSYNC();
#define PHASE(P, ...) do { if (((PHMASK >> (P)) & 1) && a.ph_lo <= (P) && (P) < a.ph_hi) { if ((REPMASK >> (P)) & 1) { __VA_ARGS__; GSYNC(); } __VA_ARGS__; if ((P) + 1 < a.ph_hi) GSYNC(); } } while (0)
    PHASE(0, phase0(a, lds));
    PHASE(1, phase1(a));
    PHASE(2, {
        pg8::Gemm gm{(const bf16_t*)(a.ws + WS_H), (const bf16_t*)(a.ws + WS_WIN), NTOK, NP, D};
        SchedIn S; S.so.init(NTOK, NP, (int)gridDim.x, (int)blockIdx.x);
        EpiIn E{a.ws};
        pg8::gemm_phase<EpiIn, SchedIn, false>(lds, gm, S, E, nullptr);
    });
    PHASE(3, phase3(a, lds));
    PHASE(5, { int it = blockIdx.x; if (it < 1024) { RetStage st; ret_load(a, it, st); for (;;) { const int nx = it + (int)gridDim.x; ret_unit(a, lds, it, st, nx < 1024 ? nx : -1); if (nx >= 1024) break; it = nx; } } });
    PHASE(6, {
        pg8::Gemm gm{(const bf16_t*)(a.ws + WS_H), (const bf16_t*)(a.ws + WS_WOUT), NTOK, D, D};
        pg8::StaticOrder S; S.init(NTOK, D, (int)gridDim.x, (int)blockIdx.x);
        EpiOut E{a.x, (const float*)(a.ws + WS_MOD), a.fnorm_w, a.out, (float*)(a.ws + WS_SLOT), (unsigned*)(a.ws + WS_CNT)};
        pg8::gemm_phase<EpiOut, pg8::StaticOrder, false>(lds, gm, S, E, nullptr);
    });
#undef PHASE
}

extern "C" void kernel_launch(void* const* d_in, const int* in_sizes, int n_in, void* d_out, int out_size, void* d_ws, size_t ws_size, hipStream_t stream) {
    static int grid = 0;
    if (grid == 0) {
        if (n_in != 16 || out_size != NTOK * D || ws_size < WS_END) { fprintf(stderr, "kernel_launch: unexpected shapes (n_in %d out %d ws %zu need %zu)\n", n_in, out_size, ws_size, (size_t)WS_END); grid = -1; return; }
        int dev = 0, cus = 0, per_cu = 0;
        (void)hipGetDevice(&dev); (void)hipDeviceGetAttribute(&cus, hipDeviceAttributeMultiprocessorCount, dev);
        if (hipFuncSetAttribute((const void*)fwd_megakernel, hipFuncAttributeMaxDynamicSharedMemorySize, LDS_BYTES) != hipSuccess) { fprintf(stderr, "kernel_launch: hipFuncSetAttribute failed\n"); grid = -1; return; }
        if (hipOccupancyMaxActiveBlocksPerMultiprocessor(&per_cu, (const void*)fwd_megakernel, NTHREADS, LDS_BYTES) != hipSuccess || per_cu < 1) { fprintf(stderr, "kernel_launch: occupancy query gives %d\n", per_cu); per_cu = 1; }
        (void)hipGetLastError();
        grid = cus;
    }
    if (grid < 0) return;
    Args a{};
    a.x = (const float*)d_in[0]; a.c = (const float*)d_in[1]; a.ctx = (const float*)d_in[2]; a.c_ctx = (const float*)d_in[3]; a.w_ada = (const float*)d_in[4]; a.b_ada = (const float*)d_in[5];
    a.norm_w = (const float*)d_in[6]; a.w_in = (const float*)d_in[7]; a.dec_f = (const float*)d_in[8]; a.dec_b = (const float*)d_in[9]; a.gn_w = (const float*)d_in[10]; a.ln_w = (const float*)d_in[11];
    a.w_s = (const float*)d_in[12]; a.b_s = (const float*)d_in[13]; a.w_out = (const float*)d_in[14]; a.fnorm_w = (const float*)d_in[15];
    a.out = (float*)d_out; a.ws = (unsigned char*)d_ws;
    (void)hipMemsetAsync((unsigned char*)d_ws + WS_BAR, 0, (size_t)XCD_BAR_WORDS * 4 + 32768, stream);
#if N_LAUNCHES == 1
    a.ph_lo = 0; a.ph_hi = 7;
    void* args[] = {&a};
    hipError_t e = hipLaunchCooperativeKernel((const void*)fwd_megakernel, dim3(grid), dim3(NTHREADS), args, LDS_BYTES, stream);
    if (e != hipSuccess) fprintf(stderr, "cooperative launch failed: %s (grid %d)\n", hipGetErrorString(e), grid);
#else
    for (int p = 0; p < 7; ++p) {
        a.ph_lo = p; a.ph_hi = p + 1;
        hipLaunchKernelGGL(fwd_megakernel, dim3(grid), dim3(NTHREADS), LDS_BYTES, stream, a);
    }
#endif
}
```
